# Optimizing an MI355X kernel written in HIP

```python
import jax, jax.numpy as jnp
from jax import lax
import numpy as np

D_MODEL = 2048
BATCH = 2
SEQ = 8192
DEPTH = 1

GDN_HEADS = 8
GDN_DK = 128
GDN_DV = 128
GDN_CONV = 4
GDN_CHUNK = 64
FOX_HEADS = 8
FOX_DH = 128
FOX_BLOCK = 128
MEM_LEN = 256
MEM_HEADS = 4
MEM_DH = 256
D_FF = 4 * D_MODEL
N_BRANCH = 3
EPS = 1e-6

GDN_QK = GDN_HEADS * GDN_DK
GDN_V = GDN_HEADS * GDN_DV
GDN_QKV = 2 * GDN_QK + GDN_V
FOX_W = FOX_HEADS * FOX_DH
MEM_W = MEM_HEADS * MEM_DH
IN_SPLITS = (GDN_QKV, GDN_V, GDN_HEADS, GDN_HEADS, FOX_W, FOX_W, FOX_W, FOX_HEADS, MEM_W, N_BRANCH * D_MODEL)
D_IN = 2 * GDN_QK + 2 * GDN_V + 2 * GDN_HEADS + 3 * FOX_W + FOX_HEADS + MEM_W + N_BRANCH * D_MODEL

kernel_name = "hybrid_gdn_fox_memory_block"


def rms_norm(x, g):
    xf = x.astype(jnp.float32)
    y = xf * lax.rsqrt(jnp.mean(xf * xf, axis=-1, keepdims=True) + EPS)
    return (y * g.astype(jnp.float32)).astype(x.dtype)


def l2_norm(x):
    return x * lax.rsqrt(jnp.sum(x * x, axis=-1, keepdims=True) + EPS)


def to_heads(t, n_heads):
    b, s, _ = t.shape
    return t.reshape(b, s, n_heads, -1).transpose(0, 2, 1, 3)


def causal_conv_silu(x, w):
    k_w = w.shape[0]
    s = x.shape[1]
    xp = jnp.pad(x, ((0, 0), (k_w - 1, 0), (0, 0)))
    y = xp[:, 0:s] * w[0]
    for i in range(1, k_w):
        y = y + xp[:, i:i + s] * w[i]
    return jax.nn.silu(y)


def gated_delta_rule(q, k, v, g, beta):
    b, h, s, dk = q.shape
    dv = v.shape[-1]
    c = GDN_CHUNK
    n = s // c
    q = q.reshape(b, h, n, c, dk)
    k = k.reshape(b, h, n, c, dk)
    v = v.reshape(b, h, n, c, dv)
    beta = beta.reshape(b, h, n, c)
    gam = jnp.cumsum(g.reshape(b, h, n, c), axis=-1)
    idx = jnp.arange(c)
    strict = idx[:, None] > idx[None, :]
    incl = idx[:, None] >= idx[None, :]
    diff = gam[..., :, None] - gam[..., None, :]
    dec_strict = jnp.where(strict, jnp.exp(jnp.where(strict, diff, 0.0)), 0.0)
    dec_incl = jnp.where(incl, jnp.exp(jnp.where(incl, diff, 0.0)), 0.0)
    m_low = beta[..., :, None] * jnp.einsum('bhnid,bhnjd->bhnij', k, k) * dec_strict
    a_mat = jnp.eye(c, dtype=jnp.float32) + m_low
    rhs = jnp.concatenate([(beta * jnp.exp(gam))[..., None] * k, beta[..., None] * v], axis=-1)
    sol = lax.linalg.triangular_solve(a_mat, rhs, left_side=True, lower=True, unit_diagonal=True)
    w_c, u_c = sol[..., :dk], sol[..., dk:]
    qk = jnp.einsum('bhnid,bhnjd->bhnij', q, k) * dec_incl
    q_dec = q * jnp.exp(gam)[..., None]
    k_dec = k * jnp.exp(gam[..., -1:] - gam)[..., None]
    chunk_dec = jnp.exp(gam[..., -1])

    def step(state, xs):
        w_i, u_i, qk_i, qd_i, kd_i, cd_i = xs
        u = u_i - jnp.einsum('bhid,bhde->bhie', w_i, state)
        o = jnp.einsum('bhid,bhde->bhie', qd_i, state) + jnp.einsum('bhij,bhje->bhie', qk_i, u)
        state = cd_i[..., None, None] * state + jnp.einsum('bhid,bhie->bhde', kd_i, u)
        return state, o

    xs = tuple(jnp.moveaxis(t, 2, 0) for t in (w_c, u_c, qk, q_dec, k_dec, chunk_dec))
    _, o = lax.scan(step, jnp.zeros((b, h, dk, dv), jnp.float32), xs)
    return jnp.moveaxis(o, 0, 2).reshape(b, h, s, dv)


def forgetting_attention(q, k, v, log_f):
    _, _, s, d = q.shape
    cum = jnp.cumsum(log_f, axis=-1)
    scale = d ** -0.5
    outs = []
    for start in range(0, s, FOX_BLOCK):
        end = start + FOX_BLOCK
        logits = jnp.einsum('bhqd,bhkd->bhqk', q[:, :, start:end], k[:, :, :end]).astype(jnp.float32) * scale
        logits = logits + cum[:, :, start:end, None] - cum[:, :, None, :end]
        mask = (start + jnp.arange(FOX_BLOCK))[:, None] >= jnp.arange(end)[None, :]
        p = jax.nn.softmax(jnp.where(mask, logits, -jnp.inf), axis=-1)
        outs.append(jnp.einsum('bhqk,bhkd->bhqd', p.astype(v.dtype), v[:, :, :end]))
    return jnp.concatenate(outs, axis=2)


def setup_inputs(seed: int = 0) -> dict:
    key = jax.random.key(seed)
    ks = jax.random.split(key, 24)
    L, D = DEPTH, D_MODEL
    nrm = lambda k, shape, fan_in: jax.random.normal(k, shape, jnp.float32) * (fan_in ** -0.5)
    gain = lambda k, shape: 1.0 + 0.02 * jax.random.normal(k, shape, jnp.float32)
    a_log = jnp.log(jax.random.uniform(ks[5], (L, GDN_HEADS), jnp.float32, 1.0, 16.0))
    dt = jnp.exp(jax.random.uniform(ks[6], (L, GDN_HEADS), jnp.float32, np.log(1e-3), np.log(1e-1)))
    dt_bias = dt + jnp.log(-jnp.expm1(-dt))
    return {
        "x": jax.random.normal(ks[0], (BATCH, SEQ, D), jnp.float32),
        "mem": jax.random.normal(ks[1], (BATCH, MEM_LEN, D), jnp.float32),
        "g_mix": gain(ks[2], (L, D)),
        "w_in": nrm(ks[3], (L, D, D_IN), D),
        "conv_w": nrm(ks[4], (L, GDN_CONV, GDN_QKV), GDN_CONV),
        "a_log": a_log,
        "dt_bias": dt_bias,
        "gdn_norm_g": gain(ks[7], (L, GDN_DV)),
        "fox_b_f": jax.random.uniform(ks[8], (L, FOX_HEADS), jnp.float32, 1.0, 4.0),
        "fox_q_norm": gain(ks[9], (L, FOX_DH)),
        "fox_k_norm": gain(ks[10], (L, FOX_DH)),
        "g_mem": gain(ks[11], (L, D)),
        "w_mem_kv": nrm(ks[12], (L, D, 2 * MEM_W), D),
        "mem_q_norm": gain(ks[13], (L, MEM_DH)),
        "mem_k_norm": gain(ks[14], (L, MEM_DH)),
        "w_up_gdn": nrm(ks[15], (L, GDN_V, D), GDN_V),
        "w_up_fox": nrm(ks[16], (L, FOX_W, D), FOX_W),
        "w_up_mem": nrm(ks[17], (L, MEM_W, D), MEM_W),
        "w_out": nrm(ks[18], (L, D, D), D),
        "g_mlp": gain(ks[19], (L, D)),
        "w_ff1": nrm(ks[20], (L, D, D_FF), D),
        "w_ff2": nrm(ks[21], (L, D_FF, D), D_FF),
    }


def reference(x, mem, g_mix, w_in, conv_w, a_log, dt_bias, gdn_norm_g, fox_b_f, fox_q_norm, fox_k_norm,
              g_mem, w_mem_kv, mem_q_norm, mem_k_norm, w_up_gdn, w_up_fox, w_up_mem, w_out, g_mlp, w_ff1, w_ff2):
    b, s, _ = x.shape
    splits = np.cumsum(IN_SPLITS)[:-1].tolist()
    f32 = jnp.float32
    for l in range(DEPTH):
        h = rms_norm(x, g_mix[l])
        proj = h @ w_in[l]
        qkv_a, z_a, b_a, a_a, q_b, k_b, v_b, f_b, q_m, gates = jnp.split(proj, splits, axis=-1)

        qkv_a = causal_conv_silu(qkv_a, conv_w[l])
        q_a, k_a, v_a = jnp.split(qkv_a, [GDN_QK, 2 * GDN_QK], axis=-1)
        q_a = l2_norm(to_heads(q_a, GDN_HEADS).astype(f32)) * (GDN_DK ** -0.5)
        k_a = l2_norm(to_heads(k_a, GDN_HEADS).astype(f32))
        v_a = to_heads(v_a, GDN_HEADS).astype(f32)
        beta = jax.nn.sigmoid(b_a.astype(f32)).transpose(0, 2, 1)
        g_dec = (-jnp.exp(a_log[l].astype(f32)) * jax.nn.softplus(a_a.astype(f32) + dt_bias[l].astype(f32))).transpose(0, 2, 1)
        o_a = gated_delta_rule(q_a, k_a, v_a, g_dec, beta).transpose(0, 2, 1, 3)
        o_a = rms_norm(o_a, gdn_norm_g[l]) * jax.nn.silu(z_a.astype(f32).reshape(b, s, GDN_HEADS, GDN_DV))
        o_a = o_a.reshape(b, s, GDN_V).astype(x.dtype)

        q_bh = rms_norm(to_heads(q_b, FOX_HEADS), fox_q_norm[l])
        k_bh = rms_norm(to_heads(k_b, FOX_HEADS), fox_k_norm[l])
        v_bh = to_heads(v_b, FOX_HEADS)
        log_f = jax.nn.log_sigmoid(f_b.astype(f32) + fox_b_f[l].astype(f32)).transpose(0, 2, 1)
        o_b = forgetting_attention(q_bh, k_bh, v_bh, log_f)
        o_b = o_b.transpose(0, 2, 1, 3).reshape(b, s, FOX_W)

        kv_m = rms_norm(mem, g_mem[l]) @ w_mem_kv[l]
        k_m, v_m = jnp.split(kv_m, 2, axis=-1)
        q_mh = rms_norm(to_heads(q_m, MEM_HEADS), mem_q_norm[l])
        k_mh = rms_norm(to_heads(k_m, MEM_HEADS), mem_k_norm[l])
        v_mh = to_heads(v_m, MEM_HEADS)
        logits_m = jnp.einsum('bhqd,bhkd->bhqk', q_mh, k_mh).astype(f32) * (MEM_DH ** -0.5)
        p_m = jax.nn.softmax(logits_m, axis=-1).astype(v_mh.dtype)
        o_m = jnp.einsum('bhqk,bhkd->bhqd', p_m, v_mh).transpose(0, 2, 1, 3).reshape(b, s, MEM_W)

        gate_a, gate_b, gate_m = jnp.split(jax.nn.sigmoid(gates), N_BRANCH, axis=-1)
        y = gate_a * (o_a @ w_up_gdn[l]) + gate_b * (o_b @ w_up_fox[l]) + gate_m * (o_m @ w_up_mem[l])
        x = x + y @ w_out[l]

        h2 = rms_norm(x, g_mlp[l])
        x = x + jnp.square(jax.nn.relu(h2 @ w_ff1[l])) @ w_ff2[l]
    return x
```

```cpp
#define STATIC_P3 1
#include <hip/hip_runtime.h>
#include <hip/hip_cooperative_groups.h>
#include <cstdio>
#include <cstdint>
namespace cg = cooperative_groups;

namespace pg8 {
#define PG8_LAS __attribute__((address_space(3)))
typedef unsigned short bf16_t;
typedef short bf16x8 __attribute__((ext_vector_type(8)));
typedef float f32x4 __attribute__((ext_vector_type(4)));
typedef unsigned u32x4 __attribute__((ext_vector_type(4)));
constexpr int BM = 256, BK = 64, HALF = 128, HTB = HALF * BK * 2  , STAGE_BYTES = 8 * HTB, NXCD = 8, WGM = 8;

__host__ __device__ __forceinline__ int lds_byte(int r, int c) { const int st = (r >> 4) * 2 + (c >> 5), rr = r & 15, cc = c & 31, ob = rr * 64 + cc * 2; return st * 1024 + (ob ^ (((ob >> 9) & 1) << 5)); }
__host__ __device__ __forceinline__ void stage_rc(int b, int& R, int& C) { const int st = b / 1024, sb = b % 1024, swz = sb ^ (((sb >> 9) & 1) << 5); R = (st >> 1) * 16 + swz / 64; C = (st & 1) * 32 + (swz % 64) / 2; }
__host__ __device__ __forceinline__ int perm32(int rho) { const int n = rho >> 4, i = rho & 15; return 8 * (i >> 2) + 4 * n + (i & 3); }

struct Unit { int pm, pn; };
struct Gemm { const bf16_t* A; const bf16_t* Bt; int M, N, K, lda, ldb; };

struct StaticOrder {
    int nM, nN, nwg, G, c;
    __host__ __device__ void init(int M, int N, int G_, int c_) { nM = M / BM; nN = N / BM; nwg = nM * nN; G = G_; c = c_; }
    __host__ __device__ bool next(int i, Unit& u) const {
        const long L = (long)i * G + c; if (L >= nwg) return false;
        int wgid = (int)L; { const int q = nwg / NXCD, r = nwg % NXCD, xcd = wgid % NXCD, off = wgid / NXCD; wgid = (xcd < r ? xcd * (q + 1) : r * (q + 1) + (xcd - r) * q) + off; }
        const int nig = WGM * nN, gid = wgid / nig, fm = gid * WGM, gsz = (nM - fm) < WGM ? (nM - fm) : WGM;
        u.pm = fm + ((wgid % nig) % gsz); u.pn = (wgid % nig) / gsz; return true;
    }
    __device__ __forceinline__ void a_ready(const Unit&) const {}
    __device__ __forceinline__ void done(const Unit&) const {}
};

typedef float f32x2_cv __attribute__((ext_vector_type(2))); typedef __bf16 bf16x2_cv __attribute__((ext_vector_type(2)));
__device__ __forceinline__ unsigned cvt_pk_bf16(float lo, float hi) { f32x2_cv v = {lo, hi}; bf16x2_cv b = __builtin_convertvector(v, bf16x2_cv); return __builtin_bit_cast(unsigned, b); }
template <class Epi, class Sched, bool ALIGN_EPI = false, bool SP2 = false>
__device__ __forceinline__ void gemm_phase(PG8_LAS unsigned char* lds, const Gemm g, const Sched& S, const Epi& E) {
    int tid_ = threadIdx.x; asm volatile("" : "+v"(tid_));
    const int tid = tid_, wid = __builtin_amdgcn_readfirstlane(tid >> 6), lane = tid & 63, wr = wid >> 2, wc = wid & 3, fr = lane & 15, fq = lane >> 4;
    const int K = g.K, nt = K / BK;
    unsigned voffA[2], voffB[2];
#pragma unroll
    for (int i = 0; i < 2; ++i) { int R, C; stage_rc(tid * 16 + i * 8192, R, C); const int Rb = Epi::PERM ? ((R & ~31) + perm32(R & 31)) : R;
        voffA[i] = (unsigned)(R * g.lda + C) * 2u; voffB[i] = (unsigned)(Rb * g.ldb + C) * 2u; }
    const size_t kstep = (size_t)(BK * 2);
    const size_t hstepA = (size_t)HALF * g.lda * 2, hstepB = (size_t)HALF * g.ldb * 2;
    const size_t tstepA = 2 * hstepA, tstepB = 2 * hstepB;
    const unsigned ldsw = (unsigned)wid * 1024u;
    const int aoff = lds_byte(wr * 64 + fr, fq * 8), boff = lds_byte(wc * 32 + fr, fq * 8);
#define PG8_SA(b, h) (((b) * 2 + (h)) * HTB)
#define PG8_SB(b, h) ((4 + (b) * 2 + (h)) * HTB)
#define PG8_STAGE(bufoff, gbase, voff) do { _Pragma("unroll") for (int _i = 0; _i < 2; ++_i) \
        __builtin_amdgcn_global_load_lds((const unsigned*)((const char*)(gbase) + (voff)[_i]), (PG8_LAS unsigned*)(lds + (bufoff) + ldsw + _i * 8192), 16, 0, 0); } while (0)
#define PG8_LDA(dst, b, h) do { _Pragma("unroll") for (int m = 0; m < 4; ++m) _Pragma("unroll") for (int k = 0; k < 2; ++k) dst[m][k] = *(const PG8_LAS bf16x8*)(lds + PG8_SA(b, h) + aoff + m * 2048 + k * 1024); } while (0)
#define PG8_LDB(dst, b, h) do { _Pragma("unroll") for (int n = 0; n < 2; ++n) _Pragma("unroll") for (int k = 0; k < 2; ++k) dst[n][k] = *(const PG8_LAS bf16x8*)(lds + PG8_SB(b, h) + boff + n * 2048 + k * 1024); } while (0)
#define PG8_MMA(ai, bj, At, Bt) do { __builtin_amdgcn_s_setprio(1); _Pragma("unroll") for (int m = 0; m < 4; ++m) _Pragma("unroll") for (int n = 0; n < 2; ++n) _Pragma("unroll") for (int k = 0; k < 2; ++k) \
        acc[ai][bj][m][n] = __builtin_amdgcn_mfma_f32_16x16x32_bf16(Bt[n][k], At[m][k], acc[ai][bj][m][n], 0, 0, 0); __builtin_amdgcn_s_setprio(0); } while (0)
#define PG8_WAIT_V(n) asm volatile("s_waitcnt vmcnt(" #n ")" ::: "memory")
#define PG8_WAIT_L(n) asm volatile("s_waitcnt lgkmcnt(" #n ")" ::: "memory")
#define PG8_BAR __builtin_amdgcn_s_barrier()
#define PG8_SCHED __builtin_amdgcn_sched_barrier(0)
    Unit cur, nxt; int ui = 0;
    if (!S.next(0, cur)) return;
    f32x4 acc[2][2][4][2];
#pragma unroll
    for (int a = 0; a < 2; ++a)
#pragma unroll
        for (int b = 0; b < 2; ++b)
#pragma unroll
            for (int m = 0; m < 4; ++m)
#pragma unroll
                for (int n = 0; n < 2; ++n) acc[a][b][m][n] = (f32x4){0.f, 0.f, 0.f, 0.f};
    bf16x8 At[4][2], B0[2][2], B1[2][2];
    const char* cA = (const char*)g.A + (size_t)cur.pm * tstepA; const char* cB = (const char*)g.Bt + (size_t)cur.pn * tstepB;
    S.a_ready(cur);
    if constexpr (SP2) {
        PG8_STAGE(PG8_SB(0, 0), cB, voffB); PG8_STAGE(PG8_SB(0, 1), cB + hstepB, voffB); PG8_STAGE(PG8_SA(0, 0), cA, voffA); PG8_STAGE(PG8_SA(0, 1), cA + hstepA, voffA);
        if (wr == 1) PG8_BAR;
        PG8_WAIT_V(2); PG8_BAR;
        PG8_STAGE(PG8_SB(1, 0), cB + kstep, voffB); PG8_STAGE(PG8_SA(1, 0), cA + kstep, voffA); PG8_STAGE(PG8_SB(1, 1), cB + hstepB + kstep, voffB);
        PG8_WAIT_V(6); PG8_BAR;
    } else {
        PG8_STAGE(PG8_SB(0, 0), cB, voffB); PG8_STAGE(PG8_SA(0, 0), cA, voffA); PG8_STAGE(PG8_SB(0, 1), cB + hstepB, voffB); PG8_STAGE(PG8_SA(0, 1), cA + hstepA, voffA);
        if (wr == 1) PG8_BAR;
        PG8_WAIT_V(4); PG8_BAR;
        PG8_STAGE(PG8_SB(1, 0), cB + kstep, voffB); PG8_STAGE(PG8_SA(1, 0), cA + kstep, voffA); PG8_STAGE(PG8_SB(1, 1), cB + hstepB + kstep, voffB);
        PG8_WAIT_V(6); PG8_BAR;
    }
    for (;;) {
        const bool has_next = S.next(ui + 1, nxt);
        const char* nA = has_next ? (const char*)g.A + (size_t)nxt.pm * tstepA : cA; const char* nB = has_next ? (const char*)g.Bt + (size_t)nxt.pn * tstepB : cB;
        for (int t = 0; t < nt; t += 2) {
            const bool last = (t == nt - 2);
            const char* a1 = cA + (size_t)(t + 1) * kstep;
            const char* a2 = last ? nA : cA + (size_t)(t + 2) * kstep; const char* b2 = last ? nB : cB + (size_t)(t + 2) * kstep;
            const char* a3 = a2 + kstep; const char* b3 = b2 + kstep;
            if (last && has_next) S.a_ready(nxt);
            if constexpr (SP2) {
            PG8_LDB(B0, 0, 0); PG8_LDB(B1, 0, 1); PG8_SCHED; PG8_LDA(At, 0, 0); PG8_STAGE(PG8_SA(1, 1), a1 + hstepA, voffA);
            PG8_WAIT_V(8); PG8_WAIT_L(0); PG8_BAR; PG8_MMA(0, 0, At, B0); PG8_MMA(0, 1, At, B1); PG8_BAR; PG8_SCHED;
            PG8_LDA(At, 0, 1); PG8_STAGE(PG8_SB(0, 0), b2, voffB); PG8_STAGE(PG8_SB(0, 1), b2 + hstepB, voffB); PG8_STAGE(PG8_SA(0, 0), a2, voffA);
            PG8_WAIT_V(8); PG8_WAIT_L(0); PG8_BAR; PG8_MMA(1, 0, At, B0); PG8_MMA(1, 1, At, B1); PG8_BAR; PG8_SCHED;
            PG8_LDB(B0, 1, 0); PG8_LDB(B1, 1, 1); PG8_SCHED; PG8_LDA(At, 1, 0); PG8_STAGE(PG8_SA(0, 1), a2 + hstepA, voffA);
            PG8_WAIT_V(8); PG8_WAIT_L(0); PG8_BAR; PG8_MMA(0, 0, At, B0); PG8_MMA(0, 1, At, B1); PG8_BAR; PG8_SCHED;
            PG8_LDA(At, 1, 1); PG8_STAGE(PG8_SB(1, 0), b3, voffB); PG8_STAGE(PG8_SB(1, 1), b3 + hstepB, voffB); PG8_STAGE(PG8_SA(1, 0), a3, voffA);
            PG8_WAIT_V(8); PG8_WAIT_L(0); PG8_BAR; PG8_MMA(1, 0, At, B0); PG8_MMA(1, 1, At, B1); PG8_BAR; PG8_SCHED;
            } else {
            PG8_LDB(B0, 0, 0); PG8_SCHED; PG8_LDA(At, 0, 0); PG8_STAGE(PG8_SA(1, 1), a1 + hstepA, voffA);
            PG8_WAIT_L(8); PG8_BAR; PG8_WAIT_L(0); PG8_MMA(0, 0, At, B0); PG8_BAR; PG8_SCHED;
            PG8_LDB(B1, 0, 1); PG8_STAGE(PG8_SB(0, 0), b2, voffB);
            PG8_BAR; PG8_WAIT_L(0); PG8_MMA(0, 1, At, B1); PG8_BAR;
            PG8_LDA(At, 0, 1); PG8_STAGE(PG8_SA(0, 0), a2, voffA);
            PG8_BAR; PG8_WAIT_L(0); PG8_MMA(1, 0, At, B0); PG8_BAR; PG8_SCHED;
            PG8_STAGE(PG8_SB(0, 1), b2 + hstepB, voffB);
            PG8_WAIT_V(6); PG8_BAR; PG8_MMA(1, 1, At, B1); PG8_BAR;
            PG8_LDB(B0, 1, 0); PG8_SCHED; PG8_LDA(At, 1, 0); PG8_STAGE(PG8_SA(0, 1), a2 + hstepA, voffA);
            PG8_WAIT_L(8); PG8_BAR; PG8_WAIT_L(0); PG8_MMA(0, 0, At, B0); PG8_BAR; PG8_SCHED;
            PG8_LDB(B1, 1, 1); PG8_STAGE(PG8_SB(1, 0), b3, voffB);
            PG8_BAR; PG8_WAIT_L(0); PG8_MMA(0, 1, At, B1); PG8_BAR;
            PG8_LDA(At, 1, 1); PG8_STAGE(PG8_SA(1, 0), a3, voffA);
            PG8_BAR; PG8_WAIT_L(0); PG8_MMA(1, 0, At, B0); PG8_BAR; PG8_SCHED;
            PG8_STAGE(PG8_SB(1, 1), b3 + hstepB, voffB);
            PG8_WAIT_V(6); PG8_BAR; PG8_MMA(1, 1, At, B1); PG8_BAR;
            }
        }
        if constexpr (ALIGN_EPI) { if (wr == 0) PG8_BAR; }
        if constexpr (!Epi::AFTER_DRAIN) { E(acc, cur, wr, wc, fr, fq); S.done(cur); }
        if (!has_next) break;
#pragma unroll
        for (int a = 0; a < 2; ++a)
#pragma unroll
            for (int b = 0; b < 2; ++b)
#pragma unroll
                for (int m = 0; m < 4; ++m)
#pragma unroll
                    for (int n = 0; n < 2; ++n) acc[a][b][m][n] = (f32x4){0.f, 0.f, 0.f, 0.f};
        cur = nxt; cA = nA; cB = nB; ++ui;
        if constexpr (ALIGN_EPI) { if (wr == 1) PG8_BAR; }
    }
    PG8_WAIT_V(0);
    if constexpr (!ALIGN_EPI) { if (wr == 0) PG8_BAR; }
    PG8_BAR;
    if constexpr (Epi::AFTER_DRAIN) { E.fused(acc, cur, wr, wc, fr, fq, lds, wid, lane); S.done(cur); }
#undef PG8_SA
#undef PG8_SB
#undef PG8_STAGE
#undef PG8_LDA
#undef PG8_LDB
#undef PG8_MMA
#undef PG8_WAIT_V
#undef PG8_WAIT_L
#undef PG8_BAR
#undef PG8_SCHED
}
}

constexpr int TOK = 16384, SEQ = 8192, DM = 2048, DIN = 14360, DFF = 8192;
constexpr int LDP = 7168;
constexpr int PC_QA = 0, PC_KA = 1024, PC_VA = 2048, PC_Z = 3072, PC_FK = 4096, PC_FQ = 5120, PC_QM = 6144;
constexpr int PC_OA = 0, PC_OB = PC_FQ, PC_OM = PC_QM, PC_GB = 1024, PC_GM = 3072;
constexpr float EPSN = 1e-6f;
constexpr float LOG2E = 1.4426950408889634f;
constexpr size_t MiB = 1u << 20;
constexpr size_t WS_CTL = 0, WS_W1T = 1 * MiB, WS_WFVT = 30 * MiB, WS_WMKVT = 34 * MiB, WS_UC = 1 * MiB;
constexpr size_t WS_SMALL = 42 * MiB, WS_KMEM = 44 * MiB, WS_VMT = 45 * MiB, WS_CUM = 46 * MiB, WS_CDEC = 46 * MiB + 512 * 1024,
                 WS_MEMN = 47 * MiB, WS_SSQ = 49 * MiB;
constexpr size_t WS_WGT = 52 * MiB, WS_WUPT = 76 * MiB, WS_WOT = 88 * MiB, WS_WFF1T = 96 * MiB, WS_WFF2T = 128 * MiB;
constexpr size_t WS_PROJ = 160 * MiB, WS_GDN = 384 * MiB, WS_END = 496 * MiB;
constexpr size_t WS_Y = 384 * MiB, WS_X1B = 160 * MiB, WS_U = 224 * MiB;
constexpr size_t DO_H = 0, DO_FOXVT = 64 * MiB, DO_GA = 64 * MiB;
constexpr int GDN_CHUNK_BYTES = 57344;
constexpr int LDS_BYTES = 163840;

#define LAS __attribute__((address_space(3)))
typedef unsigned short bf16;
typedef short bf16x8 __attribute__((ext_vector_type(8)));
typedef float f32x4 __attribute__((ext_vector_type(4)));
typedef float f32x16 __attribute__((ext_vector_type(16)));
typedef unsigned u32x4 __attribute__((ext_vector_type(4)));
typedef unsigned u32x2 __attribute__((ext_vector_type(2)));

__device__ __forceinline__ unsigned pk2(float lo, float hi) { return pg8::cvt_pk_bf16(lo, hi); }
__device__ __forceinline__ float bf2f(unsigned short v) { return __uint_as_float(((unsigned)v) << 16); }
__device__ __forceinline__ float bflo(unsigned w) { return __uint_as_float(w << 16); }
__device__ __forceinline__ float bfhi(unsigned w) { return __uint_as_float(w & 0xffff0000u); }
__device__ __forceinline__ int crow(int r, int hi) { return (r & 3) + 8 * (r >> 2) + 4 * hi; }
__device__ __forceinline__ float sigmoidf_(float x) { return 1.f / (1.f + __expf(-x)); }
__device__ __forceinline__ float softplusf_(float x) { return fmaxf(x, 0.f) + log1pf(__expf(-fabsf(x))); }

namespace pg8 {
struct EpiStore {
    static constexpr bool PERM = true, AFTER_DRAIN = false;
    bf16_t* O; int ldc;
    __device__ __forceinline__ void operator()(const f32x4 (&acc)[2][2][4][2], const Unit& u, int wr, int wc, int fr, int fq) const {
        const int row0 = u.pm * BM + wr * 64 + fr, col0 = u.pn * BM + wc * 32 + 8 * fq;
#pragma unroll
        for (int ai = 0; ai < 2; ++ai)
#pragma unroll
            for (int m = 0; m < 4; ++m) { bf16_t* rowp = O + (size_t)(row0 + ai * HALF + m * 16) * ldc + col0;
#pragma unroll
                for (int bj = 0; bj < 2; ++bj) { const f32x4 v0 = acc[ai][bj][m][0], v1 = acc[ai][bj][m][1];
                    u32x4 w; w.x = cvt_pk_bf16(v0[0], v0[1]); w.y = cvt_pk_bf16(v0[2], v0[3]); w.z = cvt_pk_bf16(v1[0], v1[1]); w.w = cvt_pk_bf16(v1[2], v1[3]);
                    *(u32x4*)(rowp + bj * HALF) = w; } }
    }
};
struct EpiProj {
    static constexpr bool PERM = true, AFTER_DRAIN = false;
    bf16_t* O; int ldc; float* small;
    __device__ __forceinline__ void operator()(const f32x4 (&acc)[2][2][4][2], const Unit& u, int wr, int wc, int fr, int fq) const {
        const int row0 = u.pm * BM + wr * 64 + fr;
        if (u.pn == 28) {
            if (wc == 0) {
#pragma unroll
                for (int ai = 0; ai < 2; ++ai)
#pragma unroll
                    for (int m = 0; m < 4; ++m) { float* p = small + (size_t)(row0 + ai * HALF + m * 16) * 32 + 8 * fq;
                        *(f32x4*)p = acc[ai][0][m][0]; *(f32x4*)(p + 4) = acc[ai][0][m][1]; }
            }
            return;
        }
        const int col0 = u.pn * BM + wc * 32 + 8 * fq;
#pragma unroll
        for (int ai = 0; ai < 2; ++ai)
#pragma unroll
            for (int m = 0; m < 4; ++m) { bf16_t* rowp = O + (size_t)(row0 + ai * HALF + m * 16) * ldc + col0;
#pragma unroll
                for (int bj = 0; bj < 2; ++bj) { const f32x4 v0 = acc[ai][bj][m][0], v1 = acc[ai][bj][m][1];
                    u32x4 w; w.x = cvt_pk_bf16(v0[0], v0[1]); w.y = cvt_pk_bf16(v0[2], v0[3]); w.z = cvt_pk_bf16(v1[0], v1[1]); w.w = cvt_pk_bf16(v1[2], v1[3]);
                    *(u32x4*)(rowp + bj * HALF) = w; } }
    }
};
struct EpiSig {
    static constexpr bool PERM = true, AFTER_DRAIN = false;
    bf16_t* O0; bf16_t* O1; bf16_t* O2; int ld0, ld1, ld2;
    __device__ __forceinline__ void operator()(const f32x4 (&acc)[2][2][4][2], const Unit& u, int wr, int wc, int fr, int fq) const {
        const int br = u.pn >> 3; bf16_t* O = br == 0 ? O0 : O1 + (size_t)(br - 1) * 2048; const int ldc = br == 0 ? ld0 : ld1;
        const int row0 = u.pm * BM + wr * 64 + fr, col0 = (u.pn & 7) * BM + wc * 32 + 8 * fq;
#pragma unroll
        for (int ai = 0; ai < 2; ++ai)
#pragma unroll
            for (int m = 0; m < 4; ++m) { bf16_t* rowp = O + (size_t)(row0 + ai * HALF + m * 16) * ldc + col0;
#pragma unroll
                for (int bj = 0; bj < 2; ++bj) { f32x4 v0 = acc[ai][bj][m][0], v1 = acc[ai][bj][m][1];
#pragma unroll
                    for (int e = 0; e < 4; ++e) { v0[e] = 1.f / (1.f + __expf(-v0[e])); v1[e] = 1.f / (1.f + __expf(-v1[e])); }
                    u32x4 w; w.x = cvt_pk_bf16(v0[0], v0[1]); w.y = cvt_pk_bf16(v0[2], v0[3]); w.z = cvt_pk_bf16(v1[0], v1[1]); w.w = cvt_pk_bf16(v1[2], v1[3]);
                    *(u32x4*)(rowp + bj * HALF) = w; } }
    }
};
template <bool FIRST> struct EpiGate {
    static constexpr bool PERM = true, AFTER_DRAIN = false;
    const bf16_t* G; int ldg; bf16_t* Y; int ldy;
    __device__ __forceinline__ void operator()(const f32x4 (&acc)[2][2][4][2], const Unit& u, int wr, int wc, int fr, int fq) const {
        const int row0 = u.pm * BM + wr * 64 + fr, col0 = u.pn * BM + wc * 32 + 8 * fq;
#pragma unroll
        for (int ai = 0; ai < 2; ++ai)
#pragma unroll
            for (int m = 0; m < 4; ++m) { const size_t r = (size_t)(row0 + ai * HALF + m * 16);
#pragma unroll
                for (int bj = 0; bj < 2; ++bj) { const f32x4 v0 = acc[ai][bj][m][0], v1 = acc[ai][bj][m][1];
                    const u32x4 g = *(const u32x4*)(G + r * ldg + col0 + bj * HALF);
                    float o[8];
                    o[0] = v0[0] * __uint_as_float(g.x << 16); o[1] = v0[1] * __uint_as_float(g.x & 0xffff0000u);
                    o[2] = v0[2] * __uint_as_float(g.y << 16); o[3] = v0[3] * __uint_as_float(g.y & 0xffff0000u);
                    o[4] = v1[0] * __uint_as_float(g.z << 16); o[5] = v1[1] * __uint_as_float(g.z & 0xffff0000u);
                    o[6] = v1[2] * __uint_as_float(g.w << 16); o[7] = v1[3] * __uint_as_float(g.w & 0xffff0000u);
                    bf16_t* yp = Y + r * ldy + col0 + bj * HALF;
                    if (!FIRST) { const u32x4 y = *(const u32x4*)yp;
                        o[0] += __uint_as_float(y.x << 16); o[1] += __uint_as_float(y.x & 0xffff0000u);
                        o[2] += __uint_as_float(y.y << 16); o[3] += __uint_as_float(y.y & 0xffff0000u);
                        o[4] += __uint_as_float(y.z << 16); o[5] += __uint_as_float(y.z & 0xffff0000u);
                        o[6] += __uint_as_float(y.w << 16); o[7] += __uint_as_float(y.w & 0xffff0000u); }
                    u32x4 w; w.x = cvt_pk_bf16(o[0], o[1]); w.y = cvt_pk_bf16(o[2], o[3]); w.z = cvt_pk_bf16(o[4], o[5]); w.w = cvt_pk_bf16(o[6], o[7]);
                    *(u32x4*)yp = w; } }
    }
};
struct EpiRes1 {
    static constexpr bool PERM = false, AFTER_DRAIN = false;
    const float* X; float* OUT; bf16_t* XB; float* SSQ;
    __device__ __forceinline__ void operator()(const f32x4 (&acc)[2][2][4][2], const Unit& u, int wr, int wc, int fr, int fq) const {
        const int row0 = u.pm * BM + wr * 64 + fr, col0 = u.pn * BM + wc * 32 + 4 * fq;
#pragma unroll
        for (int ai = 0; ai < 2; ++ai)
#pragma unroll
            for (int m = 0; m < 4; ++m) { const int row = row0 + ai * HALF + m * 16; const size_t off = (size_t)row * 2048 + col0; float s = 0.f;
#pragma unroll
                for (int bj = 0; bj < 2; ++bj)
#pragma unroll
                    for (int n = 0; n < 2; ++n) { const size_t o = off + bj * HALF + n * 16; const f32x4 xv = *(const f32x4*)(X + o); const f32x4 v = xv + acc[ai][bj][m][n];
                        *(f32x4*)(OUT + o) = v; u32x2 w; w.x = cvt_pk_bf16(v[0], v[1]); w.y = cvt_pk_bf16(v[2], v[3]); *(u32x2*)(XB + o) = w;
                        s += (v[0] * v[0] + v[1] * v[1]) + (v[2] * v[2] + v[3] * v[3]); }
                s += __shfl_xor(s, 16); s += __shfl_xor(s, 32);
                if (fq == 0) SSQ[(size_t)(u.pn * 4 + wc) * 16384 + row] = s; }
    }
};
struct EpiFF1 {
    static constexpr bool PERM = true, AFTER_DRAIN = false;
    const float* SSQ; bf16_t* O; int ldc;
    __device__ __forceinline__ void operator()(const f32x4 (&acc)[2][2][4][2], const Unit& u, int wr, int wc, int fr, int fq) const {
        const int row0 = u.pm * BM + wr * 64 + fr, col0 = u.pn * BM + wc * 32 + 8 * fq;
#pragma unroll
        for (int ai = 0; ai < 2; ++ai)
#pragma unroll
            for (int m = 0; m < 4; ++m) { const int row = row0 + ai * HALF + m * 16; float s = 0.f;
#pragma unroll
                for (int p = 0; p < 8; ++p) s += SSQ[(size_t)(fq * 8 + p) * 16384 + row];
                s += __shfl_xor(s, 16); s += __shfl_xor(s, 32);
                const float rstd = rsqrtf(s * (1.f / 2048.f) + 1e-6f);
                bf16_t* rowp = O + (size_t)row * ldc + col0;
#pragma unroll
                for (int bj = 0; bj < 2; ++bj) { f32x4 v0 = acc[ai][bj][m][0] * rstd, v1 = acc[ai][bj][m][1] * rstd;
#pragma unroll
                    for (int e = 0; e < 4; ++e) { const float a = fmaxf(v0[e], 0.f), b = fmaxf(v1[e], 0.f); v0[e] = a * a; v1[e] = b * b; }
                    u32x4 w; w.x = cvt_pk_bf16(v0[0], v0[1]); w.y = cvt_pk_bf16(v0[2], v0[3]); w.z = cvt_pk_bf16(v1[0], v1[1]); w.w = cvt_pk_bf16(v1[2], v1[3]);
                    *(u32x4*)(rowp + bj * HALF) = w; } }
    }
};
struct EpiOut {
    static constexpr bool PERM = false, AFTER_DRAIN = false;
    float* OUT;
    __device__ __forceinline__ void operator()(const f32x4 (&acc)[2][2][4][2], const Unit& u, int wr, int wc, int fr, int fq) const {
        const int row0 = u.pm * BM + wr * 64 + fr, col0 = u.pn * BM + wc * 32 + 4 * fq;
#pragma unroll
        for (int ai = 0; ai < 2; ++ai)
#pragma unroll
            for (int m = 0; m < 4; ++m) { const size_t off = (size_t)(row0 + ai * HALF + m * 16) * 2048 + col0;
#pragma unroll
                for (int bj = 0; bj < 2; ++bj)
#pragma unroll
                    for (int n = 0; n < 2; ++n) { const size_t o = off + bj * HALF + n * 16; *(f32x4*)(OUT + o) = *(const f32x4*)(OUT + o) + acc[ai][bj][m][n]; } }
    }
};
}

struct Params {
    const float *x, *mem, *g_mix, *w_in, *conv_w, *a_log, *dt_bias, *gdn_norm_g, *fox_b_f, *fox_q_norm, *fox_k_norm, *g_mem, *w_mem_kv,
                *mem_q_norm, *mem_k_norm, *w_up_gdn, *w_up_fox, *w_up_mem, *w_out, *g_mlp, *w_ff1, *w_ff2;
    float* out; unsigned char* ws;
};

__device__ __forceinline__ float wave_sum(float v) {
#pragma unroll
    for (int o = 1; o < 64; o <<= 1) v += __shfl_xor(v, o);
    return v;
}

__device__ __forceinline__ void transpose_item(const float* W, int ldw, int n0src, bf16* WT, int K, int row0dst, const float* kscale,
                                               LAS float* scr, int kb, int nb, int lane) {
    const int k0 = 64 * kb, n0 = 32 * nb;
#pragma unroll 8
    for (int i = 0; i < 32; ++i) { const int kk = 2 * i + (lane >> 5); float v = W[(size_t)(k0 + kk) * ldw + n0src + n0 + (lane & 31)];
        if (kscale) v *= kscale[k0 + kk]; scr[kk * 33 + (lane & 31)] = v; }
    asm volatile("s_waitcnt lgkmcnt(0)" ::: "memory");
    const int c = lane & 7;
#pragma unroll
    for (int j = 0; j < 4; ++j) { const int n = (lane >> 3) + 8 * j; const LAS float* s = scr + (8 * c) * 33 + n;
        u32x4 o; o.x = pk2(s[0 * 33], s[1 * 33]); o.y = pk2(s[2 * 33], s[3 * 33]); o.z = pk2(s[4 * 33], s[5 * 33]); o.w = pk2(s[6 * 33], s[7 * 33]);
        *(u32x4*)(WT + (size_t)(row0dst + n0 + n) * K + k0 + 8 * c) = o; }
    asm volatile("s_waitcnt lgkmcnt(0)" ::: "memory");
}
__device__ __forceinline__ void transpose_job(const float* W, int ldw, int n0src, int K, int ncols, bf16* WT, int row0dst, const float* kscale,
                                              LAS float* scr, int gw, int ngw, int lane) {
    const int nblk = ncols / 32, nitems = (K / 64) * nblk;
    for (int it = gw; it < nitems; it += ngw) transpose_item(W, ldw, n0src, WT, K, row0dst, kscale, scr, it / nblk, it % nblk, lane);
}
__device__ __forceinline__ void rms_row_to_bf16(const float* xrow, const float* g, bf16* orow, int lane) {
    const f32x4* xr = (const f32x4*)xrow + lane; const f32x4* gr = (const f32x4*)g + lane;
    f32x4 v[8]; float s = 0.f;
#pragma unroll
    for (int j = 0; j < 8; ++j) { v[j] = xr[64 * j]; s += (v[j].x * v[j].x + v[j].y * v[j].y) + (v[j].z * v[j].z + v[j].w * v[j].w); }
    const float rstd = rsqrtf(wave_sum(s) * (1.f / 2048.f) + EPSN);
    u32x2* o8 = (u32x2*)orow + lane;
#pragma unroll
    for (int j = 0; j < 8; ++j) { const f32x4 gg = gr[64 * j]; u32x2 w; w.x = pk2(v[j].x * rstd * gg.x, v[j].y * rstd * gg.y); w.y = pk2(v[j].z * rstd * gg.z, v[j].w * rstd * gg.w); o8[64 * j] = w; }
}

__device__ __forceinline__ void phase0(const Params& P, unsigned char* lds, int tid, int lane, int wave) {
    unsigned char* ws = P.ws;
    bf16* W1T = (bf16*)(ws + WS_W1T); bf16* WFVT = (bf16*)(ws + WS_WFVT); bf16* WMKVT = (bf16*)(ws + WS_WMKVT); bf16* WGT = (bf16*)(ws + WS_WGT);
    bf16* WUPT = (bf16*)(ws + WS_WUPT); bf16* WOT = (bf16*)(ws + WS_WOT); bf16* WFF1T = (bf16*)(ws + WS_WFF1T); bf16* WFF2T = (bf16*)(ws + WS_WFF2T);
    LAS float* scr = (LAS float*)((LAS unsigned char*)lds + wave * 16384);
    const int G = gridDim.x, gw = blockIdx.x * 8 + wave, ngw = G * 8;
    bf16* H = (bf16*)((unsigned char*)P.out + DO_H);
    for (int m = gw; m < TOK; m += ngw) rms_row_to_bf16(P.x + (size_t)m * DM, P.g_mix, H + (size_t)m * DM, lane);
    bf16* MEMN = (bf16*)(ws + WS_MEMN);
    for (int m = gw; m < 512; m += ngw) rms_row_to_bf16(P.mem + (size_t)m * DM, P.g_mem, MEMN + (size_t)m * DM, lane);
    transpose_job(P.w_in, DIN, 0, 2048, 4096, W1T, 0, nullptr, scr, gw, ngw, lane);
    transpose_job(P.w_in, DIN, 5136, 2048, 1024, W1T, PC_FK, nullptr, scr, gw, ngw, lane);
    transpose_job(P.w_in, DIN, 4112, 2048, 1024, W1T, PC_FQ, nullptr, scr, gw, ngw, lane);
    transpose_job(P.w_in, DIN, 7192, 2048, 1024, W1T, PC_QM, nullptr, scr, gw, ngw, lane);
    transpose_job(P.w_in, DIN, 6160, 2048, 1024, WFVT, 0, nullptr, scr, gw, ngw, lane);
    transpose_job(P.w_in, DIN, 8216, 2048, 6144, WGT, 0, nullptr, scr, gw, ngw, lane);
    transpose_job(P.w_mem_kv, 2048, 0, 2048, 2048, WMKVT, 0, nullptr, scr, gw, ngw, lane);
    transpose_job(P.w_up_gdn, 2048, 0, 1024, 2048, WUPT, 0, nullptr, scr, gw, ngw, lane);
    transpose_job(P.w_up_fox, 2048, 0, 1024, 2048, WUPT + (size_t)2048 * 1024, 0, nullptr, scr, gw, ngw, lane);
    transpose_job(P.w_up_mem, 2048, 0, 1024, 2048, WUPT + (size_t)2 * 2048 * 1024, 0, nullptr, scr, gw, ngw, lane);
    transpose_job(P.w_out, 2048, 0, 2048, 2048, WOT, 0, nullptr, scr, gw, ngw, lane);
    transpose_job(P.w_ff1, 8192, 0, 2048, 8192, WFF1T, 0, P.g_mlp, scr, gw, ngw, lane);
    transpose_job(P.w_ff2, 2048, 0, 8192, 2048, WFF2T, 0, nullptr, scr, gw, ngw, lane);
    for (int idx = blockIdx.x * 512 + tid; idx < 256 * 2048; idx += G * 512) {
        const int row = idx >> 11, k = idx & 2047; float v = 0.f;
        if (row < 24) { const int col = row < 8 ? 4096 + row : (row < 16 ? 4104 + (row - 8) : 7184 + (row - 16)); v = P.w_in[(size_t)k * DIN + col]; }
        W1T[(size_t)(7168 + row) * 2048 + k] = (bf16)(pk2(v, 0.f) & 0xffffu);
    }
}


__device__ __forceinline__ void gdn_prep_unit(const Params& P, unsigned char* lds_, int bh, int n, int tid, int lane, int wave) {
    float* qs = (float*)lds_;
    float* ks = qs + 64 * 132;
    float* vs = ks + 64 * 132;
    float* Mm = vs + 64 * 132;
    float* QKd = Mm + 4096;
    float* gam = QKd + 4096;
    float* beta = gam + 64;
    float* egam = beta + 64;
    const int b = bh >> 3, h = bh & 7;
    const size_t r0 = (size_t)b * SEQ + (size_t)n * 64;
    const bf16* proj = (const bf16*)(P.ws + WS_PROJ);
    const float* small = (const float*)(P.ws + WS_SMALL);
    for (int it = tid; it < 64 * 48; it += 512) {
        const int t = it / 48, c8 = it % 48, mat = c8 >> 4, ch0 = (c8 & 15) * 8;
        const int col = mat * 1024 + h * 128 + ch0;
        float y[8];
#pragma unroll
        for (int e = 0; e < 8; ++e) y[e] = 0.f;
#pragma unroll
        for (int i = 0; i < 4; ++i) {
            const int tt = n * 64 + t - 3 + i;
            if (tt >= 0) {
                const u32x4 xv = *(const u32x4*)(proj + (r0 + t - 3 + i) * LDP + col);
                const f32x4 w0 = *(const f32x4*)(P.conv_w + i * 3072 + col), w1 = *(const f32x4*)(P.conv_w + i * 3072 + col + 4);
                y[0] += bflo(xv.x) * w0.x; y[1] += bfhi(xv.x) * w0.y; y[2] += bflo(xv.y) * w0.z; y[3] += bfhi(xv.y) * w0.w;
                y[4] += bflo(xv.z) * w1.x; y[5] += bfhi(xv.z) * w1.y; y[6] += bflo(xv.w) * w1.z; y[7] += bfhi(xv.w) * w1.w;
            }
        }
        float* dst = (mat == 0 ? qs : (mat == 1 ? ks : vs)) + t * 132 + ch0;
#pragma unroll
        for (int e = 0; e < 8; ++e) dst[e] = y[e] / (1.f + __expf(-y[e]));
    }
    if (wave == 0) {
        const float av = small[(r0 + lane) * 32 + 8 + h], bv = small[(r0 + lane) * 32 + h];
        float g = -__expf(P.a_log[h]) * softplusf_(av + P.dt_bias[h]);
#pragma unroll
        for (int o = 1; o < 64; o <<= 1) { const float t_ = __shfl_up(g, o); if (lane >= o) g += t_; }
        gam[lane] = g; egam[lane] = __expf(g); beta[lane] = sigmoidf_(bv);
    }
    __syncthreads();
    for (int rr = wave * 16; rr < wave * 16 + 16; ++rr) {
        float* row = (rr < 64 ? qs + rr * 132 : ks + (rr - 64) * 132);
        const float a = row[lane], c = row[lane + 64];
        const float ss = wave_sum(a * a + c * c);
        const float sc = rsqrtf(ss + EPSN) * (rr < 64 ? 0.08838834764831845f : 1.f);
        row[lane] = a * sc; row[lane + 64] = c * sc;
    }
    __syncthreads();
    {
        const int mat = tid >> 8, tt = tid & 255, ti = tt >> 4, tj = tt & 15;
        const float* A = mat == 0 ? ks : qs;
        float acc[4][4];
#pragma unroll
        for (int a = 0; a < 4; ++a)
#pragma unroll
            for (int c = 0; c < 4; ++c) acc[a][c] = 0.f;
        for (int d = 0; d < 128; d += 4) {
            f32x4 ra[4], rb[4];
#pragma unroll
            for (int a = 0; a < 4; ++a) ra[a] = *(const f32x4*)(A + (ti + 16 * a) * 132 + d);
#pragma unroll
            for (int c = 0; c < 4; ++c) rb[c] = *(const f32x4*)(ks + (tj + 16 * c) * 132 + d);
#pragma unroll
            for (int a = 0; a < 4; ++a)
#pragma unroll
                for (int c = 0; c < 4; ++c) acc[a][c] += (ra[a].x * rb[c].x + ra[a].y * rb[c].y) + (ra[a].z * rb[c].z + ra[a].w * rb[c].w);
        }
#pragma unroll
        for (int a = 0; a < 4; ++a)
#pragma unroll
            for (int c = 0; c < 4; ++c) { const int i = ti + 16 * a, j = tj + 16 * c;
                const float e = __expf(fminf(gam[i] - gam[j], 0.f));
                if (mat == 0) Mm[j * 64 + i] = (j < i) ? beta[i] * acc[a][c] * e : 0.f;
                else QKd[i * 64 + j] = (j <= i) ? acc[a][c] * e : 0.f; }
    }
    __syncthreads();
    unsigned char* gout = P.ws + WS_GDN + (size_t)(bh * 128 + n) * GDN_CHUNK_BYTES;
    unsigned char* uout = P.ws + WS_UC + (size_t)(bh * 128 + n) * 16384;
    const float glast = gam[63];
    for (int p = tid; p < 2560; p += 512) {
        float v[8]; unsigned char* dst;
        if (p < 1024) {
            const int f = p >> 6, ln = p & 63, rt = f >> 3, kk = f & 7, row = 32 * rt + (ln & 31), hi = ln >> 5;
            const float* src = qs + row * 132 + 16 * kk; const float sc = egam[row];
#pragma unroll
            for (int j = 0; j < 8; ++j) v[j] = src[crow(j, hi)] * sc;
            dst = gout + 16384 + (size_t)p * 16;
        } else if (p < 1536) {
            const int q = p - 1024, f = q >> 6, ln = q & 63, rt = f >> 2, kk = f & 3, row = 32 * rt + (ln & 31), hi = ln >> 5;
#pragma unroll
            for (int j = 0; j < 8; ++j) v[j] = QKd[row * 64 + 16 * kk + crow(j, hi)];
            dst = gout + 32768 + (size_t)q * 16;
        } else {
            const int q = p - 1536, f = q >> 6, ln = q & 63, rt = f >> 2, kk = f & 3, dk = 32 * rt + (ln & 31), hi = ln >> 5;
#pragma unroll
            for (int j = 0; j < 8; ++j) { const int tk = 16 * kk + crow(j, hi); v[j] = ks[tk * 132 + dk] * __expf(fminf(glast - gam[tk], 0.f)); }
            dst = gout + 40960 + (size_t)q * 16;
        }
        u32x4 o; o.x = pk2(v[0], v[1]); o.y = pk2(v[2], v[3]); o.z = pk2(v[4], v[5]); o.w = pk2(v[6], v[7]);
        *(u32x4*)dst = o;
    }
    if (tid == 0) ((float*)(P.ws + WS_CDEC))[bh * 128 + n] = __expf(glast);
    __syncthreads();
    if (tid < 256) {
        float* col = (tid < 128 ? ks : vs) + (tid & 127);
#pragma unroll 1
        for (int i = 0; i < 64; ++i) col[i * 132] *= beta[i] * (tid < 128 ? egam[i] : 1.f);
#pragma unroll 1
        for (int ib = 0; ib < 4; ++ib) {
            float acc[16];
#pragma unroll
            for (int r = 0; r < 16; ++r) acc[r] = col[(ib * 16 + r) * 132];
#pragma unroll 2
            for (int j = 0; j < ib * 16; ++j) {
                const float xj = col[j * 132]; const float* mr = Mm + j * 64 + ib * 16;
                const f32x4 m0 = *(const f32x4*)mr, m1 = *(const f32x4*)(mr + 4), m2 = *(const f32x4*)(mr + 8), m3 = *(const f32x4*)(mr + 12);
                acc[0] -= m0.x * xj; acc[1] -= m0.y * xj; acc[2] -= m0.z * xj; acc[3] -= m0.w * xj;
                acc[4] -= m1.x * xj; acc[5] -= m1.y * xj; acc[6] -= m1.z * xj; acc[7] -= m1.w * xj;
                acc[8] -= m2.x * xj; acc[9] -= m2.y * xj; acc[10] -= m2.z * xj; acc[11] -= m2.w * xj;
                acc[12] -= m3.x * xj; acc[13] -= m3.y * xj; acc[14] -= m3.z * xj; acc[15] -= m3.w * xj;
            }
#pragma unroll
            for (int r2 = 0; r2 < 15; ++r2) {
                const float* mr = Mm + (ib * 16 + r2) * 64 + ib * 16; float mm[16];
#pragma unroll
                for (int q = 0; q < 4; ++q) { const f32x4 t4 = *(const f32x4*)(mr + 4 * q); mm[4 * q] = t4.x; mm[4 * q + 1] = t4.y; mm[4 * q + 2] = t4.z; mm[4 * q + 3] = t4.w; }
#pragma unroll
                for (int r = r2 + 1; r < 16; ++r) acc[r] -= mm[r] * acc[r2];
            }
#pragma unroll
            for (int r = 0; r < 16; ++r) col[(ib * 16 + r) * 132] = acc[r];
        }
    }
    __syncthreads();
    for (int p = tid; p < 2048; p += 512) {
        float v[8]; unsigned char* dst;
        if (p < 1024) {
            const int f = p >> 6, ln = p & 63, rt = f >> 3, kk = f & 7, row = 32 * rt + (ln & 31), hi = ln >> 5;
            const float* src = ks + row * 132 + 16 * kk;
#pragma unroll
            for (int j = 0; j < 8; ++j) v[j] = -src[crow(j, hi)];
            dst = gout + (size_t)p * 16;
        } else {
            const int q = p - 1024, half = q & 1, ln = (q >> 1) & 63, g2 = q >> 7, rt = g2 & 1, w4 = g2 >> 1, hi = ln >> 5;
#pragma unroll
            for (int j = 0; j < 8; ++j) v[j] = vs[(32 * rt + crow(8 * half + j, hi)) * 132 + 32 * w4 + (ln & 31)];
            dst = uout + (size_t)q * 16;
        }
        u32x4 o; o.x = pk2(v[0], v[1]); o.y = pk2(v[2], v[3]); o.z = pk2(v[4], v[5]); o.w = pk2(v[6], v[7]);
        *(u32x4*)dst = o;
    }
    __syncthreads();
}

template <int GL> __device__ __forceinline__ void norm8(bf16* p, const float* gain, float mult, float inv_n) {
    const u32x4 xv = *(const u32x4*)p;
    float v[8] = {bflo(xv.x), bfhi(xv.x), bflo(xv.y), bfhi(xv.y), bflo(xv.z), bfhi(xv.z), bflo(xv.w), bfhi(xv.w)};
    float ss = 0.f;
#pragma unroll
    for (int e = 0; e < 8; ++e) ss += v[e] * v[e];
#pragma unroll
    for (int o = 1; o < GL; o <<= 1) ss += __shfl_xor(ss, o);
    const float sc = rsqrtf(ss * inv_n + EPSN) * mult;
    const f32x4 g0 = *(const f32x4*)gain, g1 = *(const f32x4*)(gain + 4);
    u32x4 o; o.x = pk2(v[0] * sc * g0.x, v[1] * sc * g0.y); o.y = pk2(v[2] * sc * g0.z, v[3] * sc * g0.w);
    o.z = pk2(v[4] * sc * g1.x, v[5] * sc * g1.y); o.w = pk2(v[6] * sc * g1.z, v[7] * sc * g1.w);
    *(u32x4*)p = o;
}

__device__ __forceinline__ void phase2(const Params& P, unsigned char* lds, int tid, int lane, int wave) {
    const int G = gridDim.x;
    bf16* proj = (bf16*)(P.ws + WS_PROJ);
    if (blockIdx.x < 16) {
        const int bh = blockIdx.x, b = bh >> 3, h = bh & 7;
        const float* small = (const float*)(P.ws + WS_SMALL);
        float* cum = (float*)(P.ws + WS_CUM) + (size_t)bh * SEQ;
        float* wtot = (float*)lds;
        const float bf = P.fox_b_f[h];
        float v[16]; float run = 0.f;
#pragma unroll
        for (int e = 0; e < 16; ++e) { const float xx = small[((size_t)b * SEQ + tid * 16 + e) * 32 + 16 + h] + bf; run += -softplusf_(-xx) * LOG2E; v[e] = run; }
        float inc = run;
#pragma unroll
        for (int o = 1; o < 64; o <<= 1) { const float t_ = __shfl_up(inc, o); if (lane >= o) inc += t_; }
        if (lane == 63) wtot[wave] = inc;
        __syncthreads();
        float off = inc - run;
        for (int w = 0; w < wave; ++w) off += wtot[w];
#pragma unroll
        for (int e = 0; e < 16; ++e) cum[tid * 16 + e] = v[e] + off;
        __syncthreads();
    }
    for (int u = blockIdx.x; u < 2048; u += G) gdn_prep_unit(P, lds, u >> 7, u & 127, tid, lane, wave);
    for (int it = blockIdx.x; it < TOK / 2; it += G) {
        const int tok = it * 2 + (tid >> 8), cidx = (tid & 255) * 8, isq = cidx >= 1024, d = cidx & 127;
        norm8<16>(proj + (size_t)tok * LDP + PC_FK + cidx, (isq ? P.fox_q_norm : P.fox_k_norm) + d, isq ? 0.08838834764831845f * LOG2E : 1.f, 1.f / 128.f);
    }
    for (int it = blockIdx.x; it < TOK / 4; it += G) {
        const int tok = it * 4 + (tid >> 7), cidx = (tid & 127) * 8, d = cidx & 255;
        norm8<32>(proj + (size_t)tok * LDP + PC_QM + cidx, P.mem_q_norm + d, 0.0625f * LOG2E, 1.f / 256.f);
    }
    bf16* kmem = (bf16*)(P.ws + WS_KMEM);
    for (int it = blockIdx.x; it < 512 / 4; it += G) {
        const int tok = it * 4 + (tid >> 7), cidx = (tid & 127) * 8, d = cidx & 255;
        norm8<32>(kmem + (size_t)tok * 1024 + cidx, P.mem_k_norm + d, 1.f, 1.f / 256.f);
    }
}

template <int DQK, bool FOX>
__device__ __forceinline__ void attn_unit(unsigned char* lds_, const bf16* Q, int ldq, const bf16* K, int ldk, const bf16* VT, int ldvt, bf16* O, int ldo,
                                          const float* cum, int t0, int ntiles, int tid, int lane, int wave) {
    asm volatile("" : "+v"(tid), "+v"(lane));
    constexpr int KS = DQK / 16, KPITCH = DQK * 2 + 16, VPITCH = 136, ND = FOX ? 4 : 2, NH = (DQK / 32) / ND, VCH = ND / 2;
    constexpr int KCH = 64 * DQK / 8 / 512;
    LAS unsigned char* lds = (LAS unsigned char*)lds_;
    LAS unsigned char* Ks = lds; LAS unsigned char* VTs = lds + 64 * KPITCH; LAS float* cbs = (LAS float*)(lds + 64 * KPITCH + 128 * VPITCH);
    const int c = lane & 31, hi = lane >> 5;
    const int qrow = t0 + wave * 32 + c;
    bf16x8 qf[KS];
    { const bf16* qp = Q + (size_t)qrow * ldq + 8 * hi;
#pragma unroll
      for (int k = 0; k < KS; ++k) qf[k] = *(const bf16x8*)(qp + 16 * k); }
    float cref = 0.f; if (FOX) cref = cum[t0];
#pragma unroll 1
    for (int half = 0; half < NH; ++half) {
        f32x16 o[ND]; float m = -1e30f, l = 0.f;
#pragma unroll
        for (int d = 0; d < ND; ++d) o[d] = f32x16{};
        constexpr bool PREF = (DQK == 128);
        u32x4 kpre[KCH], vpre[VCH]; float cpre = 0.f;
#define ATT_PREFETCH(j_) do { const int kv0_ = 64 * (j_); \
            _Pragma("unroll") for (int i = 0; i < KCH; ++i) { const int id = tid + 512 * i, row = id / (DQK / 8), cc = id % (DQK / 8); kpre[i] = *(const u32x4*)(K + (size_t)(kv0_ + row) * ldk + cc * 8); } \
            _Pragma("unroll") for (int i = 0; i < VCH; ++i) { const int id = tid + 512 * i, row = id >> 3, cc = id & 7; vpre[i] = *(const u32x4*)(VT + (size_t)(half * ND * 32 + row) * ldvt + kv0_ + cc * 8); } \
            if (FOX) { if (tid < 64) cpre = cum[kv0_ + tid] - cref; } } while (0)
        if (PREF) ATT_PREFETCH(0);
#pragma unroll 1
        for (int j = 0; j < ntiles; ++j) {
            __syncthreads();
            if (!PREF) ATT_PREFETCH(j);
#pragma unroll
            for (int i = 0; i < KCH; ++i) { const int id = tid + 512 * i, row = id / (DQK / 8), cc = id % (DQK / 8); *(LAS u32x4*)(Ks + row * KPITCH + cc * 16) = kpre[i]; }
#pragma unroll
            for (int i = 0; i < VCH; ++i) { const int id = tid + 512 * i, row = id >> 3, cc = id & 7; LAS u32x2* d2 = (LAS u32x2*)(VTs + row * VPITCH + cc * 16);
                d2[0] = (u32x2){vpre[i].x, vpre[i].y}; d2[1] = (u32x2){vpre[i].z, vpre[i].w}; }
            if (FOX) { if (tid < 64) cbs[tid] = cpre; }
            __syncthreads();
            if (PREF && j + 1 < ntiles) ATT_PREFETCH(j + 1);
            const int kv0 = 64 * j;
            if (FOX && kv0 > t0 + wave * 32 + 31) continue;
            f32x16 p0 = f32x16{}, p1 = f32x16{};
            { const LAS unsigned char* kb = Ks + c * KPITCH + hi * 16;
#pragma unroll
              for (int k = 0; k < KS; ++k) {
                  const bf16x8 a0 = *(const LAS bf16x8*)(kb + k * 32), a1 = *(const LAS bf16x8*)(kb + 32 * KPITCH + k * 32);
                  p0 = __builtin_amdgcn_mfma_f32_32x32x16_bf16(a0, qf[k], p0, 0, 0, 0);
                  p1 = __builtin_amdgcn_mfma_f32_32x32x16_bf16(a1, qf[k], p1, 0, 0, 0); } }
            if (FOX) {
#pragma unroll
                for (int r4 = 0; r4 < 4; ++r4) { const f32x4 b0 = *(const LAS f32x4*)(cbs + 8 * r4 + 4 * hi), b1 = *(const LAS f32x4*)(cbs + 32 + 8 * r4 + 4 * hi);
#pragma unroll
                    for (int e = 0; e < 4; ++e) { p0[4 * r4 + e] -= b0[e]; p1[4 * r4 + e] -= b1[e]; } }
                if (kv0 + 63 > t0 + wave * 32) {
#pragma unroll
                    for (int r = 0; r < 16; ++r) { const int kv = kv0 + crow(r, hi); if (kv > qrow) p0[r] = -INFINITY; if (kv + 32 > qrow) p1[r] = -INFINITY; }
                }
            }
            float mx = p0[0];
#pragma unroll
            for (int r = 1; r < 16; ++r) mx = fmaxf(mx, p0[r]);
#pragma unroll
            for (int r = 0; r < 16; ++r) mx = fmaxf(mx, p1[r]);
            mx = fmaxf(mx, __shfl_xor(mx, 32));
            const float mn = fmaxf(m, mx), alpha = exp2f(m - mn); m = mn;
            float ps = 0.f;
#pragma unroll
            for (int r = 0; r < 16; ++r) { p0[r] = exp2f(p0[r] - mn); p1[r] = exp2f(p1[r] - mn); ps += p0[r] + p1[r]; }
            l = l * alpha + ps;
#pragma unroll
            for (int d = 0; d < ND; ++d)
#pragma unroll
                for (int r = 0; r < 16; ++r) o[d][r] *= alpha;
            bf16x8 pb[4];
#pragma unroll
            for (int cc = 0; cc < 4; ++cc) { u32x4 w;
                if (cc < 2) { w.x = pk2(p0[8 * cc + 0], p0[8 * cc + 1]); w.y = pk2(p0[8 * cc + 2], p0[8 * cc + 3]); w.z = pk2(p0[8 * cc + 4], p0[8 * cc + 5]); w.w = pk2(p0[8 * cc + 6], p0[8 * cc + 7]); }
                else { const int c2 = cc - 2; w.x = pk2(p1[8 * c2 + 0], p1[8 * c2 + 1]); w.y = pk2(p1[8 * c2 + 2], p1[8 * c2 + 3]); w.z = pk2(p1[8 * c2 + 4], p1[8 * c2 + 5]); w.w = pk2(p1[8 * c2 + 6], p1[8 * c2 + 7]); }
                pb[cc] = __builtin_bit_cast(bf16x8, w); }
            { const LAS unsigned char* vb = VTs + c * VPITCH + hi * 8;
#pragma unroll
              for (int d = 0; d < ND; ++d)
#pragma unroll
                  for (int cc = 0; cc < 4; ++cc) {
                      const u32x2 lo = *(const LAS u32x2*)(vb + d * 32 * VPITCH + cc * 32), hh = *(const LAS u32x2*)(vb + d * 32 * VPITCH + cc * 32 + 16);
                      const u32x4 av = (u32x4){lo.x, lo.y, hh.x, hh.y};
                      o[d] = __builtin_amdgcn_mfma_f32_32x32x16_bf16(__builtin_bit_cast(bf16x8, av), pb[cc], o[d], 0, 0, 0); } }
        }
        l += __shfl_xor(l, 32);
        const float rl = 1.f / l;
        bf16* op = O + (size_t)qrow * ldo + half * ND * 32 + 4 * hi;
#pragma unroll
        for (int d = 0; d < ND; ++d)
#pragma unroll
            for (int r4 = 0; r4 < 4; ++r4) { u32x2 w; w.x = pk2(o[d][4 * r4 + 0] * rl, o[d][4 * r4 + 1] * rl); w.y = pk2(o[d][4 * r4 + 2] * rl, o[d][4 * r4 + 3] * rl);
                *(u32x2*)(op + 32 * d + 8 * r4) = w; }
    }
    __syncthreads();
}

__device__ __forceinline__ void gdn_scan_wg(const Params& P, unsigned char* lds_, int bh, int tid, int lane, int wave) {
    LAS unsigned char* lds = (LAS unsigned char*)lds_;
    const int b = bh >> 3, h = bh & 7;
    const unsigned char* gsrc = P.ws + WS_GDN + (size_t)bh * 128 * GDN_CHUNK_BYTES;
    const unsigned char* usrc = P.ws + WS_UC + (size_t)bh * 128 * 16384;
    const float* cdec = (const float*)(P.ws + WS_CDEC) + bh * 128;
    bf16* proj = (bf16*)(P.ws + WS_PROJ);
    constexpr int OB = 114688;
    if (wave >= 4) {
        const int lt = tid - 256;
        { u32x4 r[14];
#pragma unroll
          for (int k = 0; k < 14; ++k) r[k] = *(const u32x4*)(gsrc + (size_t)(lt + 256 * k) * 16);
#pragma unroll
          for (int k = 0; k < 14; ++k) *(LAS u32x4*)(lds + (lt + 256 * k) * 16) = r[k]; }
        __syncthreads();
#pragma unroll 1
        for (int n = 0; n < 128; ++n) {
            u32x4 r[14];
            if (n + 1 < 128) {
                const unsigned char* s = gsrc + (size_t)(n + 1) * GDN_CHUNK_BYTES;
#pragma unroll
                for (int k = 0; k < 14; ++k) r[k] = *(const u32x4*)(s + (size_t)(lt + 256 * k) * 16);
            }
            if (n > 0) {
                const int tk = lt >> 2, q4 = lt & 3; const LAS unsigned char* ob = lds + OB + ((n - 1) & 1) * 16384 + tk * 256 + q4 * 64;
                float v[32]; float ss = 0.f;
#pragma unroll
                for (int i = 0; i < 4; ++i) { const u32x4 w = *(const LAS u32x4*)(ob + i * 16);
                    v[8 * i + 0] = bflo(w.x); v[8 * i + 1] = bfhi(w.x); v[8 * i + 2] = bflo(w.y); v[8 * i + 3] = bfhi(w.y);
                    v[8 * i + 4] = bflo(w.z); v[8 * i + 5] = bfhi(w.z); v[8 * i + 6] = bflo(w.w); v[8 * i + 7] = bfhi(w.w); }
#pragma unroll
                for (int e = 0; e < 32; ++e) ss += v[e] * v[e];
                ss += __shfl_xor(ss, 1); ss += __shfl_xor(ss, 2);
                const float rstd = rsqrtf(ss * (1.f / 128.f) + EPSN);
                const size_t row = (size_t)b * SEQ + (size_t)(n - 1) * 64 + tk;
                const bf16* zp = proj + row * LDP + PC_Z + h * 128 + q4 * 32; bf16* op = proj + row * LDP + PC_OA + h * 128 + q4 * 32;
                const float* gp = P.gdn_norm_g + q4 * 32;
#pragma unroll
                for (int i = 0; i < 4; ++i) { const u32x4 zw = *(const u32x4*)(zp + 8 * i);
                    const float z[8] = {bflo(zw.x), bfhi(zw.x), bflo(zw.y), bfhi(zw.y), bflo(zw.z), bfhi(zw.z), bflo(zw.w), bfhi(zw.w)};
                    float ov[8];
#pragma unroll
                    for (int e = 0; e < 8; ++e) ov[e] = v[8 * i + e] * rstd * gp[8 * i + e] * (z[e] / (1.f + __expf(-z[e])));
                    u32x4 w; w.x = pk2(ov[0], ov[1]); w.y = pk2(ov[2], ov[3]); w.z = pk2(ov[4], ov[5]); w.w = pk2(ov[6], ov[7]);
                    *(u32x4*)(op + 8 * i) = w; }
            }
            if (n + 1 < 128) {
                LAS unsigned char* d = lds + ((n + 1) & 1) * GDN_CHUNK_BYTES;
#pragma unroll
                for (int k = 0; k < 14; ++k) *(LAS u32x4*)(d + (lt + 256 * k) * 16) = r[k];
            }
            __syncthreads();
        }
        {
            const int n = 128;
            const int tk = lt >> 2, q4 = lt & 3; const LAS unsigned char* ob = lds + OB + ((n - 1) & 1) * 16384 + tk * 256 + q4 * 64;
            float v[32]; float ss = 0.f;
#pragma unroll
            for (int i = 0; i < 4; ++i) { const u32x4 w = *(const LAS u32x4*)(ob + i * 16);
                v[8 * i + 0] = bflo(w.x); v[8 * i + 1] = bfhi(w.x); v[8 * i + 2] = bflo(w.y); v[8 * i + 3] = bfhi(w.y);
                v[8 * i + 4] = bflo(w.z); v[8 * i + 5] = bfhi(w.z); v[8 * i + 6] = bflo(w.w); v[8 * i + 7] = bfhi(w.w); }
#pragma unroll
            for (int e = 0; e < 32; ++e) ss += v[e] * v[e];
            ss += __shfl_xor(ss, 1); ss += __shfl_xor(ss, 2);
            const float rstd = rsqrtf(ss * (1.f / 128.f) + EPSN);
            const size_t row = (size_t)b * SEQ + (size_t)(n - 1) * 64 + tk;
            const bf16* zp = proj + row * LDP + PC_Z + h * 128 + q4 * 32; bf16* op = proj + row * LDP + PC_OA + h * 128 + q4 * 32;
            const float* gp = P.gdn_norm_g + q4 * 32;
#pragma unroll
            for (int i = 0; i < 4; ++i) { const u32x4 zw = *(const u32x4*)(zp + 8 * i);
                const float z[8] = {bflo(zw.x), bfhi(zw.x), bflo(zw.y), bfhi(zw.y), bflo(zw.z), bfhi(zw.z), bflo(zw.w), bfhi(zw.w)};
                float ov[8];
#pragma unroll
                for (int e = 0; e < 8; ++e) ov[e] = v[8 * i + e] * rstd * gp[8 * i + e] * (z[e] / (1.f + __expf(-z[e])));
                u32x4 w; w.x = pk2(ov[0], ov[1]); w.y = pk2(ov[2], ov[3]); w.z = pk2(ov[4], ov[5]); w.w = pk2(ov[6], ov[7]);
                *(u32x4*)(op + 8 * i) = w; }
        }
    } else {
        const int w4 = wave, c = lane & 31, hi = lane >> 5;
        f32x16 S[4];
#pragma unroll
        for (int t = 0; t < 4; ++t) S[t] = f32x16{};
        bf16x8 Sb[8];
#pragma unroll
        for (int k = 0; k < 8; ++k) Sb[k] = bf16x8{};
        u32x4 ucn[4];
#pragma unroll
        for (int i = 0; i < 4; ++i) ucn[i] = *(const u32x4*)(usrc + (size_t)((w4 * 2 + (i >> 1)) * 64 + lane) * 32 + (i & 1) * 16);
        float cdn = cdec[0];
        __syncthreads();
#pragma unroll 1
        for (int n = 0; n < 128; ++n) {
            const LAS unsigned char* fb = lds + (n & 1) * GDN_CHUNK_BYTES + lane * 16;
            f32x16 U[2];
#pragma unroll
            for (int rt = 0; rt < 2; ++rt) { const u32x4 a = ucn[2 * rt], bq = ucn[2 * rt + 1];
                U[rt][0] = bflo(a.x); U[rt][1] = bfhi(a.x); U[rt][2] = bflo(a.y); U[rt][3] = bfhi(a.y); U[rt][4] = bflo(a.z); U[rt][5] = bfhi(a.z); U[rt][6] = bflo(a.w); U[rt][7] = bfhi(a.w);
                U[rt][8] = bflo(bq.x); U[rt][9] = bfhi(bq.x); U[rt][10] = bflo(bq.y); U[rt][11] = bfhi(bq.y); U[rt][12] = bflo(bq.z); U[rt][13] = bfhi(bq.z); U[rt][14] = bflo(bq.w); U[rt][15] = bfhi(bq.w); }
            const float cd = cdn;
            if (n + 1 < 128) {
                const unsigned char* us = usrc + (size_t)(n + 1) * 16384;
#pragma unroll
                for (int i = 0; i < 4; ++i) ucn[i] = *(const u32x4*)(us + (size_t)((w4 * 2 + (i >> 1)) * 64 + lane) * 32 + (i & 1) * 16);
                cdn = cdec[n + 1];
            }
#pragma unroll
            for (int rt = 0; rt < 2; ++rt)
#pragma unroll
                for (int k = 0; k < 8; ++k) U[rt] = __builtin_amdgcn_mfma_f32_32x32x16_bf16(*(const LAS bf16x8*)(fb + (rt * 8 + k) * 1024), Sb[k], U[rt], 0, 0, 0);
            f32x16 Ov[2];
#pragma unroll
            for (int rt = 0; rt < 2; ++rt) { Ov[rt] = f32x16{};
#pragma unroll
                for (int k = 0; k < 8; ++k) Ov[rt] = __builtin_amdgcn_mfma_f32_32x32x16_bf16(*(const LAS bf16x8*)(fb + 16384 + (rt * 8 + k) * 1024), Sb[k], Ov[rt], 0, 0, 0); }
            bf16x8 Ub[4];
#pragma unroll
            for (int k2 = 0; k2 < 4; ++k2) { const f32x16& uu = U[k2 >> 1]; const int o8 = 8 * (k2 & 1); u32x4 w;
                w.x = pk2(uu[o8 + 0], uu[o8 + 1]); w.y = pk2(uu[o8 + 2], uu[o8 + 3]); w.z = pk2(uu[o8 + 4], uu[o8 + 5]); w.w = pk2(uu[o8 + 6], uu[o8 + 7]); Ub[k2] = __builtin_bit_cast(bf16x8, w); }
#pragma unroll
            for (int rt = 0; rt < 2; ++rt)
#pragma unroll
                for (int k2 = 0; k2 < 4; ++k2) Ov[rt] = __builtin_amdgcn_mfma_f32_32x32x16_bf16(*(const LAS bf16x8*)(fb + 32768 + (rt * 4 + k2) * 1024), Ub[k2], Ov[rt], 0, 0, 0);
#pragma unroll
            for (int t = 0; t < 4; ++t) {
#pragma unroll
                for (int r = 0; r < 16; ++r) S[t][r] *= cd;
#pragma unroll
                for (int k2 = 0; k2 < 4; ++k2) S[t] = __builtin_amdgcn_mfma_f32_32x32x16_bf16(*(const LAS bf16x8*)(fb + 40960 + (t * 4 + k2) * 1024), Ub[k2], S[t], 0, 0, 0);
            }
            { LAS bf16* ob = (LAS bf16*)(lds + OB + (n & 1) * 16384);
#pragma unroll
              for (int rt = 0; rt < 2; ++rt)
#pragma unroll
                  for (int r = 0; r < 16; ++r) ob[(32 * rt + crow(r, hi)) * 128 + 32 * w4 + c] = (bf16)(pk2(Ov[rt][r], 0.f) & 0xffffu); }
#pragma unroll
            for (int k = 0; k < 8; ++k) { const f32x16& ss = S[k >> 1]; const int o8 = 8 * (k & 1); u32x4 w;
                w.x = pk2(ss[o8 + 0], ss[o8 + 1]); w.y = pk2(ss[o8 + 2], ss[o8 + 3]); w.z = pk2(ss[o8 + 4], ss[o8 + 5]); w.w = pk2(ss[o8 + 6], ss[o8 + 7]); Sb[k] = __builtin_bit_cast(bf16x8, w); }
            __syncthreads();
        }
    }
    __syncthreads();
}

__device__ __forceinline__ void phase3(const Params& P, unsigned char* lds, int tid, int lane, int wave) {
    bf16* proj = (bf16*)(P.ws + WS_PROJ);
#ifndef NO_SCAN
    if (blockIdx.x < 16) gdn_scan_wg(P, lds, blockIdx.x, tid, lane, wave);
#endif
    unsigned* ctr = (unsigned*)(P.ws + WS_CTL);
    LAS unsigned* sh = (LAS unsigned*)((LAS unsigned char*)lds + LDS_BYTES - 64);
    const bf16* foxvt = (const bf16*)((const unsigned char*)P.out + DO_FOXVT);
    const float* cum = (const float*)(P.ws + WS_CUM);
    const bf16* kmem = (const bf16*)(P.ws + WS_KMEM); const bf16* vmt = (const bf16*)(P.ws + WS_VMT);
#ifdef STATIC_P3
    for (unsigned idx_ = (blockIdx.x < 16 ? 100000u : blockIdx.x - 16u); idx_ < 768u; idx_ += 240u) {
        const unsigned idx = __builtin_amdgcn_readfirstlane(idx_);
#else
    for (;;) {
        if (tid == 0) sh[0] = atomicAdd(ctr, 1u);
        __syncthreads();
        const unsigned idx = __builtin_amdgcn_readfirstlane(sh[0]);
        __syncthreads();
        if (idx >= 512u + 256u) break;
#endif
        if (idx < 512u) {
#ifndef NO_FOXATT
            const int qb = 31 - (int)(idx >> 4), bh = idx & 15, b = bh >> 3, h = bh & 7;
            bf16* Qp = proj + (size_t)b * SEQ * LDP + PC_FQ + h * 128;
            const bf16* Kp = proj + (size_t)b * SEQ * LDP + PC_FK + h * 128;
            const bf16* Vp = foxvt + (size_t)(h * 128) * TOK + (size_t)b * SEQ;
            attn_unit<128, true>(lds, Qp, LDP, Kp, LDP, Vp, TOK, Qp, LDP, cum + (size_t)bh * SEQ, qb * 256, (qb + 1) * 4, tid, lane, wave);
#endif
        } else {
#ifndef NO_MEMATT
            const int u = idx - 512, qb = u & 31, bh = u >> 5, b = bh >> 2, h = bh & 3;
            bf16* Qp = proj + (size_t)b * SEQ * LDP + PC_QM + h * 256;
            const bf16* Kp = kmem + (size_t)b * 256 * 1024 + h * 256;
            const bf16* Vp = vmt + (size_t)(h * 256) * 512 + b * 256;
            attn_unit<256, false>(lds, Qp, LDP, Kp, 1024, Vp, 512, Qp, LDP, nullptr, qb * 256, 4, tid, lane, wave);
#endif
        }
    }
}


#define RLX_AGENT __ATOMIC_RELAXED, __HIP_MEMORY_SCOPE_AGENT
#define XB_TMO      128
#define XB_XCNT(j)  (256  + 64 * (j))
#define XB_XSUB(j)  (1280 + 64 * (j))
#define XB_XGEN(j)  (2304 + 64 * (j))
#define XB_TOP      3328
#define XB_TOPGEN   3392
#define XCD_BAR_WORDS 3456
#define XB_SPIN_CAP (1u << 22)

__device__ __forceinline__ unsigned xb_ld(unsigned* p)              { return __hip_atomic_load(p, __ATOMIC_RELAXED, __HIP_MEMORY_SCOPE_AGENT); }
__device__ __forceinline__ unsigned xb_add(unsigned* p, unsigned v) { return __hip_atomic_fetch_add(p, v, __ATOMIC_RELAXED, __HIP_MEMORY_SCOPE_AGENT); }
__device__ __forceinline__ unsigned xb_xcc_id() { return (unsigned)__builtin_amdgcn_s_getreg((3 << 11) | 20) & 0xFu; }
#define XB_SPIN(cond, bar) do { unsigned _sp = 0; while (cond) { __builtin_amdgcn_s_sleep(1); \
    if ((++_sp & 255u) == 0u) { if (xb_ld(&(bar)[XB_TMO])) break; if (_sp > XB_SPIN_CAP) { atomicAdd(&(bar)[XB_TMO], 1u); break; } } } } while (0)

struct XcdBarrier {
    unsigned* bar; unsigned x;
    volatile LAS unsigned* st;
};

__device__ __forceinline__ XcdBarrier xcd_barrier_post(unsigned* bar, volatile LAS unsigned* st) {
    XcdBarrier b; b.bar = bar; b.x = xb_xcc_id(); b.st = st;
    if (threadIdx.x == 0) (void)xb_add(&bar[XB_XCNT(b.x)], 1u);
    return b;
}
__device__ __forceinline__ void xcd_barrier_complete(unsigned* bar, unsigned x, unsigned& nloc, unsigned& nx) {
    const unsigned G = gridDim.x * gridDim.y * gridDim.z;
    unsigned sum, cnt, mine, sp = 0u;
    for (;;) {
        sum = 0u; cnt = 0u; mine = 0u;
#pragma unroll
        for (unsigned j = 0; j < 16; ++j) { const unsigned c = xb_ld(&bar[XB_XCNT(j)]); sum += c; cnt += (c > 0u) ? 1u : 0u; mine = (j == x) ? c : mine; }
        if (sum == G) break;
        __builtin_amdgcn_s_sleep(1);
        if ((++sp & 255u) == 0u) { if (xb_ld(&bar[XB_TMO])) break; if (sp > XB_SPIN_CAP) { atomicAdd(&bar[XB_TMO], 1u); break; } }
    }
    nloc = mine > 0u ? mine : 1u; nx = cnt > 0u ? cnt : 1u;
}

__device__ __forceinline__ void xcd_barrier(const XcdBarrier& b) {
    asm volatile("s_waitcnt vmcnt(0)" ::: "memory");
    __syncthreads();
    if (threadIdx.x == 0) {
        unsigned* bar = b.bar;
        __builtin_amdgcn_s_waitcnt(0);
        unsigned nloc = b.st[0], nx = b.st[1];
        if (nloc == 0u) { xcd_barrier_complete(bar, b.x, nloc, nx); b.st[0] = nloc; b.st[1] = nx; }
        const unsigned old = xb_add(&bar[XB_XSUB(b.x)], 1u);
        const unsigned gen = old / nloc;
        if (old + 1u == (gen + 1u) * nloc) {
            __builtin_amdgcn_fence(__ATOMIC_RELEASE, "agent");
            asm volatile("s_waitcnt vmcnt(0)" ::: "memory");
            const unsigned og = xb_add(&bar[XB_TOP], 1u);
            const unsigned tg = og / nx;
            if (og + 1u == (tg + 1u) * nx) xb_add(&bar[XB_TOPGEN], 1u);
            else XB_SPIN(xb_ld(&bar[XB_TOPGEN]) == tg, bar);
            __builtin_amdgcn_fence(__ATOMIC_ACQUIRE, "agent");
            xb_add(&bar[XB_XGEN(b.x)], 1u);
            asm volatile("s_waitcnt vmcnt(0)" ::: "memory");
        } else {
            XB_SPIN(xb_ld(&bar[XB_XGEN(b.x)]) == gen, bar);
            __builtin_amdgcn_fence(__ATOMIC_ACQUIRE, "agent");
            asm volatile("s_waitcnt vmcnt(0)" ::: "memory");
        }
    }
    __syncthreads();
}

__global__ void __launch_bounds__(512, 2) hybrid_fwd(Params P) {
    extern __shared__ __attribute__((aligned(16))) unsigned char lds[];
    cg::grid_group grid = cg::this_grid();
    const int tid = threadIdx.x, lane = tid & 63, wave = __builtin_amdgcn_readfirstlane(tid >> 6);
    const int G = gridDim.x, cb = blockIdx.x;
    unsigned char* ws = P.ws;
    LAS unsigned char* glds = (LAS unsigned char*)lds;
    bf16* H = (bf16*)((unsigned char*)P.out + DO_H);
    bf16* proj = (bf16*)(ws + WS_PROJ);
    volatile LAS unsigned* bst = (volatile LAS unsigned*)(glds + LDS_BYTES - 32);
    if (tid < 2) bst[tid] = 0u;
    __syncthreads();
    XcdBarrier bar = xcd_barrier_post((unsigned*)(ws + WS_CTL) + 1024, bst);
    grid.sync();
#define GRID_BAR() xcd_barrier(bar)

#ifndef NO_P0
    phase0(P, lds, tid, lane, wave);
#endif
    GRID_BAR();
#ifndef NO_GEMM
    {
        pg8::Gemm g{H, (const bf16*)(ws + WS_W1T), TOK, 7424, 2048, 2048, 2048}; pg8::StaticOrder S; S.init(TOK, 7424, G, cb);
        pg8::EpiProj E{proj, LDP, (float*)(ws + WS_SMALL)};
        pg8::gemm_phase<pg8::EpiProj, pg8::StaticOrder, true, true>(glds, g, S, E);
    }
    {
        pg8::Gemm g{(const bf16*)(ws + WS_WFVT), H, 1024, TOK, 2048, 2048, 2048}; pg8::StaticOrder S; S.init(1024, TOK, G, cb);
        pg8::EpiStore E{(bf16*)((unsigned char*)P.out + DO_FOXVT), TOK};
        pg8::gemm_phase<pg8::EpiStore, pg8::StaticOrder, true, true>(glds, g, S, E);
    }
    {
        const int cr = (cb + G - 64) % G;
        pg8::Gemm g{(const bf16*)(ws + WS_MEMN), (const bf16*)(ws + WS_WMKVT), 512, 1024, 2048, 2048, 2048}; pg8::StaticOrder S; S.init(512, 1024, G, cr);
        pg8::EpiStore E{(bf16*)(ws + WS_KMEM), 1024};
        pg8::gemm_phase<pg8::EpiStore, pg8::StaticOrder, true, true>(glds, g, S, E);
        const int cr2 = (cb + G - 72) % G;
        pg8::Gemm g2{(const bf16*)(ws + WS_WMKVT) + (size_t)1024 * 2048, (const bf16*)(ws + WS_MEMN), 1024, 512, 2048, 2048, 2048}; pg8::StaticOrder S2; S2.init(1024, 512, G, cr2);
        pg8::EpiStore E2{(bf16*)(ws + WS_VMT), 512};
        pg8::gemm_phase<pg8::EpiStore, pg8::StaticOrder, true, true>(glds, g2, S2, E2);
    }
#endif
    GRID_BAR();
#ifndef NO_P2
    phase2(P, lds, tid, lane, wave);
#endif
    GRID_BAR();
#ifndef NO_P3
    phase3(P, lds, tid, lane, wave);
#endif
    GRID_BAR();
#ifndef NO_GEMM
    {
        pg8::Gemm g{H, (const bf16*)(ws + WS_WGT), TOK, 6144, 2048, 2048, 2048}; pg8::StaticOrder S; S.init(TOK, 6144, G, cb);
        pg8::EpiSig E{(bf16*)((unsigned char*)P.out + DO_GA), proj + PC_GB, proj + PC_GM, 2048, LDP, LDP};
        pg8::gemm_phase<pg8::EpiSig, pg8::StaticOrder, true, true>(glds, g, S, E);
    }
    GRID_BAR();
    {
        bf16* Y = (bf16*)(ws + WS_Y); const bf16* WUPT = (const bf16*)(ws + WS_WUPT);
        pg8::StaticOrder S; S.init(TOK, 2048, G, cb);
        { pg8::Gemm g{proj + PC_OA, WUPT, TOK, 2048, 1024, LDP, 1024}; pg8::EpiGate<true> E{(const bf16*)((unsigned char*)P.out + DO_GA), 2048, Y, 2048};
          pg8::gemm_phase<pg8::EpiGate<true>, pg8::StaticOrder, true, true>(glds, g, S, E); }
        { pg8::Gemm g{proj + PC_OB, WUPT + (size_t)2048 * 1024, TOK, 2048, 1024, LDP, 1024}; pg8::EpiGate<false> E{proj + PC_GB, LDP, Y, 2048};
          pg8::gemm_phase<pg8::EpiGate<false>, pg8::StaticOrder, true, true>(glds, g, S, E); }
        { pg8::Gemm g{proj + PC_OM, WUPT + (size_t)2 * 2048 * 1024, TOK, 2048, 1024, LDP, 1024}; pg8::EpiGate<false> E{proj + PC_GM, LDP, Y, 2048};
          pg8::gemm_phase<pg8::EpiGate<false>, pg8::StaticOrder, true, true>(glds, g, S, E); }
    }
    GRID_BAR();
    {
        pg8::Gemm g{(const bf16*)(ws + WS_Y), (const bf16*)(ws + WS_WOT), TOK, 2048, 2048, 2048, 2048}; pg8::StaticOrder S; S.init(TOK, 2048, G, cb);
        pg8::EpiRes1 E{P.x, P.out, (bf16*)(ws + WS_X1B), (float*)(ws + WS_SSQ)};
        pg8::gemm_phase<pg8::EpiRes1, pg8::StaticOrder, true, true>(glds, g, S, E);
    }
    GRID_BAR();
    {
        pg8::Gemm g{(const bf16*)(ws + WS_X1B), (const bf16*)(ws + WS_WFF1T), TOK, 8192, 2048, 2048, 2048}; pg8::StaticOrder S; S.init(TOK, 8192, G, cb);
        pg8::EpiFF1 E{(const float*)(ws + WS_SSQ), (bf16*)(ws + WS_U), 8192};
        pg8::gemm_phase<pg8::EpiFF1, pg8::StaticOrder, true, true>(glds, g, S, E);
    }
    GRID_BAR();
    {
        pg8::Gemm g{(const bf16*)(ws + WS_U), (const bf16*)(ws + WS_WFF2T), TOK, 2048, 8192, 8192, 8192}; pg8::StaticOrder S; S.init(TOK, 2048, G, cb);
        pg8::EpiOut E{P.out};
        pg8::gemm_phase<pg8::EpiOut, pg8::StaticOrder, true, true>(glds, g, S, E);
    }
#endif
}

extern "C" void kernel_launch(void* const* d_in, const int* in_sizes, int n_in, void* d_out, int out_size, void* d_ws, size_t ws_size, hipStream_t stream) {
    static int grid = 0;
    if (grid == 0) {
        if (n_in != 22 || out_size != TOK * DM || ws_size < WS_END) { fprintf(stderr, "kernel_launch: unexpected shapes (n_in %d out %d ws %zu)\n", n_in, out_size, ws_size); grid = -1; return; }
        int dev = 0, cus = 0, per_cu = 0;
        hipGetDevice(&dev); hipDeviceGetAttribute(&cus, hipDeviceAttributeMultiprocessorCount, dev);
        if (hipFuncSetAttribute((const void*)hybrid_fwd, hipFuncAttributeMaxDynamicSharedMemorySize, LDS_BYTES) != hipSuccess) { fprintf(stderr, "kernel_launch: hipFuncSetAttribute failed\n"); grid = -1; return; }
        if (hipOccupancyMaxActiveBlocksPerMultiprocessor(&per_cu, (const void*)hybrid_fwd, 512, LDS_BYTES) != hipSuccess || per_cu < 1) { fprintf(stderr, "kernel_launch: occupancy query says %d\n", per_cu); per_cu = 1; }
        (void)hipGetLastError();
        grid = cus * 1;
        if (grid <= 0) grid = 256;
    }
    if (grid < 0) return;
    if (hipMemsetAsync((char*)d_ws + WS_CTL, 0, 65536, stream) != hipSuccess) { fprintf(stderr, "kernel_launch: memset failed\n"); return; }
    Params p{};
    const float** pp = (const float**)&p;
    for (int i = 0; i < 22; ++i) pp[i] = (const float*)d_in[i];
    p.out = (float*)d_out; p.ws = (unsigned char*)d_ws;
    void* args[] = {&p};
    hipError_t e = hipLaunchCooperativeKernel((const void*)hybrid_fwd, dim3(grid), dim3(512), args, LDS_BYTES, stream);
    if (e != hipSuccess) fprintf(stderr, "cooperative launch failed: %s (grid %d)\n", hipGetErrorString(e), grid);
}
```

```cpp
#include <hip/hip_runtime.h>
#include <hip/hip_cooperative_groups.h>
#include <cstdio>
#include <cstdint>
namespace cg = cooperative_groups;

namespace pg8 {
#define PG8_LAS __attribute__((address_space(3)))
typedef unsigned short bf16_t;
typedef short bf16x8 __attribute__((ext_vector_type(8)));
typedef float f32x4 __attribute__((ext_vector_type(4)));
typedef unsigned u32x4 __attribute__((ext_vector_type(4)));
constexpr int BM = 256, BK = 64, HALF = 128, HTB = HALF * BK * 2  , STAGE_BYTES = 8 * HTB, NXCD = 8, WGM = 8;

__host__ __device__ __forceinline__ int lds_byte(int r, int c) { const int st = (r >> 4) * 2 + (c >> 5), rr = r & 15, cc = c & 31, ob = rr * 64 + cc * 2; return st * 1024 + (ob ^ (((ob >> 9) & 1) << 5)); }
__host__ __device__ __forceinline__ void stage_rc(int b, int& R, int& C) { const int st = b / 1024, sb = b % 1024, swz = sb ^ (((sb >> 9) & 1) << 5); R = (st >> 1) * 16 + swz / 64; C = (st & 1) * 32 + (swz % 64) / 2; }
__host__ __device__ __forceinline__ int perm32(int rho) { const int n = rho >> 4, i = rho & 15; return 8 * (i >> 2) + 4 * n + (i & 3); }

struct Unit { int pm, pn; };
struct Gemm { const bf16_t* A; const bf16_t* Bt; int M, N, K, lda, ldb; };

struct StaticOrder {
    int nM, nN, nwg, G, c, wgm;
    __host__ __device__ void init(int M, int N, int G_, int c_, int wgm_ = WGM) { nM = M / BM; nN = N / BM; nwg = nM * nN; G = G_; c = c_; wgm = wgm_; }
    __host__ __device__ bool next(int i, Unit& u) const {
        const long L = (long)i * G + c; if (L >= nwg) return false;
        int wgid = (int)L; { const int q = nwg / NXCD, r = nwg % NXCD, xcd = wgid % NXCD, off = wgid / NXCD; wgid = (xcd < r ? xcd * (q + 1) : r * (q + 1) + (xcd - r) * q) + off; }
        const int nig = wgm * nN, gid = wgid / nig, fm = gid * wgm, gsz = (nM - fm) < wgm ? (nM - fm) : wgm;
        u.pm = fm + ((wgid % nig) % gsz); u.pn = (wgid % nig) / gsz; return true;
    }
    __device__ __forceinline__ void a_ready(const Unit&) const {}
    __device__ __forceinline__ void done(const Unit&) const {}
};

typedef float f32x2_cv __attribute__((ext_vector_type(2))); typedef __bf16 bf16x2_cv __attribute__((ext_vector_type(2)));
__device__ __forceinline__ unsigned cvt_pk_bf16(float lo, float hi) { f32x2_cv v = {lo, hi}; bf16x2_cv b = __builtin_convertvector(v, bf16x2_cv); return __builtin_bit_cast(unsigned, b); }
template <class Epi, class Sched, bool ALIGN_EPI = false, bool SP2 = false>
__device__ __forceinline__ void gemm_phase(PG8_LAS unsigned char* lds, const Gemm g, const Sched& S, const Epi& E) {
    int tid_ = threadIdx.x; asm volatile("" : "+v"(tid_));
    const int tid = tid_, wid = __builtin_amdgcn_readfirstlane(tid >> 6), lane = tid & 63, wr = wid >> 2, wc = wid & 3, fr = lane & 15, fq = lane >> 4;
    const int K = g.K, nt = K / BK;
    unsigned voffA[2], voffB[2];
#pragma unroll
    for (int i = 0; i < 2; ++i) { int R, C; stage_rc(tid * 16 + i * 8192, R, C); const int Rb = Epi::PERM ? ((R & ~31) + perm32(R & 31)) : R;
        voffA[i] = (unsigned)(R * g.lda + C) * 2u; voffB[i] = (unsigned)(Rb * g.ldb + C) * 2u; }
    const size_t kstep = (size_t)(BK * 2);
    const size_t hstepA = (size_t)HALF * g.lda * 2, hstepB = (size_t)HALF * g.ldb * 2;
    const size_t tstepA = 2 * hstepA, tstepB = 2 * hstepB;
    const unsigned ldsw = (unsigned)wid * 1024u;
    const int aoff = lds_byte(wr * 64 + fr, fq * 8), boff = lds_byte(wc * 32 + fr, fq * 8);
#define PG8_SA(b, h) (((b) * 2 + (h)) * HTB)
#define PG8_SB(b, h) ((4 + (b) * 2 + (h)) * HTB)
#define PG8_STAGE(bufoff, gbase, voff) do { _Pragma("unroll") for (int _i = 0; _i < 2; ++_i) \
        __builtin_amdgcn_global_load_lds((const unsigned*)((const char*)(gbase) + (voff)[_i]), (PG8_LAS unsigned*)(lds + (bufoff) + ldsw + _i * 8192), 16, 0, 0); } while (0)
#define PG8_LDA(dst, b, h) do { _Pragma("unroll") for (int m = 0; m < 4; ++m) _Pragma("unroll") for (int k = 0; k < 2; ++k) dst[m][k] = *(const PG8_LAS bf16x8*)(lds + PG8_SA(b, h) + aoff + m * 2048 + k * 1024); } while (0)
#define PG8_LDB(dst, b, h) do { _Pragma("unroll") for (int n = 0; n < 2; ++n) _Pragma("unroll") for (int k = 0; k < 2; ++k) dst[n][k] = *(const PG8_LAS bf16x8*)(lds + PG8_SB(b, h) + boff + n * 2048 + k * 1024); } while (0)
#define PG8_MMA(ai, bj, At, Bt) do { __builtin_amdgcn_s_setprio(1); _Pragma("unroll") for (int m = 0; m < 4; ++m) _Pragma("unroll") for (int n = 0; n < 2; ++n) _Pragma("unroll") for (int k = 0; k < 2; ++k) \
        acc[ai][bj][m][n] = __builtin_amdgcn_mfma_f32_16x16x32_bf16(Bt[n][k], At[m][k], acc[ai][bj][m][n], 0, 0, 0); __builtin_amdgcn_s_setprio(0); } while (0)
#define PG8_WAIT_V(n) asm volatile("s_waitcnt vmcnt(" #n ")" ::: "memory")
#define PG8_WAIT_L(n) asm volatile("s_waitcnt lgkmcnt(" #n ")" ::: "memory")
#define PG8_BAR __builtin_amdgcn_s_barrier()
#define PG8_SCHED __builtin_amdgcn_sched_barrier(0)
    Unit cur, nxt; int ui = 0;
    if (!S.next(0, cur)) return;
    f32x4 acc[2][2][4][2];
#pragma unroll
    for (int a = 0; a < 2; ++a)
#pragma unroll
        for (int b = 0; b < 2; ++b)
#pragma unroll
            for (int m = 0; m < 4; ++m)
#pragma unroll
                for (int n = 0; n < 2; ++n) acc[a][b][m][n] = (f32x4){0.f, 0.f, 0.f, 0.f};
    bf16x8 At[4][2], B0[2][2], B1[2][2];
    const char* cA = (const char*)g.A + (size_t)cur.pm * tstepA; const char* cB = (const char*)g.Bt + (size_t)cur.pn * tstepB;
    S.a_ready(cur);
    if constexpr (SP2) {
        PG8_STAGE(PG8_SB(0, 0), cB, voffB); PG8_STAGE(PG8_SB(0, 1), cB + hstepB, voffB); PG8_STAGE(PG8_SA(0, 0), cA, voffA); PG8_STAGE(PG8_SA(0, 1), cA + hstepA, voffA);
        if (wr == 1) PG8_BAR;
        PG8_WAIT_V(2); PG8_BAR;
        PG8_STAGE(PG8_SB(1, 0), cB + kstep, voffB); PG8_STAGE(PG8_SA(1, 0), cA + kstep, voffA); PG8_STAGE(PG8_SB(1, 1), cB + hstepB + kstep, voffB);
        PG8_WAIT_V(6); PG8_BAR;
    } else {
        PG8_STAGE(PG8_SB(0, 0), cB, voffB); PG8_STAGE(PG8_SA(0, 0), cA, voffA); PG8_STAGE(PG8_SB(0, 1), cB + hstepB, voffB); PG8_STAGE(PG8_SA(0, 1), cA + hstepA, voffA);
        if (wr == 1) PG8_BAR;
        PG8_WAIT_V(4); PG8_BAR;
        PG8_STAGE(PG8_SB(1, 0), cB + kstep, voffB); PG8_STAGE(PG8_SA(1, 0), cA + kstep, voffA); PG8_STAGE(PG8_SB(1, 1), cB + hstepB + kstep, voffB);
        PG8_WAIT_V(6); PG8_BAR;
    }
    for (;;) {
        const bool has_next = S.next(ui + 1, nxt);
        const char* nA = has_next ? (const char*)g.A + (size_t)nxt.pm * tstepA : cA; const char* nB = has_next ? (const char*)g.Bt + (size_t)nxt.pn * tstepB : cB;
        for (int t = 0; t < nt; t += 2) {
            const bool last = (t == nt - 2);
            const char* a1 = cA + (size_t)(t + 1) * kstep;
            const char* a2 = last ? nA : cA + (size_t)(t + 2) * kstep; const char* b2 = last ? nB : cB + (size_t)(t + 2) * kstep;
            const char* a3 = a2 + kstep; const char* b3 = b2 + kstep;
            if (last && has_next) S.a_ready(nxt);
            if constexpr (SP2) {
            PG8_LDB(B0, 0, 0); PG8_LDB(B1, 0, 1); PG8_SCHED; PG8_LDA(At, 0, 0); PG8_STAGE(PG8_SA(1, 1), a1 + hstepA, voffA);
            PG8_WAIT_V(8); PG8_WAIT_L(0); PG8_BAR; PG8_MMA(0, 0, At, B0); PG8_MMA(0, 1, At, B1); PG8_BAR; PG8_SCHED;
            PG8_LDA(At, 0, 1); PG8_STAGE(PG8_SB(0, 0), b2, voffB); PG8_STAGE(PG8_SB(0, 1), b2 + hstepB, voffB); PG8_STAGE(PG8_SA(0, 0), a2, voffA);
            PG8_WAIT_V(8); PG8_WAIT_L(0); PG8_BAR; PG8_MMA(1, 0, At, B0); PG8_MMA(1, 1, At, B1); PG8_BAR; PG8_SCHED;
            PG8_LDB(B0, 1, 0); PG8_LDB(B1, 1, 1); PG8_SCHED; PG8_LDA(At, 1, 0); PG8_STAGE(PG8_SA(0, 1), a2 + hstepA, voffA);
            PG8_WAIT_V(8); PG8_WAIT_L(0); PG8_BAR; PG8_MMA(0, 0, At, B0); PG8_MMA(0, 1, At, B1); PG8_BAR; PG8_SCHED;
            PG8_LDA(At, 1, 1); PG8_STAGE(PG8_SB(1, 0), b3, voffB); PG8_STAGE(PG8_SB(1, 1), b3 + hstepB, voffB); PG8_STAGE(PG8_SA(1, 0), a3, voffA);
            PG8_WAIT_V(8); PG8_WAIT_L(0); PG8_BAR; PG8_MMA(1, 0, At, B0); PG8_MMA(1, 1, At, B1); PG8_BAR; PG8_SCHED;
            } else {
            PG8_LDB(B0, 0, 0); PG8_SCHED; PG8_LDA(At, 0, 0); PG8_STAGE(PG8_SA(1, 1), a1 + hstepA, voffA);
            PG8_WAIT_L(8); PG8_BAR; PG8_WAIT_L(0); PG8_MMA(0, 0, At, B0); PG8_BAR; PG8_SCHED;
            PG8_LDB(B1, 0, 1); PG8_STAGE(PG8_SB(0, 0), b2, voffB);
            PG8_BAR; PG8_WAIT_L(0); PG8_MMA(0, 1, At, B1); PG8_BAR;
            PG8_LDA(At, 0, 1); PG8_STAGE(PG8_SA(0, 0), a2, voffA);
            PG8_BAR; PG8_WAIT_L(0); PG8_MMA(1, 0, At, B0); PG8_BAR; PG8_SCHED;
            PG8_STAGE(PG8_SB(0, 1), b2 + hstepB, voffB);
            PG8_WAIT_V(6); PG8_BAR; PG8_MMA(1, 1, At, B1); PG8_BAR;
            PG8_LDB(B0, 1, 0); PG8_SCHED; PG8_LDA(At, 1, 0); PG8_STAGE(PG8_SA(0, 1), a2 + hstepA, voffA);
            PG8_WAIT_L(8); PG8_BAR; PG8_WAIT_L(0); PG8_MMA(0, 0, At, B0); PG8_BAR; PG8_SCHED;
            PG8_LDB(B1, 1, 1); PG8_STAGE(PG8_SB(1, 0), b3, voffB);
            PG8_BAR; PG8_WAIT_L(0); PG8_MMA(0, 1, At, B1); PG8_BAR;
            PG8_LDA(At, 1, 1); PG8_STAGE(PG8_SA(1, 0), a3, voffA);
            PG8_BAR; PG8_WAIT_L(0); PG8_MMA(1, 0, At, B0); PG8_BAR; PG8_SCHED;
            PG8_STAGE(PG8_SB(1, 1), b3 + hstepB, voffB);
            PG8_WAIT_V(6); PG8_BAR; PG8_MMA(1, 1, At, B1); PG8_BAR;
            }
        }
        if constexpr (ALIGN_EPI) { if (wr == 0) PG8_BAR; }
        if constexpr (!Epi::AFTER_DRAIN) { E(acc, cur, wr, wc, fr, fq); S.done(cur); }
        if (!has_next) break;
#pragma unroll
        for (int a = 0; a < 2; ++a)
#pragma unroll
            for (int b = 0; b < 2; ++b)
#pragma unroll
                for (int m = 0; m < 4; ++m)
#pragma unroll
                    for (int n = 0; n < 2; ++n) acc[a][b][m][n] = (f32x4){0.f, 0.f, 0.f, 0.f};
        cur = nxt; cA = nA; cB = nB; ++ui;
        if constexpr (ALIGN_EPI) { if (wr == 1) PG8_BAR; }
    }
    PG8_WAIT_V(0);
    if constexpr (!ALIGN_EPI) { if (wr == 0) PG8_BAR; }
    PG8_BAR;
    if constexpr (Epi::AFTER_DRAIN) { E.fused(acc, cur, wr, wc, fr, fq, lds, wid, lane); S.done(cur); }
#undef PG8_SA
#undef PG8_SB
#undef PG8_STAGE
#undef PG8_LDA
#undef PG8_LDB
#undef PG8_MMA
#undef PG8_WAIT_V
#undef PG8_WAIT_L
#undef PG8_BAR
#undef PG8_SCHED
}
}

constexpr int TOK = 16384, SEQ = 8192, DM = 2048, DIN = 14360, DFF = 8192;
constexpr int LDP = 7168;
constexpr int PC_QA = 0, PC_KA = 1024, PC_VA = 2048, PC_Z = 3072, PC_FK = 4096, PC_FQ = 5120, PC_QM = 6144;
constexpr int PC_OA = 0, PC_OB = PC_FQ, PC_OM = PC_QM, PC_GB = 1024, PC_GM = 3072;
constexpr float EPSN = 1e-6f;
constexpr float LOG2E = 1.4426950408889634f;
constexpr size_t MiB = 1u << 20;
constexpr size_t WS_CTL = 0, WS_W1T = 1 * MiB, WS_WFVT = 30 * MiB, WS_WMKVT = 34 * MiB, WS_UC = 1 * MiB;
constexpr size_t WS_SMALL = 42 * MiB, WS_KMEM = 44 * MiB, WS_VMT = 45 * MiB, WS_CUM = 46 * MiB, WS_CDEC = 46 * MiB + 512 * 1024,
                 WS_MEMN = 47 * MiB, WS_SSQ = 49 * MiB, WS_RSTD = 51 * MiB;
constexpr size_t WS_WGT = 52 * MiB, WS_WUPT = 76 * MiB, WS_WOT = 88 * MiB, WS_WFF1T = 96 * MiB, WS_WFF2T = 128 * MiB;
constexpr size_t WS_PROJ = 160 * MiB, WS_GDN = 384 * MiB, WS_END = 496 * MiB;
constexpr int FOXVT_LD = TOK;
constexpr size_t WS_Y = 384 * MiB, WS_X1B = 160 * MiB, WS_U = 224 * MiB;
constexpr size_t DO_H = 0, DO_FOXVT = 64 * MiB, DO_GA = 64 * MiB;
constexpr int GDN_CHUNK_BYTES = 57344;
constexpr int LDS_BYTES = 163840;

#define LAS __attribute__((address_space(3)))
typedef unsigned short bf16;
typedef short bf16x8 __attribute__((ext_vector_type(8)));
typedef float f32x4 __attribute__((ext_vector_type(4)));
typedef float f32x16 __attribute__((ext_vector_type(16)));
typedef unsigned u32x4 __attribute__((ext_vector_type(4)));
typedef unsigned u32x2 __attribute__((ext_vector_type(2)));

__device__ __forceinline__ unsigned pk2(float lo, float hi) { return pg8::cvt_pk_bf16(lo, hi); }
__device__ __forceinline__ float bf2f(unsigned short v) { return __uint_as_float(((unsigned)v) << 16); }
__device__ __forceinline__ float bflo(unsigned w) { return __uint_as_float(w << 16); }
__device__ __forceinline__ float bfhi(unsigned w) { return __uint_as_float(w & 0xffff0000u); }
__device__ __forceinline__ int crow(int r, int hi) { return (r & 3) + 8 * (r >> 2) + 4 * hi; }
__device__ __forceinline__ float sigmoidf_(float x) { return 1.f / (1.f + __expf(-x)); }
__device__ __forceinline__ float softplusf_(float x) { return fmaxf(x, 0.f) + log1pf(__expf(-fabsf(x))); }

namespace pg8 {
struct EpiStore {
    static constexpr bool PERM = true, AFTER_DRAIN = false;
    bf16_t* O; int ldc;
    __device__ __forceinline__ void operator()(const f32x4 (&acc)[2][2][4][2], const Unit& u, int wr, int wc, int fr, int fq) const {
        const int row0 = u.pm * BM + wr * 64 + fr, col0 = u.pn * BM + wc * 32 + 8 * fq;
#pragma unroll
        for (int ai = 0; ai < 2; ++ai)
#pragma unroll
            for (int m = 0; m < 4; ++m) { bf16_t* rowp = O + (size_t)(row0 + ai * HALF + m * 16) * ldc + col0;
#pragma unroll
                for (int bj = 0; bj < 2; ++bj) { const f32x4 v0 = acc[ai][bj][m][0], v1 = acc[ai][bj][m][1];
                    u32x4 w; w.x = cvt_pk_bf16(v0[0], v0[1]); w.y = cvt_pk_bf16(v0[2], v0[3]); w.z = cvt_pk_bf16(v1[0], v1[1]); w.w = cvt_pk_bf16(v1[2], v1[3]);
                    *(u32x4*)(rowp + bj * HALF) = w; } }
    }
};
struct EpiProj {
    static constexpr bool PERM = true, AFTER_DRAIN = false;
    bf16_t* O; int ldc; float* small;
    __device__ __forceinline__ void operator()(const f32x4 (&acc)[2][2][4][2], const Unit& u, int wr, int wc, int fr, int fq) const {
        const int row0 = u.pm * BM + wr * 64 + fr;
        if (u.pn == 28) {
            if (wc == 0) {
#pragma unroll
                for (int ai = 0; ai < 2; ++ai)
#pragma unroll
                    for (int m = 0; m < 4; ++m) { float* p = small + (size_t)(row0 + ai * HALF + m * 16) * 32 + 8 * fq;
                        *(f32x4*)p = acc[ai][0][m][0]; *(f32x4*)(p + 4) = acc[ai][0][m][1]; }
            }
            return;
        }
        const int col0 = u.pn * BM + wc * 32 + 8 * fq;
#pragma unroll
        for (int ai = 0; ai < 2; ++ai)
#pragma unroll
            for (int m = 0; m < 4; ++m) { bf16_t* rowp = O + (size_t)(row0 + ai * HALF + m * 16) * ldc + col0;
#pragma unroll
                for (int bj = 0; bj < 2; ++bj) { const f32x4 v0 = acc[ai][bj][m][0], v1 = acc[ai][bj][m][1];
                    u32x4 w; w.x = cvt_pk_bf16(v0[0], v0[1]); w.y = cvt_pk_bf16(v0[2], v0[3]); w.z = cvt_pk_bf16(v1[0], v1[1]); w.w = cvt_pk_bf16(v1[2], v1[3]);
                    *(u32x4*)(rowp + bj * HALF) = w; } }
    }
};
struct EpiSig {
    static constexpr bool PERM = true, AFTER_DRAIN = false;
    bf16_t* O0; bf16_t* O1; bf16_t* O2; int ld0, ld1, ld2;
    __device__ __forceinline__ void operator()(const f32x4 (&acc)[2][2][4][2], const Unit& u, int wr, int wc, int fr, int fq) const {
        const int br = u.pn >> 3; bf16_t* O = br == 0 ? O0 : O1 + (size_t)(br - 1) * 2048; const int ldc = br == 0 ? ld0 : ld1;
        const int row0 = u.pm * BM + wr * 64 + fr, col0 = (u.pn & 7) * BM + wc * 32 + 8 * fq;
#pragma unroll
        for (int ai = 0; ai < 2; ++ai)
#pragma unroll
            for (int m = 0; m < 4; ++m) { bf16_t* rowp = O + (size_t)(row0 + ai * HALF + m * 16) * ldc + col0;
#pragma unroll
                for (int bj = 0; bj < 2; ++bj) { f32x4 v0 = acc[ai][bj][m][0], v1 = acc[ai][bj][m][1];
#pragma unroll
                    for (int e = 0; e < 4; ++e) { v0[e] = __builtin_amdgcn_rcpf(1.f + __builtin_amdgcn_exp2f(-1.4426950408889634f * v0[e])); v1[e] = __builtin_amdgcn_rcpf(1.f + __builtin_amdgcn_exp2f(-1.4426950408889634f * v1[e])); }
                    u32x4 w; w.x = cvt_pk_bf16(v0[0], v0[1]); w.y = cvt_pk_bf16(v0[2], v0[3]); w.z = cvt_pk_bf16(v1[0], v1[1]); w.w = cvt_pk_bf16(v1[2], v1[3]);
                    *(u32x4*)(rowp + bj * HALF) = w; } }
    }
};
template <bool FIRST> struct EpiGate {
    static constexpr bool PERM = true, AFTER_DRAIN = false;
    const bf16_t* G; int ldg; bf16_t* Y; int ldy;
    __device__ __forceinline__ void operator()(const f32x4 (&acc)[2][2][4][2], const Unit& u, int wr, int wc, int fr, int fq) const {
        const int row0 = u.pm * BM + wr * 64 + fr, col0 = u.pn * BM + wc * 32 + 8 * fq;
#pragma unroll
        for (int ai = 0; ai < 2; ++ai)
#pragma unroll
            for (int m = 0; m < 4; ++m) { const size_t r = (size_t)(row0 + ai * HALF + m * 16);
#pragma unroll
                for (int bj = 0; bj < 2; ++bj) { const f32x4 v0 = acc[ai][bj][m][0], v1 = acc[ai][bj][m][1];
                    const u32x4 g = *(const u32x4*)(G + r * ldg + col0 + bj * HALF);
                    float o[8];
                    o[0] = v0[0] * __uint_as_float(g.x << 16); o[1] = v0[1] * __uint_as_float(g.x & 0xffff0000u);
                    o[2] = v0[2] * __uint_as_float(g.y << 16); o[3] = v0[3] * __uint_as_float(g.y & 0xffff0000u);
                    o[4] = v1[0] * __uint_as_float(g.z << 16); o[5] = v1[1] * __uint_as_float(g.z & 0xffff0000u);
                    o[6] = v1[2] * __uint_as_float(g.w << 16); o[7] = v1[3] * __uint_as_float(g.w & 0xffff0000u);
                    bf16_t* yp = Y + r * ldy + col0 + bj * HALF;
                    if (!FIRST) { const u32x4 y = *(const u32x4*)yp;
                        o[0] += __uint_as_float(y.x << 16); o[1] += __uint_as_float(y.x & 0xffff0000u);
                        o[2] += __uint_as_float(y.y << 16); o[3] += __uint_as_float(y.y & 0xffff0000u);
                        o[4] += __uint_as_float(y.z << 16); o[5] += __uint_as_float(y.z & 0xffff0000u);
                        o[6] += __uint_as_float(y.w << 16); o[7] += __uint_as_float(y.w & 0xffff0000u); }
                    u32x4 w; w.x = cvt_pk_bf16(o[0], o[1]); w.y = cvt_pk_bf16(o[2], o[3]); w.z = cvt_pk_bf16(o[4], o[5]); w.w = cvt_pk_bf16(o[6], o[7]);
                    *(u32x4*)yp = w; } }
    }
};
struct EpiRes1 {
    static constexpr bool PERM = false, AFTER_DRAIN = false;
    const float* X; float* OUT; bf16_t* XB; float* SSQ;
    __device__ __forceinline__ void operator()(const f32x4 (&acc)[2][2][4][2], const Unit& u, int wr, int wc, int fr, int fq) const {
        const int row0 = u.pm * BM + wr * 64 + fr, col0 = u.pn * BM + wc * 32 + 4 * fq;
#pragma unroll
        for (int ai = 0; ai < 2; ++ai)
#pragma unroll
            for (int m = 0; m < 4; ++m) { const int row = row0 + ai * HALF + m * 16; const size_t off = (size_t)row * 2048 + col0; float s = 0.f;
#pragma unroll
                for (int bj = 0; bj < 2; ++bj)
#pragma unroll
                    for (int n = 0; n < 2; ++n) { const size_t o = off + bj * HALF + n * 16; const f32x4 xv = *(const f32x4*)(X + o); const f32x4 v = xv + acc[ai][bj][m][n];
                        *(f32x4*)(OUT + o) = v; u32x2 w; w.x = cvt_pk_bf16(v[0], v[1]); w.y = cvt_pk_bf16(v[2], v[3]); *(u32x2*)(XB + o) = w;
                        s += (v[0] * v[0] + v[1] * v[1]) + (v[2] * v[2] + v[3] * v[3]); }
                s += __shfl_xor(s, 16); s += __shfl_xor(s, 32);
                if (fq == 0) SSQ[(size_t)(u.pn * 4 + wc) * 16384 + row] = s; }
    }
};
struct EpiFF1 {
    static constexpr bool PERM = true, AFTER_DRAIN = false;
    const float* RSTD; bf16_t* O; int ldc;
    __device__ __forceinline__ void operator()(const f32x4 (&acc)[2][2][4][2], const Unit& u, int wr, int wc, int fr, int fq) const {
        const int row0 = u.pm * BM + wr * 64 + fr, col0 = u.pn * BM + wc * 32 + 8 * fq;
        float rs[2][4];
#pragma unroll
        for (int ai = 0; ai < 2; ++ai)
#pragma unroll
            for (int m = 0; m < 4; ++m) rs[ai][m] = RSTD[row0 + ai * HALF + m * 16];
#pragma unroll
        for (int ai = 0; ai < 2; ++ai)
#pragma unroll
            for (int m = 0; m < 4; ++m) { const int row = row0 + ai * HALF + m * 16; const float rstd = rs[ai][m];
                bf16_t* rowp = O + (size_t)row * ldc + col0;
#pragma unroll
                for (int bj = 0; bj < 2; ++bj) { f32x4 v0 = acc[ai][bj][m][0] * rstd, v1 = acc[ai][bj][m][1] * rstd;
#pragma unroll
                    for (int e = 0; e < 4; ++e) { const float a = fmaxf(v0[e], 0.f), b = fmaxf(v1[e], 0.f); v0[e] = a * a; v1[e] = b * b; }
                    u32x4 w; w.x = cvt_pk_bf16(v0[0], v0[1]); w.y = cvt_pk_bf16(v0[2], v0[3]); w.z = cvt_pk_bf16(v1[0], v1[1]); w.w = cvt_pk_bf16(v1[2], v1[3]);
                    *(u32x4*)(rowp + bj * HALF) = w; } }
    }
};
struct EpiOut {
    static constexpr bool PERM = false, AFTER_DRAIN = false;
    float* OUT;
    __device__ __forceinline__ void operator()(const f32x4 (&acc)[2][2][4][2], const Unit& u, int wr, int wc, int fr, int fq) const {
        const int row0 = u.pm * BM + wr * 64 + fr, col0 = u.pn * BM + wc * 32 + 4 * fq;
#pragma unroll
        for (int ai = 0; ai < 2; ++ai)
#pragma unroll
            for (int m = 0; m < 4; ++m) { const size_t off = (size_t)(row0 + ai * HALF + m * 16) * 2048 + col0;
#pragma unroll
                for (int bj = 0; bj < 2; ++bj)
#pragma unroll
                    for (int n = 0; n < 2; ++n) { const size_t o = off + bj * HALF + n * 16; *(f32x4*)(OUT + o) = *(const f32x4*)(OUT + o) + acc[ai][bj][m][n]; } }
    }
};
}

struct Params {
    const float *x, *mem, *g_mix, *w_in, *conv_w, *a_log, *dt_bias, *gdn_norm_g, *fox_b_f, *fox_q_norm, *fox_k_norm, *g_mem, *w_mem_kv,
                *mem_q_norm, *mem_k_norm, *w_up_gdn, *w_up_fox, *w_up_mem, *w_out, *g_mlp, *w_ff1, *w_ff2;
    float* out; unsigned char* ws;
};

__device__ __forceinline__ float wave_sum(float v) {
#pragma unroll
    for (int o = 1; o < 64; o <<= 1) v += __shfl_xor(v, o);
    return v;
}

__device__ __forceinline__ void transpose_item(const float* W, int ldw, int n0src, bf16* WT, int K, int row0dst, const float* kscale,
                                               LAS float* scr, int kb, int nb, int lane) {
    const int k0 = 64 * kb, n0 = 32 * nb;
    float tv[32];
#pragma unroll
    for (int i = 0; i < 32; ++i) tv[i] = W[(size_t)(k0 + 2 * i + (lane >> 5)) * ldw + n0src + n0 + (lane & 31)];
#pragma unroll
    for (int i = 0; i < 32; ++i) { const int kk = 2 * i + (lane >> 5); float v = tv[i];
        if (kscale) v *= kscale[k0 + kk]; scr[kk * 33 + (lane & 31)] = v; }
    asm volatile("s_waitcnt lgkmcnt(0)" ::: "memory");
    const int c = lane & 7;
#pragma unroll
    for (int j = 0; j < 4; ++j) { const int n = (lane >> 3) + 8 * j; const LAS float* s = scr + (8 * c) * 33 + n;
        u32x4 o; o.x = pk2(s[0 * 33], s[1 * 33]); o.y = pk2(s[2 * 33], s[3 * 33]); o.z = pk2(s[4 * 33], s[5 * 33]); o.w = pk2(s[6 * 33], s[7 * 33]);
        *(u32x4*)(WT + (size_t)(row0dst + n0 + n) * K + k0 + 8 * c) = o; }
    asm volatile("s_waitcnt lgkmcnt(0)" ::: "memory");
}
__device__ __forceinline__ void transpose_job(const float* W, int ldw, int n0src, int K, int ncols, bf16* WT, int row0dst, const float* kscale,
                                              LAS float* scr, int gw, int ngw, int lane) {
    const int nblk = ncols / 32, nitems = (K / 64) * nblk;
    for (int it = gw; it < nitems; it += ngw) transpose_item(W, ldw, n0src, WT, K, row0dst, kscale, scr, it / nblk, it % nblk, lane);
}
__device__ __forceinline__ void rms_row_to_bf16(const float* xrow, const float* g, bf16* orow, int lane) {
    const f32x4* xr = (const f32x4*)xrow + lane; const f32x4* gr = (const f32x4*)g + lane;
    f32x4 v[8]; float s = 0.f;
#pragma unroll
    for (int j = 0; j < 8; ++j) { v[j] = xr[64 * j]; s += (v[j].x * v[j].x + v[j].y * v[j].y) + (v[j].z * v[j].z + v[j].w * v[j].w); }
    const float rstd = rsqrtf(wave_sum(s) * (1.f / 2048.f) + EPSN);
    u32x2* o8 = (u32x2*)orow + lane;
#pragma unroll
    for (int j = 0; j < 8; ++j) { const f32x4 gg = gr[64 * j]; u32x2 w; w.x = pk2(v[j].x * rstd * gg.x, v[j].y * rstd * gg.y); w.y = pk2(v[j].z * rstd * gg.z, v[j].w * rstd * gg.w); o8[64 * j] = w; }
}

__device__ __forceinline__ void phase0(const Params& P, unsigned char* lds, int tid, int lane, int wave) {
    unsigned char* ws = P.ws;
    bf16* W1T = (bf16*)(ws + WS_W1T); bf16* WFVT = (bf16*)(ws + WS_WFVT); bf16* WMKVT = (bf16*)(ws + WS_WMKVT); bf16* WGT = (bf16*)(ws + WS_WGT);
    bf16* WUPT = (bf16*)(ws + WS_WUPT); bf16* WOT = (bf16*)(ws + WS_WOT); bf16* WFF1T = (bf16*)(ws + WS_WFF1T); bf16* WFF2T = (bf16*)(ws + WS_WFF2T);
    LAS float* scr = (LAS float*)((LAS unsigned char*)lds + wave * 16384);
    const int G = gridDim.x, gw = blockIdx.x * 8 + wave, ngw = G * 8;
    bf16* H = (bf16*)((unsigned char*)P.out + DO_H);
    for (int m = gw; m < TOK; m += ngw) rms_row_to_bf16(P.x + (size_t)m * DM, P.g_mix, H + (size_t)m * DM, lane);
    bf16* MEMN = (bf16*)(ws + WS_MEMN);
    for (int m = gw; m < 512; m += ngw) rms_row_to_bf16(P.mem + (size_t)m * DM, P.g_mem, MEMN + (size_t)m * DM, lane);
    transpose_job(P.w_in, DIN, 0, 2048, 4096, W1T, 0, nullptr, scr, gw, ngw, lane);
    transpose_job(P.w_in, DIN, 5136, 2048, 1024, W1T, PC_FK, nullptr, scr, gw, ngw, lane);
    transpose_job(P.w_in, DIN, 4112, 2048, 1024, W1T, PC_FQ, nullptr, scr, gw, ngw, lane);
    transpose_job(P.w_in, DIN, 7192, 2048, 1024, W1T, PC_QM, nullptr, scr, gw, ngw, lane);
    transpose_job(P.w_in, DIN, 6160, 2048, 1024, WFVT, 0, nullptr, scr, gw, ngw, lane);
    transpose_job(P.w_in, DIN, 8216, 2048, 6144, WGT, 0, nullptr, scr, gw, ngw, lane);
    transpose_job(P.w_mem_kv, 2048, 0, 2048, 2048, WMKVT, 0, nullptr, scr, gw, ngw, lane);
    transpose_job(P.w_up_gdn, 2048, 0, 1024, 2048, WUPT, 0, nullptr, scr, gw, ngw, lane);
    transpose_job(P.w_up_fox, 2048, 0, 1024, 2048, WUPT + (size_t)2048 * 1024, 0, nullptr, scr, gw, ngw, lane);
    transpose_job(P.w_up_mem, 2048, 0, 1024, 2048, WUPT + (size_t)2 * 2048 * 1024, 0, nullptr, scr, gw, ngw, lane);
    transpose_job(P.w_out, 2048, 0, 2048, 2048, WOT, 0, nullptr, scr, gw, ngw, lane);
    transpose_job(P.w_ff1, 8192, 0, 2048, 8192, WFF1T, 0, P.g_mlp, scr, gw, ngw, lane);
    transpose_job(P.w_ff2, 2048, 0, 8192, 2048, WFF2T, 0, nullptr, scr, gw, ngw, lane);
    for (int idx = blockIdx.x * 512 + tid; idx < 256 * 2048; idx += G * 512) {
        const int row = idx >> 11, k = idx & 2047; float v = 0.f;
        if (row < 24) { const int col = row < 8 ? 4096 + row : (row < 16 ? 4104 + (row - 8) : 7184 + (row - 16)); v = P.w_in[(size_t)k * DIN + col]; }
        W1T[(size_t)(7168 + row) * 2048 + k] = (bf16)(pk2(v, 0.f) & 0xffffu);
    }
}


__device__ __forceinline__ void gdn_prep_unit(const Params& P, unsigned char* lds_, int bh, int n, int tid, int lane, int wave) {
    float* qs = (float*)lds_;
    float* ks = qs + 64 * 132;
    float* vs = ks + 64 * 132;
    float* Mm = vs + 64 * 132;
    float* QKd = Mm + 4096;
    float* gam = QKd + 4096;
    float* beta = gam + 64;
    float* egam = beta + 64;
    const int b = bh >> 3, h = bh & 7;
    const size_t r0 = (size_t)b * SEQ + (size_t)n * 64;
    const bf16* proj = (const bf16*)(P.ws + WS_PROJ);
    const float* small = (const float*)(P.ws + WS_SMALL);
    if (tid < 384) {
        const int c8 = tid % 48, tg = tid / 48, mat = c8 >> 4, ch0 = (c8 & 15) * 8, col = mat * 1024 + h * 128 + ch0, tb = tg * 8;
        u32x4 xr[11];
#pragma unroll
        for (int i = 0; i < 11; ++i) { const int tt = n * 64 + tb - 3 + i;
            xr[i] = tt >= 0 ? *(const u32x4*)(proj + (r0 + tb - 3 + i) * LDP + col) : u32x4{0u, 0u, 0u, 0u}; }
        f32x4 w0[4], w1[4];
#pragma unroll
        for (int i = 0; i < 4; ++i) { w0[i] = *(const f32x4*)(P.conv_w + i * 3072 + col); w1[i] = *(const f32x4*)(P.conv_w + i * 3072 + col + 4); }
        float* dstb = (mat == 0 ? qs : (mat == 1 ? ks : vs)) + tb * 132 + ch0;
#pragma unroll
        for (int t = 0; t < 8; ++t) {
            float y[8];
#pragma unroll
            for (int e = 0; e < 8; ++e) y[e] = 0.f;
#pragma unroll
            for (int i = 0; i < 4; ++i) { const u32x4 xv = xr[t + i];
                y[0] += bflo(xv.x) * w0[i].x; y[1] += bfhi(xv.x) * w0[i].y; y[2] += bflo(xv.y) * w0[i].z; y[3] += bfhi(xv.y) * w0[i].w;
                y[4] += bflo(xv.z) * w1[i].x; y[5] += bfhi(xv.z) * w1[i].y; y[6] += bflo(xv.w) * w1[i].z; y[7] += bfhi(xv.w) * w1[i].w; }
            f32x4 o0, o1;
            o0.x = y[0] * __builtin_amdgcn_rcpf(1.f + __builtin_amdgcn_exp2f(-LOG2E * y[0])); o0.y = y[1] * __builtin_amdgcn_rcpf(1.f + __builtin_amdgcn_exp2f(-LOG2E * y[1]));
            o0.z = y[2] * __builtin_amdgcn_rcpf(1.f + __builtin_amdgcn_exp2f(-LOG2E * y[2])); o0.w = y[3] * __builtin_amdgcn_rcpf(1.f + __builtin_amdgcn_exp2f(-LOG2E * y[3]));
            o1.x = y[4] * __builtin_amdgcn_rcpf(1.f + __builtin_amdgcn_exp2f(-LOG2E * y[4])); o1.y = y[5] * __builtin_amdgcn_rcpf(1.f + __builtin_amdgcn_exp2f(-LOG2E * y[5]));
            o1.z = y[6] * __builtin_amdgcn_rcpf(1.f + __builtin_amdgcn_exp2f(-LOG2E * y[6])); o1.w = y[7] * __builtin_amdgcn_rcpf(1.f + __builtin_amdgcn_exp2f(-LOG2E * y[7]));
            *(f32x4*)(dstb + t * 132) = o0; *(f32x4*)(dstb + t * 132 + 4) = o1;
        }
    }
    if (wave == 7) {
        const float av = small[(r0 + lane) * 32 + 8 + h], bv = small[(r0 + lane) * 32 + h];
        float g = -__expf(P.a_log[h]) * softplusf_(av + P.dt_bias[h]);
#pragma unroll
        for (int o = 1; o < 64; o <<= 1) { const float t_ = __shfl_up(g, o); if (lane >= o) g += t_; }
        gam[lane] = g; egam[lane] = __expf(g); beta[lane] = sigmoidf_(bv);
    }
    __syncthreads();
    for (int rr = wave * 16; rr < wave * 16 + 16; ++rr) {
        float* row = (rr < 64 ? qs + rr * 132 : ks + (rr - 64) * 132);
        const float a = row[lane], c = row[lane + 64];
        const float ss = wave_sum(a * a + c * c);
        const float sc = rsqrtf(ss + EPSN) * (rr < 64 ? 0.08838834764831845f : 1.f);
        row[lane] = a * sc; row[lane + 64] = c * sc;
    }
    __syncthreads();
    {
        const int mat = tid >> 8, tt = tid & 255, ti = tt >> 4, tj = tt & 15;
        const float* A = mat == 0 ? ks : qs;
        float acc[4][4];
#pragma unroll
        for (int a = 0; a < 4; ++a)
#pragma unroll
            for (int c = 0; c < 4; ++c) acc[a][c] = 0.f;
        for (int d = 0; d < 128; d += 4) {
            f32x4 ra[4], rb[4];
#pragma unroll
            for (int a = 0; a < 4; ++a) ra[a] = *(const f32x4*)(A + (ti + 16 * a) * 132 + d);
#pragma unroll
            for (int c = 0; c < 4; ++c) rb[c] = *(const f32x4*)(ks + (tj + 16 * c) * 132 + d);
#pragma unroll
            for (int a = 0; a < 4; ++a)
#pragma unroll
                for (int c = 0; c < 4; ++c) acc[a][c] += (ra[a].x * rb[c].x + ra[a].y * rb[c].y) + (ra[a].z * rb[c].z + ra[a].w * rb[c].w);
        }
#pragma unroll
        for (int a = 0; a < 4; ++a)
#pragma unroll
            for (int c = 0; c < 4; ++c) { const int i = ti + 16 * a, j = tj + 16 * c;
                const float e = __expf(fminf(gam[i] - gam[j], 0.f));
                if (mat == 0) Mm[j * 64 + i] = (j < i) ? beta[i] * acc[a][c] * e : 0.f;
                else QKd[i * 64 + j] = (j <= i) ? acc[a][c] * e : 0.f; }
    }
    __syncthreads();
    unsigned char* gout = P.ws + WS_GDN + (size_t)(bh * 128 + n) * GDN_CHUNK_BYTES;
    unsigned char* uout = P.ws + WS_UC + (size_t)(bh * 128 + n) * 16384;
    const float glast = gam[63];
    for (int p = tid; p < 2560; p += 512) {
        float v[8]; unsigned char* dst;
        if (p < 1024) {
            const int f = p >> 6, ln = p & 63, rt = f >> 3, kk = f & 7, row = 32 * rt + (ln & 31), hi = ln >> 5;
            const float* src = qs + row * 132 + 16 * kk; const float sc = egam[row];
#pragma unroll
            for (int j = 0; j < 8; ++j) v[j] = src[crow(j, hi)] * sc;
            dst = gout + 16384 + (size_t)p * 16;
        } else if (p < 1536) {
            const int q = p - 1024, f = q >> 6, ln = q & 63, rt = f >> 2, kk = f & 3, row = 32 * rt + (ln & 31), hi = ln >> 5;
#pragma unroll
            for (int j = 0; j < 8; ++j) v[j] = QKd[row * 64 + 16 * kk + crow(j, hi)];
            dst = gout + 32768 + (size_t)q * 16;
        } else {
            const int q = p - 1536, f = q >> 6, ln = q & 63, rt = f >> 2, kk = f & 3, dk = 32 * rt + (ln & 31), hi = ln >> 5;
#pragma unroll
            for (int j = 0; j < 8; ++j) { const int tk = 16 * kk + crow(j, hi); v[j] = ks[tk * 132 + dk] * __expf(fminf(glast - gam[tk], 0.f)); }
            dst = gout + 40960 + (size_t)q * 16;
        }
        u32x4 o; o.x = pk2(v[0], v[1]); o.y = pk2(v[2], v[3]); o.z = pk2(v[4], v[5]); o.w = pk2(v[6], v[7]);
        *(u32x4*)dst = o;
    }
    if (tid == 0) ((float*)(P.ws + WS_CDEC))[bh * 128 + n] = __expf(glast);
    __syncthreads();
    if (tid < 256) {
        float* col = (tid < 128 ? ks : vs) + (tid & 127);
        int zero; asm volatile("v_mov_b32 %0, 0" : "=v"(zero));
#pragma unroll 8
        for (int i = 0; i < 64; ++i) col[i * 132] *= beta[i + zero] * (tid < 128 ? egam[i + zero] : 1.f);
#pragma unroll 1
        for (int ib = 0; ib < 4; ++ib) {
            float acc[16];
#pragma unroll
            for (int r = 0; r < 16; ++r) acc[r] = col[(ib * 16 + r) * 132];
#pragma unroll 4
            for (int j = 0; j < ib * 16; ++j) {
                const float xj = col[j * 132]; const float* mr = Mm + zero + j * 64 + ib * 16;
                const f32x4 m0 = *(const f32x4*)mr, m1 = *(const f32x4*)(mr + 4), m2 = *(const f32x4*)(mr + 8), m3 = *(const f32x4*)(mr + 12);
                acc[0] -= m0.x * xj; acc[1] -= m0.y * xj; acc[2] -= m0.z * xj; acc[3] -= m0.w * xj;
                acc[4] -= m1.x * xj; acc[5] -= m1.y * xj; acc[6] -= m1.z * xj; acc[7] -= m1.w * xj;
                acc[8] -= m2.x * xj; acc[9] -= m2.y * xj; acc[10] -= m2.z * xj; acc[11] -= m2.w * xj;
                acc[12] -= m3.x * xj; acc[13] -= m3.y * xj; acc[14] -= m3.z * xj; acc[15] -= m3.w * xj;
            }
#pragma unroll
            for (int r2 = 0; r2 < 15; ++r2) {
                const float* mr = Mm + (ib * 16 + r2) * 64 + ib * 16; float mm[16];
#pragma unroll
                for (int q = 0; q < 4; ++q) { const f32x4 t4 = *(const f32x4*)(mr + 4 * q); mm[4 * q] = t4.x; mm[4 * q + 1] = t4.y; mm[4 * q + 2] = t4.z; mm[4 * q + 3] = t4.w; }
#pragma unroll
                for (int r = r2 + 1; r < 16; ++r) acc[r] -= mm[r] * acc[r2];
            }
#pragma unroll
            for (int r = 0; r < 16; ++r) col[(ib * 16 + r) * 132] = acc[r];
        }
    }
    __syncthreads();
    for (int p = tid; p < 2048; p += 512) {
        float v[8]; unsigned char* dst;
        if (p < 1024) {
            const int f = p >> 6, ln = p & 63, rt = f >> 3, kk = f & 7, row = 32 * rt + (ln & 31), hi = ln >> 5;
            const float* src = ks + row * 132 + 16 * kk;
#pragma unroll
            for (int j = 0; j < 8; ++j) v[j] = -src[crow(j, hi)];
            dst = gout + (size_t)p * 16;
        } else {
            const int q = p - 1024, half = q & 1, ln = (q >> 1) & 63, g2 = q >> 7, rt = g2 & 1, w4 = g2 >> 1, hi = ln >> 5;
#pragma unroll
            for (int j = 0; j < 8; ++j) v[j] = vs[(32 * rt + crow(8 * half + j, hi)) * 132 + 32 * w4 + (ln & 31)];
            dst = uout + (size_t)q * 16;
        }
        u32x4 o; o.x = pk2(v[0], v[1]); o.y = pk2(v[2], v[3]); o.z = pk2(v[4], v[5]); o.w = pk2(v[6], v[7]);
        *(u32x4*)dst = o;
    }
    __syncthreads();
}

template <int GL, int NB> __device__ __forceinline__ void norm8b(bf16* const (&p)[NB], const bool (&ok)[NB], const float* gain, float mult, float inv_n) {
    u32x4 xv[NB];
#pragma unroll
    for (int b = 0; b < NB; ++b) xv[b] = ok[b] ? *(const u32x4*)p[b] : u32x4{0u, 0u, 0u, 0u};
    const f32x4 g0 = *(const f32x4*)gain, g1 = *(const f32x4*)(gain + 4);
#pragma unroll
    for (int b = 0; b < NB; ++b) {
        float v[8] = {bflo(xv[b].x), bfhi(xv[b].x), bflo(xv[b].y), bfhi(xv[b].y), bflo(xv[b].z), bfhi(xv[b].z), bflo(xv[b].w), bfhi(xv[b].w)};
        float ss = 0.f;
#pragma unroll
        for (int e = 0; e < 8; ++e) ss += v[e] * v[e];
#pragma unroll
        for (int o = 1; o < GL; o <<= 1) ss += __shfl_xor(ss, o);
        const float sc = rsqrtf(ss * inv_n + EPSN) * mult;
        u32x4 o; o.x = pk2(v[0] * sc * g0.x, v[1] * sc * g0.y); o.y = pk2(v[2] * sc * g0.z, v[3] * sc * g0.w);
        o.z = pk2(v[4] * sc * g1.x, v[5] * sc * g1.y); o.w = pk2(v[6] * sc * g1.z, v[7] * sc * g1.w);
        if (ok[b]) *(u32x4*)p[b] = o;
    }
}

__device__ __forceinline__ void phase2(const Params& P, unsigned char* lds, int tid, int lane, int wave) {
    const int G = gridDim.x;
    bf16* proj = (bf16*)(P.ws + WS_PROJ);
    if (blockIdx.x < 16) {
        const int bh = blockIdx.x, b = bh >> 3, h = bh & 7;
        const float* small = (const float*)(P.ws + WS_SMALL);
        float* cum = (float*)(P.ws + WS_CUM) + (size_t)bh * SEQ;
        float* wtot = (float*)lds;
        const float bf = P.fox_b_f[h];
        float v[16]; float run = 0.f;
#pragma unroll
        for (int e = 0; e < 16; ++e) { const float xx = small[((size_t)b * SEQ + tid * 16 + e) * 32 + 16 + h] + bf; run += -softplusf_(-xx) * LOG2E; v[e] = run; }
        float inc = run;
#pragma unroll
        for (int o = 1; o < 64; o <<= 1) { const float t_ = __shfl_up(inc, o); if (lane >= o) inc += t_; }
        if (lane == 63) wtot[wave] = inc;
        { float gq = tid < 128 ? fabsf(P.fox_q_norm[tid]) : 0.f, gk = tid < 128 ? fabsf(P.fox_k_norm[tid]) : 0.f;
#pragma unroll
          for (int o = 1; o < 64; o <<= 1) { gq = fmaxf(gq, __shfl_xor(gq, o)); gk = fmaxf(gk, __shfl_xor(gk, o)); }
          if (lane == 0) { wtot[8 + wave] = gq; wtot[16 + wave] = gk; } }
        __syncthreads();
        if (bh == 0 && tid == 0) { float gq = 0.f, gk = 0.f; for (int w = 0; w < 8; ++w) { gq = fmaxf(gq, wtot[8 + w]); gk = fmaxf(gk, wtot[16 + w]); }
            ((float*)(P.ws + WS_CDEC + 16384))[0] = 150.f + 2.f * 1.03f * (128.f * 0.08838834764831845f * LOG2E) * gq * gk; }
        float off = inc - run;
        for (int w = 0; w < wave; ++w) off += wtot[w];
#pragma unroll
        for (int e = 0; e < 16; ++e) cum[tid * 16 + e] = v[e] + off;
        __syncthreads();
    }
    for (int u = blockIdx.x; u < 2048; u += G) gdn_prep_unit(P, lds, u >> 7, u & 127, tid, lane, wave);
    for (int it0 = blockIdx.x; it0 < TOK / 2; it0 += 4 * G) {
        const int cidx = (tid & 255) * 8, isq = cidx >= 1024, d = cidx & 127;
        bf16* pp[4]; bool ok[4];
#pragma unroll
        for (int b = 0; b < 4; ++b) { const int it = it0 + b * G; ok[b] = it < TOK / 2; pp[b] = proj + (size_t)((ok[b] ? it : 0) * 2 + (tid >> 8)) * LDP + PC_FK + cidx; }
        norm8b<16, 4>(pp, ok, (isq ? P.fox_q_norm : P.fox_k_norm) + d, isq ? 0.08838834764831845f * LOG2E : 1.f, 1.f / 128.f);
    }
    for (int it0 = blockIdx.x; it0 < TOK / 4; it0 += 4 * G) {
        const int cidx = (tid & 127) * 8, d = cidx & 255;
        bf16* pp[4]; bool ok[4];
#pragma unroll
        for (int b = 0; b < 4; ++b) { const int it = it0 + b * G; ok[b] = it < TOK / 4; pp[b] = proj + (size_t)((ok[b] ? it : 0) * 4 + (tid >> 7)) * LDP + PC_QM + cidx; }
        norm8b<32, 4>(pp, ok, P.mem_q_norm + d, 0.0625f * LOG2E, 1.f / 256.f);
    }
    bf16* kmem = (bf16*)(P.ws + WS_KMEM);
    for (int it = blockIdx.x; it < 512 / 4; it += G) {
        const int cidx = (tid & 127) * 8, d = cidx & 255;
        bf16* pp[1] = {kmem + (size_t)(it * 4 + (tid >> 7)) * 1024 + cidx}; const bool ok[1] = {true};
        norm8b<32, 1>(pp, ok, P.mem_k_norm + d, 1.f, 1.f / 256.f);
    }
}

template <int DQK, bool FOX>
__device__ __forceinline__ void attn_unit(unsigned char* lds_, const bf16* Q, int ldq, const bf16* K, int ldk, const bf16* VT, int ldvt, bf16* O, int ldo,
                                          const float* cum, float skip_lim, int t0, int ntiles, int tid, int lane, int wave, int& dbg_tiles, unsigned char* dbg_ws = nullptr) {
    asm volatile("" : "+v"(tid), "+v"(lane));
    constexpr int KS = DQK / 16, KPITCH = DQK * 2 + 16, VPITCH = 136, ND = FOX ? 4 : 2, NH = (DQK / 32) / ND, VCH = ND / 2;
    constexpr int KCH = 64 * DQK / 8 / 512;
    LAS unsigned char* lds = (LAS unsigned char*)lds_;
    LAS unsigned char* Ks = lds; LAS unsigned char* VTs = lds + 64 * KPITCH; LAS float* cbs = (LAS float*)(lds + 64 * KPITCH + 128 * VPITCH);
    const int c = lane & 31, hi = lane >> 5;
    const int qrow = t0 + wave * 32 + c;
    bf16x8 qf[KS];
    { const bf16* qp = Q + (size_t)qrow * ldq + 8 * hi;
#pragma unroll
      for (int k = 0; k < KS; ++k) qf[k] = *(const bf16x8*)(qp + 16 * k); }
    float cref = 0.f; int jmin = 0;
    if (FOX) {
        cref = cum[t0];
        LAS int* jm = (LAS int*)(cbs + 64);
        if (wave < 2) { const int j = wave * 64 + lane; bool need = false; if (j < ntiles) need = (cref - cum[64 * j + 63]) >= -skip_lim;
            const unsigned long long mk = __ballot(need); if (lane == 0) jm[wave] = mk ? (int)__builtin_ctzll(mk) + wave * 64 : (1 << 20); }
        __syncthreads();
        jmin = min(min(jm[0], jm[1]), ntiles - 1);
        jmin = __builtin_amdgcn_readfirstlane(jmin);
    }
    dbg_tiles = 0;
#ifdef PROBE_TS
    if (FOX && dbg_ws && blockIdx.x == 16 && tid == 0) { volatile unsigned long long* dg_ = (volatile unsigned long long*)(dbg_ws + WS_CTL + 32768); dg_[16] += (unsigned long long)(ntiles - jmin) * 375ull; }
#endif
#pragma unroll 1
    for (int half = 0; half < NH; ++half) {
        f32x16 o[ND]; float m = -1e30f, l = 0.f;
#pragma unroll
        for (int d = 0; d < ND; ++d) o[d] = f32x16{};
        constexpr bool PREF = (DQK == 128);
        u32x4 kpre[KCH], vpre[VCH]; float cpre = 0.f;
#define ATT_PREFETCH(j_) do { const int kv0_ = 64 * (j_); \
            _Pragma("unroll") for (int i = 0; i < KCH; ++i) { const int id = tid + 512 * i, row = id / (DQK / 8), cc = id % (DQK / 8); kpre[i] = *(const u32x4*)(K + (size_t)(kv0_ + row) * ldk + cc * 8); } \
            _Pragma("unroll") for (int i = 0; i < VCH; ++i) { const int id = tid + 512 * i, row = id >> 3, cc = id & 7; vpre[i] = *(const u32x4*)(VT + (size_t)(half * ND * 32 + row) * ldvt + kv0_ + cc * 8); } \
            if (FOX) { if (tid < 64) cpre = cum[kv0_ + tid] - cref; } } while (0)
        if (PREF) ATT_PREFETCH(jmin);
#pragma unroll 1
        for (int j = jmin; j < ntiles; ++j) {
            __syncthreads();
            if (!PREF) ATT_PREFETCH(j);
#pragma unroll
            for (int i = 0; i < KCH; ++i) { const int id = tid + 512 * i, row = id / (DQK / 8), cc = id % (DQK / 8); *(LAS u32x4*)(Ks + row * KPITCH + cc * 16) = kpre[i]; }
#pragma unroll
            for (int i = 0; i < VCH; ++i) { const int id = tid + 512 * i, row = id >> 3, cc = id & 7; LAS u32x2* d2 = (LAS u32x2*)(VTs + row * VPITCH + cc * 16);
                d2[0] = (u32x2){vpre[i].x, vpre[i].y}; d2[1] = (u32x2){vpre[i].z, vpre[i].w}; }
            if (FOX) { if (tid < 64) cbs[tid] = cpre; }
            __syncthreads();
            if (PREF && j + 1 < ntiles) ATT_PREFETCH(j + 1);
            const int kv0 = 64 * j;
            if (FOX && kv0 > t0 + wave * 32 + 31) continue;
            f32x16 p0 = f32x16{}, p1 = f32x16{};
            const LAS unsigned char* vb = VTs + c * VPITCH + hi * 8;
            u32x2 vlo[FOX ? 8 : 1], vhh[FOX ? 8 : 1];
            if constexpr (FOX) {
                const LAS unsigned char* kb = Ks + c * KPITCH + hi * 16;
                bf16x8 kf[2 * KS];
#pragma unroll
                for (int k = 0; k < KS; ++k) { kf[2 * k] = *(const LAS bf16x8*)(kb + k * 32); kf[2 * k + 1] = *(const LAS bf16x8*)(kb + 32 * KPITCH + k * 32); }
                __builtin_amdgcn_sched_barrier(0);
#pragma unroll
                for (int k = 0; k < KS; ++k) {
                    p0 = __builtin_amdgcn_mfma_f32_32x32x16_bf16(kf[2 * k], qf[k], p0, 0, 0, 0);
                    p1 = __builtin_amdgcn_mfma_f32_32x32x16_bf16(kf[2 * k + 1], qf[k], p1, 0, 0, 0); }
                __builtin_amdgcn_sched_barrier(0);
#pragma unroll
                for (int d = 0; d < 2; ++d)
#pragma unroll
                    for (int cc = 0; cc < 4; ++cc) { vlo[d * 4 + cc] = *(const LAS u32x2*)(vb + d * 32 * VPITCH + cc * 32); vhh[d * 4 + cc] = *(const LAS u32x2*)(vb + d * 32 * VPITCH + cc * 32 + 16); }
                __builtin_amdgcn_sched_barrier(0);
            } else {
                const LAS unsigned char* kb = Ks + c * KPITCH + hi * 16;
#pragma unroll
                for (int k = 0; k < KS; ++k) {
                    const bf16x8 a0 = *(const LAS bf16x8*)(kb + k * 32), a1 = *(const LAS bf16x8*)(kb + 32 * KPITCH + k * 32);
                    p0 = __builtin_amdgcn_mfma_f32_32x32x16_bf16(a0, qf[k], p0, 0, 0, 0);
                    p1 = __builtin_amdgcn_mfma_f32_32x32x16_bf16(a1, qf[k], p1, 0, 0, 0); }
            }
            if (FOX) {
#pragma unroll
                for (int r4 = 0; r4 < 4; ++r4) { const f32x4 b0 = *(const LAS f32x4*)(cbs + 8 * r4 + 4 * hi), b1 = *(const LAS f32x4*)(cbs + 32 + 8 * r4 + 4 * hi);
#pragma unroll
                    for (int e = 0; e < 4; ++e) { p0[4 * r4 + e] -= b0[e]; p1[4 * r4 + e] -= b1[e]; } }
                if (kv0 + 63 > t0 + wave * 32) {
#pragma unroll
                    for (int r = 0; r < 16; ++r) { const int kv = kv0 + crow(r, hi); if (kv > qrow) p0[r] = -INFINITY; if (kv + 32 > qrow) p1[r] = -INFINITY; }
                }
            }
            float mx = p0[0];
#pragma unroll
            for (int r = 1; r < 16; ++r) mx = fmaxf(mx, p0[r]);
#pragma unroll
            for (int r = 0; r < 16; ++r) mx = fmaxf(mx, p1[r]);
            mx = fmaxf(mx, __shfl_xor(mx, 32));
            const float mn = fmaxf(m, mx), alpha = __builtin_amdgcn_exp2f(m - mn); m = mn;
            float ps = 0.f;
#pragma unroll
            for (int r = 0; r < 16; ++r) { p0[r] = __builtin_amdgcn_exp2f(p0[r] - mn); p1[r] = __builtin_amdgcn_exp2f(p1[r] - mn); ps += p0[r] + p1[r]; }
            l = l * alpha + ps;
#pragma unroll
            for (int d = 0; d < ND; ++d)
#pragma unroll
                for (int r = 0; r < 16; ++r) o[d][r] *= alpha;
            bf16x8 pb[4];
#pragma unroll
            for (int cc = 0; cc < 4; ++cc) { u32x4 w;
                if (cc < 2) { w.x = pk2(p0[8 * cc + 0], p0[8 * cc + 1]); w.y = pk2(p0[8 * cc + 2], p0[8 * cc + 3]); w.z = pk2(p0[8 * cc + 4], p0[8 * cc + 5]); w.w = pk2(p0[8 * cc + 6], p0[8 * cc + 7]); }
                else { const int c2 = cc - 2; w.x = pk2(p1[8 * c2 + 0], p1[8 * c2 + 1]); w.y = pk2(p1[8 * c2 + 2], p1[8 * c2 + 3]); w.z = pk2(p1[8 * c2 + 4], p1[8 * c2 + 5]); w.w = pk2(p1[8 * c2 + 6], p1[8 * c2 + 7]); }
                pb[cc] = __builtin_bit_cast(bf16x8, w); }
            if constexpr (FOX) {
                u32x2 wlo[8], whh[8];
#pragma unroll
                for (int d = 0; d < 2; ++d)
#pragma unroll
                    for (int cc = 0; cc < 4; ++cc) { wlo[d * 4 + cc] = *(const LAS u32x2*)(vb + (d + 2) * 32 * VPITCH + cc * 32); whh[d * 4 + cc] = *(const LAS u32x2*)(vb + (d + 2) * 32 * VPITCH + cc * 32 + 16); }
                __builtin_amdgcn_sched_barrier(0);
#pragma unroll
                for (int cc = 0; cc < 4; ++cc)
#pragma unroll
                    for (int d = 0; d < 2; ++d) { const u32x4 av = (u32x4){vlo[d * 4 + cc].x, vlo[d * 4 + cc].y, vhh[d * 4 + cc].x, vhh[d * 4 + cc].y};
                        o[d] = __builtin_amdgcn_mfma_f32_32x32x16_bf16(__builtin_bit_cast(bf16x8, av), pb[cc], o[d], 0, 0, 0); }
                __builtin_amdgcn_sched_barrier(0);
#pragma unroll
                for (int cc = 0; cc < 4; ++cc)
#pragma unroll
                    for (int d = 0; d < 2; ++d) { const u32x4 av = (u32x4){wlo[d * 4 + cc].x, wlo[d * 4 + cc].y, whh[d * 4 + cc].x, whh[d * 4 + cc].y};
                        o[d + 2] = __builtin_amdgcn_mfma_f32_32x32x16_bf16(__builtin_bit_cast(bf16x8, av), pb[cc], o[d + 2], 0, 0, 0); }
            } else {
#pragma unroll
              for (int d = 0; d < ND; ++d)
#pragma unroll
                  for (int cc = 0; cc < 4; ++cc) {
                      const u32x2 lo = *(const LAS u32x2*)(vb + d * 32 * VPITCH + cc * 32), hh = *(const LAS u32x2*)(vb + d * 32 * VPITCH + cc * 32 + 16);
                      const u32x4 av = (u32x4){lo.x, lo.y, hh.x, hh.y};
                      o[d] = __builtin_amdgcn_mfma_f32_32x32x16_bf16(__builtin_bit_cast(bf16x8, av), pb[cc], o[d], 0, 0, 0); } }
        }
        l += __shfl_xor(l, 32);
        const float rl = 1.f / l;
        bf16* op = O + (size_t)qrow * ldo + half * ND * 32 + 4 * hi;
#pragma unroll
        for (int d = 0; d < ND; ++d)
#pragma unroll
            for (int r4 = 0; r4 < 4; ++r4) { u32x2 w; w.x = pk2(o[d][4 * r4 + 0] * rl, o[d][4 * r4 + 1] * rl); w.y = pk2(o[d][4 * r4 + 2] * rl, o[d][4 * r4 + 3] * rl);
                *(u32x2*)(op + 32 * d + 8 * r4) = w; }
    }
    __syncthreads();
}

__device__ __forceinline__ void gdn_scan_wg(const Params& P, unsigned char* lds_, int bh, int tid, int lane, int wave) {
    LAS unsigned char* lds = (LAS unsigned char*)lds_;
    const int b = bh >> 3, h = bh & 7;
    const unsigned char* gsrc = P.ws + WS_GDN + (size_t)bh * 128 * GDN_CHUNK_BYTES;
    const unsigned char* usrc = P.ws + WS_UC + (size_t)bh * 128 * 16384;
    const float* cdec = (const float*)(P.ws + WS_CDEC) + bh * 128;
    bf16* proj = (bf16*)(P.ws + WS_PROJ);
#define SCAN_BAR() asm volatile("s_waitcnt lgkmcnt(0)\n\ts_barrier" ::: "memory")
    constexpr int OB = 114688;
    if (wave >= 4) {
        const int lt = tid - 256, tk = lt >> 2, q4 = lt & 3;
        const size_t rowb = (size_t)b * SEQ + tk;
        bf16* obase = proj + rowb * LDP + PC_OA + h * 128 + q4 * 32;
        u32x4 r[14];
#pragma unroll
        for (int k = 0; k < 14; ++k) r[k] = *(const u32x4*)(gsrc + (size_t)(lt + 256 * k) * 16);
#pragma unroll
        for (int k = 0; k < 14; ++k) *(LAS u32x4*)(lds + (lt + 256 * k) * 16) = r[k];
#pragma unroll
        for (int k = 0; k < 14; ++k) r[k] = *(const u32x4*)(gsrc + (size_t)GDN_CHUNK_BYTES + (size_t)(lt + 256 * k) * 16);
        __syncthreads();
#define GDN_NORM(CH) do { const LAS unsigned char* ob_ = lds + OB + ((CH) & 1) * 16384 + tk * 256 + q4 * 64; bf16* op_ = obase + (size_t)(CH) * 64 * LDP; \
            _Pragma("unroll") for (int i = 0; i < 4; ++i) { const u32x4 w_ = *(const LAS u32x4*)(ob_ + i * 16); *(u32x4*)(op_ + 8 * i) = w_; } } while (0)
#pragma unroll 1
        for (int n = 0; n < 128; ++n) {
            if (n + 1 < 128) {
                LAS unsigned char* d = lds + ((n + 1) & 1) * GDN_CHUNK_BYTES;
#pragma unroll
                for (int k = 0; k < 14; ++k) *(LAS u32x4*)(d + (lt + 256 * k) * 16) = r[k];
            }
            if (n + 2 < 128) {
                const unsigned char* s2 = gsrc + (size_t)(n + 2) * GDN_CHUNK_BYTES;
#pragma unroll
                for (int k = 0; k < 14; ++k) r[k] = *(const u32x4*)(s2 + (size_t)(lt + 256 * k) * 16);
            }
            if (n > 0) GDN_NORM(n - 1);
            SCAN_BAR();
        }
        GDN_NORM(127);
#undef GDN_NORM
    } else {
        const int w4 = wave, c = lane & 31, hi = lane >> 5;
        f32x16 S[4];
#pragma unroll
        for (int t = 0; t < 4; ++t) S[t] = f32x16{};
        bf16x8 Sb[8];
#pragma unroll
        for (int k = 0; k < 8; ++k) Sb[k] = bf16x8{};
        u32x4 ucn[4];
#pragma unroll
        for (int i = 0; i < 4; ++i) ucn[i] = *(const u32x4*)(usrc + (size_t)((w4 * 2 + (i >> 1)) * 64 + lane) * 32 + (i & 1) * 16);
        float cdn = cdec[0];
        __syncthreads();
#pragma unroll 1
        for (int n = 0; n < 128; ++n) {
            const LAS unsigned char* fb = lds + (n & 1) * GDN_CHUNK_BYTES + lane * 16;
            f32x16 U[2];
#pragma unroll
            for (int rt = 0; rt < 2; ++rt) { const u32x4 a = ucn[2 * rt], bq = ucn[2 * rt + 1];
                U[rt][0] = bflo(a.x); U[rt][1] = bfhi(a.x); U[rt][2] = bflo(a.y); U[rt][3] = bfhi(a.y); U[rt][4] = bflo(a.z); U[rt][5] = bfhi(a.z); U[rt][6] = bflo(a.w); U[rt][7] = bfhi(a.w);
                U[rt][8] = bflo(bq.x); U[rt][9] = bfhi(bq.x); U[rt][10] = bflo(bq.y); U[rt][11] = bfhi(bq.y); U[rt][12] = bflo(bq.z); U[rt][13] = bfhi(bq.z); U[rt][14] = bflo(bq.w); U[rt][15] = bfhi(bq.w); }
            const float cd = cdn;
            if (n + 1 < 128) {
                const unsigned char* us = usrc + (size_t)(n + 1) * 16384;
#pragma unroll
                for (int i = 0; i < 4; ++i) ucn[i] = *(const u32x4*)(us + (size_t)((w4 * 2 + (i >> 1)) * 64 + lane) * 32 + (i & 1) * 16);
                cdn = cdec[n + 1];
            }
#define FRAG(off) (*(const LAS bf16x8*)(fb + (off)))
#define SBAR() __builtin_amdgcn_sched_barrier(0)
            bf16x8 A0[8], A1[8];
#pragma unroll
            for (int i = 0; i < 8; ++i) A0[i] = FRAG(((i & 1) * 8 + (i >> 1)) * 1024);
            SBAR();
#pragma unroll
            for (int i = 0; i < 8; ++i) A1[i] = FRAG(((i & 1) * 8 + 4 + (i >> 1)) * 1024);
            SBAR();
#pragma unroll
            for (int i = 0; i < 8; ++i) U[i & 1] = __builtin_amdgcn_mfma_f32_32x32x16_bf16(A0[i], Sb[i >> 1], U[i & 1], 0, 0, 0);
            SBAR();
#pragma unroll
            for (int i = 0; i < 8; ++i) A0[i] = FRAG(16384 + ((i & 1) * 8 + (i >> 1)) * 1024);
            SBAR();
#pragma unroll
            for (int i = 0; i < 8; ++i) U[i & 1] = __builtin_amdgcn_mfma_f32_32x32x16_bf16(A1[i], Sb[4 + (i >> 1)], U[i & 1], 0, 0, 0);
            SBAR();
#pragma unroll
            for (int i = 0; i < 8; ++i) A1[i] = FRAG(16384 + ((i & 1) * 8 + 4 + (i >> 1)) * 1024);
            SBAR();
            f32x16 Ov[2]; Ov[0] = f32x16{}; Ov[1] = f32x16{};
#pragma unroll
            for (int i = 0; i < 8; ++i) Ov[i & 1] = __builtin_amdgcn_mfma_f32_32x32x16_bf16(A0[i], Sb[i >> 1], Ov[i & 1], 0, 0, 0);
            SBAR();
#pragma unroll
            for (int i = 0; i < 8; ++i) A0[i] = FRAG(32768 + ((i & 1) * 4 + (i >> 1)) * 1024);
            SBAR();
#pragma unroll
            for (int i = 0; i < 8; ++i) Ov[i & 1] = __builtin_amdgcn_mfma_f32_32x32x16_bf16(A1[i], Sb[4 + (i >> 1)], Ov[i & 1], 0, 0, 0);
            SBAR();
            bf16x8 Ub[4];
#pragma unroll
            for (int k2 = 0; k2 < 4; ++k2) { const f32x16& uu = U[k2 >> 1]; const int o8 = 8 * (k2 & 1); u32x4 w;
                w.x = pk2(uu[o8 + 0], uu[o8 + 1]); w.y = pk2(uu[o8 + 2], uu[o8 + 3]); w.z = pk2(uu[o8 + 4], uu[o8 + 5]); w.w = pk2(uu[o8 + 6], uu[o8 + 7]); Ub[k2] = __builtin_bit_cast(bf16x8, w); }
#pragma unroll
            for (int i = 0; i < 8; ++i) A1[i] = FRAG(40960 + ((i & 3) * 4 + (i >> 2)) * 1024);
            SBAR();
#pragma unroll
            for (int i = 0; i < 8; ++i) Ov[i & 1] = __builtin_amdgcn_mfma_f32_32x32x16_bf16(A0[i], Ub[i >> 1], Ov[i & 1], 0, 0, 0);
            SBAR();
#pragma unroll
            for (int i = 0; i < 8; ++i) A0[i] = FRAG(40960 + ((i & 3) * 4 + 2 + (i >> 2)) * 1024);
            SBAR();
#pragma unroll
            for (int t = 0; t < 4; ++t)
#pragma unroll
                for (int r = 0; r < 16; ++r) S[t][r] *= cd;
#pragma unroll
            for (int i = 0; i < 8; ++i) S[i & 3] = __builtin_amdgcn_mfma_f32_32x32x16_bf16(A1[i], Ub[i >> 2], S[i & 3], 0, 0, 0);
            SBAR();
#pragma unroll
            for (int i = 0; i < 8; ++i) S[i & 3] = __builtin_amdgcn_mfma_f32_32x32x16_bf16(A0[i], Ub[2 + (i >> 2)], S[i & 3], 0, 0, 0);
            SBAR();
            { LAS bf16* ob = (LAS bf16*)(lds + OB + (n & 1) * 16384);
#pragma unroll
              for (int rt = 0; rt < 2; ++rt)
#pragma unroll
                  for (int r = 0; r < 16; ++r) ob[(32 * rt + crow(r, hi)) * 128 + 32 * w4 + c] = (bf16)(pk2(Ov[rt][r], 0.f) & 0xffffu); }
#pragma unroll
            for (int k = 0; k < 8; ++k) { const f32x16& ss = S[k >> 1]; const int o8 = 8 * (k & 1); u32x4 w;
                w.x = pk2(ss[o8 + 0], ss[o8 + 1]); w.y = pk2(ss[o8 + 2], ss[o8 + 3]); w.z = pk2(ss[o8 + 4], ss[o8 + 5]); w.w = pk2(ss[o8 + 6], ss[o8 + 7]); Sb[k] = __builtin_bit_cast(bf16x8, w); }
#undef FRAG
#undef SBAR
            SCAN_BAR();
        }
    }
    __syncthreads();
}

__device__ __forceinline__ void phase3(const Params& P, unsigned char* lds, int tid, int lane, int wave) {
    bf16* proj = (bf16*)(P.ws + WS_PROJ);
#ifndef NO_SCAN
    if (blockIdx.x < 16) gdn_scan_wg(P, lds, blockIdx.x, tid, lane, wave);
#endif
#ifdef PROBE_TS
    if (blockIdx.x == 0 && tid == 0) ((volatile unsigned long long*)(P.ws + WS_CTL + 32768))[10] = __builtin_amdgcn_s_memrealtime();
#endif
    unsigned* ctr = (unsigned*)(P.ws + WS_CTL);
    LAS unsigned* sh = (LAS unsigned*)((LAS unsigned char*)lds + LDS_BYTES - 64);
    const bf16* foxvt = (const bf16*)((const unsigned char*)P.out + DO_FOXVT);
    const float* cum = (const float*)(P.ws + WS_CUM);
    const bf16* kmem = (const bf16*)(P.ws + WS_KMEM); const bf16* vmt = (const bf16*)(P.ws + WS_VMT);
#ifdef STATIC_P3
    for (unsigned idx_ = (blockIdx.x < 16 ? 100000u : blockIdx.x - 16u); idx_ < 768u; idx_ += 240u) {
        const unsigned idx = __builtin_amdgcn_readfirstlane(idx_);
#else
    for (;;) {
        if (tid == 0) sh[0] = atomicAdd(ctr, 1u);
        __syncthreads();
        const unsigned idx = __builtin_amdgcn_readfirstlane(sh[0]);
        __syncthreads();
        if (idx >= 512u + 256u) break;
#endif
        int dbg_t = 0;
#ifdef PROBE_TS
        if (blockIdx.x == 16 && tid == 0) ((volatile unsigned long long*)(P.ws + WS_CTL + 32768))[20] = __builtin_amdgcn_s_memrealtime();
#endif
        if (idx < 512u) {
#ifndef NO_FOXATT
            const int qb = 31 - (int)(idx >> 4), bh = idx & 15, b = bh >> 3, h = bh & 7;
            bf16* Qp = proj + (size_t)b * SEQ * LDP + PC_FQ + h * 128;
            const bf16* Kp = proj + (size_t)b * SEQ * LDP + PC_FK + h * 128;
            const bf16* Vp = foxvt + (size_t)(h * 128) * TOK + (size_t)b * SEQ;
            attn_unit<128, true>(lds, Qp, LDP, Kp, LDP, Vp, TOK, Qp, LDP, cum + (size_t)bh * SEQ, ((const float*)(P.ws + WS_CDEC + 16384))[0], qb * 256, (qb + 1) * 4, tid, lane, wave, dbg_t, P.ws);
#ifdef PROBE_TS
            if (blockIdx.x == 16 && tid == 0) { volatile unsigned long long* dg = (volatile unsigned long long*)(P.ws + WS_CTL + 32768); dg[14] += __builtin_amdgcn_s_memrealtime() - dg[20]; }
#endif
#endif
        } else {
#ifndef NO_MEMATT
            const int u = idx - 512, qb = u & 31, bh = u >> 5, b = bh >> 2, h = bh & 3;
            bf16* Qp = proj + (size_t)b * SEQ * LDP + PC_QM + h * 256;
            const bf16* Kp = kmem + (size_t)b * 256 * 1024 + h * 256;
            const bf16* Vp = vmt + (size_t)(h * 256) * 512 + b * 256;
            attn_unit<256, false>(lds, Qp, LDP, Kp, 1024, Vp, 512, Qp, LDP, nullptr, 0.f, qb * 256, 4, tid, lane, wave, dbg_t);
#ifdef PROBE_TS
            if (blockIdx.x == 16 && tid == 0) { volatile unsigned long long* dg = (volatile unsigned long long*)(P.ws + WS_CTL + 32768); dg[18] += __builtin_amdgcn_s_memrealtime() - dg[20]; }
#endif
#endif
        }
    }
#ifdef PROBE_TS
    if (blockIdx.x == 0 && tid == 0) ((volatile unsigned long long*)(P.ws + WS_CTL + 32768))[11] = __builtin_amdgcn_s_memrealtime();
#endif
}


__device__ __forceinline__ void gdn_gate_norm_pass(const Params& P, int tid) {
    bf16* proj = (bf16*)(P.ws + WS_PROJ);
    const int cidx = (tid & 127) * 8, d = cidx & 127;
    const f32x4 g0 = *(const f32x4*)(P.gdn_norm_g + d), g1 = *(const f32x4*)(P.gdn_norm_g + d + 4);
    const float gg[8] = {g0.x, g0.y, g0.z, g0.w, g1.x, g1.y, g1.z, g1.w};
    for (int it0 = blockIdx.x; it0 < TOK / 4; it0 += 4 * gridDim.x) {
        u32x4 ov[4], zv[4]; bool ok[4]; bf16* op[4];
#pragma unroll
        for (int b = 0; b < 4; ++b) { const int it = it0 + b * gridDim.x; ok[b] = it < TOK / 4; const size_t row = (size_t)((ok[b] ? it : 0) * 4 + (tid >> 7));
            op[b] = proj + row * LDP + PC_OA + cidx; ov[b] = *(const u32x4*)op[b]; zv[b] = *(const u32x4*)(proj + row * LDP + PC_Z + cidx); }
#pragma unroll
        for (int b = 0; b < 4; ++b) {
            const float v[8] = {bflo(ov[b].x), bfhi(ov[b].x), bflo(ov[b].y), bfhi(ov[b].y), bflo(ov[b].z), bfhi(ov[b].z), bflo(ov[b].w), bfhi(ov[b].w)};
            const float z[8] = {bflo(zv[b].x), bfhi(zv[b].x), bflo(zv[b].y), bfhi(zv[b].y), bflo(zv[b].z), bfhi(zv[b].z), bflo(zv[b].w), bfhi(zv[b].w)};
            float ss = 0.f;
#pragma unroll
            for (int e = 0; e < 8; ++e) ss += v[e] * v[e];
            ss += __shfl_xor(ss, 1); ss += __shfl_xor(ss, 2); ss += __shfl_xor(ss, 4); ss += __shfl_xor(ss, 8);
            const float rstd = rsqrtf(ss * (1.f / 128.f) + EPSN);
            float o[8];
#pragma unroll
            for (int e = 0; e < 8; ++e) o[e] = v[e] * rstd * gg[e] * (z[e] * __builtin_amdgcn_rcpf(1.f + __builtin_amdgcn_exp2f(-LOG2E * z[e])));
            u32x4 w; w.x = pk2(o[0], o[1]); w.y = pk2(o[2], o[3]); w.z = pk2(o[4], o[5]); w.w = pk2(o[6], o[7]);
            if (ok[b]) *(u32x4*)op[b] = w;
        }
    }
}

#define RLX_AGENT __ATOMIC_RELAXED, __HIP_MEMORY_SCOPE_AGENT
#define XB_TMO      128
#define XB_XCNT(j)  (256  + 64 * (j))
#define XB_XSUB(j)  (1280 + 64 * (j))
#define XB_XGEN(j)  (2304 + 64 * (j))
#define XB_TOP      3328
#define XB_TOPGEN   3392
#define XCD_BAR_WORDS 3456
#define XB_SPIN_CAP (1u << 22)

__device__ __forceinline__ unsigned xb_ld(unsigned* p)              { return __hip_atomic_load(p, __ATOMIC_RELAXED, __HIP_MEMORY_SCOPE_AGENT); }
__device__ __forceinline__ unsigned xb_add(unsigned* p, unsigned v) { return __hip_atomic_fetch_add(p, v, __ATOMIC_RELAXED, __HIP_MEMORY_SCOPE_AGENT); }
__device__ __forceinline__ unsigned xb_xcc_id() { return (unsigned)__builtin_amdgcn_s_getreg((3 << 11) | 20) & 0xFu; }
#define XB_SPIN(cond, bar) do { unsigned _sp = 0; while (cond) { __builtin_amdgcn_s_sleep(1); \
    if ((++_sp & 255u) == 0u) { if (xb_ld(&(bar)[XB_TMO])) break; if (_sp > XB_SPIN_CAP) { atomicAdd(&(bar)[XB_TMO], 1u); break; } } } } while (0)

struct XcdBarrier {
    unsigned* bar; unsigned x;
    volatile LAS unsigned* st;
};

__device__ __forceinline__ XcdBarrier xcd_barrier_post(unsigned* bar, volatile LAS unsigned* st) {
    XcdBarrier b; b.bar = bar; b.x = xb_xcc_id(); b.st = st;
    if (threadIdx.x == 0) (void)xb_add(&bar[XB_XCNT(b.x)], 1u);
    return b;
}
__device__ __forceinline__ void xcd_barrier_complete(unsigned* bar, unsigned x, unsigned& nloc, unsigned& nx) {
    const unsigned G = gridDim.x * gridDim.y * gridDim.z;
    unsigned sum, cnt, mine, sp = 0u;
    for (;;) {
        sum = 0u; cnt = 0u; mine = 0u;
#pragma unroll
        for (unsigned j = 0; j < 16; ++j) { const unsigned c = xb_ld(&bar[XB_XCNT(j)]); sum += c; cnt += (c > 0u) ? 1u : 0u; mine = (j == x) ? c : mine; }
        if (sum == G) break;
        __builtin_amdgcn_s_sleep(1);
        if ((++sp & 255u) == 0u) { if (xb_ld(&bar[XB_TMO])) break; if (sp > XB_SPIN_CAP) { atomicAdd(&bar[XB_TMO], 1u); break; } }
    }
    nloc = mine > 0u ? mine : 1u; nx = cnt > 0u ? cnt : 1u;
}

__device__ __forceinline__ void xcd_barrier(const XcdBarrier& b) {
    asm volatile("s_waitcnt vmcnt(0)" ::: "memory");
    __syncthreads();
    if (threadIdx.x == 0) {
        unsigned* bar = b.bar;
        __builtin_amdgcn_s_waitcnt(0);
        unsigned nloc = b.st[0], nx = b.st[1];
        if (nloc == 0u) { xcd_barrier_complete(bar, b.x, nloc, nx); b.st[0] = nloc; b.st[1] = nx; }
        const unsigned old = xb_add(&bar[XB_XSUB(b.x)], 1u);
        const unsigned gen = old / nloc;
        if (old + 1u == (gen + 1u) * nloc) {
            __builtin_amdgcn_fence(__ATOMIC_RELEASE, "agent");
            asm volatile("s_waitcnt vmcnt(0)" ::: "memory");
            const unsigned og = xb_add(&bar[XB_TOP], 1u);
            const unsigned tg = og / nx;
            if (og + 1u == (tg + 1u) * nx) xb_add(&bar[XB_TOPGEN], 1u);
            else XB_SPIN(xb_ld(&bar[XB_TOPGEN]) == tg, bar);
            __builtin_amdgcn_fence(__ATOMIC_ACQUIRE, "agent");
            xb_add(&bar[XB_XGEN(b.x)], 1u);
            asm volatile("s_waitcnt vmcnt(0)" ::: "memory");
        } else {
            XB_SPIN(xb_ld(&bar[XB_XGEN(b.x)]) == gen, bar);
            __builtin_amdgcn_fence(__ATOMIC_ACQUIRE, "agent");
            asm volatile("s_waitcnt vmcnt(0)" ::: "memory");
        }
    }
    __syncthreads();
}

__global__ void __launch_bounds__(512, 2) hybrid_fwd(Params P) {
    extern __shared__ __attribute__((aligned(16))) unsigned char lds[];
    cg::grid_group grid = cg::this_grid();
    const int tid = threadIdx.x, lane = tid & 63, wave = __builtin_amdgcn_readfirstlane(tid >> 6);
    const int G = gridDim.x, cb = blockIdx.x;
    unsigned char* ws = P.ws;
    LAS unsigned char* glds = (LAS unsigned char*)lds;
    bf16* H = (bf16*)((unsigned char*)P.out + DO_H);
    bf16* proj = (bf16*)(ws + WS_PROJ);
    volatile LAS unsigned* bst = (volatile LAS unsigned*)(glds + LDS_BYTES - 32);
    if (tid < 2) bst[tid] = 0u;
    __syncthreads();
    XcdBarrier bar = xcd_barrier_post((unsigned*)(ws + WS_CTL) + 1024, bst);
#ifdef PROBE_TS
    volatile unsigned long long* tsg_ = (volatile unsigned long long*)(ws + WS_CTL + 32768);
    if (blockIdx.x == 0 && tid == 0) tsg_[0] = __builtin_amdgcn_s_memrealtime();
#endif
    grid.sync();
#ifdef PROBE_TS
#define GRID_BAR(k_) do { xcd_barrier(bar); if (blockIdx.x == 0 && tid == 0) tsg_[k_] = __builtin_amdgcn_s_memrealtime(); } while (0)
#else
#define GRID_BAR(k_) xcd_barrier(bar)
#endif

#ifndef NO_P0
    phase0(P, lds, tid, lane, wave);
#endif
    GRID_BAR(1);
#ifndef NO_GEMM
    {
        pg8::Gemm g{H, (const bf16*)(ws + WS_W1T), TOK, 7424, 2048, 2048, 2048}; pg8::StaticOrder S; S.init(TOK, 7424, G, cb);
        pg8::EpiProj E{proj, LDP, (float*)(ws + WS_SMALL)};
        pg8::gemm_phase<pg8::EpiProj, pg8::StaticOrder, true, true>(glds, g, S, E);
    }
    {
        pg8::Gemm g{(const bf16*)(ws + WS_WFVT), H, 1024, TOK, 2048, 2048, 2048}; pg8::StaticOrder S; S.init(1024, TOK, G, cb);
        pg8::EpiStore E{(bf16*)((unsigned char*)P.out + DO_FOXVT), TOK};
        pg8::gemm_phase<pg8::EpiStore, pg8::StaticOrder, true, true>(glds, g, S, E);
    }
    {
        const int cr = (cb + G - 64) % G;
        pg8::Gemm g{(const bf16*)(ws + WS_MEMN), (const bf16*)(ws + WS_WMKVT), 512, 1024, 2048, 2048, 2048}; pg8::StaticOrder S; S.init(512, 1024, G, cr);
        pg8::EpiStore E{(bf16*)(ws + WS_KMEM), 1024};
        pg8::gemm_phase<pg8::EpiStore, pg8::StaticOrder, true, true>(glds, g, S, E);
        const int cr2 = (cb + G - 72) % G;
        pg8::Gemm g2{(const bf16*)(ws + WS_WMKVT) + (size_t)1024 * 2048, (const bf16*)(ws + WS_MEMN), 1024, 512, 2048, 2048, 2048}; pg8::StaticOrder S2; S2.init(1024, 512, G, cr2);
        pg8::EpiStore E2{(bf16*)(ws + WS_VMT), 512};
        pg8::gemm_phase<pg8::EpiStore, pg8::StaticOrder, true, true>(glds, g2, S2, E2);
    }
#endif
    GRID_BAR(2);
#ifndef NO_P2
    phase2(P, lds, tid, lane, wave);
#endif
    GRID_BAR(3);
#ifndef NO_P3
    phase3(P, lds, tid, lane, wave);
#endif
    GRID_BAR(4);
#ifndef NO_GEMM
    gdn_gate_norm_pass(P, tid);
    {
        pg8::Gemm g{H, (const bf16*)(ws + WS_WGT), TOK, 6144, 2048, 2048, 2048}; pg8::StaticOrder S; S.init(TOK, 6144, G, cb);
        pg8::EpiSig E{(bf16*)((unsigned char*)P.out + DO_GA), proj + PC_GB, proj + PC_GM, 2048, LDP, LDP};
        pg8::gemm_phase<pg8::EpiSig, pg8::StaticOrder, true, true>(glds, g, S, E);
    }
    GRID_BAR(5);
    {
        bf16* Y = (bf16*)(ws + WS_Y); const bf16* WUPT = (const bf16*)(ws + WS_WUPT);
        pg8::StaticOrder S; S.init(TOK, 2048, G, cb);
        { pg8::Gemm g{proj + PC_OA, WUPT, TOK, 2048, 1024, LDP, 1024}; pg8::EpiGate<true> E{(const bf16*)((unsigned char*)P.out + DO_GA), 2048, Y, 2048};
          pg8::gemm_phase<pg8::EpiGate<true>, pg8::StaticOrder, true, true>(glds, g, S, E); }
        { pg8::Gemm g{proj + PC_OB, WUPT + (size_t)2048 * 1024, TOK, 2048, 1024, LDP, 1024}; pg8::EpiGate<false> E{proj + PC_GB, LDP, Y, 2048};
          pg8::gemm_phase<pg8::EpiGate<false>, pg8::StaticOrder, true, true>(glds, g, S, E); }
        { pg8::Gemm g{proj + PC_OM, WUPT + (size_t)2 * 2048 * 1024, TOK, 2048, 1024, LDP, 1024}; pg8::EpiGate<false> E{proj + PC_GM, LDP, Y, 2048};
          pg8::gemm_phase<pg8::EpiGate<false>, pg8::StaticOrder, true, true>(glds, g, S, E); }
    }
    GRID_BAR(6);
    {
        pg8::Gemm g{(const bf16*)(ws + WS_Y), (const bf16*)(ws + WS_WOT), TOK, 2048, 2048, 2048, 2048}; pg8::StaticOrder S; S.init(TOK, 2048, G, cb);
        pg8::EpiRes1 E{P.x, P.out, (bf16*)(ws + WS_X1B), (float*)(ws + WS_SSQ)};
        pg8::gemm_phase<pg8::EpiRes1, pg8::StaticOrder, true, true>(glds, g, S, E);
    }
    GRID_BAR(7);
    {
        const float* SSQ = (const float*)(ws + WS_SSQ); float* RSTD = (float*)(ws + WS_RSTD);
        const int g = cb * 512 + tid;
        if (g < TOK * 8) { const int row = g >> 3, part = g & 7; float sq = 0.f;
#pragma unroll
            for (int q = 0; q < 4; ++q) sq += SSQ[(size_t)(part * 4 + q) * 16384 + row];
            sq += __shfl_xor(sq, 1); sq += __shfl_xor(sq, 2); sq += __shfl_xor(sq, 4);
            if (part == 0) RSTD[row] = rsqrtf(sq * (1.f / 2048.f) + 1e-6f); }
    }
    GRID_BAR(8);
    {
        pg8::Gemm g{(const bf16*)(ws + WS_X1B), (const bf16*)(ws + WS_WFF1T), TOK, 8192, 2048, 2048, 2048}; pg8::StaticOrder S; S.init(TOK, 8192, G, cb);
        pg8::EpiFF1 E{(const float*)(ws + WS_RSTD), (bf16*)(ws + WS_U), 8192};
        pg8::gemm_phase<pg8::EpiFF1, pg8::StaticOrder, true, true>(glds, g, S, E);
    }
    GRID_BAR(9);
    {
        pg8::Gemm g{(const bf16*)(ws + WS_U), (const bf16*)(ws + WS_WFF2T), TOK, 2048, 8192, 8192, 8192}; pg8::StaticOrder S; S.init(TOK, 2048, G, cb, 4);
        pg8::EpiOut E{P.out};
        pg8::gemm_phase<pg8::EpiOut, pg8::StaticOrder, true, true>(glds, g, S, E);
    }
#endif
#ifdef PROBE_TS
    if (blockIdx.x == 0 && tid == 0) {
        const unsigned long long tend = __builtin_amdgcn_s_memrealtime();
        tsg_[12] = tend;
        long long qa = ((long long)(tsg_[PROBE_A1] - tsg_[PROBE_A0]) + 1500) / 3000; if (qa > 35) qa = 35;
        long long qb = ((long long)(tsg_[PROBE_B1] - tsg_[PROBE_B0]) + 1500) / 3000; if (qb > 35) qb = 35;
        long long qc = ((long long)(tsg_[PROBE_C1] - tsg_[PROBE_C0]) + 1500) / 3000; if (qc > 35) qc = 35;
        const unsigned long long until = tend + (unsigned long long)(qa + 36 * qb + 1296 * qc) * 2000ull;
        while (__builtin_amdgcn_s_memrealtime() < until) __builtin_amdgcn_s_sleep(8);
    }
#endif
}

extern "C" void kernel_launch(void* const* d_in, const int* in_sizes, int n_in, void* d_out, int out_size, void* d_ws, size_t ws_size, hipStream_t stream) {
    static int grid = 0;
    if (grid == 0) {
        if (n_in != 22 || out_size != TOK * DM || ws_size < WS_END) { fprintf(stderr, "kernel_launch: unexpected shapes (n_in %d out %d ws %zu)\n", n_in, out_size, ws_size); grid = -1; return; }
        int dev = 0, cus = 0, per_cu = 0;
        hipGetDevice(&dev); hipDeviceGetAttribute(&cus, hipDeviceAttributeMultiprocessorCount, dev);
        if (hipFuncSetAttribute((const void*)hybrid_fwd, hipFuncAttributeMaxDynamicSharedMemorySize, LDS_BYTES) != hipSuccess) { fprintf(stderr, "kernel_launch: hipFuncSetAttribute failed\n"); grid = -1; return; }
        if (hipOccupancyMaxActiveBlocksPerMultiprocessor(&per_cu, (const void*)hybrid_fwd, 512, LDS_BYTES) != hipSuccess || per_cu < 1) { fprintf(stderr, "kernel_launch: occupancy query says %d\n", per_cu); per_cu = 1; }
        (void)hipGetLastError();
        grid = cus * 1;
        if (grid <= 0) grid = 256;
    }
    if (grid < 0) return;
    if (hipMemsetAsync((char*)d_ws + WS_CTL, 0, 65536, stream) != hipSuccess) { fprintf(stderr, "kernel_launch: memset failed\n"); return; }
    Params p{};
    const float** pp = (const float**)&p;
    for (int i = 0; i < 22; ++i) pp[i] = (const float*)d_in[i];
    p.out = (float*)d_out; p.ws = (unsigned char*)d_ws;
    void* args[] = {&p};
    hipError_t e = hipLaunchCooperativeKernel((const void*)hybrid_fwd, dim3(grid), dim3(512), args, LDS_BYTES, stream);
    if (e != hipSuccess) fprintf(stderr, "cooperative launch failed: %s (grid %d)\n", hipGetErrorString(e), grid);
}
```

```cpp
#include <hip/hip_runtime.h>
#include <hip/hip_cooperative_groups.h>
#include <cstdio>
#include <cstdint>
namespace cg = cooperative_groups;

namespace pg8 {
#define PG8_LAS __attribute__((address_space(3)))
typedef unsigned short bf16_t;
typedef short bf16x8 __attribute__((ext_vector_type(8)));
typedef float f32x4 __attribute__((ext_vector_type(4)));
typedef unsigned u32x4 __attribute__((ext_vector_type(4)));
constexpr int BM = 256, BK = 64, HALF = 128, HTB = HALF * BK * 2  , STAGE_BYTES = 8 * HTB, NXCD = 8, WGM = 8;

__host__ __device__ __forceinline__ int lds_byte(int r, int c) { const int st = (r >> 4) * 2 + (c >> 5), rr = r & 15, cc = c & 31, ob = rr * 64 + cc * 2; return st * 1024 + (ob ^ (((ob >> 9) & 1) << 5)); }
__host__ __device__ __forceinline__ void stage_rc(int b, int& R, int& C) { const int st = b / 1024, sb = b % 1024, swz = sb ^ (((sb >> 9) & 1) << 5); R = (st >> 1) * 16 + swz / 64; C = (st & 1) * 32 + (swz % 64) / 2; }
__host__ __device__ __forceinline__ int perm32(int rho) { const int n = rho >> 4, i = rho & 15; return 8 * (i >> 2) + 4 * n + (i & 3); }

struct Unit { int pm, pn; };
struct Gemm { const bf16_t* A; const bf16_t* Bt; int M, N, K, lda, ldb; };

struct StaticOrder {
    int nM, nN, nwg, G, c, wgm;
    __host__ __device__ void init(int M, int N, int G_, int c_, int wgm_ = WGM) { nM = M / BM; nN = N / BM; nwg = nM * nN; G = G_; c = c_; wgm = wgm_; }
    __host__ __device__ bool next(int i, Unit& u) const {
        const long L = (long)i * G + c; if (L >= nwg) return false;
        int wgid = (int)L; { const int q = nwg / NXCD, r = nwg % NXCD, xcd = wgid % NXCD, off = wgid / NXCD; wgid = (xcd < r ? xcd * (q + 1) : r * (q + 1) + (xcd - r) * q) + off; }
        const int nig = wgm * nN, gid = wgid / nig, fm = gid * wgm, gsz = (nM - fm) < wgm ? (nM - fm) : wgm;
        u.pm = fm + ((wgid % nig) % gsz); u.pn = (wgid % nig) / gsz; return true;
    }
    __device__ __forceinline__ void a_ready(const Unit&) const {}
    __device__ __forceinline__ void done(const Unit&) const {}
};

typedef float f32x2_cv __attribute__((ext_vector_type(2))); typedef __bf16 bf16x2_cv __attribute__((ext_vector_type(2)));
__device__ __forceinline__ unsigned cvt_pk_bf16(float lo, float hi) { f32x2_cv v = {lo, hi}; bf16x2_cv b = __builtin_convertvector(v, bf16x2_cv); return __builtin_bit_cast(unsigned, b); }
template <class Epi, class Sched, bool ALIGN_EPI = false, bool SP2 = false>
__device__ __forceinline__ void gemm_phase(PG8_LAS unsigned char* lds, const Gemm g, const Sched& S, const Epi& E) {
    int tid_ = threadIdx.x; asm volatile("" : "+v"(tid_));
    const int tid = tid_, wid = __builtin_amdgcn_readfirstlane(tid >> 6), lane = tid & 63, wr = wid >> 2, wc = wid & 3, fr = lane & 15, fq = lane >> 4;
    const int K = g.K, nt = K / BK;
    unsigned voffA[2], voffB[2];
#pragma unroll
    for (int i = 0; i < 2; ++i) { int R, C; stage_rc(tid * 16 + i * 8192, R, C); const int Rb = Epi::PERM ? ((R & ~31) + perm32(R & 31)) : R;
        voffA[i] = (unsigned)(R * g.lda + C) * 2u; voffB[i] = (unsigned)(Rb * g.ldb + C) * 2u; }
    const size_t kstep = (size_t)(BK * 2);
    const size_t hstepA = (size_t)HALF * g.lda * 2, hstepB = (size_t)HALF * g.ldb * 2;
    const size_t tstepA = 2 * hstepA, tstepB = 2 * hstepB;
    const unsigned ldsw = (unsigned)wid * 1024u;
    const int aoff = lds_byte(wr * 64 + fr, fq * 8), boff = lds_byte(wc * 32 + fr, fq * 8);
#define PG8_SA(b, h) (((b) * 2 + (h)) * HTB)
#define PG8_SB(b, h) ((4 + (b) * 2 + (h)) * HTB)
#define PG8_STAGE(bufoff, gbase, voff) do { _Pragma("unroll") for (int _i = 0; _i < 2; ++_i) \
        __builtin_amdgcn_global_load_lds((const unsigned*)((const char*)(gbase) + (voff)[_i]), (PG8_LAS unsigned*)(lds + (bufoff) + ldsw + _i * 8192), 16, 0, 0); } while (0)
#define PG8_LDA(dst, b, h) do { _Pragma("unroll") for (int m = 0; m < 4; ++m) _Pragma("unroll") for (int k = 0; k < 2; ++k) dst[m][k] = *(const PG8_LAS bf16x8*)(lds + PG8_SA(b, h) + aoff + m * 2048 + k * 1024); } while (0)
#define PG8_LDB(dst, b, h) do { _Pragma("unroll") for (int n = 0; n < 2; ++n) _Pragma("unroll") for (int k = 0; k < 2; ++k) dst[n][k] = *(const PG8_LAS bf16x8*)(lds + PG8_SB(b, h) + boff + n * 2048 + k * 1024); } while (0)
#define PG8_MMA(ai, bj, At, Bt) do { __builtin_amdgcn_s_setprio(1); _Pragma("unroll") for (int m = 0; m < 4; ++m) _Pragma("unroll") for (int n = 0; n < 2; ++n) _Pragma("unroll") for (int k = 0; k < 2; ++k) \
        acc[ai][bj][m][n] = __builtin_amdgcn_mfma_f32_16x16x32_bf16(Bt[n][k], At[m][k], acc[ai][bj][m][n], 0, 0, 0); __builtin_amdgcn_s_setprio(0); } while (0)
#define PG8_WAIT_V(n) asm volatile("s_waitcnt vmcnt(" #n ")" ::: "memory")
#define PG8_WAIT_L(n) asm volatile("s_waitcnt lgkmcnt(" #n ")" ::: "memory")
#define PG8_BAR __builtin_amdgcn_s_barrier()
#define PG8_SCHED __builtin_amdgcn_sched_barrier(0)
    Unit cur, nxt; int ui = 0;
    if (!S.next(0, cur)) return;
    f32x4 acc[2][2][4][2];
#pragma unroll
    for (int a = 0; a < 2; ++a)
#pragma unroll
        for (int b = 0; b < 2; ++b)
#pragma unroll
            for (int m = 0; m < 4; ++m)
#pragma unroll
                for (int n = 0; n < 2; ++n) acc[a][b][m][n] = (f32x4){0.f, 0.f, 0.f, 0.f};
    bf16x8 At[4][2], B0[2][2], B1[2][2];
    const char* cA = (const char*)g.A + (size_t)cur.pm * tstepA; const char* cB = (const char*)g.Bt + (size_t)cur.pn * tstepB;
    S.a_ready(cur);
    if constexpr (SP2) {
        PG8_STAGE(PG8_SB(0, 0), cB, voffB); PG8_STAGE(PG8_SB(0, 1), cB + hstepB, voffB); PG8_STAGE(PG8_SA(0, 0), cA, voffA); PG8_STAGE(PG8_SA(0, 1), cA + hstepA, voffA);
        if (wr == 1) PG8_BAR;
        PG8_WAIT_V(2); PG8_BAR;
        PG8_STAGE(PG8_SB(1, 0), cB + kstep, voffB); PG8_STAGE(PG8_SA(1, 0), cA + kstep, voffA); PG8_STAGE(PG8_SB(1, 1), cB + hstepB + kstep, voffB);
        PG8_WAIT_V(6); PG8_BAR;
    } else {
        PG8_STAGE(PG8_SB(0, 0), cB, voffB); PG8_STAGE(PG8_SA(0, 0), cA, voffA); PG8_STAGE(PG8_SB(0, 1), cB + hstepB, voffB); PG8_STAGE(PG8_SA(0, 1), cA + hstepA, voffA);
        if (wr == 1) PG8_BAR;
        PG8_WAIT_V(4); PG8_BAR;
        PG8_STAGE(PG8_SB(1, 0), cB + kstep, voffB); PG8_STAGE(PG8_SA(1, 0), cA + kstep, voffA); PG8_STAGE(PG8_SB(1, 1), cB + hstepB + kstep, voffB);
        PG8_WAIT_V(6); PG8_BAR;
    }
    for (;;) {
        const bool has_next = S.next(ui + 1, nxt);
        const char* nA = has_next ? (const char*)g.A + (size_t)nxt.pm * tstepA : cA; const char* nB = has_next ? (const char*)g.Bt + (size_t)nxt.pn * tstepB : cB;
        for (int t = 0; t < nt; t += 2) {
            const bool last = (t == nt - 2);
            const char* a1 = cA + (size_t)(t + 1) * kstep;
            const char* a2 = last ? nA : cA + (size_t)(t + 2) * kstep; const char* b2 = last ? nB : cB + (size_t)(t + 2) * kstep;
            const char* a3 = a2 + kstep; const char* b3 = b2 + kstep;
            if (last && has_next) S.a_ready(nxt);
            if constexpr (SP2) {
            PG8_LDB(B0, 0, 0); PG8_LDB(B1, 0, 1); PG8_SCHED; PG8_LDA(At, 0, 0); PG8_STAGE(PG8_SA(1, 1), a1 + hstepA, voffA);
            PG8_WAIT_V(8); PG8_WAIT_L(0); PG8_BAR; PG8_MMA(0, 0, At, B0); PG8_MMA(0, 1, At, B1); PG8_BAR; PG8_SCHED;
            PG8_LDA(At, 0, 1); PG8_STAGE(PG8_SB(0, 0), b2, voffB); PG8_STAGE(PG8_SB(0, 1), b2 + hstepB, voffB); PG8_STAGE(PG8_SA(0, 0), a2, voffA);
            PG8_WAIT_V(8); PG8_WAIT_L(0); PG8_BAR; PG8_MMA(1, 0, At, B0); PG8_MMA(1, 1, At, B1); PG8_BAR; PG8_SCHED;
            PG8_LDB(B0, 1, 0); PG8_LDB(B1, 1, 1); PG8_SCHED; PG8_LDA(At, 1, 0); PG8_STAGE(PG8_SA(0, 1), a2 + hstepA, voffA);
            PG8_WAIT_V(8); PG8_WAIT_L(0); PG8_BAR; PG8_MMA(0, 0, At, B0); PG8_MMA(0, 1, At, B1); PG8_BAR; PG8_SCHED;
            PG8_LDA(At, 1, 1); PG8_STAGE(PG8_SB(1, 0), b3, voffB); PG8_STAGE(PG8_SB(1, 1), b3 + hstepB, voffB); PG8_STAGE(PG8_SA(1, 0), a3, voffA);
            PG8_WAIT_V(8); PG8_WAIT_L(0); PG8_BAR; PG8_MMA(1, 0, At, B0); PG8_MMA(1, 1, At, B1); PG8_BAR; PG8_SCHED;
            } else {
            PG8_LDB(B0, 0, 0); PG8_SCHED; PG8_LDA(At, 0, 0); PG8_STAGE(PG8_SA(1, 1), a1 + hstepA, voffA);
            PG8_WAIT_L(8); PG8_BAR; PG8_WAIT_L(0); PG8_MMA(0, 0, At, B0); PG8_BAR; PG8_SCHED;
            PG8_LDB(B1, 0, 1); PG8_STAGE(PG8_SB(0, 0), b2, voffB);
            PG8_BAR; PG8_WAIT_L(0); PG8_MMA(0, 1, At, B1); PG8_BAR;
            PG8_LDA(At, 0, 1); PG8_STAGE(PG8_SA(0, 0), a2, voffA);
            PG8_BAR; PG8_WAIT_L(0); PG8_MMA(1, 0, At, B0); PG8_BAR; PG8_SCHED;
            PG8_STAGE(PG8_SB(0, 1), b2 + hstepB, voffB);
            PG8_WAIT_V(6); PG8_BAR; PG8_MMA(1, 1, At, B1); PG8_BAR;
            PG8_LDB(B0, 1, 0); PG8_SCHED; PG8_LDA(At, 1, 0); PG8_STAGE(PG8_SA(0, 1), a2 + hstepA, voffA);
            PG8_WAIT_L(8); PG8_BAR; PG8_WAIT_L(0); PG8_MMA(0, 0, At, B0); PG8_BAR; PG8_SCHED;
            PG8_LDB(B1, 1, 1); PG8_STAGE(PG8_SB(1, 0), b3, voffB);
            PG8_BAR; PG8_WAIT_L(0); PG8_MMA(0, 1, At, B1); PG8_BAR;
            PG8_LDA(At, 1, 1); PG8_STAGE(PG8_SA(1, 0), a3, voffA);
            PG8_BAR; PG8_WAIT_L(0); PG8_MMA(1, 0, At, B0); PG8_BAR; PG8_SCHED;
            PG8_STAGE(PG8_SB(1, 1), b3 + hstepB, voffB);
            PG8_WAIT_V(6); PG8_BAR; PG8_MMA(1, 1, At, B1); PG8_BAR;
            }
        }
        if constexpr (ALIGN_EPI) { if (wr == 0) PG8_BAR; }
        if constexpr (!Epi::AFTER_DRAIN) { E(acc, cur, wr, wc, fr, fq); S.done(cur); }
        if (!has_next) break;
#pragma unroll
        for (int a = 0; a < 2; ++a)
#pragma unroll
            for (int b = 0; b < 2; ++b)
#pragma unroll
                for (int m = 0; m < 4; ++m)
#pragma unroll
                    for (int n = 0; n < 2; ++n) acc[a][b][m][n] = (f32x4){0.f, 0.f, 0.f, 0.f};
        cur = nxt; cA = nA; cB = nB; ++ui;
        if constexpr (ALIGN_EPI) { if (wr == 1) PG8_BAR; }
    }
    PG8_WAIT_V(0);
    if constexpr (!ALIGN_EPI) { if (wr == 0) PG8_BAR; }
    PG8_BAR;
    if constexpr (Epi::AFTER_DRAIN) { E.fused(acc, cur, wr, wc, fr, fq, lds, wid, lane); S.done(cur); }
#undef PG8_SA
#undef PG8_SB
#undef PG8_STAGE
#undef PG8_LDA
#undef PG8_LDB
#undef PG8_MMA
#undef PG8_WAIT_V
#undef PG8_WAIT_L
#undef PG8_BAR
#undef PG8_SCHED
}
}

constexpr int TOK = 16384, SEQ = 8192, DM = 2048, DIN = 14360, DFF = 8192;
constexpr int LDP = 7168;
constexpr int PC_QA = 0, PC_KA = 1024, PC_VA = 2048, PC_Z = 3072, PC_FK = 4096, PC_FQ = 5120, PC_QM = 6144;
constexpr int PC_OA = 0, PC_OB = PC_FQ, PC_OM = PC_QM, PC_GB = 1024, PC_GM = 3072;
constexpr float EPSN = 1e-6f;
constexpr float LOG2E = 1.4426950408889634f;
constexpr size_t MiB = 1u << 20;
constexpr size_t WS_CTL = 0, WS_W1T = 1 * MiB, WS_WFVT = 30 * MiB, WS_WMKVT = 34 * MiB, WS_UC = 1 * MiB;
constexpr size_t WS_SMALL = 42 * MiB, WS_KMEM = 44 * MiB, WS_VMT = 45 * MiB, WS_CUM = 46 * MiB, WS_CDEC = 46 * MiB + 512 * 1024,
                 WS_MEMN = 47 * MiB, WS_SSQ = 49 * MiB, WS_RSTD = 51 * MiB;
constexpr size_t WS_WGT = 52 * MiB, WS_WUPT = 76 * MiB, WS_WOT = 88 * MiB, WS_WFF1T = 96 * MiB, WS_WFF2T = 128 * MiB;
constexpr size_t WS_PROJ = 160 * MiB, WS_GDN = 384 * MiB, WS_END = 496 * MiB;
constexpr int FOXVT_LD = TOK;
constexpr size_t WS_Y = 384 * MiB, WS_X1B = 160 * MiB, WS_U = 224 * MiB;
constexpr size_t DO_H = 0, DO_FOXVT = 64 * MiB, DO_GA = 64 * MiB;
constexpr int GDN_CHUNK_BYTES = 57344;
constexpr int LDS_BYTES = 163840;

#define LAS __attribute__((address_space(3)))
typedef unsigned short bf16;
typedef short bf16x8 __attribute__((ext_vector_type(8)));
typedef float f32x4 __attribute__((ext_vector_type(4)));
typedef float f32x16 __attribute__((ext_vector_type(16)));
typedef unsigned u32x4 __attribute__((ext_vector_type(4)));
typedef unsigned u32x2 __attribute__((ext_vector_type(2)));

__device__ __forceinline__ unsigned pk2(float lo, float hi) { return pg8::cvt_pk_bf16(lo, hi); }
__device__ __forceinline__ float bf2f(unsigned short v) { return __uint_as_float(((unsigned)v) << 16); }
__device__ __forceinline__ float bflo(unsigned w) { return __uint_as_float(w << 16); }
__device__ __forceinline__ float bfhi(unsigned w) { return __uint_as_float(w & 0xffff0000u); }
__device__ __forceinline__ int crow(int r, int hi) { return (r & 3) + 8 * (r >> 2) + 4 * hi; }
__device__ __forceinline__ float sigmoidf_(float x) { return 1.f / (1.f + __expf(-x)); }
__device__ __forceinline__ float softplusf_(float x) { return fmaxf(x, 0.f) + log1pf(__expf(-fabsf(x))); }

namespace pg8 {
struct EpiStore {
    static constexpr bool PERM = true, AFTER_DRAIN = false;
    bf16_t* O; int ldc;
    __device__ __forceinline__ void operator()(const f32x4 (&acc)[2][2][4][2], const Unit& u, int wr, int wc, int fr, int fq) const {
        const int row0 = u.pm * BM + wr * 64 + fr, col0 = u.pn * BM + wc * 32 + 8 * fq;
#pragma unroll
        for (int ai = 0; ai < 2; ++ai)
#pragma unroll
            for (int m = 0; m < 4; ++m) { bf16_t* rowp = O + (size_t)(row0 + ai * HALF + m * 16) * ldc + col0;
#pragma unroll
                for (int bj = 0; bj < 2; ++bj) { const f32x4 v0 = acc[ai][bj][m][0], v1 = acc[ai][bj][m][1];
                    u32x4 w; w.x = cvt_pk_bf16(v0[0], v0[1]); w.y = cvt_pk_bf16(v0[2], v0[3]); w.z = cvt_pk_bf16(v1[0], v1[1]); w.w = cvt_pk_bf16(v1[2], v1[3]);
                    *(u32x4*)(rowp + bj * HALF) = w; } }
    }
};
struct EpiProj {
    static constexpr bool PERM = true, AFTER_DRAIN = false;
    bf16_t* O; int ldc; float* small;
    __device__ __forceinline__ void operator()(const f32x4 (&acc)[2][2][4][2], const Unit& u, int wr, int wc, int fr, int fq) const {
        const int row0 = u.pm * BM + wr * 64 + fr;
        if (u.pn == 28) {
            if (wc == 0) {
#pragma unroll
                for (int ai = 0; ai < 2; ++ai)
#pragma unroll
                    for (int m = 0; m < 4; ++m) { float* p = small + (size_t)(row0 + ai * HALF + m * 16) * 32 + 8 * fq;
                        *(f32x4*)p = acc[ai][0][m][0]; *(f32x4*)(p + 4) = acc[ai][0][m][1]; }
            }
            return;
        }
        const int col0 = u.pn * BM + wc * 32 + 8 * fq;
#pragma unroll
        for (int ai = 0; ai < 2; ++ai)
#pragma unroll
            for (int m = 0; m < 4; ++m) { bf16_t* rowp = O + (size_t)(row0 + ai * HALF + m * 16) * ldc + col0;
#pragma unroll
                for (int bj = 0; bj < 2; ++bj) { const f32x4 v0 = acc[ai][bj][m][0], v1 = acc[ai][bj][m][1];
                    u32x4 w; w.x = cvt_pk_bf16(v0[0], v0[1]); w.y = cvt_pk_bf16(v0[2], v0[3]); w.z = cvt_pk_bf16(v1[0], v1[1]); w.w = cvt_pk_bf16(v1[2], v1[3]);
                    *(u32x4*)(rowp + bj * HALF) = w; } }
    }
};
struct EpiSig {
    static constexpr bool PERM = true, AFTER_DRAIN = false;
    unsigned char* O0; unsigned char* O1; int ld0, ld1;
    __device__ __forceinline__ void operator()(const f32x4 (&acc)[2][2][4][2], const Unit& u, int wr, int wc, int fr, int fq) const {
        const int br = u.pn >> 3; unsigned char* O = br == 0 ? O0 : O1 + (size_t)(br - 1) * 2048; const int ldc = br == 0 ? ld0 : ld1;
        const int row0 = u.pm * BM + wr * 64 + fr, col0 = (u.pn & 7) * BM + wc * 32 + 8 * fq;
#pragma unroll
        for (int ai = 0; ai < 2; ++ai)
#pragma unroll
            for (int m = 0; m < 4; ++m) { unsigned char* rowp = O + (size_t)(row0 + ai * HALF + m * 16) * ldc + col0;
#pragma unroll
                for (int bj = 0; bj < 2; ++bj) { const f32x4 v0 = acc[ai][bj][m][0], v1 = acc[ai][bj][m][1]; unsigned q[8];
#pragma unroll
                    for (int e = 0; e < 4; ++e) { q[e] = (unsigned)(255.f * __builtin_amdgcn_rcpf(1.f + __builtin_amdgcn_exp2f(-1.4426950408889634f * v0[e])) + 0.5f);
                                                  q[4 + e] = (unsigned)(255.f * __builtin_amdgcn_rcpf(1.f + __builtin_amdgcn_exp2f(-1.4426950408889634f * v1[e])) + 0.5f); }
                    u32x2 w; w.x = q[0] | (q[1] << 8) | (q[2] << 16) | (q[3] << 24); w.y = q[4] | (q[5] << 8) | (q[6] << 16) | (q[7] << 24);
                    *(u32x2*)(rowp + bj * HALF) = w; } }
    }
};
template <bool FIRST> struct EpiGate {
    static constexpr bool PERM = true, AFTER_DRAIN = false;
    const unsigned char* G; int ldg; bf16_t* Y; int ldy;
    __device__ __forceinline__ void operator()(const f32x4 (&acc)[2][2][4][2], const Unit& u, int wr, int wc, int fr, int fq) const {
        const int row0 = u.pm * BM + wr * 64 + fr, col0 = u.pn * BM + wc * 32 + 8 * fq;
        constexpr float S = 1.f / 255.f;
#pragma unroll
        for (int ai = 0; ai < 2; ++ai)
#pragma unroll
            for (int m = 0; m < 4; ++m) { const size_t r = (size_t)(row0 + ai * HALF + m * 16);
#pragma unroll
                for (int bj = 0; bj < 2; ++bj) { const f32x4 v0 = acc[ai][bj][m][0], v1 = acc[ai][bj][m][1];
                    const u32x2 g = *(const u32x2*)(G + r * ldg + col0 + bj * HALF);
                    float o[8];
                    o[0] = v0[0] * ((float)(g.x & 0xffu) * S); o[1] = v0[1] * ((float)((g.x >> 8) & 0xffu) * S);
                    o[2] = v0[2] * ((float)((g.x >> 16) & 0xffu) * S); o[3] = v0[3] * ((float)(g.x >> 24) * S);
                    o[4] = v1[0] * ((float)(g.y & 0xffu) * S); o[5] = v1[1] * ((float)((g.y >> 8) & 0xffu) * S);
                    o[6] = v1[2] * ((float)((g.y >> 16) & 0xffu) * S); o[7] = v1[3] * ((float)(g.y >> 24) * S);
                    bf16_t* yp = Y + r * ldy + col0 + bj * HALF;
                    if (!FIRST) { const u32x4 y = *(const u32x4*)yp;
                        o[0] += __uint_as_float(y.x << 16); o[1] += __uint_as_float(y.x & 0xffff0000u);
                        o[2] += __uint_as_float(y.y << 16); o[3] += __uint_as_float(y.y & 0xffff0000u);
                        o[4] += __uint_as_float(y.z << 16); o[5] += __uint_as_float(y.z & 0xffff0000u);
                        o[6] += __uint_as_float(y.w << 16); o[7] += __uint_as_float(y.w & 0xffff0000u); }
                    u32x4 w; w.x = cvt_pk_bf16(o[0], o[1]); w.y = cvt_pk_bf16(o[2], o[3]); w.z = cvt_pk_bf16(o[4], o[5]); w.w = cvt_pk_bf16(o[6], o[7]);
                    *(u32x4*)yp = w; } }
    }
};
struct EpiRes1 {
    static constexpr bool PERM = false, AFTER_DRAIN = false;
    const float* X; bf16_t* XB; float* SSQ;
    __device__ __forceinline__ void operator()(const f32x4 (&acc)[2][2][4][2], const Unit& u, int wr, int wc, int fr, int fq) const {
        const int row0 = u.pm * BM + wr * 64 + fr, col0 = u.pn * BM + wc * 32 + 4 * fq;
#pragma unroll
        for (int ai = 0; ai < 2; ++ai)
#pragma unroll
            for (int m = 0; m < 4; ++m) { const int row = row0 + ai * HALF + m * 16; const size_t off = (size_t)row * 2048 + col0; float s = 0.f;
#pragma unroll
                for (int bj = 0; bj < 2; ++bj)
#pragma unroll
                    for (int n = 0; n < 2; ++n) { const size_t o = off + bj * HALF + n * 16; const f32x4 xv = *(const f32x4*)(X + o); const f32x4 v = xv + acc[ai][bj][m][n];
                        u32x2 w; w.x = cvt_pk_bf16(v[0], v[1]); w.y = cvt_pk_bf16(v[2], v[3]); *(u32x2*)(XB + o) = w;
                        s += (v[0] * v[0] + v[1] * v[1]) + (v[2] * v[2] + v[3] * v[3]); }
                s += __shfl_xor(s, 16); s += __shfl_xor(s, 32);
                if (fq == 0) SSQ[(size_t)(u.pn * 4 + wc) * 16384 + row] = s; }
    }
};
struct EpiFF1 {
    static constexpr bool PERM = true, AFTER_DRAIN = false;
    const float* RSTD; bf16_t* O; int ldc;
    __device__ __forceinline__ void operator()(const f32x4 (&acc)[2][2][4][2], const Unit& u, int wr, int wc, int fr, int fq) const {
        const int row0 = u.pm * BM + wr * 64 + fr, col0 = u.pn * BM + wc * 32 + 8 * fq;
        float rs[2][4];
#pragma unroll
        for (int ai = 0; ai < 2; ++ai)
#pragma unroll
            for (int m = 0; m < 4; ++m) rs[ai][m] = RSTD[row0 + ai * HALF + m * 16];
#pragma unroll
        for (int ai = 0; ai < 2; ++ai)
#pragma unroll
            for (int m = 0; m < 4; ++m) { const int row = row0 + ai * HALF + m * 16; const float rstd = rs[ai][m];
                bf16_t* rowp = O + (size_t)row * ldc + col0;
#pragma unroll
                for (int bj = 0; bj < 2; ++bj) { f32x4 v0 = acc[ai][bj][m][0] * rstd, v1 = acc[ai][bj][m][1] * rstd;
#pragma unroll
                    for (int e = 0; e < 4; ++e) { const float a = fmaxf(v0[e], 0.f), b = fmaxf(v1[e], 0.f); v0[e] = a * a; v1[e] = b * b; }
                    u32x4 w; w.x = cvt_pk_bf16(v0[0], v0[1]); w.y = cvt_pk_bf16(v0[2], v0[3]); w.z = cvt_pk_bf16(v1[0], v1[1]); w.w = cvt_pk_bf16(v1[2], v1[3]);
                    *(u32x4*)(rowp + bj * HALF) = w; } }
    }
};
struct EpiOut {
    static constexpr bool PERM = false, AFTER_DRAIN = false;
    const bf16_t* XB; float* OUT;
    __device__ __forceinline__ void operator()(const f32x4 (&acc)[2][2][4][2], const Unit& u, int wr, int wc, int fr, int fq) const {
        const int row0 = u.pm * BM + wr * 64 + fr, col0 = u.pn * BM + wc * 32 + 4 * fq;
#pragma unroll
        for (int ai = 0; ai < 2; ++ai)
#pragma unroll
            for (int m = 0; m < 4; ++m) { const size_t off = (size_t)(row0 + ai * HALF + m * 16) * 2048 + col0;
#pragma unroll
                for (int bj = 0; bj < 2; ++bj)
#pragma unroll
                    for (int n = 0; n < 2; ++n) { const size_t o = off + bj * HALF + n * 16; const u32x2 xb = *(const u32x2*)(XB + o);
                        f32x4 xv; xv[0] = __uint_as_float(xb.x << 16); xv[1] = __uint_as_float(xb.x & 0xffff0000u); xv[2] = __uint_as_float(xb.y << 16); xv[3] = __uint_as_float(xb.y & 0xffff0000u);
                        *(f32x4*)(OUT + o) = xv + acc[ai][bj][m][n]; } }
    }
};
}

struct Params {
    const float *x, *mem, *g_mix, *w_in, *conv_w, *a_log, *dt_bias, *gdn_norm_g, *fox_b_f, *fox_q_norm, *fox_k_norm, *g_mem, *w_mem_kv,
                *mem_q_norm, *mem_k_norm, *w_up_gdn, *w_up_fox, *w_up_mem, *w_out, *g_mlp, *w_ff1, *w_ff2;
    float* out; unsigned char* ws;
};

__device__ __forceinline__ float wave_sum(float v) {
#pragma unroll
    for (int o = 1; o < 64; o <<= 1) v += __shfl_xor(v, o);
    return v;
}

__device__ __forceinline__ void transpose_item(const float* W, int ldw, int n0src, bf16* WT, int K, int row0dst, const float* kscale,
                                               LAS float* scr, int kb, int nb, int lane) {
    const int k0 = 64 * kb, n0 = 32 * nb;
    float tv[32];
#pragma unroll
    for (int i = 0; i < 32; ++i) tv[i] = W[(size_t)(k0 + 2 * i + (lane >> 5)) * ldw + n0src + n0 + (lane & 31)];
#pragma unroll
    for (int i = 0; i < 32; ++i) { const int kk = 2 * i + (lane >> 5); float v = tv[i];
        if (kscale) v *= kscale[k0 + kk]; scr[kk * 33 + (lane & 31)] = v; }
    asm volatile("s_waitcnt lgkmcnt(0)" ::: "memory");
    const int c = lane & 7;
#pragma unroll
    for (int j = 0; j < 4; ++j) { const int n = (lane >> 3) + 8 * j; const LAS float* s = scr + (8 * c) * 33 + n;
        u32x4 o; o.x = pk2(s[0 * 33], s[1 * 33]); o.y = pk2(s[2 * 33], s[3 * 33]); o.z = pk2(s[4 * 33], s[5 * 33]); o.w = pk2(s[6 * 33], s[7 * 33]);
        *(u32x4*)(WT + (size_t)(row0dst + n0 + n) * K + k0 + 8 * c) = o; }
    asm volatile("s_waitcnt lgkmcnt(0)" ::: "memory");
}
__device__ __forceinline__ void transpose_job(const float* W, int ldw, int n0src, int K, int ncols, bf16* WT, int row0dst, const float* kscale,
                                              LAS float* scr, int gw, int ngw, int lane) {
    const int nblk = ncols / 32, nitems = (K / 64) * nblk;
    for (int it = gw; it < nitems; it += ngw) transpose_item(W, ldw, n0src, WT, K, row0dst, kscale, scr, it / nblk, it % nblk, lane);
}
__device__ __forceinline__ void rms_row_to_bf16(const float* xrow, const float* g, bf16* orow, int lane) {
    const f32x4* xr = (const f32x4*)xrow + lane; const f32x4* gr = (const f32x4*)g + lane;
    f32x4 v[8]; float s = 0.f;
#pragma unroll
    for (int j = 0; j < 8; ++j) { v[j] = xr[64 * j]; s += (v[j].x * v[j].x + v[j].y * v[j].y) + (v[j].z * v[j].z + v[j].w * v[j].w); }
    const float rstd = rsqrtf(wave_sum(s) * (1.f / 2048.f) + EPSN);
    u32x2* o8 = (u32x2*)orow + lane;
#pragma unroll
    for (int j = 0; j < 8; ++j) { const f32x4 gg = gr[64 * j]; u32x2 w; w.x = pk2(v[j].x * rstd * gg.x, v[j].y * rstd * gg.y); w.y = pk2(v[j].z * rstd * gg.z, v[j].w * rstd * gg.w); o8[64 * j] = w; }
}

__device__ __forceinline__ void phase0(const Params& P, unsigned char* lds, int tid, int lane, int wave) {
    unsigned char* ws = P.ws;
    bf16* W1T = (bf16*)(ws + WS_W1T); bf16* WFVT = (bf16*)(ws + WS_WFVT); bf16* WMKVT = (bf16*)(ws + WS_WMKVT); bf16* WGT = (bf16*)(ws + WS_WGT);
    bf16* WUPT = (bf16*)(ws + WS_WUPT); bf16* WOT = (bf16*)(ws + WS_WOT); bf16* WFF1T = (bf16*)(ws + WS_WFF1T); bf16* WFF2T = (bf16*)(ws + WS_WFF2T);
    LAS float* scr = (LAS float*)((LAS unsigned char*)lds + wave * 16384);
    const int G = gridDim.x, gw = blockIdx.x * 8 + wave, ngw = G * 8;
    bf16* H = (bf16*)((unsigned char*)P.out + DO_H);
    for (int m = gw; m < TOK; m += ngw) rms_row_to_bf16(P.x + (size_t)m * DM, P.g_mix, H + (size_t)m * DM, lane);
    bf16* MEMN = (bf16*)(ws + WS_MEMN);
    for (int m = gw; m < 512; m += ngw) rms_row_to_bf16(P.mem + (size_t)m * DM, P.g_mem, MEMN + (size_t)m * DM, lane);
    transpose_job(P.w_in, DIN, 0, 2048, 4096, W1T, 0, nullptr, scr, gw, ngw, lane);
    transpose_job(P.w_in, DIN, 5136, 2048, 1024, W1T, PC_FK, nullptr, scr, gw, ngw, lane);
    transpose_job(P.w_in, DIN, 4112, 2048, 1024, W1T, PC_FQ, nullptr, scr, gw, ngw, lane);
    transpose_job(P.w_in, DIN, 7192, 2048, 1024, W1T, PC_QM, nullptr, scr, gw, ngw, lane);
    transpose_job(P.w_in, DIN, 6160, 2048, 1024, WFVT, 0, nullptr, scr, gw, ngw, lane);
    transpose_job(P.w_in, DIN, 8216, 2048, 6144, WGT, 0, nullptr, scr, gw, ngw, lane);
    transpose_job(P.w_mem_kv, 2048, 0, 2048, 2048, WMKVT, 0, nullptr, scr, gw, ngw, lane);
    transpose_job(P.w_up_gdn, 2048, 0, 1024, 2048, WUPT, 0, nullptr, scr, gw, ngw, lane);
    transpose_job(P.w_up_fox, 2048, 0, 1024, 2048, WUPT + (size_t)2048 * 1024, 0, nullptr, scr, gw, ngw, lane);
    transpose_job(P.w_up_mem, 2048, 0, 1024, 2048, WUPT + (size_t)2 * 2048 * 1024, 0, nullptr, scr, gw, ngw, lane);
    transpose_job(P.w_out, 2048, 0, 2048, 2048, WOT, 0, nullptr, scr, gw, ngw, lane);
    transpose_job(P.w_ff1, 8192, 0, 2048, 8192, WFF1T, 0, P.g_mlp, scr, gw, ngw, lane);
    transpose_job(P.w_ff2, 2048, 0, 8192, 2048, WFF2T, 0, nullptr, scr, gw, ngw, lane);
    for (int idx = blockIdx.x * 512 + tid; idx < 256 * 2048; idx += G * 512) {
        const int row = idx >> 11, k = idx & 2047; float v = 0.f;
        if (row < 24) { const int col = row < 8 ? 4096 + row : (row < 16 ? 4104 + (row - 8) : 7184 + (row - 16)); v = P.w_in[(size_t)k * DIN + col]; }
        W1T[(size_t)(7168 + row) * 2048 + k] = (bf16)(pk2(v, 0.f) & 0xffffu);
    }
}


__device__ __forceinline__ void gdn_prep_unit(const Params& P, unsigned char* lds_, int bh, int n, int tid, int lane, int wave) {
    float* qs = (float*)lds_;
    float* ks = qs + 64 * 132;
    float* vs = ks + 64 * 132;
    float* Mm = vs + 64 * 132;
    float* QKd = Mm + 4096;
    float* gam = QKd + 4096;
    float* beta = gam + 64;
    float* egam = beta + 64;
    const int b = bh >> 3, h = bh & 7;
    const size_t r0 = (size_t)b * SEQ + (size_t)n * 64;
    const bf16* proj = (const bf16*)(P.ws + WS_PROJ);
    const float* small = (const float*)(P.ws + WS_SMALL);
    if (tid < 384) {
        const int c8 = tid % 48, tg = tid / 48, mat = c8 >> 4, ch0 = (c8 & 15) * 8, col = mat * 1024 + h * 128 + ch0, tb = tg * 8;
        u32x4 xr[11];
#pragma unroll
        for (int i = 0; i < 11; ++i) { const int tt = n * 64 + tb - 3 + i;
            xr[i] = tt >= 0 ? *(const u32x4*)(proj + (r0 + tb - 3 + i) * LDP + col) : u32x4{0u, 0u, 0u, 0u}; }
        f32x4 w0[4], w1[4];
#pragma unroll
        for (int i = 0; i < 4; ++i) { w0[i] = *(const f32x4*)(P.conv_w + i * 3072 + col); w1[i] = *(const f32x4*)(P.conv_w + i * 3072 + col + 4); }
        float* dstb = (mat == 0 ? qs : (mat == 1 ? ks : vs)) + tb * 132 + ch0;
#pragma unroll
        for (int t = 0; t < 8; ++t) {
            float y[8];
#pragma unroll
            for (int e = 0; e < 8; ++e) y[e] = 0.f;
#pragma unroll
            for (int i = 0; i < 4; ++i) { const u32x4 xv = xr[t + i];
                y[0] += bflo(xv.x) * w0[i].x; y[1] += bfhi(xv.x) * w0[i].y; y[2] += bflo(xv.y) * w0[i].z; y[3] += bfhi(xv.y) * w0[i].w;
                y[4] += bflo(xv.z) * w1[i].x; y[5] += bfhi(xv.z) * w1[i].y; y[6] += bflo(xv.w) * w1[i].z; y[7] += bfhi(xv.w) * w1[i].w; }
            f32x4 o0, o1;
            o0.x = y[0] * __builtin_amdgcn_rcpf(1.f + __builtin_amdgcn_exp2f(-LOG2E * y[0])); o0.y = y[1] * __builtin_amdgcn_rcpf(1.f + __builtin_amdgcn_exp2f(-LOG2E * y[1]));
            o0.z = y[2] * __builtin_amdgcn_rcpf(1.f + __builtin_amdgcn_exp2f(-LOG2E * y[2])); o0.w = y[3] * __builtin_amdgcn_rcpf(1.f + __builtin_amdgcn_exp2f(-LOG2E * y[3]));
            o1.x = y[4] * __builtin_amdgcn_rcpf(1.f + __builtin_amdgcn_exp2f(-LOG2E * y[4])); o1.y = y[5] * __builtin_amdgcn_rcpf(1.f + __builtin_amdgcn_exp2f(-LOG2E * y[5]));
            o1.z = y[6] * __builtin_amdgcn_rcpf(1.f + __builtin_amdgcn_exp2f(-LOG2E * y[6])); o1.w = y[7] * __builtin_amdgcn_rcpf(1.f + __builtin_amdgcn_exp2f(-LOG2E * y[7]));
            *(f32x4*)(dstb + t * 132) = o0; *(f32x4*)(dstb + t * 132 + 4) = o1;
        }
    }
    if (wave == 7) {
        const float av = small[(r0 + lane) * 32 + 8 + h], bv = small[(r0 + lane) * 32 + h];
        float g = -__expf(P.a_log[h]) * softplusf_(av + P.dt_bias[h]);
#pragma unroll
        for (int o = 1; o < 64; o <<= 1) { const float t_ = __shfl_up(g, o); if (lane >= o) g += t_; }
        gam[lane] = g; egam[lane] = __expf(g); beta[lane] = sigmoidf_(bv);
    }
    __syncthreads();
    for (int rr = wave * 16; rr < wave * 16 + 16; ++rr) {
        float* row = (rr < 64 ? qs + rr * 132 : ks + (rr - 64) * 132);
        const float a = row[lane], c = row[lane + 64];
        const float ss = wave_sum(a * a + c * c);
        const float sc = rsqrtf(ss + EPSN) * (rr < 64 ? 0.08838834764831845f : 1.f);
        row[lane] = a * sc; row[lane + 64] = c * sc;
    }
    __syncthreads();
    {
        const int mat = tid >> 8, tt = tid & 255, ti = tt >> 4, tj = tt & 15;
        const float* A = mat == 0 ? ks : qs;
        float acc[4][4];
#pragma unroll
        for (int a = 0; a < 4; ++a)
#pragma unroll
            for (int c = 0; c < 4; ++c) acc[a][c] = 0.f;
        for (int d = 0; d < 128; d += 4) {
            f32x4 ra[4], rb[4];
#pragma unroll
            for (int a = 0; a < 4; ++a) ra[a] = *(const f32x4*)(A + (ti + 16 * a) * 132 + d);
#pragma unroll
            for (int c = 0; c < 4; ++c) rb[c] = *(const f32x4*)(ks + (tj + 16 * c) * 132 + d);
#pragma unroll
            for (int a = 0; a < 4; ++a)
#pragma unroll
                for (int c = 0; c < 4; ++c) acc[a][c] += (ra[a].x * rb[c].x + ra[a].y * rb[c].y) + (ra[a].z * rb[c].z + ra[a].w * rb[c].w);
        }
#pragma unroll
        for (int a = 0; a < 4; ++a)
#pragma unroll
            for (int c = 0; c < 4; ++c) { const int i = ti + 16 * a, j = tj + 16 * c;
                const float e = __expf(fminf(gam[i] - gam[j], 0.f));
                if (mat == 0) Mm[j * 64 + i] = (j < i) ? beta[i] * acc[a][c] * e : 0.f;
                else QKd[i * 64 + j] = (j <= i) ? acc[a][c] * e : 0.f; }
    }
    __syncthreads();
    unsigned char* gout = P.ws + WS_GDN + (size_t)(bh * 128 + n) * GDN_CHUNK_BYTES;
    unsigned char* uout = P.ws + WS_UC + (size_t)(bh * 128 + n) * 16384;
    const float glast = gam[63];
    for (int p = tid; p < 2560; p += 512) {
        float v[8]; unsigned char* dst;
        if (p < 1024) {
            const int f = p >> 6, ln = p & 63, rt = f >> 3, kk = f & 7, row = 32 * rt + (ln & 31), hi = ln >> 5;
            const float* src = qs + row * 132 + 16 * kk; const float sc = egam[row];
#pragma unroll
            for (int j = 0; j < 8; ++j) v[j] = src[crow(j, hi)] * sc;
            dst = gout + 16384 + (size_t)p * 16;
        } else if (p < 1536) {
            const int q = p - 1024, f = q >> 6, ln = q & 63, rt = f >> 2, kk = f & 3, row = 32 * rt + (ln & 31), hi = ln >> 5;
#pragma unroll
            for (int j = 0; j < 8; ++j) v[j] = QKd[row * 64 + 16 * kk + crow(j, hi)];
            dst = gout + 32768 + (size_t)q * 16;
        } else {
            const int q = p - 1536, f = q >> 6, ln = q & 63, rt = f >> 2, kk = f & 3, dk = 32 * rt + (ln & 31), hi = ln >> 5;
#pragma unroll
            for (int j = 0; j < 8; ++j) { const int tk = 16 * kk + crow(j, hi); v[j] = ks[tk * 132 + dk] * __expf(fminf(glast - gam[tk], 0.f)); }
            dst = gout + 40960 + (size_t)q * 16;
        }
        u32x4 o; o.x = pk2(v[0], v[1]); o.y = pk2(v[2], v[3]); o.z = pk2(v[4], v[5]); o.w = pk2(v[6], v[7]);
        *(u32x4*)dst = o;
    }
    if (tid == 0) ((float*)(P.ws + WS_CDEC))[bh * 128 + n] = __expf(glast);
    __syncthreads();
    if (tid < 256) {
        float* col = (tid < 128 ? ks : vs) + (tid & 127);
        int zero; asm volatile("v_mov_b32 %0, 0" : "=v"(zero));
#pragma unroll 8
        for (int i = 0; i < 64; ++i) col[i * 132] *= beta[i + zero] * (tid < 128 ? egam[i + zero] : 1.f);
#pragma unroll 1
        for (int ib = 0; ib < 4; ++ib) {
            float acc[16];
#pragma unroll
            for (int r = 0; r < 16; ++r) acc[r] = col[(ib * 16 + r) * 132];
#pragma unroll 4
            for (int j = 0; j < ib * 16; ++j) {
                const float xj = col[j * 132]; const float* mr = Mm + zero + j * 64 + ib * 16;
                const f32x4 m0 = *(const f32x4*)mr, m1 = *(const f32x4*)(mr + 4), m2 = *(const f32x4*)(mr + 8), m3 = *(const f32x4*)(mr + 12);
                acc[0] -= m0.x * xj; acc[1] -= m0.y * xj; acc[2] -= m0.z * xj; acc[3] -= m0.w * xj;
                acc[4] -= m1.x * xj; acc[5] -= m1.y * xj; acc[6] -= m1.z * xj; acc[7] -= m1.w * xj;
                acc[8] -= m2.x * xj; acc[9] -= m2.y * xj; acc[10] -= m2.z * xj; acc[11] -= m2.w * xj;
                acc[12] -= m3.x * xj; acc[13] -= m3.y * xj; acc[14] -= m3.z * xj; acc[15] -= m3.w * xj;
            }
#pragma unroll
            for (int r2 = 0; r2 < 15; ++r2) {
                const float* mr = Mm + (ib * 16 + r2) * 64 + ib * 16; float mm[16];
#pragma unroll
                for (int q = 0; q < 4; ++q) { const f32x4 t4 = *(const f32x4*)(mr + 4 * q); mm[4 * q] = t4.x; mm[4 * q + 1] = t4.y; mm[4 * q + 2] = t4.z; mm[4 * q + 3] = t4.w; }
#pragma unroll
                for (int r = r2 + 1; r < 16; ++r) acc[r] -= mm[r] * acc[r2];
            }
#pragma unroll
            for (int r = 0; r < 16; ++r) col[(ib * 16 + r) * 132] = acc[r];
        }
    }
    __syncthreads();
    for (int p = tid; p < 2048; p += 512) {
        float v[8]; unsigned char* dst;
        if (p < 1024) {
            const int f = p >> 6, ln = p & 63, rt = f >> 3, kk = f & 7, row = 32 * rt + (ln & 31), hi = ln >> 5;
            const float* src = ks + row * 132 + 16 * kk;
#pragma unroll
            for (int j = 0; j < 8; ++j) v[j] = -src[crow(j, hi)];
            dst = gout + (size_t)p * 16;
        } else {
            const int q = p - 1024, half = q & 1, ln = (q >> 1) & 63, g2 = q >> 7, rt = g2 & 1, w4 = g2 >> 1, hi = ln >> 5;
#pragma unroll
            for (int j = 0; j < 8; ++j) v[j] = vs[(32 * rt + crow(8 * half + j, hi)) * 132 + 32 * w4 + (ln & 31)];
            dst = uout + (size_t)q * 16;
        }
        u32x4 o; o.x = pk2(v[0], v[1]); o.y = pk2(v[2], v[3]); o.z = pk2(v[4], v[5]); o.w = pk2(v[6], v[7]);
        *(u32x4*)dst = o;
    }
    __syncthreads();
}

template <int GL, int NB> __device__ __forceinline__ void norm8b(bf16* const (&p)[NB], const bool (&ok)[NB], const float* gain, float mult, float inv_n) {
    u32x4 xv[NB];
#pragma unroll
    for (int b = 0; b < NB; ++b) xv[b] = ok[b] ? *(const u32x4*)p[b] : u32x4{0u, 0u, 0u, 0u};
    const f32x4 g0 = *(const f32x4*)gain, g1 = *(const f32x4*)(gain + 4);
#pragma unroll
    for (int b = 0; b < NB; ++b) {
        float v[8] = {bflo(xv[b].x), bfhi(xv[b].x), bflo(xv[b].y), bfhi(xv[b].y), bflo(xv[b].z), bfhi(xv[b].z), bflo(xv[b].w), bfhi(xv[b].w)};
        float ss = 0.f;
#pragma unroll
        for (int e = 0; e < 8; ++e) ss += v[e] * v[e];
#pragma unroll
        for (int o = 1; o < GL; o <<= 1) ss += __shfl_xor(ss, o);
        const float sc = rsqrtf(ss * inv_n + EPSN) * mult;
        u32x4 o; o.x = pk2(v[0] * sc * g0.x, v[1] * sc * g0.y); o.y = pk2(v[2] * sc * g0.z, v[3] * sc * g0.w);
        o.z = pk2(v[4] * sc * g1.x, v[5] * sc * g1.y); o.w = pk2(v[6] * sc * g1.z, v[7] * sc * g1.w);
        if (ok[b]) *(u32x4*)p[b] = o;
    }
}

__device__ __forceinline__ void phase2(const Params& P, unsigned char* lds, int tid, int lane, int wave) {
    const int G = gridDim.x;
    bf16* proj = (bf16*)(P.ws + WS_PROJ);
    if (blockIdx.x < 16) {
        const int bh = blockIdx.x, b = bh >> 3, h = bh & 7;
        const float* small = (const float*)(P.ws + WS_SMALL);
        float* cum = (float*)(P.ws + WS_CUM) + (size_t)bh * SEQ;
        float* wtot = (float*)lds;
        const float bf = P.fox_b_f[h];
        float v[16]; float run = 0.f;
#pragma unroll
        for (int e = 0; e < 16; ++e) { const float xx = small[((size_t)b * SEQ + tid * 16 + e) * 32 + 16 + h] + bf; run += -softplusf_(-xx) * LOG2E; v[e] = run; }
        float inc = run;
#pragma unroll
        for (int o = 1; o < 64; o <<= 1) { const float t_ = __shfl_up(inc, o); if (lane >= o) inc += t_; }
        if (lane == 63) wtot[wave] = inc;
        { float gq = tid < 128 ? fabsf(P.fox_q_norm[tid]) : 0.f, gk = tid < 128 ? fabsf(P.fox_k_norm[tid]) : 0.f;
#pragma unroll
          for (int o = 1; o < 64; o <<= 1) { gq = fmaxf(gq, __shfl_xor(gq, o)); gk = fmaxf(gk, __shfl_xor(gk, o)); }
          if (lane == 0) { wtot[8 + wave] = gq; wtot[16 + wave] = gk; } }
        __syncthreads();
        if (bh == 0 && tid == 0) { float gq = 0.f, gk = 0.f; for (int w = 0; w < 8; ++w) { gq = fmaxf(gq, wtot[8 + w]); gk = fmaxf(gk, wtot[16 + w]); }
            ((float*)(P.ws + WS_CDEC + 16384))[0] = 150.f + 2.f * 1.03f * (128.f * 0.08838834764831845f * LOG2E) * gq * gk; }
        float off = inc - run;
        for (int w = 0; w < wave; ++w) off += wtot[w];
#pragma unroll
        for (int e = 0; e < 16; ++e) cum[tid * 16 + e] = v[e] + off;
        __syncthreads();
    }
    for (int u = blockIdx.x; u < 2048; u += G) gdn_prep_unit(P, lds, u >> 7, u & 127, tid, lane, wave);
    for (int it0 = blockIdx.x; it0 < TOK / 2; it0 += 4 * G) {
        const int cidx = (tid & 255) * 8, isq = cidx >= 1024, d = cidx & 127;
        bf16* pp[4]; bool ok[4];
#pragma unroll
        for (int b = 0; b < 4; ++b) { const int it = it0 + b * G; ok[b] = it < TOK / 2; pp[b] = proj + (size_t)((ok[b] ? it : 0) * 2 + (tid >> 8)) * LDP + PC_FK + cidx; }
        norm8b<16, 4>(pp, ok, (isq ? P.fox_q_norm : P.fox_k_norm) + d, isq ? 0.08838834764831845f * LOG2E : 1.f, 1.f / 128.f);
    }
    for (int it0 = blockIdx.x; it0 < TOK / 4; it0 += 4 * G) {
        const int cidx = (tid & 127) * 8, d = cidx & 255;
        bf16* pp[4]; bool ok[4];
#pragma unroll
        for (int b = 0; b < 4; ++b) { const int it = it0 + b * G; ok[b] = it < TOK / 4; pp[b] = proj + (size_t)((ok[b] ? it : 0) * 4 + (tid >> 7)) * LDP + PC_QM + cidx; }
        norm8b<32, 4>(pp, ok, P.mem_q_norm + d, 0.0625f * LOG2E, 1.f / 256.f);
    }
    bf16* kmem = (bf16*)(P.ws + WS_KMEM);
    for (int it = blockIdx.x; it < 512 / 4; it += G) {
        const int cidx = (tid & 127) * 8, d = cidx & 255;
        bf16* pp[1] = {kmem + (size_t)(it * 4 + (tid >> 7)) * 1024 + cidx}; const bool ok[1] = {true};
        norm8b<32, 1>(pp, ok, P.mem_k_norm + d, 1.f, 1.f / 256.f);
    }
}

template <int DQK, bool FOX>
__device__ __forceinline__ void attn_unit(unsigned char* lds_, const bf16* Q, int ldq, const bf16* K, int ldk, const bf16* VT, int ldvt, bf16* O, int ldo,
                                          const float* cum, float skip_lim, int t0, int ntiles, int tid, int lane, int wave, int& dbg_tiles, unsigned char* dbg_ws = nullptr) {
    asm volatile("" : "+v"(tid), "+v"(lane));
    constexpr int KS = DQK / 16, KPITCH = DQK * 2 + 16, VPITCH = 136, ND = FOX ? 4 : 2, NH = (DQK / 32) / ND, VCH = ND / 2;
    constexpr int KCH = 64 * DQK / 8 / 512;
    LAS unsigned char* lds = (LAS unsigned char*)lds_;
    LAS unsigned char* Ks = lds; LAS unsigned char* VTs = lds + 64 * KPITCH; LAS float* cbs = (LAS float*)(lds + 64 * KPITCH + 128 * VPITCH);
    const int c = lane & 31, hi = lane >> 5;
    const int qrow = t0 + wave * 32 + c;
    bf16x8 qf[KS];
    { const bf16* qp = Q + (size_t)qrow * ldq + 8 * hi;
#pragma unroll
      for (int k = 0; k < KS; ++k) qf[k] = *(const bf16x8*)(qp + 16 * k); }
    float cref = 0.f; int jmin = 0;
    if (FOX) {
        cref = cum[t0];
        LAS int* jm = (LAS int*)(cbs + 64);
        if (wave < 2) { const int j = wave * 64 + lane; bool need = false; if (j < ntiles) need = (cref - cum[64 * j + 63]) >= -skip_lim;
            const unsigned long long mk = __ballot(need); if (lane == 0) jm[wave] = mk ? (int)__builtin_ctzll(mk) + wave * 64 : (1 << 20); }
        __syncthreads();
        jmin = min(min(jm[0], jm[1]), ntiles - 1);
        jmin = __builtin_amdgcn_readfirstlane(jmin);
    }
    dbg_tiles = 0;
#ifdef PROBE_TS
    if (FOX && dbg_ws && blockIdx.x == 16 && tid == 0) { volatile unsigned long long* dg_ = (volatile unsigned long long*)(dbg_ws + WS_CTL + 32768); dg_[16] += (unsigned long long)(ntiles - jmin) * 375ull; }
#endif
#pragma unroll 1
    for (int half = 0; half < NH; ++half) {
        f32x16 o[ND]; float m = -1e30f, l = 0.f;
#pragma unroll
        for (int d = 0; d < ND; ++d) o[d] = f32x16{};
        constexpr bool PREF = (DQK == 128);
        u32x4 kpre[KCH], vpre[VCH]; float cpre = 0.f;
#define ATT_PREFETCH(j_) do { const int kv0_ = 64 * (j_); \
            _Pragma("unroll") for (int i = 0; i < KCH; ++i) { const int id = tid + 512 * i, row = id / (DQK / 8), cc = id % (DQK / 8); kpre[i] = *(const u32x4*)(K + (size_t)(kv0_ + row) * ldk + cc * 8); } \
            _Pragma("unroll") for (int i = 0; i < VCH; ++i) { const int id = tid + 512 * i, row = id >> 3, cc = id & 7; vpre[i] = *(const u32x4*)(VT + (size_t)(half * ND * 32 + row) * ldvt + kv0_ + cc * 8); } \
            if (FOX) { if (tid < 64) cpre = cum[kv0_ + tid] - cref; } } while (0)
        if (PREF) ATT_PREFETCH(jmin);
#pragma unroll 1
        for (int j = jmin; j < ntiles; ++j) {
            __syncthreads();
            if (!PREF) ATT_PREFETCH(j);
#pragma unroll
            for (int i = 0; i < KCH; ++i) { const int id = tid + 512 * i, row = id / (DQK / 8), cc = id % (DQK / 8); *(LAS u32x4*)(Ks + row * KPITCH + cc * 16) = kpre[i]; }
#pragma unroll
            for (int i = 0; i < VCH; ++i) { const int id = tid + 512 * i, row = id >> 3, cc = id & 7; LAS u32x2* d2 = (LAS u32x2*)(VTs + row * VPITCH + cc * 16);
                d2[0] = (u32x2){vpre[i].x, vpre[i].y}; d2[1] = (u32x2){vpre[i].z, vpre[i].w}; }
            if (FOX) { if (tid < 64) cbs[tid] = cpre; }
            __syncthreads();
            if (PREF && j + 1 < ntiles) ATT_PREFETCH(j + 1);
            const int kv0 = 64 * j;
            if (FOX && kv0 > t0 + wave * 32 + 31) continue;
            f32x16 p0 = f32x16{}, p1 = f32x16{};
            const LAS unsigned char* vb = VTs + c * VPITCH + hi * 8;
            u32x2 vlo[FOX ? 8 : 1], vhh[FOX ? 8 : 1];
            if constexpr (FOX) {
                const LAS unsigned char* kb = Ks + c * KPITCH + hi * 16;
                bf16x8 kf[2 * KS];
#pragma unroll
                for (int k = 0; k < KS; ++k) { kf[2 * k] = *(const LAS bf16x8*)(kb + k * 32); kf[2 * k + 1] = *(const LAS bf16x8*)(kb + 32 * KPITCH + k * 32); }
                __builtin_amdgcn_sched_barrier(0);
#pragma unroll
                for (int k = 0; k < KS; ++k) {
                    p0 = __builtin_amdgcn_mfma_f32_32x32x16_bf16(kf[2 * k], qf[k], p0, 0, 0, 0);
                    p1 = __builtin_amdgcn_mfma_f32_32x32x16_bf16(kf[2 * k + 1], qf[k], p1, 0, 0, 0); }
                __builtin_amdgcn_sched_barrier(0);
#pragma unroll
                for (int d = 0; d < 2; ++d)
#pragma unroll
                    for (int cc = 0; cc < 4; ++cc) { vlo[d * 4 + cc] = *(const LAS u32x2*)(vb + d * 32 * VPITCH + cc * 32); vhh[d * 4 + cc] = *(const LAS u32x2*)(vb + d * 32 * VPITCH + cc * 32 + 16); }
                __builtin_amdgcn_sched_barrier(0);
            } else {
                const LAS unsigned char* kb = Ks + c * KPITCH + hi * 16;
#pragma unroll
                for (int k = 0; k < KS; ++k) {
                    const bf16x8 a0 = *(const LAS bf16x8*)(kb + k * 32), a1 = *(const LAS bf16x8*)(kb + 32 * KPITCH + k * 32);
                    p0 = __builtin_amdgcn_mfma_f32_32x32x16_bf16(a0, qf[k], p0, 0, 0, 0);
                    p1 = __builtin_amdgcn_mfma_f32_32x32x16_bf16(a1, qf[k], p1, 0, 0, 0); }
            }
            if (FOX) {
#pragma unroll
                for (int r4 = 0; r4 < 4; ++r4) { const f32x4 b0 = *(const LAS f32x4*)(cbs + 8 * r4 + 4 * hi), b1 = *(const LAS f32x4*)(cbs + 32 + 8 * r4 + 4 * hi);
#pragma unroll
                    for (int e = 0; e < 4; ++e) { p0[4 * r4 + e] -= b0[e]; p1[4 * r4 + e] -= b1[e]; } }
                if (kv0 + 63 > t0 + wave * 32) {
#pragma unroll
                    for (int r = 0; r < 16; ++r) { const int kv = kv0 + crow(r, hi); if (kv > qrow) p0[r] = -INFINITY; if (kv + 32 > qrow) p1[r] = -INFINITY; }
                }
            }
            float mx = p0[0];
#pragma unroll
            for (int r = 1; r < 16; ++r) mx = fmaxf(mx, p0[r]);
#pragma unroll
            for (int r = 0; r < 16; ++r) mx = fmaxf(mx, p1[r]);
            mx = fmaxf(mx, __shfl_xor(mx, 32));
            const float mn = fmaxf(m, mx), alpha = __builtin_amdgcn_exp2f(m - mn); m = mn;
            float ps = 0.f;
#pragma unroll
            for (int r = 0; r < 16; ++r) { p0[r] = __builtin_amdgcn_exp2f(p0[r] - mn); p1[r] = __builtin_amdgcn_exp2f(p1[r] - mn); ps += p0[r] + p1[r]; }
            l = l * alpha + ps;
#pragma unroll
            for (int d = 0; d < ND; ++d)
#pragma unroll
                for (int r = 0; r < 16; ++r) o[d][r] *= alpha;
            bf16x8 pb[4];
#pragma unroll
            for (int cc = 0; cc < 4; ++cc) { u32x4 w;
                if (cc < 2) { w.x = pk2(p0[8 * cc + 0], p0[8 * cc + 1]); w.y = pk2(p0[8 * cc + 2], p0[8 * cc + 3]); w.z = pk2(p0[8 * cc + 4], p0[8 * cc + 5]); w.w = pk2(p0[8 * cc + 6], p0[8 * cc + 7]); }
                else { const int c2 = cc - 2; w.x = pk2(p1[8 * c2 + 0], p1[8 * c2 + 1]); w.y = pk2(p1[8 * c2 + 2], p1[8 * c2 + 3]); w.z = pk2(p1[8 * c2 + 4], p1[8 * c2 + 5]); w.w = pk2(p1[8 * c2 + 6], p1[8 * c2 + 7]); }
                pb[cc] = __builtin_bit_cast(bf16x8, w); }
            if constexpr (FOX) {
                u32x2 wlo[8], whh[8];
#pragma unroll
                for (int d = 0; d < 2; ++d)
#pragma unroll
                    for (int cc = 0; cc < 4; ++cc) { wlo[d * 4 + cc] = *(const LAS u32x2*)(vb + (d + 2) * 32 * VPITCH + cc * 32); whh[d * 4 + cc] = *(const LAS u32x2*)(vb + (d + 2) * 32 * VPITCH + cc * 32 + 16); }
                __builtin_amdgcn_sched_barrier(0);
#pragma unroll
                for (int cc = 0; cc < 4; ++cc)
#pragma unroll
                    for (int d = 0; d < 2; ++d) { const u32x4 av = (u32x4){vlo[d * 4 + cc].x, vlo[d * 4 + cc].y, vhh[d * 4 + cc].x, vhh[d * 4 + cc].y};
                        o[d] = __builtin_amdgcn_mfma_f32_32x32x16_bf16(__builtin_bit_cast(bf16x8, av), pb[cc], o[d], 0, 0, 0); }
                __builtin_amdgcn_sched_barrier(0);
#pragma unroll
                for (int cc = 0; cc < 4; ++cc)
#pragma unroll
                    for (int d = 0; d < 2; ++d) { const u32x4 av = (u32x4){wlo[d * 4 + cc].x, wlo[d * 4 + cc].y, whh[d * 4 + cc].x, whh[d * 4 + cc].y};
                        o[d + 2] = __builtin_amdgcn_mfma_f32_32x32x16_bf16(__builtin_bit_cast(bf16x8, av), pb[cc], o[d + 2], 0, 0, 0); }
            } else {
#pragma unroll
              for (int d = 0; d < ND; ++d)
#pragma unroll
                  for (int cc = 0; cc < 4; ++cc) {
                      const u32x2 lo = *(const LAS u32x2*)(vb + d * 32 * VPITCH + cc * 32), hh = *(const LAS u32x2*)(vb + d * 32 * VPITCH + cc * 32 + 16);
                      const u32x4 av = (u32x4){lo.x, lo.y, hh.x, hh.y};
                      o[d] = __builtin_amdgcn_mfma_f32_32x32x16_bf16(__builtin_bit_cast(bf16x8, av), pb[cc], o[d], 0, 0, 0); } }
        }
        l += __shfl_xor(l, 32);
        const float rl = 1.f / l;
        bf16* op = O + (size_t)qrow * ldo + half * ND * 32 + 4 * hi;
#pragma unroll
        for (int d = 0; d < ND; ++d)
#pragma unroll
            for (int r4 = 0; r4 < 4; ++r4) { u32x2 w; w.x = pk2(o[d][4 * r4 + 0] * rl, o[d][4 * r4 + 1] * rl); w.y = pk2(o[d][4 * r4 + 2] * rl, o[d][4 * r4 + 3] * rl);
                *(u32x2*)(op + 32 * d + 8 * r4) = w; }
    }
    __syncthreads();
}

__device__ __forceinline__ void gdn_scan_wg(const Params& P, unsigned char* lds_, int bh, int tid, int lane, int wave) {
    LAS unsigned char* lds = (LAS unsigned char*)lds_;
    const int b = bh >> 3, h = bh & 7;
    const unsigned char* gsrc = P.ws + WS_GDN + (size_t)bh * 128 * GDN_CHUNK_BYTES;
    const unsigned char* usrc = P.ws + WS_UC + (size_t)bh * 128 * 16384;
    const float* cdec = (const float*)(P.ws + WS_CDEC) + bh * 128;
    bf16* proj = (bf16*)(P.ws + WS_PROJ);
#define SCAN_BAR() asm volatile("s_waitcnt lgkmcnt(0)\n\ts_barrier" ::: "memory")
    constexpr int OB = 114688;
    if (wave >= 4) {
        const int lt = tid - 256, tk = lt >> 2, q4 = lt & 3;
        const size_t rowb = (size_t)b * SEQ + tk;
        bf16* obase = proj + rowb * LDP + PC_OA + h * 128 + q4 * 32;
        u32x4 r[14];
#pragma unroll
        for (int k = 0; k < 14; ++k) r[k] = *(const u32x4*)(gsrc + (size_t)(lt + 256 * k) * 16);
#pragma unroll
        for (int k = 0; k < 14; ++k) *(LAS u32x4*)(lds + (lt + 256 * k) * 16) = r[k];
#pragma unroll
        for (int k = 0; k < 14; ++k) r[k] = *(const u32x4*)(gsrc + (size_t)GDN_CHUNK_BYTES + (size_t)(lt + 256 * k) * 16);
        __syncthreads();
#define GDN_NORM(CH) do { const LAS unsigned char* ob_ = lds + OB + ((CH) & 1) * 16384 + tk * 256 + q4 * 64; bf16* op_ = obase + (size_t)(CH) * 64 * LDP; \
            _Pragma("unroll") for (int i = 0; i < 4; ++i) { const u32x4 w_ = *(const LAS u32x4*)(ob_ + i * 16); *(u32x4*)(op_ + 8 * i) = w_; } } while (0)
#pragma unroll 1
        for (int n = 0; n < 128; ++n) {
            if (n + 1 < 128) {
                LAS unsigned char* d = lds + ((n + 1) & 1) * GDN_CHUNK_BYTES;
#pragma unroll
                for (int k = 0; k < 14; ++k) *(LAS u32x4*)(d + (lt + 256 * k) * 16) = r[k];
            }
            if (n + 2 < 128) {
                const unsigned char* s2 = gsrc + (size_t)(n + 2) * GDN_CHUNK_BYTES;
#pragma unroll
                for (int k = 0; k < 14; ++k) r[k] = *(const u32x4*)(s2 + (size_t)(lt + 256 * k) * 16);
            }
            if (n > 0) GDN_NORM(n - 1);
            SCAN_BAR();
        }
        GDN_NORM(127);
#undef GDN_NORM
    } else {
        const int w4 = wave, c = lane & 31, hi = lane >> 5;
        f32x16 S[4];
#pragma unroll
        for (int t = 0; t < 4; ++t) S[t] = f32x16{};
        bf16x8 Sb[8];
#pragma unroll
        for (int k = 0; k < 8; ++k) Sb[k] = bf16x8{};
        u32x4 ucn[4];
#pragma unroll
        for (int i = 0; i < 4; ++i) ucn[i] = *(const u32x4*)(usrc + (size_t)((w4 * 2 + (i >> 1)) * 64 + lane) * 32 + (i & 1) * 16);
        float cdn = cdec[0];
        __syncthreads();
#pragma unroll 1
        for (int n = 0; n < 128; ++n) {
            const LAS unsigned char* fb = lds + (n & 1) * GDN_CHUNK_BYTES + lane * 16;
            f32x16 U[2];
#pragma unroll
            for (int rt = 0; rt < 2; ++rt) { const u32x4 a = ucn[2 * rt], bq = ucn[2 * rt + 1];
                U[rt][0] = bflo(a.x); U[rt][1] = bfhi(a.x); U[rt][2] = bflo(a.y); U[rt][3] = bfhi(a.y); U[rt][4] = bflo(a.z); U[rt][5] = bfhi(a.z); U[rt][6] = bflo(a.w); U[rt][7] = bfhi(a.w);
                U[rt][8] = bflo(bq.x); U[rt][9] = bfhi(bq.x); U[rt][10] = bflo(bq.y); U[rt][11] = bfhi(bq.y); U[rt][12] = bflo(bq.z); U[rt][13] = bfhi(bq.z); U[rt][14] = bflo(bq.w); U[rt][15] = bfhi(bq.w); }
            const float cd = cdn;
            if (n + 1 < 128) {
                const unsigned char* us = usrc + (size_t)(n + 1) * 16384;
#pragma unroll
                for (int i = 0; i < 4; ++i) ucn[i] = *(const u32x4*)(us + (size_t)((w4 * 2 + (i >> 1)) * 64 + lane) * 32 + (i & 1) * 16);
                cdn = cdec[n + 1];
            }
#define FRAG(off) (*(const LAS bf16x8*)(fb + (off)))
#define SBAR() __builtin_amdgcn_sched_barrier(0)
            bf16x8 A0[8], A1[8];
#pragma unroll
            for (int i = 0; i < 8; ++i) A0[i] = FRAG(((i & 1) * 8 + (i >> 1)) * 1024);
            SBAR();
#pragma unroll
            for (int i = 0; i < 8; ++i) A1[i] = FRAG(((i & 1) * 8 + 4 + (i >> 1)) * 1024);
            SBAR();
#pragma unroll
            for (int i = 0; i < 8; ++i) U[i & 1] = __builtin_amdgcn_mfma_f32_32x32x16_bf16(A0[i], Sb[i >> 1], U[i & 1], 0, 0, 0);
            SBAR();
#pragma unroll
            for (int i = 0; i < 8; ++i) A0[i] = FRAG(16384 + ((i & 1) * 8 + (i >> 1)) * 1024);
            SBAR();
#pragma unroll
            for (int i = 0; i < 8; ++i) U[i & 1] = __builtin_amdgcn_mfma_f32_32x32x16_bf16(A1[i], Sb[4 + (i >> 1)], U[i & 1], 0, 0, 0);
            SBAR();
#pragma unroll
            for (int i = 0; i < 8; ++i) A1[i] = FRAG(16384 + ((i & 1) * 8 + 4 + (i >> 1)) * 1024);
            SBAR();
            f32x16 Ov[2]; Ov[0] = f32x16{}; Ov[1] = f32x16{};
#pragma unroll
            for (int i = 0; i < 8; ++i) Ov[i & 1] = __builtin_amdgcn_mfma_f32_32x32x16_bf16(A0[i], Sb[i >> 1], Ov[i & 1], 0, 0, 0);
            SBAR();
#pragma unroll
            for (int i = 0; i < 8; ++i) A0[i] = FRAG(32768 + ((i & 1) * 4 + (i >> 1)) * 1024);
            SBAR();
#pragma unroll
            for (int i = 0; i < 8; ++i) Ov[i & 1] = __builtin_amdgcn_mfma_f32_32x32x16_bf16(A1[i], Sb[4 + (i >> 1)], Ov[i & 1], 0, 0, 0);
            SBAR();
            bf16x8 Ub[4];
#pragma unroll
            for (int k2 = 0; k2 < 4; ++k2) { const f32x16& uu = U[k2 >> 1]; const int o8 = 8 * (k2 & 1); u32x4 w;
                w.x = pk2(uu[o8 + 0], uu[o8 + 1]); w.y = pk2(uu[o8 + 2], uu[o8 + 3]); w.z = pk2(uu[o8 + 4], uu[o8 + 5]); w.w = pk2(uu[o8 + 6], uu[o8 + 7]); Ub[k2] = __builtin_bit_cast(bf16x8, w); }
#pragma unroll
            for (int i = 0; i < 8; ++i) A1[i] = FRAG(40960 + ((i & 3) * 4 + (i >> 2)) * 1024);
            SBAR();
#pragma unroll
            for (int i = 0; i < 8; ++i) Ov[i & 1] = __builtin_amdgcn_mfma_f32_32x32x16_bf16(A0[i], Ub[i >> 1], Ov[i & 1], 0, 0, 0);
            SBAR();
#pragma unroll
            for (int i = 0; i < 8; ++i) A0[i] = FRAG(40960 + ((i & 3) * 4 + 2 + (i >> 2)) * 1024);
            SBAR();
#pragma unroll
            for (int t = 0; t < 4; ++t)
#pragma unroll
                for (int r = 0; r < 16; ++r) S[t][r] *= cd;
#pragma unroll
            for (int i = 0; i < 8; ++i) S[i & 3] = __builtin_amdgcn_mfma_f32_32x32x16_bf16(A1[i], Ub[i >> 2], S[i & 3], 0, 0, 0);
            SBAR();
#pragma unroll
            for (int i = 0; i < 8; ++i) S[i & 3] = __builtin_amdgcn_mfma_f32_32x32x16_bf16(A0[i], Ub[2 + (i >> 2)], S[i & 3], 0, 0, 0);
            SBAR();
            { LAS bf16* ob = (LAS bf16*)(lds + OB + (n & 1) * 16384);
#pragma unroll
              for (int rt = 0; rt < 2; ++rt)
#pragma unroll
                  for (int r = 0; r < 16; ++r) ob[(32 * rt + crow(r, hi)) * 128 + 32 * w4 + c] = (bf16)(pk2(Ov[rt][r], 0.f) & 0xffffu); }
#pragma unroll
            for (int k = 0; k < 8; ++k) { const f32x16& ss = S[k >> 1]; const int o8 = 8 * (k & 1); u32x4 w;
                w.x = pk2(ss[o8 + 0], ss[o8 + 1]); w.y = pk2(ss[o8 + 2], ss[o8 + 3]); w.z = pk2(ss[o8 + 4], ss[o8 + 5]); w.w = pk2(ss[o8 + 6], ss[o8 + 7]); Sb[k] = __builtin_bit_cast(bf16x8, w); }
#undef FRAG
#undef SBAR
            SCAN_BAR();
        }
    }
    __syncthreads();
}

__device__ __forceinline__ void phase3(const Params& P, unsigned char* lds, int tid, int lane, int wave) {
    bf16* proj = (bf16*)(P.ws + WS_PROJ);
#ifndef NO_SCAN
    if (blockIdx.x < 16) gdn_scan_wg(P, lds, blockIdx.x, tid, lane, wave);
#endif
#ifdef PROBE_TS
    if (blockIdx.x == 0 && tid == 0) ((volatile unsigned long long*)(P.ws + WS_CTL + 32768))[10] = __builtin_amdgcn_s_memrealtime();
#endif
    unsigned* ctr = (unsigned*)(P.ws + WS_CTL);
    LAS unsigned* sh = (LAS unsigned*)((LAS unsigned char*)lds + LDS_BYTES - 64);
    const bf16* foxvt = (const bf16*)((const unsigned char*)P.out + DO_FOXVT);
    const float* cum = (const float*)(P.ws + WS_CUM);
    const bf16* kmem = (const bf16*)(P.ws + WS_KMEM); const bf16* vmt = (const bf16*)(P.ws + WS_VMT);
#ifdef STATIC_P3
    for (unsigned idx_ = (blockIdx.x < 16 ? 100000u : blockIdx.x - 16u); idx_ < 768u; idx_ += 240u) {
        const unsigned idx = __builtin_amdgcn_readfirstlane(idx_);
#else
    for (;;) {
        if (tid == 0) sh[0] = atomicAdd(ctr, 1u);
        __syncthreads();
        const unsigned idx = __builtin_amdgcn_readfirstlane(sh[0]);
        __syncthreads();
        if (idx >= 512u + 256u) break;
#endif
        int dbg_t = 0;
#ifdef PROBE_TS
        if (blockIdx.x == 16 && tid == 0) ((volatile unsigned long long*)(P.ws + WS_CTL + 32768))[20] = __builtin_amdgcn_s_memrealtime();
#endif
        if (idx < 512u) {
#ifndef NO_FOXATT
            const int qb = 31 - (int)(idx >> 4), bh = idx & 15, b = bh >> 3, h = bh & 7;
            bf16* Qp = proj + (size_t)b * SEQ * LDP + PC_FQ + h * 128;
            const bf16* Kp = proj + (size_t)b * SEQ * LDP + PC_FK + h * 128;
            const bf16* Vp = foxvt + (size_t)(h * 128) * TOK + (size_t)b * SEQ;
            attn_unit<128, true>(lds, Qp, LDP, Kp, LDP, Vp, TOK, Qp, LDP, cum + (size_t)bh * SEQ, ((const float*)(P.ws + WS_CDEC + 16384))[0], qb * 256, (qb + 1) * 4, tid, lane, wave, dbg_t, P.ws);
#ifdef PROBE_TS
            if (blockIdx.x == 16 && tid == 0) { volatile unsigned long long* dg = (volatile unsigned long long*)(P.ws + WS_CTL + 32768); dg[14] += __builtin_amdgcn_s_memrealtime() - dg[20]; }
#endif
#endif
        } else {
#ifndef NO_MEMATT
            const int u = idx - 512, qb = u & 31, bh = u >> 5, b = bh >> 2, h = bh & 3;
            bf16* Qp = proj + (size_t)b * SEQ * LDP + PC_QM + h * 256;
            const bf16* Kp = kmem + (size_t)b * 256 * 1024 + h * 256;
            const bf16* Vp = vmt + (size_t)(h * 256) * 512 + b * 256;
            attn_unit<256, false>(lds, Qp, LDP, Kp, 1024, Vp, 512, Qp, LDP, nullptr, 0.f, qb * 256, 4, tid, lane, wave, dbg_t);
#ifdef PROBE_TS
            if (blockIdx.x == 16 && tid == 0) { volatile unsigned long long* dg = (volatile unsigned long long*)(P.ws + WS_CTL + 32768); dg[18] += __builtin_amdgcn_s_memrealtime() - dg[20]; }
#endif
#endif
        }
    }
#ifdef PROBE_TS
    if (blockIdx.x == 0 && tid == 0) ((volatile unsigned long long*)(P.ws + WS_CTL + 32768))[11] = __builtin_amdgcn_s_memrealtime();
#endif
}


__device__ __forceinline__ void gdn_gate_norm_pass(const Params& P, int tid) {
    bf16* proj = (bf16*)(P.ws + WS_PROJ);
    const int cidx = (tid & 127) * 8, d = cidx & 127;
    const f32x4 g0 = *(const f32x4*)(P.gdn_norm_g + d), g1 = *(const f32x4*)(P.gdn_norm_g + d + 4);
    const float gg[8] = {g0.x, g0.y, g0.z, g0.w, g1.x, g1.y, g1.z, g1.w};
    for (int it0 = blockIdx.x; it0 < TOK / 4; it0 += 4 * gridDim.x) {
        u32x4 ov[4], zv[4]; bool ok[4]; bf16* op[4];
#pragma unroll
        for (int b = 0; b < 4; ++b) { const int it = it0 + b * gridDim.x; ok[b] = it < TOK / 4; const size_t row = (size_t)((ok[b] ? it : 0) * 4 + (tid >> 7));
            op[b] = proj + row * LDP + PC_OA + cidx; ov[b] = *(const u32x4*)op[b]; zv[b] = *(const u32x4*)(proj + row * LDP + PC_Z + cidx); }
#pragma unroll
        for (int b = 0; b < 4; ++b) {
            const float v[8] = {bflo(ov[b].x), bfhi(ov[b].x), bflo(ov[b].y), bfhi(ov[b].y), bflo(ov[b].z), bfhi(ov[b].z), bflo(ov[b].w), bfhi(ov[b].w)};
            const float z[8] = {bflo(zv[b].x), bfhi(zv[b].x), bflo(zv[b].y), bfhi(zv[b].y), bflo(zv[b].z), bfhi(zv[b].z), bflo(zv[b].w), bfhi(zv[b].w)};
            float ss = 0.f;
#pragma unroll
            for (int e = 0; e < 8; ++e) ss += v[e] * v[e];
            ss += __shfl_xor(ss, 1); ss += __shfl_xor(ss, 2); ss += __shfl_xor(ss, 4); ss += __shfl_xor(ss, 8);
            const float rstd = rsqrtf(ss * (1.f / 128.f) + EPSN);
            float o[8];
#pragma unroll
            for (int e = 0; e < 8; ++e) o[e] = v[e] * rstd * gg[e] * (z[e] * __builtin_amdgcn_rcpf(1.f + __builtin_amdgcn_exp2f(-LOG2E * z[e])));
            u32x4 w; w.x = pk2(o[0], o[1]); w.y = pk2(o[2], o[3]); w.z = pk2(o[4], o[5]); w.w = pk2(o[6], o[7]);
            if (ok[b]) *(u32x4*)op[b] = w;
        }
    }
}

#define RLX_AGENT __ATOMIC_RELAXED, __HIP_MEMORY_SCOPE_AGENT
#define XB_TMO      128
#define XB_XCNT(j)  (256  + 64 * (j))
#define XB_XSUB(j)  (1280 + 64 * (j))
#define XB_XGEN(j)  (2304 + 64 * (j))
#define XB_TOP      3328
#define XB_TOPGEN   3392
#define XCD_BAR_WORDS 3456
#define XB_SPIN_CAP (1u << 22)

__device__ __forceinline__ unsigned xb_ld(unsigned* p)              { return __hip_atomic_load(p, __ATOMIC_RELAXED, __HIP_MEMORY_SCOPE_AGENT); }
__device__ __forceinline__ unsigned xb_add(unsigned* p, unsigned v) { return __hip_atomic_fetch_add(p, v, __ATOMIC_RELAXED, __HIP_MEMORY_SCOPE_AGENT); }
__device__ __forceinline__ unsigned xb_xcc_id() { return (unsigned)__builtin_amdgcn_s_getreg((3 << 11) | 20) & 0xFu; }
#define XB_SPIN(cond, bar) do { unsigned _sp = 0; while (cond) { __builtin_amdgcn_s_sleep(1); \
    if ((++_sp & 255u) == 0u) { if (xb_ld(&(bar)[XB_TMO])) break; if (_sp > XB_SPIN_CAP) { atomicAdd(&(bar)[XB_TMO], 1u); break; } } } } while (0)

struct XcdBarrier {
    unsigned* bar; unsigned x;
    volatile LAS unsigned* st;
};

__device__ __forceinline__ XcdBarrier xcd_barrier_post(unsigned* bar, volatile LAS unsigned* st) {
    XcdBarrier b; b.bar = bar; b.x = xb_xcc_id(); b.st = st;
    if (threadIdx.x == 0) (void)xb_add(&bar[XB_XCNT(b.x)], 1u);
    return b;
}
__device__ __forceinline__ void xcd_barrier_complete(unsigned* bar, unsigned x, unsigned& nloc, unsigned& nx) {
    const unsigned G = gridDim.x * gridDim.y * gridDim.z;
    unsigned sum, cnt, mine, sp = 0u;
    for (;;) {
        sum = 0u; cnt = 0u; mine = 0u;
#pragma unroll
        for (unsigned j = 0; j < 16; ++j) { const unsigned c = xb_ld(&bar[XB_XCNT(j)]); sum += c; cnt += (c > 0u) ? 1u : 0u; mine = (j == x) ? c : mine; }
        if (sum == G) break;
        __builtin_amdgcn_s_sleep(1);
        if ((++sp & 255u) == 0u) { if (xb_ld(&bar[XB_TMO])) break; if (sp > XB_SPIN_CAP) { atomicAdd(&bar[XB_TMO], 1u); break; } }
    }
    nloc = mine > 0u ? mine : 1u; nx = cnt > 0u ? cnt : 1u;
}

__device__ __forceinline__ void xcd_barrier(const XcdBarrier& b) {
    asm volatile("s_waitcnt vmcnt(0)" ::: "memory");
    __syncthreads();
    if (threadIdx.x == 0) {
        unsigned* bar = b.bar;
        __builtin_amdgcn_s_waitcnt(0);
        unsigned nloc = b.st[0], nx = b.st[1];
        if (nloc == 0u) { xcd_barrier_complete(bar, b.x, nloc, nx); b.st[0] = nloc; b.st[1] = nx; }
        const unsigned old = xb_add(&bar[XB_XSUB(b.x)], 1u);
        const unsigned gen = old / nloc;
        if (old + 1u == (gen + 1u) * nloc) {
            __builtin_amdgcn_fence(__ATOMIC_RELEASE, "agent");
            asm volatile("s_waitcnt vmcnt(0)" ::: "memory");
            const unsigned og = xb_add(&bar[XB_TOP], 1u);
            const unsigned tg = og / nx;
            if (og + 1u == (tg + 1u) * nx) xb_add(&bar[XB_TOPGEN], 1u);
            else XB_SPIN(xb_ld(&bar[XB_TOPGEN]) == tg, bar);
            __builtin_amdgcn_fence(__ATOMIC_ACQUIRE, "agent");
            xb_add(&bar[XB_XGEN(b.x)], 1u);
            asm volatile("s_waitcnt vmcnt(0)" ::: "memory");
        } else {
            XB_SPIN(xb_ld(&bar[XB_XGEN(b.x)]) == gen, bar);
            __builtin_amdgcn_fence(__ATOMIC_ACQUIRE, "agent");
            asm volatile("s_waitcnt vmcnt(0)" ::: "memory");
        }
    }
    __syncthreads();
}

__global__ void __launch_bounds__(512, 2) hybrid_fwd(Params P) {
    extern __shared__ __attribute__((aligned(16))) unsigned char lds[];
    cg::grid_group grid = cg::this_grid();
    const int tid = threadIdx.x, lane = tid & 63, wave = __builtin_amdgcn_readfirstlane(tid >> 6);
    const int G = gridDim.x, cb = blockIdx.x;
    unsigned char* ws = P.ws;
    LAS unsigned char* glds = (LAS unsigned char*)lds;
    bf16* H = (bf16*)((unsigned char*)P.out + DO_H);
    bf16* proj = (bf16*)(ws + WS_PROJ);
    volatile LAS unsigned* bst = (volatile LAS unsigned*)(glds + LDS_BYTES - 32);
    if (tid < 2) bst[tid] = 0u;
    __syncthreads();
    XcdBarrier bar = xcd_barrier_post((unsigned*)(ws + WS_CTL) + 1024, bst);
#ifdef PROBE_TS
    volatile unsigned long long* tsg_ = (volatile unsigned long long*)(ws + WS_CTL + 32768);
    if (blockIdx.x == 0 && tid == 0) tsg_[0] = __builtin_amdgcn_s_memrealtime();
#endif
    grid.sync();
#ifdef PROBE_TS
#define GRID_BAR(k_) do { xcd_barrier(bar); if (blockIdx.x == 0 && tid == 0) tsg_[k_] = __builtin_amdgcn_s_memrealtime(); } while (0)
#else
#define GRID_BAR(k_) xcd_barrier(bar)
#endif

#ifndef NO_P0
    phase0(P, lds, tid, lane, wave);
#endif
    GRID_BAR(1);
#ifndef NO_GEMM
    {
        pg8::Gemm g{H, (const bf16*)(ws + WS_W1T), TOK, 7424, 2048, 2048, 2048}; pg8::StaticOrder S; S.init(TOK, 7424, G, cb);
        pg8::EpiProj E{proj, LDP, (float*)(ws + WS_SMALL)};
        pg8::gemm_phase<pg8::EpiProj, pg8::StaticOrder, true, true>(glds, g, S, E);
    }
    {
        pg8::Gemm g{(const bf16*)(ws + WS_WFVT), H, 1024, TOK, 2048, 2048, 2048}; pg8::StaticOrder S; S.init(1024, TOK, G, cb);
        pg8::EpiStore E{(bf16*)((unsigned char*)P.out + DO_FOXVT), TOK};
        pg8::gemm_phase<pg8::EpiStore, pg8::StaticOrder, true, true>(glds, g, S, E);
    }
    {
        const int cr = (cb + G - 64) % G;
        pg8::Gemm g{(const bf16*)(ws + WS_MEMN), (const bf16*)(ws + WS_WMKVT), 512, 1024, 2048, 2048, 2048}; pg8::StaticOrder S; S.init(512, 1024, G, cr);
        pg8::EpiStore E{(bf16*)(ws + WS_KMEM), 1024};
        pg8::gemm_phase<pg8::EpiStore, pg8::StaticOrder, true, true>(glds, g, S, E);
        const int cr2 = (cb + G - 72) % G;
        pg8::Gemm g2{(const bf16*)(ws + WS_WMKVT) + (size_t)1024 * 2048, (const bf16*)(ws + WS_MEMN), 1024, 512, 2048, 2048, 2048}; pg8::StaticOrder S2; S2.init(1024, 512, G, cr2);
        pg8::EpiStore E2{(bf16*)(ws + WS_VMT), 512};
        pg8::gemm_phase<pg8::EpiStore, pg8::StaticOrder, true, true>(glds, g2, S2, E2);
    }
#endif
    GRID_BAR(2);
#ifndef NO_P2
    phase2(P, lds, tid, lane, wave);
#endif
    GRID_BAR(3);
#ifndef NO_P3
    phase3(P, lds, tid, lane, wave);
#endif
    GRID_BAR(4);
#ifndef NO_GEMM
    gdn_gate_norm_pass(P, tid);
    {
        pg8::Gemm g{H, (const bf16*)(ws + WS_WGT), TOK, 6144, 2048, 2048, 2048}; pg8::StaticOrder S; S.init(TOK, 6144, G, cb);
        pg8::EpiSig E{(unsigned char*)P.out + DO_GA, (unsigned char*)(proj + PC_GB), 2048, LDP * 2};
        pg8::gemm_phase<pg8::EpiSig, pg8::StaticOrder, true, true>(glds, g, S, E);
    }
    GRID_BAR(5);
    {
        bf16* Y = (bf16*)(ws + WS_Y); const bf16* WUPT = (const bf16*)(ws + WS_WUPT);
        pg8::StaticOrder S; S.init(TOK, 2048, G, cb);
        { pg8::Gemm g{proj + PC_OA, WUPT, TOK, 2048, 1024, LDP, 1024}; pg8::EpiGate<true> E{(const unsigned char*)P.out + DO_GA, 2048, Y, 2048};
          pg8::gemm_phase<pg8::EpiGate<true>, pg8::StaticOrder, true, true>(glds, g, S, E); }
        { pg8::Gemm g{proj + PC_OB, WUPT + (size_t)2048 * 1024, TOK, 2048, 1024, LDP, 1024}; pg8::EpiGate<false> E{(const unsigned char*)(proj + PC_GB), LDP * 2, Y, 2048};
          pg8::gemm_phase<pg8::EpiGate<false>, pg8::StaticOrder, true, true>(glds, g, S, E); }
        { pg8::Gemm g{proj + PC_OM, WUPT + (size_t)2 * 2048 * 1024, TOK, 2048, 1024, LDP, 1024}; pg8::EpiGate<false> E{(const unsigned char*)(proj + PC_GB) + 2048, LDP * 2, Y, 2048};
          pg8::gemm_phase<pg8::EpiGate<false>, pg8::StaticOrder, true, true>(glds, g, S, E); }
    }
    GRID_BAR(6);
    {
        pg8::Gemm g{(const bf16*)(ws + WS_Y), (const bf16*)(ws + WS_WOT), TOK, 2048, 2048, 2048, 2048}; pg8::StaticOrder S; S.init(TOK, 2048, G, cb);
        pg8::EpiRes1 E{P.x, (bf16*)(ws + WS_X1B), (float*)(ws + WS_SSQ)};
        pg8::gemm_phase<pg8::EpiRes1, pg8::StaticOrder, true, true>(glds, g, S, E);
    }
    GRID_BAR(7);
    {
        const float* SSQ = (const float*)(ws + WS_SSQ); float* RSTD = (float*)(ws + WS_RSTD);
        const int g = cb * 512 + tid;
        if (g < TOK * 8) { const int row = g >> 3, part = g & 7; float sq = 0.f;
#pragma unroll
            for (int q = 0; q < 4; ++q) sq += SSQ[(size_t)(part * 4 + q) * 16384 + row];
            sq += __shfl_xor(sq, 1); sq += __shfl_xor(sq, 2); sq += __shfl_xor(sq, 4);
            if (part == 0) RSTD[row] = rsqrtf(sq * (1.f / 2048.f) + 1e-6f); }
    }
    GRID_BAR(8);
    {
        pg8::Gemm g{(const bf16*)(ws + WS_X1B), (const bf16*)(ws + WS_WFF1T), TOK, 8192, 2048, 2048, 2048}; pg8::StaticOrder S; S.init(TOK, 8192, G, cb);
        pg8::EpiFF1 E{(const float*)(ws + WS_RSTD), (bf16*)(ws + WS_U), 8192};
        pg8::gemm_phase<pg8::EpiFF1, pg8::StaticOrder, true, true>(glds, g, S, E);
    }
    GRID_BAR(9);
    {
        pg8::Gemm g{(const bf16*)(ws + WS_U), (const bf16*)(ws + WS_WFF2T), TOK, 2048, 8192, 8192, 8192}; pg8::StaticOrder S; S.init(TOK, 2048, G, cb, 4);
        pg8::EpiOut E{(const bf16*)(ws + WS_X1B), P.out};
        pg8::gemm_phase<pg8::EpiOut, pg8::StaticOrder, true, true>(glds, g, S, E);
    }
#endif
#ifdef PROBE_TS
    if (blockIdx.x == 0 && tid == 0) {
        const unsigned long long tend = __builtin_amdgcn_s_memrealtime();
        tsg_[12] = tend;
        long long qa = ((long long)(tsg_[PROBE_A1] - tsg_[PROBE_A0]) + 1500) / 3000; if (qa > 35) qa = 35;
        long long qb = ((long long)(tsg_[PROBE_B1] - tsg_[PROBE_B0]) + 1500) / 3000; if (qb > 35) qb = 35;
        long long qc = ((long long)(tsg_[PROBE_C1] - tsg_[PROBE_C0]) + 1500) / 3000; if (qc > 35) qc = 35;
        const unsigned long long until = tend + (unsigned long long)(qa + 36 * qb + 1296 * qc) * 2000ull;
        while (__builtin_amdgcn_s_memrealtime() < until) __builtin_amdgcn_s_sleep(8);
    }
#endif
}

extern "C" void kernel_launch(void* const* d_in, const int* in_sizes, int n_in, void* d_out, int out_size, void* d_ws, size_t ws_size, hipStream_t stream) {
    static int grid = 0;
    if (grid == 0) {
        if (n_in != 22 || out_size != TOK * DM || ws_size < WS_END) { fprintf(stderr, "kernel_launch: unexpected shapes (n_in %d out %d ws %zu)\n", n_in, out_size, ws_size); grid = -1; return; }
        int dev = 0, cus = 0, per_cu = 0;
        hipGetDevice(&dev); hipDeviceGetAttribute(&cus, hipDeviceAttributeMultiprocessorCount, dev);
        if (hipFuncSetAttribute((const void*)hybrid_fwd, hipFuncAttributeMaxDynamicSharedMemorySize, LDS_BYTES) != hipSuccess) { fprintf(stderr, "kernel_launch: hipFuncSetAttribute failed\n"); grid = -1; return; }
        if (hipOccupancyMaxActiveBlocksPerMultiprocessor(&per_cu, (const void*)hybrid_fwd, 512, LDS_BYTES) != hipSuccess || per_cu < 1) { fprintf(stderr, "kernel_launch: occupancy query says %d\n", per_cu); per_cu = 1; }
        (void)hipGetLastError();
        grid = cus * 1;
        if (grid <= 0) grid = 256;
    }
    if (grid < 0) return;
    if (hipMemsetAsync((char*)d_ws + WS_CTL, 0, 65536, stream) != hipSuccess) { fprintf(stderr, "kernel_launch: memset failed\n"); return; }
    Params p{};
    const float** pp = (const float**)&p;
    for (int i = 0; i < 22; ++i) pp[i] = (const float*)d_in[i];
    p.out = (float*)d_out; p.ws = (unsigned char*)d_ws;
    void* args[] = {&p};
    hipError_t e = hipLaunchCooperativeKernel((const void*)hybrid_fwd, dim3(grid), dim3(512), args, LDS_BYTES, stream);
    if (e != hipSuccess) fprintf(stderr, "cooperative launch failed: %s (grid %d)\n", hipGetErrorString(e), grid);
}
```

```cpp
#include <hip/hip_runtime.h>
#include <hip/hip_cooperative_groups.h>
#include <cstdio>
#include <cstdint>
namespace cg = cooperative_groups;

namespace pg8 {
#define PG8_LAS __attribute__((address_space(3)))
typedef unsigned short bf16_t;
typedef short bf16x8 __attribute__((ext_vector_type(8)));
typedef float f32x4 __attribute__((ext_vector_type(4)));
typedef unsigned u32x4 __attribute__((ext_vector_type(4)));
constexpr int BM = 256, BK = 64, HALF = 128, HTB = HALF * BK * 2  , STAGE_BYTES = 8 * HTB, NXCD = 8, WGM = 8;

__host__ __device__ __forceinline__ int lds_byte(int r, int c) { const int st = (r >> 4) * 2 + (c >> 5), rr = r & 15, cc = c & 31, ob = rr * 64 + cc * 2; return st * 1024 + (ob ^ (((ob >> 9) & 1) << 5)); }
__host__ __device__ __forceinline__ void stage_rc(int b, int& R, int& C) { const int st = b / 1024, sb = b % 1024, swz = sb ^ (((sb >> 9) & 1) << 5); R = (st >> 1) * 16 + swz / 64; C = (st & 1) * 32 + (swz % 64) / 2; }
__host__ __device__ __forceinline__ int perm32(int rho) { const int n = rho >> 4, i = rho & 15; return 8 * (i >> 2) + 4 * n + (i & 3); }

struct Unit { int pm, pn; };
struct Gemm { const bf16_t* A; const bf16_t* Bt; int M, N, K, lda, ldb; };

struct StaticOrder {
    int nM, nN, nwg, G, c, wgm;
    __host__ __device__ void init(int M, int N, int G_, int c_, int wgm_ = WGM) { nM = M / BM; nN = N / BM; nwg = nM * nN; G = G_; c = c_; wgm = wgm_; }
    __host__ __device__ bool next(int i, Unit& u) const {
        const long L = (long)i * G + c; if (L >= nwg) return false;
        int wgid = (int)L; { const int q = nwg / NXCD, r = nwg % NXCD, xcd = wgid % NXCD, off = wgid / NXCD; wgid = (xcd < r ? xcd * (q + 1) : r * (q + 1) + (xcd - r) * q) + off; }
        const int nig = wgm * nN, gid = wgid / nig, fm = gid * wgm, gsz = (nM - fm) < wgm ? (nM - fm) : wgm;
        u.pm = fm + ((wgid % nig) % gsz); u.pn = (wgid % nig) / gsz; return true;
    }
    __device__ __forceinline__ void a_ready(const Unit&) const {}
    __device__ __forceinline__ void done(const Unit&) const {}
};

typedef float f32x2_cv __attribute__((ext_vector_type(2))); typedef __bf16 bf16x2_cv __attribute__((ext_vector_type(2)));
__device__ __forceinline__ unsigned cvt_pk_bf16(float lo, float hi) { f32x2_cv v = {lo, hi}; bf16x2_cv b = __builtin_convertvector(v, bf16x2_cv); return __builtin_bit_cast(unsigned, b); }
template <class Epi, class Sched, bool ALIGN_EPI = false, bool SP2 = false>
__device__ __forceinline__ void gemm_phase(PG8_LAS unsigned char* lds, const Gemm g, const Sched& S, const Epi& E) {
    int tid_ = threadIdx.x; asm volatile("" : "+v"(tid_));
    const int tid = tid_, wid = __builtin_amdgcn_readfirstlane(tid >> 6), lane = tid & 63, wr = wid >> 2, wc = wid & 3, fr = lane & 15, fq = lane >> 4;
    const int K = g.K, nt = K / BK;
    unsigned voffA[2], voffB[2];
#pragma unroll
    for (int i = 0; i < 2; ++i) { int R, C; stage_rc(tid * 16 + i * 8192, R, C); const int Rb = Epi::PERM ? ((R & ~31) + perm32(R & 31)) : R;
        voffA[i] = (unsigned)(R * g.lda + C) * 2u; voffB[i] = (unsigned)(Rb * g.ldb + C) * 2u; }
    const size_t kstep = (size_t)(BK * 2);
    const size_t hstepA = (size_t)HALF * g.lda * 2, hstepB = (size_t)HALF * g.ldb * 2;
    const size_t tstepA = 2 * hstepA, tstepB = 2 * hstepB;
    const unsigned ldsw = (unsigned)wid * 1024u;
    const int aoff = lds_byte(wr * 64 + fr, fq * 8), boff = lds_byte(wc * 32 + fr, fq * 8);
#define PG8_SA(b, h) (((b) * 2 + (h)) * HTB)
#define PG8_SB(b, h) ((4 + (b) * 2 + (h)) * HTB)
#define PG8_STAGE(bufoff, gbase, voff) do { _Pragma("unroll") for (int _i = 0; _i < 2; ++_i) \
        __builtin_amdgcn_global_load_lds((const unsigned*)((const char*)(gbase) + (voff)[_i]), (PG8_LAS unsigned*)(lds + (bufoff) + ldsw + _i * 8192), 16, 0, 0); } while (0)
#define PG8_LDA(dst, b, h) do { _Pragma("unroll") for (int m = 0; m < 4; ++m) _Pragma("unroll") for (int k = 0; k < 2; ++k) dst[m][k] = *(const PG8_LAS bf16x8*)(lds + PG8_SA(b, h) + aoff + m * 2048 + k * 1024); } while (0)
#define PG8_LDB(dst, b, h) do { _Pragma("unroll") for (int n = 0; n < 2; ++n) _Pragma("unroll") for (int k = 0; k < 2; ++k) dst[n][k] = *(const PG8_LAS bf16x8*)(lds + PG8_SB(b, h) + boff + n * 2048 + k * 1024); } while (0)
#define PG8_MMA(ai, bj, At, Bt) do { __builtin_amdgcn_s_setprio(1); _Pragma("unroll") for (int m = 0; m < 4; ++m) _Pragma("unroll") for (int n = 0; n < 2; ++n) _Pragma("unroll") for (int k = 0; k < 2; ++k) \
        acc[ai][bj][m][n] = __builtin_amdgcn_mfma_f32_16x16x32_bf16(Bt[n][k], At[m][k], acc[ai][bj][m][n], 0, 0, 0); __builtin_amdgcn_s_setprio(0); } while (0)
#define PG8_WAIT_V(n) asm volatile("s_waitcnt vmcnt(" #n ")" ::: "memory")
#define PG8_WAIT_L(n) asm volatile("s_waitcnt lgkmcnt(" #n ")" ::: "memory")
#define PG8_BAR __builtin_amdgcn_s_barrier()
#define PG8_SCHED __builtin_amdgcn_sched_barrier(0)
    Unit cur, nxt; int ui = 0;
    if (!S.next(0, cur)) return;
    f32x4 acc[2][2][4][2];
#pragma unroll
    for (int a = 0; a < 2; ++a)
#pragma unroll
        for (int b = 0; b < 2; ++b)
#pragma unroll
            for (int m = 0; m < 4; ++m)
#pragma unroll
                for (int n = 0; n < 2; ++n) acc[a][b][m][n] = (f32x4){0.f, 0.f, 0.f, 0.f};
    bf16x8 At[4][2], B0[2][2], B1[2][2];
    const char* cA = (const char*)g.A + (size_t)cur.pm * tstepA; const char* cB = (const char*)g.Bt + (size_t)cur.pn * tstepB;
    S.a_ready(cur);
    if constexpr (SP2) {
        PG8_STAGE(PG8_SB(0, 0), cB, voffB); PG8_STAGE(PG8_SB(0, 1), cB + hstepB, voffB); PG8_STAGE(PG8_SA(0, 0), cA, voffA); PG8_STAGE(PG8_SA(0, 1), cA + hstepA, voffA);
        if (wr == 1) PG8_BAR;
        PG8_WAIT_V(2); PG8_BAR;
        PG8_STAGE(PG8_SB(1, 0), cB + kstep, voffB); PG8_STAGE(PG8_SA(1, 0), cA + kstep, voffA); PG8_STAGE(PG8_SB(1, 1), cB + hstepB + kstep, voffB);
        PG8_WAIT_V(6); PG8_BAR;
    } else {
        PG8_STAGE(PG8_SB(0, 0), cB, voffB); PG8_STAGE(PG8_SA(0, 0), cA, voffA); PG8_STAGE(PG8_SB(0, 1), cB + hstepB, voffB); PG8_STAGE(PG8_SA(0, 1), cA + hstepA, voffA);
        if (wr == 1) PG8_BAR;
        PG8_WAIT_V(4); PG8_BAR;
        PG8_STAGE(PG8_SB(1, 0), cB + kstep, voffB); PG8_STAGE(PG8_SA(1, 0), cA + kstep, voffA); PG8_STAGE(PG8_SB(1, 1), cB + hstepB + kstep, voffB);
        PG8_WAIT_V(6); PG8_BAR;
    }
    for (;;) {
        const bool has_next = S.next(ui + 1, nxt);
        const char* nA = has_next ? (const char*)g.A + (size_t)nxt.pm * tstepA : cA; const char* nB = has_next ? (const char*)g.Bt + (size_t)nxt.pn * tstepB : cB;
        for (int t = 0; t < nt; t += 2) {
            const bool last = (t == nt - 2);
            const char* a1 = cA + (size_t)(t + 1) * kstep;
            const char* a2 = last ? nA : cA + (size_t)(t + 2) * kstep; const char* b2 = last ? nB : cB + (size_t)(t + 2) * kstep;
            const char* a3 = a2 + kstep; const char* b3 = b2 + kstep;
            if (last && has_next) S.a_ready(nxt);
            if constexpr (SP2) {
            PG8_LDB(B0, 0, 0); PG8_LDB(B1, 0, 1); PG8_SCHED; PG8_LDA(At, 0, 0); PG8_STAGE(PG8_SA(1, 1), a1 + hstepA, voffA);
            PG8_WAIT_V(8); PG8_WAIT_L(0); PG8_BAR; PG8_MMA(0, 0, At, B0); PG8_MMA(0, 1, At, B1); PG8_BAR; PG8_SCHED;
            PG8_LDA(At, 0, 1); PG8_STAGE(PG8_SB(0, 0), b2, voffB); PG8_STAGE(PG8_SB(0, 1), b2 + hstepB, voffB); PG8_STAGE(PG8_SA(0, 0), a2, voffA);
            PG8_WAIT_V(8); PG8_WAIT_L(0); PG8_BAR; PG8_MMA(1, 0, At, B0); PG8_MMA(1, 1, At, B1); PG8_BAR; PG8_SCHED;
            PG8_LDB(B0, 1, 0); PG8_LDB(B1, 1, 1); PG8_SCHED; PG8_LDA(At, 1, 0); PG8_STAGE(PG8_SA(0, 1), a2 + hstepA, voffA);
            PG8_WAIT_V(8); PG8_WAIT_L(0); PG8_BAR; PG8_MMA(0, 0, At, B0); PG8_MMA(0, 1, At, B1); PG8_BAR; PG8_SCHED;
            PG8_LDA(At, 1, 1); PG8_STAGE(PG8_SB(1, 0), b3, voffB); PG8_STAGE(PG8_SB(1, 1), b3 + hstepB, voffB); PG8_STAGE(PG8_SA(1, 0), a3, voffA);
            PG8_WAIT_V(8); PG8_WAIT_L(0); PG8_BAR; PG8_MMA(1, 0, At, B0); PG8_MMA(1, 1, At, B1); PG8_BAR; PG8_SCHED;
            } else {
            PG8_LDB(B0, 0, 0); PG8_SCHED; PG8_LDA(At, 0, 0); PG8_STAGE(PG8_SA(1, 1), a1 + hstepA, voffA);
            PG8_WAIT_L(8); PG8_BAR; PG8_WAIT_L(0); PG8_MMA(0, 0, At, B0); PG8_BAR; PG8_SCHED;
            PG8_LDB(B1, 0, 1); PG8_STAGE(PG8_SB(0, 0), b2, voffB);
            PG8_BAR; PG8_WAIT_L(0); PG8_MMA(0, 1, At, B1); PG8_BAR;
            PG8_LDA(At, 0, 1); PG8_STAGE(PG8_SA(0, 0), a2, voffA);
            PG8_BAR; PG8_WAIT_L(0); PG8_MMA(1, 0, At, B0); PG8_BAR; PG8_SCHED;
            PG8_STAGE(PG8_SB(0, 1), b2 + hstepB, voffB);
            PG8_WAIT_V(6); PG8_BAR; PG8_MMA(1, 1, At, B1); PG8_BAR;
            PG8_LDB(B0, 1, 0); PG8_SCHED; PG8_LDA(At, 1, 0); PG8_STAGE(PG8_SA(0, 1), a2 + hstepA, voffA);
            PG8_WAIT_L(8); PG8_BAR; PG8_WAIT_L(0); PG8_MMA(0, 0, At, B0); PG8_BAR; PG8_SCHED;
            PG8_LDB(B1, 1, 1); PG8_STAGE(PG8_SB(1, 0), b3, voffB);
            PG8_BAR; PG8_WAIT_L(0); PG8_MMA(0, 1, At, B1); PG8_BAR;
            PG8_LDA(At, 1, 1); PG8_STAGE(PG8_SA(1, 0), a3, voffA);
            PG8_BAR; PG8_WAIT_L(0); PG8_MMA(1, 0, At, B0); PG8_BAR; PG8_SCHED;
            PG8_STAGE(PG8_SB(1, 1), b3 + hstepB, voffB);
            PG8_WAIT_V(6); PG8_BAR; PG8_MMA(1, 1, At, B1); PG8_BAR;
            }
        }
        if constexpr (ALIGN_EPI) { if (wr == 0) PG8_BAR; }
        if constexpr (!Epi::AFTER_DRAIN) { E(acc, cur, wr, wc, fr, fq); S.done(cur); }
        if (!has_next) break;
#pragma unroll
        for (int a = 0; a < 2; ++a)
#pragma unroll
            for (int b = 0; b < 2; ++b)
#pragma unroll
                for (int m = 0; m < 4; ++m)
#pragma unroll
                    for (int n = 0; n < 2; ++n) acc[a][b][m][n] = (f32x4){0.f, 0.f, 0.f, 0.f};
        cur = nxt; cA = nA; cB = nB; ++ui;
        if constexpr (ALIGN_EPI) { if (wr == 1) PG8_BAR; }
    }
    PG8_WAIT_V(0);
    if constexpr (!ALIGN_EPI) { if (wr == 0) PG8_BAR; }
    PG8_BAR;
    if constexpr (Epi::AFTER_DRAIN) { E.fused(acc, cur, wr, wc, fr, fq, lds, wid, lane); S.done(cur); }
#undef PG8_SA
#undef PG8_SB
#undef PG8_STAGE
#undef PG8_LDA
#undef PG8_LDB
#undef PG8_MMA
#undef PG8_WAIT_V
#undef PG8_WAIT_L
#undef PG8_BAR
#undef PG8_SCHED
}
}

constexpr int TOK = 16384, SEQ = 8192, DM = 2048, DIN = 14360, DFF = 8192;
constexpr int LDP = 7168;
constexpr int PC_QA = 0, PC_KA = 1024, PC_VA = 2048, PC_Z = 3072, PC_FK = 4096, PC_FQ = 5120, PC_QM = 6144;
constexpr int PC_OA = 0, PC_OB = PC_FQ, PC_OM = PC_QM, PC_GB = 1024, PC_GM = 3072;
constexpr float EPSN = 1e-6f;
constexpr float LOG2E = 1.4426950408889634f;
constexpr size_t MiB = 1u << 20;
constexpr size_t WS_CTL = 0, WS_W1T = 1 * MiB, WS_WFVT = 30 * MiB, WS_WMKVT = 34 * MiB, WS_UC = 1 * MiB;
constexpr size_t WS_SMALL = 42 * MiB, WS_KMEM = 44 * MiB, WS_VMT = 45 * MiB, WS_CUM = 46 * MiB, WS_CDEC = 46 * MiB + 512 * 1024,
                 WS_MEMN = 47 * MiB, WS_SSQ = 49 * MiB, WS_RSTD = 51 * MiB;
constexpr size_t WS_WGT = 52 * MiB, WS_WUPT = 76 * MiB, WS_WOT = 88 * MiB, WS_WFF1T = 96 * MiB, WS_WFF2T = 128 * MiB;
constexpr size_t WS_PROJ = 160 * MiB, WS_GDN = 384 * MiB, WS_END = 496 * MiB;
constexpr int FOXVT_LD = TOK;
constexpr size_t WS_Y = 384 * MiB, WS_X1B = 160 * MiB, WS_U = 224 * MiB;
constexpr size_t DO_H = 0, DO_FOXVT = 64 * MiB, DO_GA = 64 * MiB;
constexpr int GDN_CHUNK_BYTES = 57344;
constexpr int LDS_BYTES = 163840;

#define LAS __attribute__((address_space(3)))
typedef unsigned short bf16;
typedef short bf16x8 __attribute__((ext_vector_type(8)));
typedef float f32x4 __attribute__((ext_vector_type(4)));
typedef float f32x16 __attribute__((ext_vector_type(16)));
typedef unsigned u32x4 __attribute__((ext_vector_type(4)));
typedef unsigned u32x2 __attribute__((ext_vector_type(2)));

__device__ __forceinline__ unsigned pk2(float lo, float hi) { return pg8::cvt_pk_bf16(lo, hi); }
__device__ __forceinline__ float bf2f(unsigned short v) { return __uint_as_float(((unsigned)v) << 16); }
__device__ __forceinline__ float bflo(unsigned w) { return __uint_as_float(w << 16); }
__device__ __forceinline__ float bfhi(unsigned w) { return __uint_as_float(w & 0xffff0000u); }
__device__ __forceinline__ int crow(int r, int hi) { return (r & 3) + 8 * (r >> 2) + 4 * hi; }
__device__ __forceinline__ float sigmoidf_(float x) { return 1.f / (1.f + __expf(-x)); }
__device__ __forceinline__ float softplusf_(float x) { return fmaxf(x, 0.f) + log1pf(__expf(-fabsf(x))); }

namespace pg8 {
struct EpiStore {
    static constexpr bool PERM = true, AFTER_DRAIN = false;
    bf16_t* O; int ldc;
    __device__ __forceinline__ void operator()(const f32x4 (&acc)[2][2][4][2], const Unit& u, int wr, int wc, int fr, int fq) const {
        const int row0 = u.pm * BM + wr * 64 + fr, col0 = u.pn * BM + wc * 32 + 8 * fq;
#pragma unroll
        for (int ai = 0; ai < 2; ++ai)
#pragma unroll
            for (int m = 0; m < 4; ++m) { bf16_t* rowp = O + (size_t)(row0 + ai * HALF + m * 16) * ldc + col0;
#pragma unroll
                for (int bj = 0; bj < 2; ++bj) { const f32x4 v0 = acc[ai][bj][m][0], v1 = acc[ai][bj][m][1];
                    u32x4 w; w.x = cvt_pk_bf16(v0[0], v0[1]); w.y = cvt_pk_bf16(v0[2], v0[3]); w.z = cvt_pk_bf16(v1[0], v1[1]); w.w = cvt_pk_bf16(v1[2], v1[3]);
                    *(u32x4*)(rowp + bj * HALF) = w; } }
    }
};
struct EpiProj {
    static constexpr bool PERM = true, AFTER_DRAIN = false;
    bf16_t* O; int ldc; float* small;
    __device__ __forceinline__ void operator()(const f32x4 (&acc)[2][2][4][2], const Unit& u, int wr, int wc, int fr, int fq) const {
        const int row0 = u.pm * BM + wr * 64 + fr;
        if (u.pn == 28) {
            if (wc == 0) {
#pragma unroll
                for (int ai = 0; ai < 2; ++ai)
#pragma unroll
                    for (int m = 0; m < 4; ++m) { float* p = small + (size_t)(row0 + ai * HALF + m * 16) * 32 + 8 * fq;
                        *(f32x4*)p = acc[ai][0][m][0]; *(f32x4*)(p + 4) = acc[ai][0][m][1]; }
            }
            return;
        }
        const int col0 = u.pn * BM + wc * 32 + 8 * fq;
#pragma unroll
        for (int ai = 0; ai < 2; ++ai)
#pragma unroll
            for (int m = 0; m < 4; ++m) { bf16_t* rowp = O + (size_t)(row0 + ai * HALF + m * 16) * ldc + col0;
#pragma unroll
                for (int bj = 0; bj < 2; ++bj) { const f32x4 v0 = acc[ai][bj][m][0], v1 = acc[ai][bj][m][1];
                    u32x4 w; w.x = cvt_pk_bf16(v0[0], v0[1]); w.y = cvt_pk_bf16(v0[2], v0[3]); w.z = cvt_pk_bf16(v1[0], v1[1]); w.w = cvt_pk_bf16(v1[2], v1[3]);
                    *(u32x4*)(rowp + bj * HALF) = w; } }
    }
};
struct EpiSig {
    static constexpr bool PERM = true, AFTER_DRAIN = false;
    unsigned char* O0; unsigned char* O1; int ld0, ld1;
    __device__ __forceinline__ void operator()(const f32x4 (&acc)[2][2][4][2], const Unit& u, int wr, int wc, int fr, int fq) const {
        const int br = u.pn >> 3; unsigned char* O = br == 0 ? O0 : O1 + (size_t)(br - 1) * 2048; const int ldc = br == 0 ? ld0 : ld1;
        const int row0 = u.pm * BM + wr * 64 + fr, col0 = (u.pn & 7) * BM + wc * 32 + 8 * fq;
#pragma unroll
        for (int ai = 0; ai < 2; ++ai)
#pragma unroll
            for (int m = 0; m < 4; ++m) { unsigned char* rowp = O + (size_t)(row0 + ai * HALF + m * 16) * ldc + col0;
#pragma unroll
                for (int bj = 0; bj < 2; ++bj) { const f32x4 v0 = acc[ai][bj][m][0], v1 = acc[ai][bj][m][1]; unsigned q[8];
#pragma unroll
                    for (int e = 0; e < 4; ++e) { q[e] = (unsigned)(255.f * __builtin_amdgcn_rcpf(1.f + __builtin_amdgcn_exp2f(-1.4426950408889634f * v0[e])) + 0.5f);
                                                  q[4 + e] = (unsigned)(255.f * __builtin_amdgcn_rcpf(1.f + __builtin_amdgcn_exp2f(-1.4426950408889634f * v1[e])) + 0.5f); }
                    u32x2 w; w.x = q[0] | (q[1] << 8) | (q[2] << 16) | (q[3] << 24); w.y = q[4] | (q[5] << 8) | (q[6] << 16) | (q[7] << 24);
                    *(u32x2*)(rowp + bj * HALF) = w; } }
    }
};
template <bool FIRST> struct EpiGate {
    static constexpr bool PERM = true, AFTER_DRAIN = false;
    const unsigned char* G; int ldg; bf16_t* Y; int ldy;
    __device__ __forceinline__ void operator()(const f32x4 (&acc)[2][2][4][2], const Unit& u, int wr, int wc, int fr, int fq) const {
        const int row0 = u.pm * BM + wr * 64 + fr, col0 = u.pn * BM + wc * 32 + 8 * fq;
        constexpr float S = 1.f / 255.f;
#pragma unroll
        for (int ai = 0; ai < 2; ++ai)
#pragma unroll
            for (int m = 0; m < 4; ++m) { const size_t r = (size_t)(row0 + ai * HALF + m * 16);
#pragma unroll
                for (int bj = 0; bj < 2; ++bj) { const f32x4 v0 = acc[ai][bj][m][0], v1 = acc[ai][bj][m][1];
                    const u32x2 g = *(const u32x2*)(G + r * ldg + col0 + bj * HALF);
                    float o[8];
                    o[0] = v0[0] * ((float)(g.x & 0xffu) * S); o[1] = v0[1] * ((float)((g.x >> 8) & 0xffu) * S);
                    o[2] = v0[2] * ((float)((g.x >> 16) & 0xffu) * S); o[3] = v0[3] * ((float)(g.x >> 24) * S);
                    o[4] = v1[0] * ((float)(g.y & 0xffu) * S); o[5] = v1[1] * ((float)((g.y >> 8) & 0xffu) * S);
                    o[6] = v1[2] * ((float)((g.y >> 16) & 0xffu) * S); o[7] = v1[3] * ((float)(g.y >> 24) * S);
                    bf16_t* yp = Y + r * ldy + col0 + bj * HALF;
                    if (!FIRST) { const u32x4 y = *(const u32x4*)yp;
                        o[0] += __uint_as_float(y.x << 16); o[1] += __uint_as_float(y.x & 0xffff0000u);
                        o[2] += __uint_as_float(y.y << 16); o[3] += __uint_as_float(y.y & 0xffff0000u);
                        o[4] += __uint_as_float(y.z << 16); o[5] += __uint_as_float(y.z & 0xffff0000u);
                        o[6] += __uint_as_float(y.w << 16); o[7] += __uint_as_float(y.w & 0xffff0000u); }
                    u32x4 w; w.x = cvt_pk_bf16(o[0], o[1]); w.y = cvt_pk_bf16(o[2], o[3]); w.z = cvt_pk_bf16(o[4], o[5]); w.w = cvt_pk_bf16(o[6], o[7]);
                    *(u32x4*)yp = w; } }
    }
};
struct EpiRes1 {
    static constexpr bool PERM = false, AFTER_DRAIN = false;
    const float* X; bf16_t* XB; float* SSQ;
    __device__ __forceinline__ void operator()(const f32x4 (&acc)[2][2][4][2], const Unit& u, int wr, int wc, int fr, int fq) const {
        const int row0 = u.pm * BM + wr * 64 + fr, col0 = u.pn * BM + wc * 32 + 4 * fq;
#pragma unroll
        for (int ai = 0; ai < 2; ++ai)
#pragma unroll
            for (int m = 0; m < 4; ++m) { const int row = row0 + ai * HALF + m * 16; const size_t off = (size_t)row * 2048 + col0; float s = 0.f;
#pragma unroll
                for (int bj = 0; bj < 2; ++bj)
#pragma unroll
                    for (int n = 0; n < 2; ++n) { const size_t o = off + bj * HALF + n * 16; const f32x4 xv = *(const f32x4*)(X + o); const f32x4 v = xv + acc[ai][bj][m][n];
                        u32x2 w; w.x = cvt_pk_bf16(v[0], v[1]); w.y = cvt_pk_bf16(v[2], v[3]); *(u32x2*)(XB + o) = w;
                        s += (v[0] * v[0] + v[1] * v[1]) + (v[2] * v[2] + v[3] * v[3]); }
                s += __shfl_xor(s, 16); s += __shfl_xor(s, 32);
                if (fq == 0) SSQ[(size_t)(u.pn * 4 + wc) * 16384 + row] = s; }
    }
};
struct EpiFF1 {
    static constexpr bool PERM = true, AFTER_DRAIN = false;
    const float* RSTD; bf16_t* O; int ldc;
    __device__ __forceinline__ void operator()(const f32x4 (&acc)[2][2][4][2], const Unit& u, int wr, int wc, int fr, int fq) const {
        const int row0 = u.pm * BM + wr * 64 + fr, col0 = u.pn * BM + wc * 32 + 8 * fq;
        float rs[2][4];
#pragma unroll
        for (int ai = 0; ai < 2; ++ai)
#pragma unroll
            for (int m = 0; m < 4; ++m) rs[ai][m] = RSTD[row0 + ai * HALF + m * 16];
#pragma unroll
        for (int ai = 0; ai < 2; ++ai)
#pragma unroll
            for (int m = 0; m < 4; ++m) { const int row = row0 + ai * HALF + m * 16; const float rstd = rs[ai][m];
                bf16_t* rowp = O + (size_t)row * ldc + col0;
#pragma unroll
                for (int bj = 0; bj < 2; ++bj) { f32x4 v0 = acc[ai][bj][m][0] * rstd, v1 = acc[ai][bj][m][1] * rstd;
#pragma unroll
                    for (int e = 0; e < 4; ++e) { const float a = fmaxf(v0[e], 0.f), b = fmaxf(v1[e], 0.f); v0[e] = a * a; v1[e] = b * b; }
                    u32x4 w; w.x = cvt_pk_bf16(v0[0], v0[1]); w.y = cvt_pk_bf16(v0[2], v0[3]); w.z = cvt_pk_bf16(v1[0], v1[1]); w.w = cvt_pk_bf16(v1[2], v1[3]);
                    *(u32x4*)(rowp + bj * HALF) = w; } }
    }
};
struct EpiOut {
    static constexpr bool PERM = false, AFTER_DRAIN = false;
    const bf16_t* XB; float* OUT;
    __device__ __forceinline__ void operator()(const f32x4 (&acc)[2][2][4][2], const Unit& u, int wr, int wc, int fr, int fq) const {
        const int row0 = u.pm * BM + wr * 64 + fr, col0 = u.pn * BM + wc * 32 + 4 * fq;
#pragma unroll
        for (int ai = 0; ai < 2; ++ai)
#pragma unroll
            for (int m = 0; m < 4; ++m) { const size_t off = (size_t)(row0 + ai * HALF + m * 16) * 2048 + col0;
#pragma unroll
                for (int bj = 0; bj < 2; ++bj)
#pragma unroll
                    for (int n = 0; n < 2; ++n) { const size_t o = off + bj * HALF + n * 16; const u32x2 xb = *(const u32x2*)(XB + o);
                        f32x4 xv; xv[0] = __uint_as_float(xb.x << 16); xv[1] = __uint_as_float(xb.x & 0xffff0000u); xv[2] = __uint_as_float(xb.y << 16); xv[3] = __uint_as_float(xb.y & 0xffff0000u);
                        *(f32x4*)(OUT + o) = xv + acc[ai][bj][m][n]; } }
    }
};
}

struct Params {
    const float *x, *mem, *g_mix, *w_in, *conv_w, *a_log, *dt_bias, *gdn_norm_g, *fox_b_f, *fox_q_norm, *fox_k_norm, *g_mem, *w_mem_kv,
                *mem_q_norm, *mem_k_norm, *w_up_gdn, *w_up_fox, *w_up_mem, *w_out, *g_mlp, *w_ff1, *w_ff2;
    float* out; unsigned char* ws;
};

__device__ __forceinline__ float wave_sum(float v) {
#pragma unroll
    for (int o = 1; o < 64; o <<= 1) v += __shfl_xor(v, o);
    return v;
}

__device__ __forceinline__ void transpose_item(const float* W, int ldw, int n0src, bf16* WT, int K, int row0dst, const float* kscale,
                                               LAS float* scr, int kb, int nb, int lane) {
    const int k0 = 64 * kb, n0 = 32 * nb;
    float tv[32];
#pragma unroll
    for (int i = 0; i < 32; ++i) tv[i] = W[(size_t)(k0 + 2 * i + (lane >> 5)) * ldw + n0src + n0 + (lane & 31)];
#pragma unroll
    for (int i = 0; i < 32; ++i) { const int kk = 2 * i + (lane >> 5); float v = tv[i];
        if (kscale) v *= kscale[k0 + kk]; scr[kk * 33 + (lane & 31)] = v; }
    asm volatile("s_waitcnt lgkmcnt(0)" ::: "memory");
    const int c = lane & 7;
#pragma unroll
    for (int j = 0; j < 4; ++j) { const int n = (lane >> 3) + 8 * j; const LAS float* s = scr + (8 * c) * 33 + n;
        u32x4 o; o.x = pk2(s[0 * 33], s[1 * 33]); o.y = pk2(s[2 * 33], s[3 * 33]); o.z = pk2(s[4 * 33], s[5 * 33]); o.w = pk2(s[6 * 33], s[7 * 33]);
        *(u32x4*)(WT + (size_t)(row0dst + n0 + n) * K + k0 + 8 * c) = o; }
    asm volatile("s_waitcnt lgkmcnt(0)" ::: "memory");
}
__device__ __forceinline__ void transpose_job(const float* W, int ldw, int n0src, int K, int ncols, bf16* WT, int row0dst, const float* kscale,
                                              LAS float* scr, int gw, int ngw, int lane) {
    const int nblk = ncols / 32, nitems = (K / 64) * nblk;
    for (int it = gw; it < nitems; it += ngw) transpose_item(W, ldw, n0src, WT, K, row0dst, kscale, scr, it / nblk, it % nblk, lane);
}
__device__ __forceinline__ void rms_row_to_bf16(const float* xrow, const float* g, bf16* orow, int lane) {
    const f32x4* xr = (const f32x4*)xrow + lane; const f32x4* gr = (const f32x4*)g + lane;
    f32x4 v[8]; float s = 0.f;
#pragma unroll
    for (int j = 0; j < 8; ++j) { v[j] = xr[64 * j]; s += (v[j].x * v[j].x + v[j].y * v[j].y) + (v[j].z * v[j].z + v[j].w * v[j].w); }
    const float rstd = rsqrtf(wave_sum(s) * (1.f / 2048.f) + EPSN);
    u32x2* o8 = (u32x2*)orow + lane;
#pragma unroll
    for (int j = 0; j < 8; ++j) { const f32x4 gg = gr[64 * j]; u32x2 w; w.x = pk2(v[j].x * rstd * gg.x, v[j].y * rstd * gg.y); w.y = pk2(v[j].z * rstd * gg.z, v[j].w * rstd * gg.w); o8[64 * j] = w; }
}

__device__ __forceinline__ void phase0(const Params& P, unsigned char* lds, int tid, int lane, int wave) {
    unsigned char* ws = P.ws;
    bf16* W1T = (bf16*)(ws + WS_W1T); bf16* WFVT = (bf16*)(ws + WS_WFVT); bf16* WMKVT = (bf16*)(ws + WS_WMKVT); bf16* WGT = (bf16*)(ws + WS_WGT);
    bf16* WUPT = (bf16*)(ws + WS_WUPT); bf16* WOT = (bf16*)(ws + WS_WOT); bf16* WFF1T = (bf16*)(ws + WS_WFF1T); bf16* WFF2T = (bf16*)(ws + WS_WFF2T);
    LAS float* scr = (LAS float*)((LAS unsigned char*)lds + wave * 16384);
    const int G = gridDim.x, gw = blockIdx.x * 8 + wave, ngw = G * 8;
    bf16* H = (bf16*)((unsigned char*)P.out + DO_H);
    for (int m = gw; m < TOK; m += ngw) rms_row_to_bf16(P.x + (size_t)m * DM, P.g_mix, H + (size_t)m * DM, lane);
    bf16* MEMN = (bf16*)(ws + WS_MEMN);
    for (int m = gw; m < 512; m += ngw) rms_row_to_bf16(P.mem + (size_t)m * DM, P.g_mem, MEMN + (size_t)m * DM, lane);
    transpose_job(P.w_in, DIN, 0, 2048, 4096, W1T, 0, nullptr, scr, gw, ngw, lane);
    transpose_job(P.w_in, DIN, 5136, 2048, 1024, W1T, PC_FK, nullptr, scr, gw, ngw, lane);
    transpose_job(P.w_in, DIN, 4112, 2048, 1024, W1T, PC_FQ, nullptr, scr, gw, ngw, lane);
    transpose_job(P.w_in, DIN, 7192, 2048, 1024, W1T, PC_QM, nullptr, scr, gw, ngw, lane);
    transpose_job(P.w_in, DIN, 6160, 2048, 1024, WFVT, 0, nullptr, scr, gw, ngw, lane);
    transpose_job(P.w_in, DIN, 8216, 2048, 6144, WGT, 0, nullptr, scr, gw, ngw, lane);
    transpose_job(P.w_mem_kv, 2048, 0, 2048, 2048, WMKVT, 0, nullptr, scr, gw, ngw, lane);
    transpose_job(P.w_up_gdn, 2048, 0, 1024, 2048, WUPT, 0, nullptr, scr, gw, ngw, lane);
    transpose_job(P.w_up_fox, 2048, 0, 1024, 2048, WUPT + (size_t)2048 * 1024, 0, nullptr, scr, gw, ngw, lane);
    transpose_job(P.w_up_mem, 2048, 0, 1024, 2048, WUPT + (size_t)2 * 2048 * 1024, 0, nullptr, scr, gw, ngw, lane);
    transpose_job(P.w_out, 2048, 0, 2048, 2048, WOT, 0, nullptr, scr, gw, ngw, lane);
    transpose_job(P.w_ff1, 8192, 0, 2048, 8192, WFF1T, 0, P.g_mlp, scr, gw, ngw, lane);
    transpose_job(P.w_ff2, 2048, 0, 8192, 2048, WFF2T, 0, nullptr, scr, gw, ngw, lane);
    for (int idx = blockIdx.x * 512 + tid; idx < 256 * 2048; idx += G * 512) {
        const int row = idx >> 11, k = idx & 2047; float v = 0.f;
        if (row < 24) { const int col = row < 8 ? 4096 + row : (row < 16 ? 4104 + (row - 8) : 7184 + (row - 16)); v = P.w_in[(size_t)k * DIN + col]; }
        W1T[(size_t)(7168 + row) * 2048 + k] = (bf16)(pk2(v, 0.f) & 0xffffu);
    }
}


__device__ __forceinline__ void gdn_prep_unit(const Params& P, unsigned char* lds_, int bh, int n, int tid, int lane, int wave) {
    float* qs = (float*)lds_;
    float* ks = qs + 64 * 132;
    float* vs = ks + 64 * 132;
    float* Mm = vs + 64 * 132;
    float* QKd = Mm + 4096;
    float* gam = QKd + 4096;
    float* beta = gam + 64;
    float* egam = beta + 64;
    const int b = bh >> 3, h = bh & 7;
    const size_t r0 = (size_t)b * SEQ + (size_t)n * 64;
    const bf16* proj = (const bf16*)(P.ws + WS_PROJ);
    const float* small = (const float*)(P.ws + WS_SMALL);
    if (tid < 384) {
        const int c8 = tid % 48, tg = tid / 48, mat = c8 >> 4, ch0 = (c8 & 15) * 8, col = mat * 1024 + h * 128 + ch0, tb = tg * 8;
        u32x4 xr[11];
#pragma unroll
        for (int i = 0; i < 11; ++i) { const int tt = n * 64 + tb - 3 + i;
            xr[i] = tt >= 0 ? *(const u32x4*)(proj + (r0 + tb - 3 + i) * LDP + col) : u32x4{0u, 0u, 0u, 0u}; }
        f32x4 w0[4], w1[4];
#pragma unroll
        for (int i = 0; i < 4; ++i) { w0[i] = *(const f32x4*)(P.conv_w + i * 3072 + col); w1[i] = *(const f32x4*)(P.conv_w + i * 3072 + col + 4); }
        float* dstb = (mat == 0 ? qs : (mat == 1 ? ks : vs)) + tb * 132 + ch0;
#pragma unroll
        for (int t = 0; t < 8; ++t) {
            float y[8];
#pragma unroll
            for (int e = 0; e < 8; ++e) y[e] = 0.f;
#pragma unroll
            for (int i = 0; i < 4; ++i) { const u32x4 xv = xr[t + i];
                y[0] += bflo(xv.x) * w0[i].x; y[1] += bfhi(xv.x) * w0[i].y; y[2] += bflo(xv.y) * w0[i].z; y[3] += bfhi(xv.y) * w0[i].w;
                y[4] += bflo(xv.z) * w1[i].x; y[5] += bfhi(xv.z) * w1[i].y; y[6] += bflo(xv.w) * w1[i].z; y[7] += bfhi(xv.w) * w1[i].w; }
            f32x4 o0, o1;
            o0.x = y[0] * __builtin_amdgcn_rcpf(1.f + __builtin_amdgcn_exp2f(-LOG2E * y[0])); o0.y = y[1] * __builtin_amdgcn_rcpf(1.f + __builtin_amdgcn_exp2f(-LOG2E * y[1]));
            o0.z = y[2] * __builtin_amdgcn_rcpf(1.f + __builtin_amdgcn_exp2f(-LOG2E * y[2])); o0.w = y[3] * __builtin_amdgcn_rcpf(1.f + __builtin_amdgcn_exp2f(-LOG2E * y[3]));
            o1.x = y[4] * __builtin_amdgcn_rcpf(1.f + __builtin_amdgcn_exp2f(-LOG2E * y[4])); o1.y = y[5] * __builtin_amdgcn_rcpf(1.f + __builtin_amdgcn_exp2f(-LOG2E * y[5]));
            o1.z = y[6] * __builtin_amdgcn_rcpf(1.f + __builtin_amdgcn_exp2f(-LOG2E * y[6])); o1.w = y[7] * __builtin_amdgcn_rcpf(1.f + __builtin_amdgcn_exp2f(-LOG2E * y[7]));
            *(f32x4*)(dstb + t * 132) = o0; *(f32x4*)(dstb + t * 132 + 4) = o1;
        }
    }
    if (wave == 7) {
        const float av = small[(r0 + lane) * 32 + 8 + h], bv = small[(r0 + lane) * 32 + h];
        float g = -__expf(P.a_log[h]) * softplusf_(av + P.dt_bias[h]);
#pragma unroll
        for (int o = 1; o < 64; o <<= 1) { const float t_ = __shfl_up(g, o); if (lane >= o) g += t_; }
        gam[lane] = g; egam[lane] = __expf(g); beta[lane] = sigmoidf_(bv);
    }
    __syncthreads();
    for (int rr = wave * 16; rr < wave * 16 + 16; ++rr) {
        float* row = (rr < 64 ? qs + rr * 132 : ks + (rr - 64) * 132);
        const float a = row[lane], c = row[lane + 64];
        const float ss = wave_sum(a * a + c * c);
        const float sc = rsqrtf(ss + EPSN) * (rr < 64 ? 0.08838834764831845f : 1.f);
        row[lane] = a * sc; row[lane + 64] = c * sc;
    }
    __syncthreads();
    {
        const int mat = tid >> 8, tt = tid & 255, ti = tt >> 4, tj = tt & 15;
        const float* A = mat == 0 ? ks : qs;
        float acc[4][4];
#pragma unroll
        for (int a = 0; a < 4; ++a)
#pragma unroll
            for (int c = 0; c < 4; ++c) acc[a][c] = 0.f;
        for (int d = 0; d < 128; d += 4) {
            f32x4 ra[4], rb[4];
#pragma unroll
            for (int a = 0; a < 4; ++a) ra[a] = *(const f32x4*)(A + (ti + 16 * a) * 132 + d);
#pragma unroll
            for (int c = 0; c < 4; ++c) rb[c] = *(const f32x4*)(ks + (tj + 16 * c) * 132 + d);
#pragma unroll
            for (int a = 0; a < 4; ++a)
#pragma unroll
                for (int c = 0; c < 4; ++c) acc[a][c] += (ra[a].x * rb[c].x + ra[a].y * rb[c].y) + (ra[a].z * rb[c].z + ra[a].w * rb[c].w);
        }
#pragma unroll
        for (int a = 0; a < 4; ++a)
#pragma unroll
            for (int c = 0; c < 4; ++c) { const int i = ti + 16 * a, j = tj + 16 * c;
                const float e = __expf(fminf(gam[i] - gam[j], 0.f));
                if (mat == 0) Mm[j * 64 + i] = (j < i) ? beta[i] * acc[a][c] * e : 0.f;
                else QKd[i * 64 + j] = (j <= i) ? acc[a][c] * e : 0.f; }
    }
    __syncthreads();
    unsigned char* gout = P.ws + WS_GDN + (size_t)(bh * 128 + n) * GDN_CHUNK_BYTES;
    unsigned char* uout = P.ws + WS_UC + (size_t)(bh * 128 + n) * 16384;
    const float glast = gam[63];
    for (int p = tid; p < 2560; p += 512) {
        float v[8]; unsigned char* dst;
        if (p < 1024) {
            const int f = p >> 6, ln = p & 63, rt = f >> 3, kk = f & 7, row = 32 * rt + (ln & 31), hi = ln >> 5;
            const float* src = qs + row * 132 + 16 * kk; const float sc = egam[row];
#pragma unroll
            for (int j = 0; j < 8; ++j) v[j] = src[crow(j, hi)] * sc;
            dst = gout + 16384 + (size_t)p * 16;
        } else if (p < 1536) {
            const int q = p - 1024, f = q >> 6, ln = q & 63, rt = f >> 2, kk = f & 3, row = 32 * rt + (ln & 31), hi = ln >> 5;
#pragma unroll
            for (int j = 0; j < 8; ++j) v[j] = QKd[row * 64 + 16 * kk + crow(j, hi)];
            dst = gout + 32768 + (size_t)q * 16;
        } else {
            const int q = p - 1536, f = q >> 6, ln = q & 63, rt = f >> 2, kk = f & 3, dk = 32 * rt + (ln & 31), hi = ln >> 5;
#pragma unroll
            for (int j = 0; j < 8; ++j) { const int tk = 16 * kk + crow(j, hi); v[j] = ks[tk * 132 + dk] * __expf(fminf(glast - gam[tk], 0.f)); }
            dst = gout + 40960 + (size_t)q * 16;
        }
        u32x4 o; o.x = pk2(v[0], v[1]); o.y = pk2(v[2], v[3]); o.z = pk2(v[4], v[5]); o.w = pk2(v[6], v[7]);
        *(u32x4*)dst = o;
    }
    if (tid == 0) ((float*)(P.ws + WS_CDEC))[bh * 128 + n] = __expf(glast);
    __syncthreads();
    if (tid < 256) {
        float* col = (tid < 128 ? ks : vs) + (tid & 127);
        int zero; asm volatile("v_mov_b32 %0, 0" : "=v"(zero));
#pragma unroll 8
        for (int i = 0; i < 64; ++i) col[i * 132] *= beta[i + zero] * (tid < 128 ? egam[i + zero] : 1.f);
#pragma unroll 1
        for (int ib = 0; ib < 4; ++ib) {
            float acc[16];
#pragma unroll
            for (int r = 0; r < 16; ++r) acc[r] = col[(ib * 16 + r) * 132];
#pragma unroll 4
            for (int j = 0; j < ib * 16; ++j) {
                const float xj = col[j * 132]; const float* mr = Mm + zero + j * 64 + ib * 16;
                const f32x4 m0 = *(const f32x4*)mr, m1 = *(const f32x4*)(mr + 4), m2 = *(const f32x4*)(mr + 8), m3 = *(const f32x4*)(mr + 12);
                acc[0] -= m0.x * xj; acc[1] -= m0.y * xj; acc[2] -= m0.z * xj; acc[3] -= m0.w * xj;
                acc[4] -= m1.x * xj; acc[5] -= m1.y * xj; acc[6] -= m1.z * xj; acc[7] -= m1.w * xj;
                acc[8] -= m2.x * xj; acc[9] -= m2.y * xj; acc[10] -= m2.z * xj; acc[11] -= m2.w * xj;
                acc[12] -= m3.x * xj; acc[13] -= m3.y * xj; acc[14] -= m3.z * xj; acc[15] -= m3.w * xj;
            }
#pragma unroll
            for (int r2 = 0; r2 < 15; ++r2) {
                const float* mr = Mm + (ib * 16 + r2) * 64 + ib * 16; float mm[16];
#pragma unroll
                for (int q = 0; q < 4; ++q) { const f32x4 t4 = *(const f32x4*)(mr + 4 * q); mm[4 * q] = t4.x; mm[4 * q + 1] = t4.y; mm[4 * q + 2] = t4.z; mm[4 * q + 3] = t4.w; }
#pragma unroll
                for (int r = r2 + 1; r < 16; ++r) acc[r] -= mm[r] * acc[r2];
            }
#pragma unroll
            for (int r = 0; r < 16; ++r) col[(ib * 16 + r) * 132] = acc[r];
        }
    }
    __syncthreads();
    for (int p = tid; p < 2048; p += 512) {
        float v[8]; unsigned char* dst;
        if (p < 1024) {
            const int f = p >> 6, ln = p & 63, rt = f >> 3, kk = f & 7, row = 32 * rt + (ln & 31), hi = ln >> 5;
            const float* src = ks + row * 132 + 16 * kk;
#pragma unroll
            for (int j = 0; j < 8; ++j) v[j] = -src[crow(j, hi)];
            dst = gout + (size_t)p * 16;
        } else {
            const int q = p - 1024, half = q & 1, ln = (q >> 1) & 63, g2 = q >> 7, rt = g2 & 1, w4 = g2 >> 1, hi = ln >> 5;
#pragma unroll
            for (int j = 0; j < 8; ++j) v[j] = vs[(32 * rt + crow(8 * half + j, hi)) * 132 + 32 * w4 + (ln & 31)];
            dst = uout + (size_t)q * 16;
        }
        u32x4 o; o.x = pk2(v[0], v[1]); o.y = pk2(v[2], v[3]); o.z = pk2(v[4], v[5]); o.w = pk2(v[6], v[7]);
        *(u32x4*)dst = o;
    }
    __syncthreads();
}

template <int GL, int NB> __device__ __forceinline__ void norm8b(bf16* const (&p)[NB], const bool (&ok)[NB], const float* gain, float mult, float inv_n) {
    u32x4 xv[NB];
#pragma unroll
    for (int b = 0; b < NB; ++b) xv[b] = ok[b] ? *(const u32x4*)p[b] : u32x4{0u, 0u, 0u, 0u};
    const f32x4 g0 = *(const f32x4*)gain, g1 = *(const f32x4*)(gain + 4);
#pragma unroll
    for (int b = 0; b < NB; ++b) {
        float v[8] = {bflo(xv[b].x), bfhi(xv[b].x), bflo(xv[b].y), bfhi(xv[b].y), bflo(xv[b].z), bfhi(xv[b].z), bflo(xv[b].w), bfhi(xv[b].w)};
        float ss = 0.f;
#pragma unroll
        for (int e = 0; e < 8; ++e) ss += v[e] * v[e];
#pragma unroll
        for (int o = 1; o < GL; o <<= 1) ss += __shfl_xor(ss, o);
        const float sc = rsqrtf(ss * inv_n + EPSN) * mult;
        u32x4 o; o.x = pk2(v[0] * sc * g0.x, v[1] * sc * g0.y); o.y = pk2(v[2] * sc * g0.z, v[3] * sc * g0.w);
        o.z = pk2(v[4] * sc * g1.x, v[5] * sc * g1.y); o.w = pk2(v[6] * sc * g1.z, v[7] * sc * g1.w);
        if (ok[b]) *(u32x4*)p[b] = o;
    }
}

__device__ __forceinline__ void phase2(const Params& P, unsigned char* lds, int tid, int lane, int wave) {
    const int G = gridDim.x;
    bf16* proj = (bf16*)(P.ws + WS_PROJ);
    if (blockIdx.x < 16) {
        const int bh = blockIdx.x, b = bh >> 3, h = bh & 7;
        const float* small = (const float*)(P.ws + WS_SMALL);
        float* cum = (float*)(P.ws + WS_CUM) + (size_t)bh * SEQ;
        float* wtot = (float*)lds;
        const float bf = P.fox_b_f[h];
        float v[16]; float run = 0.f;
#pragma unroll
        for (int e = 0; e < 16; ++e) { const float xx = small[((size_t)b * SEQ + tid * 16 + e) * 32 + 16 + h] + bf; run += -softplusf_(-xx) * LOG2E; v[e] = run; }
        float inc = run;
#pragma unroll
        for (int o = 1; o < 64; o <<= 1) { const float t_ = __shfl_up(inc, o); if (lane >= o) inc += t_; }
        if (lane == 63) wtot[wave] = inc;
        { float gq = tid < 128 ? fabsf(P.fox_q_norm[tid]) : 0.f, gk = tid < 128 ? fabsf(P.fox_k_norm[tid]) : 0.f;
#pragma unroll
          for (int o = 1; o < 64; o <<= 1) { gq = fmaxf(gq, __shfl_xor(gq, o)); gk = fmaxf(gk, __shfl_xor(gk, o)); }
          if (lane == 0) { wtot[8 + wave] = gq; wtot[16 + wave] = gk; } }
        __syncthreads();
        if (bh == 0 && tid == 0) { float gq = 0.f, gk = 0.f; for (int w = 0; w < 8; ++w) { gq = fmaxf(gq, wtot[8 + w]); gk = fmaxf(gk, wtot[16 + w]); }
            ((float*)(P.ws + WS_CDEC + 16384))[0] = 150.f + 2.f * 1.03f * (128.f * 0.08838834764831845f * LOG2E) * gq * gk; }
        float off = inc - run;
        for (int w = 0; w < wave; ++w) off += wtot[w];
#pragma unroll
        for (int e = 0; e < 16; ++e) cum[tid * 16 + e] = v[e] + off;
        __syncthreads();
    }
    for (int u = blockIdx.x; u < 2048; u += G) gdn_prep_unit(P, lds, u >> 7, u & 127, tid, lane, wave);
    for (int it0 = blockIdx.x; it0 < TOK / 2; it0 += 4 * G) {
        const int cidx = (tid & 255) * 8, isq = cidx >= 1024, d = cidx & 127;
        bf16* pp[4]; bool ok[4];
#pragma unroll
        for (int b = 0; b < 4; ++b) { const int it = it0 + b * G; ok[b] = it < TOK / 2; pp[b] = proj + (size_t)((ok[b] ? it : 0) * 2 + (tid >> 8)) * LDP + PC_FK + cidx; }
        norm8b<16, 4>(pp, ok, (isq ? P.fox_q_norm : P.fox_k_norm) + d, isq ? 0.08838834764831845f * LOG2E : 1.f, 1.f / 128.f);
    }
    for (int it0 = blockIdx.x; it0 < TOK / 4; it0 += 4 * G) {
        const int cidx = (tid & 127) * 8, d = cidx & 255;
        bf16* pp[4]; bool ok[4];
#pragma unroll
        for (int b = 0; b < 4; ++b) { const int it = it0 + b * G; ok[b] = it < TOK / 4; pp[b] = proj + (size_t)((ok[b] ? it : 0) * 4 + (tid >> 7)) * LDP + PC_QM + cidx; }
        norm8b<32, 4>(pp, ok, P.mem_q_norm + d, 0.0625f * LOG2E, 1.f / 256.f);
    }
    bf16* kmem = (bf16*)(P.ws + WS_KMEM);
    for (int it = blockIdx.x; it < 512 / 4; it += G) {
        const int cidx = (tid & 127) * 8, d = cidx & 255;
        bf16* pp[1] = {kmem + (size_t)(it * 4 + (tid >> 7)) * 1024 + cidx}; const bool ok[1] = {true};
        norm8b<32, 1>(pp, ok, P.mem_k_norm + d, 1.f, 1.f / 256.f);
    }
}

template <int DQK, bool FOX>
__device__ __forceinline__ void attn_unit(unsigned char* lds_, const bf16* Q, int ldq, const bf16* K, int ldk, const bf16* VT, int ldvt, bf16* O, int ldo,
                                          const float* cum, float skip_lim, int t0, int ntiles, int tid, int lane, int wave, int& dbg_tiles, unsigned char* dbg_ws = nullptr) {
    asm volatile("" : "+v"(tid), "+v"(lane));
    constexpr int KS = DQK / 16, KPITCH = DQK * 2 + 16, VPITCH = 136, ND = FOX ? 4 : 2, NH = (DQK / 32) / ND, VCH = ND / 2;
    constexpr int KCH = 64 * DQK / 8 / 512;
    LAS unsigned char* lds = (LAS unsigned char*)lds_;
    LAS unsigned char* Ks = lds; LAS unsigned char* VTs = lds + 64 * KPITCH; LAS float* cbs = (LAS float*)(lds + 64 * KPITCH + 128 * VPITCH);
    const int c = lane & 31, hi = lane >> 5;
    const int qrow = t0 + wave * 32 + c;
    bf16x8 qf[KS];
    { const bf16* qp = Q + (size_t)qrow * ldq + 8 * hi;
#pragma unroll
      for (int k = 0; k < KS; ++k) qf[k] = *(const bf16x8*)(qp + 16 * k); }
    float cref = 0.f; int jmin = 0;
    if (FOX) {
        cref = cum[t0];
        LAS int* jm = (LAS int*)(cbs + 64);
        if (wave < 2) { const int j = wave * 64 + lane; bool need = false; if (j < ntiles) need = (cref - cum[64 * j + 63]) >= -skip_lim;
            const unsigned long long mk = __ballot(need); if (lane == 0) jm[wave] = mk ? (int)__builtin_ctzll(mk) + wave * 64 : (1 << 20); }
        __syncthreads();
        jmin = min(min(jm[0], jm[1]), ntiles - 1);
        jmin = __builtin_amdgcn_readfirstlane(jmin);
    }
    dbg_tiles = 0;
#ifdef PROBE_TS
    if (FOX && dbg_ws && blockIdx.x == 16 && tid == 0) { volatile unsigned long long* dg_ = (volatile unsigned long long*)(dbg_ws + WS_CTL + 32768); dg_[16] += (unsigned long long)(ntiles - jmin) * 375ull; }
#endif
#pragma unroll 1
    for (int half = 0; half < NH; ++half) {
        f32x16 o[ND]; float m = -1e30f, l = 0.f;
#pragma unroll
        for (int d = 0; d < ND; ++d) o[d] = f32x16{};
        constexpr bool PREF = (DQK == 128);
        u32x4 kpre[KCH], vpre[VCH]; float cpre = 0.f;
#define ATT_PREFETCH(j_) do { const int kv0_ = 64 * (j_); \
            _Pragma("unroll") for (int i = 0; i < KCH; ++i) { const int id = tid + 512 * i, row = id / (DQK / 8), cc = id % (DQK / 8); kpre[i] = *(const u32x4*)(K + (size_t)(kv0_ + row) * ldk + cc * 8); } \
            _Pragma("unroll") for (int i = 0; i < VCH; ++i) { const int id = tid + 512 * i, row = id >> 3, cc = id & 7; vpre[i] = *(const u32x4*)(VT + (size_t)(half * ND * 32 + row) * ldvt + kv0_ + cc * 8); } \
            if (FOX) { if (tid < 64) cpre = cum[kv0_ + tid] - cref; } } while (0)
        if (PREF) ATT_PREFETCH(jmin);
#pragma unroll 1
        for (int j = jmin; j < ntiles; ++j) {
            __syncthreads();
            if (!PREF) ATT_PREFETCH(j);
#pragma unroll
            for (int i = 0; i < KCH; ++i) { const int id = tid + 512 * i, row = id / (DQK / 8), cc = id % (DQK / 8); *(LAS u32x4*)(Ks + row * KPITCH + cc * 16) = kpre[i]; }
#pragma unroll
            for (int i = 0; i < VCH; ++i) { const int id = tid + 512 * i, row = id >> 3, cc = id & 7; LAS u32x2* d2 = (LAS u32x2*)(VTs + row * VPITCH + cc * 16);
                d2[0] = (u32x2){vpre[i].x, vpre[i].y}; d2[1] = (u32x2){vpre[i].z, vpre[i].w}; }
            if (FOX) { if (tid < 64) cbs[tid] = cpre; }
            __syncthreads();
            if (PREF && j + 1 < ntiles) ATT_PREFETCH(j + 1);
            const int kv0 = 64 * j;
            if (FOX && kv0 > t0 + wave * 32 + 31) continue;
            f32x16 p0 = f32x16{}, p1 = f32x16{};
            const LAS unsigned char* vb = VTs + c * VPITCH + hi * 8;
            u32x2 vlo[FOX ? 8 : 1], vhh[FOX ? 8 : 1];
            if constexpr (FOX) {
                const LAS unsigned char* kb = Ks + c * KPITCH + hi * 16;
                bf16x8 kf[2 * KS];
#pragma unroll
                for (int k = 0; k < KS; ++k) { kf[2 * k] = *(const LAS bf16x8*)(kb + k * 32); kf[2 * k + 1] = *(const LAS bf16x8*)(kb + 32 * KPITCH + k * 32); }
                __builtin_amdgcn_sched_barrier(0);
#pragma unroll
                for (int k = 0; k < KS; ++k) {
                    p0 = __builtin_amdgcn_mfma_f32_32x32x16_bf16(kf[2 * k], qf[k], p0, 0, 0, 0);
                    p1 = __builtin_amdgcn_mfma_f32_32x32x16_bf16(kf[2 * k + 1], qf[k], p1, 0, 0, 0); }
                __builtin_amdgcn_sched_barrier(0);
#pragma unroll
                for (int d = 0; d < 2; ++d)
#pragma unroll
                    for (int cc = 0; cc < 4; ++cc) { vlo[d * 4 + cc] = *(const LAS u32x2*)(vb + d * 32 * VPITCH + cc * 32); vhh[d * 4 + cc] = *(const LAS u32x2*)(vb + d * 32 * VPITCH + cc * 32 + 16); }
                __builtin_amdgcn_sched_barrier(0);
            } else {
                const LAS unsigned char* kb = Ks + c * KPITCH + hi * 16;
#pragma unroll
                for (int k = 0; k < KS; ++k) {
                    const bf16x8 a0 = *(const LAS bf16x8*)(kb + k * 32), a1 = *(const LAS bf16x8*)(kb + 32 * KPITCH + k * 32);
                    p0 = __builtin_amdgcn_mfma_f32_32x32x16_bf16(a0, qf[k], p0, 0, 0, 0);
                    p1 = __builtin_amdgcn_mfma_f32_32x32x16_bf16(a1, qf[k], p1, 0, 0, 0); }
            }
            if (FOX) {
#pragma unroll
                for (int r4 = 0; r4 < 4; ++r4) { const f32x4 b0 = *(const LAS f32x4*)(cbs + 8 * r4 + 4 * hi), b1 = *(const LAS f32x4*)(cbs + 32 + 8 * r4 + 4 * hi);
#pragma unroll
                    for (int e = 0; e < 4; ++e) { p0[4 * r4 + e] -= b0[e]; p1[4 * r4 + e] -= b1[e]; } }
                if (kv0 + 63 > t0 + wave * 32) {
#pragma unroll
                    for (int r = 0; r < 16; ++r) { const int kv = kv0 + crow(r, hi); if (kv > qrow) p0[r] = -INFINITY; if (kv + 32 > qrow) p1[r] = -INFINITY; }
                }
            }
            float mx = p0[0];
#pragma unroll
            for (int r = 1; r < 16; ++r) mx = fmaxf(mx, p0[r]);
#pragma unroll
            for (int r = 0; r < 16; ++r) mx = fmaxf(mx, p1[r]);
            mx = fmaxf(mx, __shfl_xor(mx, 32));
            const float mn = fmaxf(m, mx), alpha = __builtin_amdgcn_exp2f(m - mn); m = mn;
            float ps = 0.f;
#pragma unroll
            for (int r = 0; r < 16; ++r) { p0[r] = __builtin_amdgcn_exp2f(p0[r] - mn); p1[r] = __builtin_amdgcn_exp2f(p1[r] - mn); ps += p0[r] + p1[r]; }
            l = l * alpha + ps;
#pragma unroll
            for (int d = 0; d < ND; ++d)
#pragma unroll
                for (int r = 0; r < 16; ++r) o[d][r] *= alpha;
            bf16x8 pb[4];
#pragma unroll
            for (int cc = 0; cc < 4; ++cc) { u32x4 w;
                if (cc < 2) { w.x = pk2(p0[8 * cc + 0], p0[8 * cc + 1]); w.y = pk2(p0[8 * cc + 2], p0[8 * cc + 3]); w.z = pk2(p0[8 * cc + 4], p0[8 * cc + 5]); w.w = pk2(p0[8 * cc + 6], p0[8 * cc + 7]); }
                else { const int c2 = cc - 2; w.x = pk2(p1[8 * c2 + 0], p1[8 * c2 + 1]); w.y = pk2(p1[8 * c2 + 2], p1[8 * c2 + 3]); w.z = pk2(p1[8 * c2 + 4], p1[8 * c2 + 5]); w.w = pk2(p1[8 * c2 + 6], p1[8 * c2 + 7]); }
                pb[cc] = __builtin_bit_cast(bf16x8, w); }
            if constexpr (FOX) {
                u32x2 wlo[8], whh[8];
#pragma unroll
                for (int d = 0; d < 2; ++d)
#pragma unroll
                    for (int cc = 0; cc < 4; ++cc) { wlo[d * 4 + cc] = *(const LAS u32x2*)(vb + (d + 2) * 32 * VPITCH + cc * 32); whh[d * 4 + cc] = *(const LAS u32x2*)(vb + (d + 2) * 32 * VPITCH + cc * 32 + 16); }
                __builtin_amdgcn_sched_barrier(0);
#pragma unroll
                for (int cc = 0; cc < 4; ++cc)
#pragma unroll
                    for (int d = 0; d < 2; ++d) { const u32x4 av = (u32x4){vlo[d * 4 + cc].x, vlo[d * 4 + cc].y, vhh[d * 4 + cc].x, vhh[d * 4 + cc].y};
                        o[d] = __builtin_amdgcn_mfma_f32_32x32x16_bf16(__builtin_bit_cast(bf16x8, av), pb[cc], o[d], 0, 0, 0); }
                __builtin_amdgcn_sched_barrier(0);
#pragma unroll
                for (int cc = 0; cc < 4; ++cc)
#pragma unroll
                    for (int d = 0; d < 2; ++d) { const u32x4 av = (u32x4){wlo[d * 4 + cc].x, wlo[d * 4 + cc].y, whh[d * 4 + cc].x, whh[d * 4 + cc].y};
                        o[d + 2] = __builtin_amdgcn_mfma_f32_32x32x16_bf16(__builtin_bit_cast(bf16x8, av), pb[cc], o[d + 2], 0, 0, 0); }
            } else {
#pragma unroll
              for (int d = 0; d < ND; ++d)
#pragma unroll
                  for (int cc = 0; cc < 4; ++cc) {
                      const u32x2 lo = *(const LAS u32x2*)(vb + d * 32 * VPITCH + cc * 32), hh = *(const LAS u32x2*)(vb + d * 32 * VPITCH + cc * 32 + 16);
                      const u32x4 av = (u32x4){lo.x, lo.y, hh.x, hh.y};
                      o[d] = __builtin_amdgcn_mfma_f32_32x32x16_bf16(__builtin_bit_cast(bf16x8, av), pb[cc], o[d], 0, 0, 0); } }
        }
        l += __shfl_xor(l, 32);
        const float rl = 1.f / l;
        bf16* op = O + (size_t)qrow * ldo + half * ND * 32 + 4 * hi;
#pragma unroll
        for (int d = 0; d < ND; ++d)
#pragma unroll
            for (int r4 = 0; r4 < 4; ++r4) { u32x2 w; w.x = pk2(o[d][4 * r4 + 0] * rl, o[d][4 * r4 + 1] * rl); w.y = pk2(o[d][4 * r4 + 2] * rl, o[d][4 * r4 + 3] * rl);
                *(u32x2*)(op + 32 * d + 8 * r4) = w; }
    }
    __syncthreads();
}

__device__ __forceinline__ void gdn_scan_wg(const Params& P, unsigned char* lds_, int unit, int tid, int lane, int wave) {
    const int bh = unit >> 1, half = unit & 1;
    LAS unsigned char* lds = (LAS unsigned char*)lds_;
    const int b = bh >> 3, h = bh & 7;
    const unsigned char* gsrc = P.ws + WS_GDN + (size_t)bh * 128 * GDN_CHUNK_BYTES;
    const unsigned char* usrc = P.ws + WS_UC + (size_t)bh * 128 * 16384;
    const float* cdec = (const float*)(P.ws + WS_CDEC) + bh * 128;
    bf16* proj = (bf16*)(P.ws + WS_PROJ);
#define SCAN_BAR() asm volatile("s_waitcnt lgkmcnt(0)\n\ts_barrier" ::: "memory")
    constexpr int OB = 114688;
    if (wave >= 4) {
        const int lt = tid - 256, tk = lt >> 2, q4 = lt & 3;
        const size_t rowb = (size_t)b * SEQ + tk;
        bf16* obase = proj + rowb * LDP + PC_OA + h * 128 + q4 * 32;
        u32x4 r[14];
#pragma unroll
        for (int k = 0; k < 14; ++k) r[k] = *(const u32x4*)(gsrc + (size_t)(lt + 256 * k) * 16);
#pragma unroll
        for (int k = 0; k < 14; ++k) *(LAS u32x4*)(lds + (lt + 256 * k) * 16) = r[k];
#pragma unroll
        for (int k = 0; k < 14; ++k) r[k] = *(const u32x4*)(gsrc + (size_t)GDN_CHUNK_BYTES + (size_t)(lt + 256 * k) * 16);
        __syncthreads();
#define GDN_NORM(CH) do { if ((q4 >> 1) == half) { const LAS unsigned char* ob_ = lds + OB + ((CH) & 1) * 16384 + tk * 256 + q4 * 64; bf16* op_ = obase + (size_t)(CH) * 64 * LDP; \
            _Pragma("unroll") for (int i = 0; i < 4; ++i) { const u32x4 w_ = *(const LAS u32x4*)(ob_ + i * 16); *(u32x4*)(op_ + 8 * i) = w_; } } } while (0)
#pragma unroll 1
        for (int n = 0; n < 128; ++n) {
            if (n + 1 < 128) {
                LAS unsigned char* d = lds + ((n + 1) & 1) * GDN_CHUNK_BYTES;
#pragma unroll
                for (int k = 0; k < 14; ++k) *(LAS u32x4*)(d + (lt + 256 * k) * 16) = r[k];
            }
            if (n + 2 < 128) {
                const unsigned char* s2 = gsrc + (size_t)(n + 2) * GDN_CHUNK_BYTES;
#pragma unroll
                for (int k = 0; k < 14; ++k) r[k] = *(const u32x4*)(s2 + (size_t)(lt + 256 * k) * 16);
            }
            if (n > 0) GDN_NORM(n - 1);
            SCAN_BAR();
        }
        GDN_NORM(127);
#undef GDN_NORM
    } else if (wave >= 2) {
        __syncthreads();
#pragma unroll 1
        for (int n = 0; n < 128; ++n) SCAN_BAR();
    } else {
        const int w4 = 2 * half + wave, c = lane & 31, hi = lane >> 5;
        f32x16 S[4];
#pragma unroll
        for (int t = 0; t < 4; ++t) S[t] = f32x16{};
        bf16x8 Sb[8];
#pragma unroll
        for (int k = 0; k < 8; ++k) Sb[k] = bf16x8{};
        u32x4 ucn[4];
#pragma unroll
        for (int i = 0; i < 4; ++i) ucn[i] = *(const u32x4*)(usrc + (size_t)((w4 * 2 + (i >> 1)) * 64 + lane) * 32 + (i & 1) * 16);
        float cdn = cdec[0];
        __syncthreads();
#pragma unroll 1
        for (int n = 0; n < 128; ++n) {
            const LAS unsigned char* fb = lds + (n & 1) * GDN_CHUNK_BYTES + lane * 16;
            f32x16 U[2];
#pragma unroll
            for (int rt = 0; rt < 2; ++rt) { const u32x4 a = ucn[2 * rt], bq = ucn[2 * rt + 1];
                U[rt][0] = bflo(a.x); U[rt][1] = bfhi(a.x); U[rt][2] = bflo(a.y); U[rt][3] = bfhi(a.y); U[rt][4] = bflo(a.z); U[rt][5] = bfhi(a.z); U[rt][6] = bflo(a.w); U[rt][7] = bfhi(a.w);
                U[rt][8] = bflo(bq.x); U[rt][9] = bfhi(bq.x); U[rt][10] = bflo(bq.y); U[rt][11] = bfhi(bq.y); U[rt][12] = bflo(bq.z); U[rt][13] = bfhi(bq.z); U[rt][14] = bflo(bq.w); U[rt][15] = bfhi(bq.w); }
            const float cd = cdn;
            if (n + 1 < 128) {
                const unsigned char* us = usrc + (size_t)(n + 1) * 16384;
#pragma unroll
                for (int i = 0; i < 4; ++i) ucn[i] = *(const u32x4*)(us + (size_t)((w4 * 2 + (i >> 1)) * 64 + lane) * 32 + (i & 1) * 16);
                cdn = cdec[n + 1];
            }
#define FRAG(off) (*(const LAS bf16x8*)(fb + (off)))
#define SBAR() __builtin_amdgcn_sched_barrier(0)
            bf16x8 A0[8], A1[8];
#pragma unroll
            for (int i = 0; i < 8; ++i) A0[i] = FRAG(((i & 1) * 8 + (i >> 1)) * 1024);
            SBAR();
#pragma unroll
            for (int i = 0; i < 8; ++i) A1[i] = FRAG(((i & 1) * 8 + 4 + (i >> 1)) * 1024);
            SBAR();
#pragma unroll
            for (int i = 0; i < 8; ++i) U[i & 1] = __builtin_amdgcn_mfma_f32_32x32x16_bf16(A0[i], Sb[i >> 1], U[i & 1], 0, 0, 0);
            SBAR();
#pragma unroll
            for (int i = 0; i < 8; ++i) A0[i] = FRAG(16384 + ((i & 1) * 8 + (i >> 1)) * 1024);
            SBAR();
#pragma unroll
            for (int i = 0; i < 8; ++i) U[i & 1] = __builtin_amdgcn_mfma_f32_32x32x16_bf16(A1[i], Sb[4 + (i >> 1)], U[i & 1], 0, 0, 0);
            SBAR();
#pragma unroll
            for (int i = 0; i < 8; ++i) A1[i] = FRAG(16384 + ((i & 1) * 8 + 4 + (i >> 1)) * 1024);
            SBAR();
            f32x16 Ov[2]; Ov[0] = f32x16{}; Ov[1] = f32x16{};
#pragma unroll
            for (int i = 0; i < 8; ++i) Ov[i & 1] = __builtin_amdgcn_mfma_f32_32x32x16_bf16(A0[i], Sb[i >> 1], Ov[i & 1], 0, 0, 0);
            SBAR();
#pragma unroll
            for (int i = 0; i < 8; ++i) A0[i] = FRAG(32768 + ((i & 1) * 4 + (i >> 1)) * 1024);
            SBAR();
#pragma unroll
            for (int i = 0; i < 8; ++i) Ov[i & 1] = __builtin_amdgcn_mfma_f32_32x32x16_bf16(A1[i], Sb[4 + (i >> 1)], Ov[i & 1], 0, 0, 0);
            SBAR();
            bf16x8 Ub[4];
#pragma unroll
            for (int k2 = 0; k2 < 4; ++k2) { const f32x16& uu = U[k2 >> 1]; const int o8 = 8 * (k2 & 1); u32x4 w;
                w.x = pk2(uu[o8 + 0], uu[o8 + 1]); w.y = pk2(uu[o8 + 2], uu[o8 + 3]); w.z = pk2(uu[o8 + 4], uu[o8 + 5]); w.w = pk2(uu[o8 + 6], uu[o8 + 7]); Ub[k2] = __builtin_bit_cast(bf16x8, w); }
#pragma unroll
            for (int i = 0; i < 8; ++i) A1[i] = FRAG(40960 + ((i & 3) * 4 + (i >> 2)) * 1024);
            SBAR();
#pragma unroll
            for (int i = 0; i < 8; ++i) Ov[i & 1] = __builtin_amdgcn_mfma_f32_32x32x16_bf16(A0[i], Ub[i >> 1], Ov[i & 1], 0, 0, 0);
            SBAR();
#pragma unroll
            for (int i = 0; i < 8; ++i) A0[i] = FRAG(40960 + ((i & 3) * 4 + 2 + (i >> 2)) * 1024);
            SBAR();
#pragma unroll
            for (int t = 0; t < 4; ++t)
#pragma unroll
                for (int r = 0; r < 16; ++r) S[t][r] *= cd;
#pragma unroll
            for (int i = 0; i < 8; ++i) S[i & 3] = __builtin_amdgcn_mfma_f32_32x32x16_bf16(A1[i], Ub[i >> 2], S[i & 3], 0, 0, 0);
            SBAR();
#pragma unroll
            for (int i = 0; i < 8; ++i) S[i & 3] = __builtin_amdgcn_mfma_f32_32x32x16_bf16(A0[i], Ub[2 + (i >> 2)], S[i & 3], 0, 0, 0);
            SBAR();
            { LAS bf16* ob = (LAS bf16*)(lds + OB + (n & 1) * 16384);
#pragma unroll
              for (int rt = 0; rt < 2; ++rt)
#pragma unroll
                  for (int r = 0; r < 16; ++r) ob[(32 * rt + crow(r, hi)) * 128 + 32 * w4 + c] = (bf16)(pk2(Ov[rt][r], 0.f) & 0xffffu); }
#pragma unroll
            for (int k = 0; k < 8; ++k) { const f32x16& ss = S[k >> 1]; const int o8 = 8 * (k & 1); u32x4 w;
                w.x = pk2(ss[o8 + 0], ss[o8 + 1]); w.y = pk2(ss[o8 + 2], ss[o8 + 3]); w.z = pk2(ss[o8 + 4], ss[o8 + 5]); w.w = pk2(ss[o8 + 6], ss[o8 + 7]); Sb[k] = __builtin_bit_cast(bf16x8, w); }
#undef FRAG
#undef SBAR
            SCAN_BAR();
        }
    }
    __syncthreads();
}

__device__ __forceinline__ void phase3(const Params& P, unsigned char* lds, int tid, int lane, int wave) {
    bf16* proj = (bf16*)(P.ws + WS_PROJ);
#ifndef NO_SCAN
    if (blockIdx.x < 32) gdn_scan_wg(P, lds, blockIdx.x, tid, lane, wave);
#endif
#ifdef PROBE_TS
    if (blockIdx.x == 0 && tid == 0) ((volatile unsigned long long*)(P.ws + WS_CTL + 32768))[10] = __builtin_amdgcn_s_memrealtime();
#endif
    unsigned* ctr = (unsigned*)(P.ws + WS_CTL);
    LAS unsigned* sh = (LAS unsigned*)((LAS unsigned char*)lds + LDS_BYTES - 64);
    const bf16* foxvt = (const bf16*)((const unsigned char*)P.out + DO_FOXVT);
    const float* cum = (const float*)(P.ws + WS_CUM);
    const bf16* kmem = (const bf16*)(P.ws + WS_KMEM); const bf16* vmt = (const bf16*)(P.ws + WS_VMT);
#ifdef STATIC_P3
    for (unsigned idx_ = (blockIdx.x < 16 ? 100000u : blockIdx.x - 16u); idx_ < 768u; idx_ += 240u) {
        const unsigned idx = __builtin_amdgcn_readfirstlane(idx_);
#else
    for (;;) {
        if (tid == 0) sh[0] = atomicAdd(ctr, 1u);
        __syncthreads();
        const unsigned idx = __builtin_amdgcn_readfirstlane(sh[0]);
        __syncthreads();
        if (idx >= 512u + 256u) break;
#endif
        int dbg_t = 0;
#ifdef PROBE_TS
        if (blockIdx.x == 16 && tid == 0) ((volatile unsigned long long*)(P.ws + WS_CTL + 32768))[20] = __builtin_amdgcn_s_memrealtime();
#endif
        if (idx < 512u) {
#ifndef NO_FOXATT
            const int qb = 31 - (int)(idx >> 4), bh = idx & 15, b = bh >> 3, h = bh & 7;
            bf16* Qp = proj + (size_t)b * SEQ * LDP + PC_FQ + h * 128;
            const bf16* Kp = proj + (size_t)b * SEQ * LDP + PC_FK + h * 128;
            const bf16* Vp = foxvt + (size_t)(h * 128) * TOK + (size_t)b * SEQ;
            attn_unit<128, true>(lds, Qp, LDP, Kp, LDP, Vp, TOK, Qp, LDP, cum + (size_t)bh * SEQ, ((const float*)(P.ws + WS_CDEC + 16384))[0], qb * 256, (qb + 1) * 4, tid, lane, wave, dbg_t, P.ws);
#ifdef PROBE_TS
            if (blockIdx.x == 16 && tid == 0) { volatile unsigned long long* dg = (volatile unsigned long long*)(P.ws + WS_CTL + 32768); dg[14] += __builtin_amdgcn_s_memrealtime() - dg[20]; }
#endif
#endif
        } else {
#ifndef NO_MEMATT
            const int u = idx - 512, qb = u & 31, bh = u >> 5, b = bh >> 2, h = bh & 3;
            bf16* Qp = proj + (size_t)b * SEQ * LDP + PC_QM + h * 256;
            const bf16* Kp = kmem + (size_t)b * 256 * 1024 + h * 256;
            const bf16* Vp = vmt + (size_t)(h * 256) * 512 + b * 256;
            attn_unit<256, false>(lds, Qp, LDP, Kp, 1024, Vp, 512, Qp, LDP, nullptr, 0.f, qb * 256, 4, tid, lane, wave, dbg_t);
#ifdef PROBE_TS
            if (blockIdx.x == 16 && tid == 0) { volatile unsigned long long* dg = (volatile unsigned long long*)(P.ws + WS_CTL + 32768); dg[18] += __builtin_amdgcn_s_memrealtime() - dg[20]; }
#endif
#endif
        }
    }
#ifdef PROBE_TS
    if (blockIdx.x == 0 && tid == 0) ((volatile unsigned long long*)(P.ws + WS_CTL + 32768))[11] = __builtin_amdgcn_s_memrealtime();
#endif
}


__device__ __forceinline__ void gdn_gate_norm_pass(const Params& P, int tid) {
    bf16* proj = (bf16*)(P.ws + WS_PROJ);
    const int cidx = (tid & 127) * 8, d = cidx & 127;
    const f32x4 g0 = *(const f32x4*)(P.gdn_norm_g + d), g1 = *(const f32x4*)(P.gdn_norm_g + d + 4);
    const float gg[8] = {g0.x, g0.y, g0.z, g0.w, g1.x, g1.y, g1.z, g1.w};
    for (int it0 = blockIdx.x; it0 < TOK / 4; it0 += 4 * gridDim.x) {
        u32x4 ov[4], zv[4]; bool ok[4]; bf16* op[4];
#pragma unroll
        for (int b = 0; b < 4; ++b) { const int it = it0 + b * gridDim.x; ok[b] = it < TOK / 4; const size_t row = (size_t)((ok[b] ? it : 0) * 4 + (tid >> 7));
            op[b] = proj + row * LDP + PC_OA + cidx; ov[b] = *(const u32x4*)op[b]; zv[b] = *(const u32x4*)(proj + row * LDP + PC_Z + cidx); }
#pragma unroll
        for (int b = 0; b < 4; ++b) {
            const float v[8] = {bflo(ov[b].x), bfhi(ov[b].x), bflo(ov[b].y), bfhi(ov[b].y), bflo(ov[b].z), bfhi(ov[b].z), bflo(ov[b].w), bfhi(ov[b].w)};
            const float z[8] = {bflo(zv[b].x), bfhi(zv[b].x), bflo(zv[b].y), bfhi(zv[b].y), bflo(zv[b].z), bfhi(zv[b].z), bflo(zv[b].w), bfhi(zv[b].w)};
            float ss = 0.f;
#pragma unroll
            for (int e = 0; e < 8; ++e) ss += v[e] * v[e];
            ss += __shfl_xor(ss, 1); ss += __shfl_xor(ss, 2); ss += __shfl_xor(ss, 4); ss += __shfl_xor(ss, 8);
            const float rstd = rsqrtf(ss * (1.f / 128.f) + EPSN);
            float o[8];
#pragma unroll
            for (int e = 0; e < 8; ++e) o[e] = v[e] * rstd * gg[e] * (z[e] * __builtin_amdgcn_rcpf(1.f + __builtin_amdgcn_exp2f(-LOG2E * z[e])));
            u32x4 w; w.x = pk2(o[0], o[1]); w.y = pk2(o[2], o[3]); w.z = pk2(o[4], o[5]); w.w = pk2(o[6], o[7]);
            if (ok[b]) *(u32x4*)op[b] = w;
        }
    }
}

#define RLX_AGENT __ATOMIC_RELAXED, __HIP_MEMORY_SCOPE_AGENT
#define XB_TMO      128
#define XB_XCNT(j)  (256  + 64 * (j))
#define XB_XSUB(j)  (1280 + 64 * (j))
#define XB_XGEN(j)  (2304 + 64 * (j))
#define XB_TOP      3328
#define XB_TOPGEN   3392
#define XCD_BAR_WORDS 3456
#define XB_SPIN_CAP (1u << 22)

__device__ __forceinline__ unsigned xb_ld(unsigned* p)              { return __hip_atomic_load(p, __ATOMIC_RELAXED, __HIP_MEMORY_SCOPE_AGENT); }
__device__ __forceinline__ unsigned xb_add(unsigned* p, unsigned v) { return __hip_atomic_fetch_add(p, v, __ATOMIC_RELAXED, __HIP_MEMORY_SCOPE_AGENT); }
__device__ __forceinline__ unsigned xb_xcc_id() { return (unsigned)__builtin_amdgcn_s_getreg((3 << 11) | 20) & 0xFu; }
#define XB_SPIN(cond, bar) do { unsigned _sp = 0; while (cond) { __builtin_amdgcn_s_sleep(1); \
    if ((++_sp & 255u) == 0u) { if (xb_ld(&(bar)[XB_TMO])) break; if (_sp > XB_SPIN_CAP) { atomicAdd(&(bar)[XB_TMO], 1u); break; } } } } while (0)

struct XcdBarrier {
    unsigned* bar; unsigned x;
    volatile LAS unsigned* st;
};

__device__ __forceinline__ XcdBarrier xcd_barrier_post(unsigned* bar, volatile LAS unsigned* st) {
    XcdBarrier b; b.bar = bar; b.x = xb_xcc_id(); b.st = st;
    if (threadIdx.x == 0) (void)xb_add(&bar[XB_XCNT(b.x)], 1u);
    return b;
}
__device__ __forceinline__ void xcd_barrier_complete(unsigned* bar, unsigned x, unsigned& nloc, unsigned& nx) {
    const unsigned G = gridDim.x * gridDim.y * gridDim.z;
    unsigned sum, cnt, mine, sp = 0u;
    for (;;) {
        sum = 0u; cnt = 0u; mine = 0u;
#pragma unroll
        for (unsigned j = 0; j < 16; ++j) { const unsigned c = xb_ld(&bar[XB_XCNT(j)]); sum += c; cnt += (c > 0u) ? 1u : 0u; mine = (j == x) ? c : mine; }
        if (sum == G) break;
        __builtin_amdgcn_s_sleep(1);
        if ((++sp & 255u) == 0u) { if (xb_ld(&bar[XB_TMO])) break; if (sp > XB_SPIN_CAP) { atomicAdd(&bar[XB_TMO], 1u); break; } }
    }
    nloc = mine > 0u ? mine : 1u; nx = cnt > 0u ? cnt : 1u;
}

__device__ __forceinline__ void xcd_barrier(const XcdBarrier& b) {
    asm volatile("s_waitcnt vmcnt(0)" ::: "memory");
    __syncthreads();
    if (threadIdx.x == 0) {
        unsigned* bar = b.bar;
        __builtin_amdgcn_s_waitcnt(0);
        unsigned nloc = b.st[0], nx = b.st[1];
        if (nloc == 0u) { xcd_barrier_complete(bar, b.x, nloc, nx); b.st[0] = nloc; b.st[1] = nx; }
        const unsigned old = xb_add(&bar[XB_XSUB(b.x)], 1u);
        const unsigned gen = old / nloc;
        if (old + 1u == (gen + 1u) * nloc) {
            __builtin_amdgcn_fence(__ATOMIC_RELEASE, "agent");
            asm volatile("s_waitcnt vmcnt(0)" ::: "memory");
            const unsigned og = xb_add(&bar[XB_TOP], 1u);
            const unsigned tg = og / nx;
            if (og + 1u == (tg + 1u) * nx) xb_add(&bar[XB_TOPGEN], 1u);
            else XB_SPIN(xb_ld(&bar[XB_TOPGEN]) == tg, bar);
            __builtin_amdgcn_fence(__ATOMIC_ACQUIRE, "agent");
            xb_add(&bar[XB_XGEN(b.x)], 1u);
            asm volatile("s_waitcnt vmcnt(0)" ::: "memory");
        } else {
            XB_SPIN(xb_ld(&bar[XB_XGEN(b.x)]) == gen, bar);
            __builtin_amdgcn_fence(__ATOMIC_ACQUIRE, "agent");
            asm volatile("s_waitcnt vmcnt(0)" ::: "memory");
        }
    }
    __syncthreads();
}

__global__ void __launch_bounds__(512, 2) hybrid_fwd(Params P) {
    extern __shared__ __attribute__((aligned(16))) unsigned char lds[];
    cg::grid_group grid = cg::this_grid();
    const int tid = threadIdx.x, lane = tid & 63, wave = __builtin_amdgcn_readfirstlane(tid >> 6);
    const int G = gridDim.x, cb = blockIdx.x;
    unsigned char* ws = P.ws;
    LAS unsigned char* glds = (LAS unsigned char*)lds;
    bf16* H = (bf16*)((unsigned char*)P.out + DO_H);
    bf16* proj = (bf16*)(ws + WS_PROJ);
    volatile LAS unsigned* bst = (volatile LAS unsigned*)(glds + LDS_BYTES - 32);
    if (tid < 2) bst[tid] = 0u;
    __syncthreads();
    XcdBarrier bar = xcd_barrier_post((unsigned*)(ws + WS_CTL) + 1024, bst);
#ifdef PROBE_TS
    volatile unsigned long long* tsg_ = (volatile unsigned long long*)(ws + WS_CTL + 32768);
    if (blockIdx.x == 0 && tid == 0) tsg_[0] = __builtin_amdgcn_s_memrealtime();
#endif
    grid.sync();
#ifdef PROBE_TS
#define GRID_BAR(k_) do { xcd_barrier(bar); if (blockIdx.x == 0 && tid == 0) tsg_[k_] = __builtin_amdgcn_s_memrealtime(); } while (0)
#else
#define GRID_BAR(k_) xcd_barrier(bar)
#endif

#ifndef NO_P0
    phase0(P, lds, tid, lane, wave);
#endif
    GRID_BAR(1);
#ifndef NO_GEMM
    {
        pg8::Gemm g{H, (const bf16*)(ws + WS_W1T), TOK, 7424, 2048, 2048, 2048}; pg8::StaticOrder S; S.init(TOK, 7424, G, cb);
        pg8::EpiProj E{proj, LDP, (float*)(ws + WS_SMALL)};
        pg8::gemm_phase<pg8::EpiProj, pg8::StaticOrder, true, true>(glds, g, S, E);
    }
    {
        pg8::Gemm g{(const bf16*)(ws + WS_WFVT), H, 1024, TOK, 2048, 2048, 2048}; pg8::StaticOrder S; S.init(1024, TOK, G, cb);
        pg8::EpiStore E{(bf16*)((unsigned char*)P.out + DO_FOXVT), TOK};
        pg8::gemm_phase<pg8::EpiStore, pg8::StaticOrder, true, true>(glds, g, S, E);
    }
    {
        const int cr = (cb + G - 64) % G;
        pg8::Gemm g{(const bf16*)(ws + WS_MEMN), (const bf16*)(ws + WS_WMKVT), 512, 1024, 2048, 2048, 2048}; pg8::StaticOrder S; S.init(512, 1024, G, cr);
        pg8::EpiStore E{(bf16*)(ws + WS_KMEM), 1024};
        pg8::gemm_phase<pg8::EpiStore, pg8::StaticOrder, true, true>(glds, g, S, E);
        const int cr2 = (cb + G - 72) % G;
        pg8::Gemm g2{(const bf16*)(ws + WS_WMKVT) + (size_t)1024 * 2048, (const bf16*)(ws + WS_MEMN), 1024, 512, 2048, 2048, 2048}; pg8::StaticOrder S2; S2.init(1024, 512, G, cr2);
        pg8::EpiStore E2{(bf16*)(ws + WS_VMT), 512};
        pg8::gemm_phase<pg8::EpiStore, pg8::StaticOrder, true, true>(glds, g2, S2, E2);
    }
#endif
    GRID_BAR(2);
#ifndef NO_P2
    phase2(P, lds, tid, lane, wave);
#endif
    GRID_BAR(3);
#ifndef NO_P3
    phase3(P, lds, tid, lane, wave);
#endif
    GRID_BAR(4);
#ifndef NO_GEMM
    gdn_gate_norm_pass(P, tid);
    {
        pg8::Gemm g{H, (const bf16*)(ws + WS_WGT), TOK, 6144, 2048, 2048, 2048}; pg8::StaticOrder S; S.init(TOK, 6144, G, cb);
        pg8::EpiSig E{(unsigned char*)P.out + DO_GA, (unsigned char*)(proj + PC_GB), 2048, LDP * 2};
        pg8::gemm_phase<pg8::EpiSig, pg8::StaticOrder, true, true>(glds, g, S, E);
    }
    GRID_BAR(5);
    {
        bf16* Y = (bf16*)(ws + WS_Y); const bf16* WUPT = (const bf16*)(ws + WS_WUPT);
        pg8::StaticOrder S; S.init(TOK, 2048, G, cb);
        { pg8::Gemm g{proj + PC_OA, WUPT, TOK, 2048, 1024, LDP, 1024}; pg8::EpiGate<true> E{(const unsigned char*)P.out + DO_GA, 2048, Y, 2048};
          pg8::gemm_phase<pg8::EpiGate<true>, pg8::StaticOrder, true, true>(glds, g, S, E); }
        { pg8::Gemm g{proj + PC_OB, WUPT + (size_t)2048 * 1024, TOK, 2048, 1024, LDP, 1024}; pg8::EpiGate<false> E{(const unsigned char*)(proj + PC_GB), LDP * 2, Y, 2048};
          pg8::gemm_phase<pg8::EpiGate<false>, pg8::StaticOrder, true, true>(glds, g, S, E); }
        { pg8::Gemm g{proj + PC_OM, WUPT + (size_t)2 * 2048 * 1024, TOK, 2048, 1024, LDP, 1024}; pg8::EpiGate<false> E{(const unsigned char*)(proj + PC_GB) + 2048, LDP * 2, Y, 2048};
          pg8::gemm_phase<pg8::EpiGate<false>, pg8::StaticOrder, true, true>(glds, g, S, E); }
    }
    GRID_BAR(6);
    {
        pg8::Gemm g{(const bf16*)(ws + WS_Y), (const bf16*)(ws + WS_WOT), TOK, 2048, 2048, 2048, 2048}; pg8::StaticOrder S; S.init(TOK, 2048, G, cb);
        pg8::EpiRes1 E{P.x, (bf16*)(ws + WS_X1B), (float*)(ws + WS_SSQ)};
        pg8::gemm_phase<pg8::EpiRes1, pg8::StaticOrder, true, true>(glds, g, S, E);
    }
    GRID_BAR(7);
    {
        const float* SSQ = (const float*)(ws + WS_SSQ); float* RSTD = (float*)(ws + WS_RSTD);
        const int g = cb * 512 + tid;
        if (g < TOK * 8) { const int row = g >> 3, part = g & 7; float sq = 0.f;
#pragma unroll
            for (int q = 0; q < 4; ++q) sq += SSQ[(size_t)(part * 4 + q) * 16384 + row];
            sq += __shfl_xor(sq, 1); sq += __shfl_xor(sq, 2); sq += __shfl_xor(sq, 4);
            if (part == 0) RSTD[row] = rsqrtf(sq * (1.f / 2048.f) + 1e-6f); }
    }
    GRID_BAR(8);
    {
        pg8::Gemm g{(const bf16*)(ws + WS_X1B), (const bf16*)(ws + WS_WFF1T), TOK, 8192, 2048, 2048, 2048}; pg8::StaticOrder S; S.init(TOK, 8192, G, cb);
        pg8::EpiFF1 E{(const float*)(ws + WS_RSTD), (bf16*)(ws + WS_U), 8192};
        pg8::gemm_phase<pg8::EpiFF1, pg8::StaticOrder, true, true>(glds, g, S, E);
    }
    GRID_BAR(9);
    {
        pg8::Gemm g{(const bf16*)(ws + WS_U), (const bf16*)(ws + WS_WFF2T), TOK, 2048, 8192, 8192, 8192}; pg8::StaticOrder S; S.init(TOK, 2048, G, cb, 4);
        pg8::EpiOut E{(const bf16*)(ws + WS_X1B), P.out};
        pg8::gemm_phase<pg8::EpiOut, pg8::StaticOrder, true, true>(glds, g, S, E);
    }
#endif
#ifdef PROBE_TS
    if (blockIdx.x == 0 && tid == 0) {
        const unsigned long long tend = __builtin_amdgcn_s_memrealtime();
        tsg_[12] = tend;
        long long qa = ((long long)(tsg_[PROBE_A1] - tsg_[PROBE_A0]) + 1500) / 3000; if (qa > 35) qa = 35;
        long long qb = ((long long)(tsg_[PROBE_B1] - tsg_[PROBE_B0]) + 1500) / 3000; if (qb > 35) qb = 35;
        long long qc = ((long long)(tsg_[PROBE_C1] - tsg_[PROBE_C0]) + 1500) / 3000; if (qc > 35) qc = 35;
        const unsigned long long until = tend + (unsigned long long)(qa + 36 * qb + 1296 * qc) * 2000ull;
        while (__builtin_amdgcn_s_memrealtime() < until) __builtin_amdgcn_s_sleep(8);
    }
#endif
}

extern "C" void kernel_launch(void* const* d_in, const int* in_sizes, int n_in, void* d_out, int out_size, void* d_ws, size_t ws_size, hipStream_t stream) {
    static int grid = 0;
    if (grid == 0) {
        if (n_in != 22 || out_size != TOK * DM || ws_size < WS_END) { fprintf(stderr, "kernel_launch: unexpected shapes (n_in %d out %d ws %zu)\n", n_in, out_size, ws_size); grid = -1; return; }
        int dev = 0, cus = 0, per_cu = 0;
        hipGetDevice(&dev); hipDeviceGetAttribute(&cus, hipDeviceAttributeMultiprocessorCount, dev);
        if (hipFuncSetAttribute((const void*)hybrid_fwd, hipFuncAttributeMaxDynamicSharedMemorySize, LDS_BYTES) != hipSuccess) { fprintf(stderr, "kernel_launch: hipFuncSetAttribute failed\n"); grid = -1; return; }
        if (hipOccupancyMaxActiveBlocksPerMultiprocessor(&per_cu, (const void*)hybrid_fwd, 512, LDS_BYTES) != hipSuccess || per_cu < 1) { fprintf(stderr, "kernel_launch: occupancy query says %d\n", per_cu); per_cu = 1; }
        (void)hipGetLastError();
        grid = cus * 1;
        if (grid <= 0) grid = 256;
    }
    if (grid < 0) return;
    if (hipMemsetAsync((char*)d_ws + WS_CTL, 0, 65536, stream) != hipSuccess) { fprintf(stderr, "kernel_launch: memset failed\n"); return; }
    Params p{};
    const float** pp = (const float**)&p;
    for (int i = 0; i < 22; ++i) pp[i] = (const float*)d_in[i];
    p.out = (float*)d_out; p.ws = (unsigned char*)d_ws;
    void* args[] = {&p};
    hipError_t e = hipLaunchCooperativeKernel((const void*)hybrid_fwd, dim3(grid), dim3(512), args, LDS_BYTES, stream);
    if (e != hipSuccess) fprintf(stderr, "cooperative launch failed: %s (grid %d)\n", hipGetErrorString(e), grid);
}
```

```cpp
#include <hip/hip_runtime.h>
#include <hip/hip_cooperative_groups.h>
#include <cstdio>
#include <cstdint>
namespace cg = cooperative_groups;

namespace pg8 {
#define PG8_LAS __attribute__((address_space(3)))
typedef unsigned short bf16_t;
typedef short bf16x8 __attribute__((ext_vector_type(8)));
typedef float f32x4 __attribute__((ext_vector_type(4)));
typedef unsigned u32x4 __attribute__((ext_vector_type(4)));
constexpr int BM = 256, BK = 64, HALF = 128, HTB = HALF * BK * 2  , STAGE_BYTES = 8 * HTB, NXCD = 8, WGM = 8;

__host__ __device__ __forceinline__ int lds_byte(int r, int c) { const int st = (r >> 4) * 2 + (c >> 5), rr = r & 15, cc = c & 31, ob = rr * 64 + cc * 2; return st * 1024 + (ob ^ (((ob >> 9) & 1) << 5)); }
__host__ __device__ __forceinline__ void stage_rc(int b, int& R, int& C) { const int st = b / 1024, sb = b % 1024, swz = sb ^ (((sb >> 9) & 1) << 5); R = (st >> 1) * 16 + swz / 64; C = (st & 1) * 32 + (swz % 64) / 2; }
__host__ __device__ __forceinline__ int perm32(int rho) { const int n = rho >> 4, i = rho & 15; return 8 * (i >> 2) + 4 * n + (i & 3); }

struct Unit { int pm, pn; };
struct Gemm { const bf16_t* A; const bf16_t* Bt; int M, N, K, lda, ldb; };

struct StaticOrder {
    int nM, nN, nwg, G, c, wgm;
    __host__ __device__ void init(int M, int N, int G_, int c_, int wgm_ = WGM) { nM = M / BM; nN = N / BM; nwg = nM * nN; G = G_; c = c_; wgm = wgm_; }
    __host__ __device__ bool next(int i, Unit& u) const {
        const long L = (long)i * G + c; if (L >= nwg) return false;
        int wgid = (int)L; { const int q = nwg / NXCD, r = nwg % NXCD, xcd = wgid % NXCD, off = wgid / NXCD; wgid = (xcd < r ? xcd * (q + 1) : r * (q + 1) + (xcd - r) * q) + off; }
        const int nig = wgm * nN, gid = wgid / nig, fm = gid * wgm, gsz = (nM - fm) < wgm ? (nM - fm) : wgm;
        u.pm = fm + ((wgid % nig) % gsz); u.pn = (wgid % nig) / gsz; return true;
    }
    __device__ __forceinline__ void a_ready(const Unit&) const {}
    __device__ __forceinline__ void done(const Unit&) const {}
};

typedef float f32x2_cv __attribute__((ext_vector_type(2))); typedef __bf16 bf16x2_cv __attribute__((ext_vector_type(2)));
__device__ __forceinline__ unsigned cvt_pk_bf16(float lo, float hi) { f32x2_cv v = {lo, hi}; bf16x2_cv b = __builtin_convertvector(v, bf16x2_cv); return __builtin_bit_cast(unsigned, b); }
template <class Epi, class Sched, bool ALIGN_EPI = false, bool SP2 = false>
__device__ __forceinline__ void gemm_phase(PG8_LAS unsigned char* lds, const Gemm g, const Sched& S, const Epi& E) {
    int tid_ = threadIdx.x; asm volatile("" : "+v"(tid_));
    const int tid = tid_, wid = __builtin_amdgcn_readfirstlane(tid >> 6), lane = tid & 63, wr = wid >> 2, wc = wid & 3, fr = lane & 15, fq = lane >> 4;
    const int K = g.K, nt = K / BK;
    unsigned voffA[2], voffB[2];
#pragma unroll
    for (int i = 0; i < 2; ++i) { int R, C; stage_rc(tid * 16 + i * 8192, R, C); const int Rb = Epi::PERM ? ((R & ~31) + perm32(R & 31)) : R;
        voffA[i] = (unsigned)(R * g.lda + C) * 2u; voffB[i] = (unsigned)(Rb * g.ldb + C) * 2u; }
    const size_t kstep = (size_t)(BK * 2);
    const size_t hstepA = (size_t)HALF * g.lda * 2, hstepB = (size_t)HALF * g.ldb * 2;
    const size_t tstepA = 2 * hstepA, tstepB = 2 * hstepB;
    const unsigned ldsw = (unsigned)wid * 1024u;
    const int aoff = lds_byte(wr * 64 + fr, fq * 8), boff = lds_byte(wc * 32 + fr, fq * 8);
#define PG8_SA(b, h) (((b) * 2 + (h)) * HTB)
#define PG8_SB(b, h) ((4 + (b) * 2 + (h)) * HTB)
#define PG8_STAGE(bufoff, gbase, voff) do { _Pragma("unroll") for (int _i = 0; _i < 2; ++_i) \
        __builtin_amdgcn_global_load_lds((const unsigned*)((const char*)(gbase) + (voff)[_i]), (PG8_LAS unsigned*)(lds + (bufoff) + ldsw + _i * 8192), 16, 0, 0); } while (0)
#define PG8_LDA(dst, b, h) do { _Pragma("unroll") for (int m = 0; m < 4; ++m) _Pragma("unroll") for (int k = 0; k < 2; ++k) dst[m][k] = *(const PG8_LAS bf16x8*)(lds + PG8_SA(b, h) + aoff + m * 2048 + k * 1024); } while (0)
#define PG8_LDB(dst, b, h) do { _Pragma("unroll") for (int n = 0; n < 2; ++n) _Pragma("unroll") for (int k = 0; k < 2; ++k) dst[n][k] = *(const PG8_LAS bf16x8*)(lds + PG8_SB(b, h) + boff + n * 2048 + k * 1024); } while (0)
#define PG8_MMA(ai, bj, At, Bt) do { __builtin_amdgcn_s_setprio(1); _Pragma("unroll") for (int m = 0; m < 4; ++m) _Pragma("unroll") for (int n = 0; n < 2; ++n) _Pragma("unroll") for (int k = 0; k < 2; ++k) \
        acc[ai][bj][m][n] = __builtin_amdgcn_mfma_f32_16x16x32_bf16(Bt[n][k], At[m][k], acc[ai][bj][m][n], 0, 0, 0); __builtin_amdgcn_s_setprio(0); } while (0)
#define PG8_WAIT_V(n) asm volatile("s_waitcnt vmcnt(" #n ")" ::: "memory")
#define PG8_WAIT_L(n) asm volatile("s_waitcnt lgkmcnt(" #n ")" ::: "memory")
#define PG8_BAR __builtin_amdgcn_s_barrier()
#define PG8_SCHED __builtin_amdgcn_sched_barrier(0)
    Unit cur, nxt; int ui = 0;
    if (!S.next(0, cur)) return;
    f32x4 acc[2][2][4][2];
#pragma unroll
    for (int a = 0; a < 2; ++a)
#pragma unroll
        for (int b = 0; b < 2; ++b)
#pragma unroll
            for (int m = 0; m < 4; ++m)
#pragma unroll
                for (int n = 0; n < 2; ++n) acc[a][b][m][n] = (f32x4){0.f, 0.f, 0.f, 0.f};
    bf16x8 At[4][2], B0[2][2], B1[2][2];
    const char* cA = (const char*)g.A + (size_t)cur.pm * tstepA; const char* cB = (const char*)g.Bt + (size_t)cur.pn * tstepB;
    S.a_ready(cur);
    if constexpr (SP2) {
        PG8_STAGE(PG8_SB(0, 0), cB, voffB); PG8_STAGE(PG8_SB(0, 1), cB + hstepB, voffB); PG8_STAGE(PG8_SA(0, 0), cA, voffA); PG8_STAGE(PG8_SA(0, 1), cA + hstepA, voffA);
        if (wr == 1) PG8_BAR;
        PG8_WAIT_V(2); PG8_BAR;
        PG8_STAGE(PG8_SB(1, 0), cB + kstep, voffB); PG8_STAGE(PG8_SA(1, 0), cA + kstep, voffA); PG8_STAGE(PG8_SB(1, 1), cB + hstepB + kstep, voffB);
        PG8_WAIT_V(6); PG8_BAR;
    } else {
        PG8_STAGE(PG8_SB(0, 0), cB, voffB); PG8_STAGE(PG8_SA(0, 0), cA, voffA); PG8_STAGE(PG8_SB(0, 1), cB + hstepB, voffB); PG8_STAGE(PG8_SA(0, 1), cA + hstepA, voffA);
        if (wr == 1) PG8_BAR;
        PG8_WAIT_V(4); PG8_BAR;
        PG8_STAGE(PG8_SB(1, 0), cB + kstep, voffB); PG8_STAGE(PG8_SA(1, 0), cA + kstep, voffA); PG8_STAGE(PG8_SB(1, 1), cB + hstepB + kstep, voffB);
        PG8_WAIT_V(6); PG8_BAR;
    }
    for (;;) {
        const bool has_next = S.next(ui + 1, nxt);
        const char* nA = has_next ? (const char*)g.A + (size_t)nxt.pm * tstepA : cA; const char* nB = has_next ? (const char*)g.Bt + (size_t)nxt.pn * tstepB : cB;
        for (int t = 0; t < nt; t += 2) {
            const bool last = (t == nt - 2);
            const char* a1 = cA + (size_t)(t + 1) * kstep;
            const char* a2 = last ? nA : cA + (size_t)(t + 2) * kstep; const char* b2 = last ? nB : cB + (size_t)(t + 2) * kstep;
            const char* a3 = a2 + kstep; const char* b3 = b2 + kstep;
            if (last && has_next) S.a_ready(nxt);
            if constexpr (SP2) {
            PG8_LDB(B0, 0, 0); PG8_LDB(B1, 0, 1); PG8_SCHED; PG8_LDA(At, 0, 0); PG8_STAGE(PG8_SA(1, 1), a1 + hstepA, voffA);
            PG8_WAIT_V(8); PG8_WAIT_L(0); PG8_BAR; PG8_MMA(0, 0, At, B0); PG8_MMA(0, 1, At, B1); PG8_BAR; PG8_SCHED;
            PG8_LDA(At, 0, 1); PG8_STAGE(PG8_SB(0, 0), b2, voffB); PG8_STAGE(PG8_SB(0, 1), b2 + hstepB, voffB); PG8_STAGE(PG8_SA(0, 0), a2, voffA);
            PG8_WAIT_V(8); PG8_WAIT_L(0); PG8_BAR; PG8_MMA(1, 0, At, B0); PG8_MMA(1, 1, At, B1); PG8_BAR; PG8_SCHED;
            PG8_LDB(B0, 1, 0); PG8_LDB(B1, 1, 1); PG8_SCHED; PG8_LDA(At, 1, 0); PG8_STAGE(PG8_SA(0, 1), a2 + hstepA, voffA);
            PG8_WAIT_V(8); PG8_WAIT_L(0); PG8_BAR; PG8_MMA(0, 0, At, B0); PG8_MMA(0, 1, At, B1); PG8_BAR; PG8_SCHED;
            PG8_LDA(At, 1, 1); PG8_STAGE(PG8_SB(1, 0), b3, voffB); PG8_STAGE(PG8_SB(1, 1), b3 + hstepB, voffB); PG8_STAGE(PG8_SA(1, 0), a3, voffA);
            PG8_WAIT_V(8); PG8_WAIT_L(0); PG8_BAR; PG8_MMA(1, 0, At, B0); PG8_MMA(1, 1, At, B1); PG8_BAR; PG8_SCHED;
            } else {
            PG8_LDB(B0, 0, 0); PG8_SCHED; PG8_LDA(At, 0, 0); PG8_STAGE(PG8_SA(1, 1), a1 + hstepA, voffA);
            PG8_WAIT_L(8); PG8_BAR; PG8_WAIT_L(0); PG8_MMA(0, 0, At, B0); PG8_BAR; PG8_SCHED;
            PG8_LDB(B1, 0, 1); PG8_STAGE(PG8_SB(0, 0), b2, voffB);
            PG8_BAR; PG8_WAIT_L(0); PG8_MMA(0, 1, At, B1); PG8_BAR;
            PG8_LDA(At, 0, 1); PG8_STAGE(PG8_SA(0, 0), a2, voffA);
            PG8_BAR; PG8_WAIT_L(0); PG8_MMA(1, 0, At, B0); PG8_BAR; PG8_SCHED;
            PG8_STAGE(PG8_SB(0, 1), b2 + hstepB, voffB);
            PG8_WAIT_V(6); PG8_BAR; PG8_MMA(1, 1, At, B1); PG8_BAR;
            PG8_LDB(B0, 1, 0); PG8_SCHED; PG8_LDA(At, 1, 0); PG8_STAGE(PG8_SA(0, 1), a2 + hstepA, voffA);
            PG8_WAIT_L(8); PG8_BAR; PG8_WAIT_L(0); PG8_MMA(0, 0, At, B0); PG8_BAR; PG8_SCHED;
            PG8_LDB(B1, 1, 1); PG8_STAGE(PG8_SB(1, 0), b3, voffB);
            PG8_BAR; PG8_WAIT_L(0); PG8_MMA(0, 1, At, B1); PG8_BAR;
            PG8_LDA(At, 1, 1); PG8_STAGE(PG8_SA(1, 0), a3, voffA);
            PG8_BAR; PG8_WAIT_L(0); PG8_MMA(1, 0, At, B0); PG8_BAR; PG8_SCHED;
            PG8_STAGE(PG8_SB(1, 1), b3 + hstepB, voffB);
            PG8_WAIT_V(6); PG8_BAR; PG8_MMA(1, 1, At, B1); PG8_BAR;
            }
        }
        if constexpr (ALIGN_EPI) { if (wr == 0) PG8_BAR; }
        if constexpr (!Epi::AFTER_DRAIN) { E(acc, cur, wr, wc, fr, fq); S.done(cur); }
        if (!has_next) break;
#pragma unroll
        for (int a = 0; a < 2; ++a)
#pragma unroll
            for (int b = 0; b < 2; ++b)
#pragma unroll
                for (int m = 0; m < 4; ++m)
#pragma unroll
                    for (int n = 0; n < 2; ++n) acc[a][b][m][n] = (f32x4){0.f, 0.f, 0.f, 0.f};
        cur = nxt; cA = nA; cB = nB; ++ui;
        if constexpr (ALIGN_EPI) { if (wr == 1) PG8_BAR; }
    }
    PG8_WAIT_V(0);
    if constexpr (!ALIGN_EPI) { if (wr == 0) PG8_BAR; }
    PG8_BAR;
    if constexpr (Epi::AFTER_DRAIN) { E.fused(acc, cur, wr, wc, fr, fq, lds, wid, lane); S.done(cur); }
#undef PG8_SA
#undef PG8_SB
#undef PG8_STAGE
#undef PG8_LDA
#undef PG8_LDB
#undef PG8_MMA
#undef PG8_WAIT_V
#undef PG8_WAIT_L
#undef PG8_BAR
#undef PG8_SCHED
}
}

constexpr int TOK = 16384, SEQ = 8192, DM = 2048, DIN = 14360, DFF = 8192;
constexpr int LDP = 7168;
constexpr int PC_QA = 0, PC_KA = 1024, PC_VA = 2048, PC_Z = 3072, PC_FK = 4096, PC_FQ = 5120, PC_QM = 6144;
constexpr int PC_OA = 0, PC_OB = PC_FQ, PC_OM = PC_QM, PC_GB = 1024, PC_GM = 3072;
constexpr float EPSN = 1e-6f;
constexpr float LOG2E = 1.4426950408889634f;
constexpr size_t MiB = 1u << 20;
constexpr size_t WS_CTL = 0, WS_W1T = 1 * MiB, WS_WFVT = 30 * MiB, WS_WMKVT = 34 * MiB, WS_UC = 1 * MiB;
constexpr size_t WS_SMALL = 42 * MiB, WS_KMEM = 44 * MiB, WS_VMT = 45 * MiB, WS_CUM = 46 * MiB, WS_CDEC = 46 * MiB + 512 * 1024,
                 WS_MEMN = 47 * MiB, WS_SSQ = 49 * MiB, WS_RSTD = 51 * MiB;
constexpr size_t WS_WGT = 52 * MiB, WS_WUPT = 76 * MiB, WS_WOT = 88 * MiB, WS_WFF1T = 96 * MiB, WS_WFF2T = 128 * MiB;
constexpr size_t WS_PROJ = 160 * MiB, WS_GDN = 384 * MiB, WS_END = 496 * MiB;
constexpr int FOXVT_LD = TOK;
constexpr size_t WS_Y = 384 * MiB, WS_X1B = 160 * MiB, WS_U = 224 * MiB;
constexpr size_t DO_H = 0, DO_FOXVT = 64 * MiB, DO_GA = 64 * MiB;
constexpr int GDN_CHUNK_BYTES = 57344;
constexpr int LDS_BYTES = 163840;

#define LAS __attribute__((address_space(3)))
typedef unsigned short bf16;
typedef short bf16x8 __attribute__((ext_vector_type(8)));
typedef float f32x4 __attribute__((ext_vector_type(4)));
typedef float f32x16 __attribute__((ext_vector_type(16)));
typedef unsigned u32x4 __attribute__((ext_vector_type(4)));
typedef unsigned u32x2 __attribute__((ext_vector_type(2)));

__device__ __forceinline__ unsigned pk2(float lo, float hi) { return pg8::cvt_pk_bf16(lo, hi); }
__device__ __forceinline__ float bf2f(unsigned short v) { return __uint_as_float(((unsigned)v) << 16); }
__device__ __forceinline__ float bflo(unsigned w) { return __uint_as_float(w << 16); }
__device__ __forceinline__ float bfhi(unsigned w) { return __uint_as_float(w & 0xffff0000u); }
__device__ __forceinline__ int crow(int r, int hi) { return (r & 3) + 8 * (r >> 2) + 4 * hi; }
__device__ __forceinline__ float sigmoidf_(float x) { return 1.f / (1.f + __expf(-x)); }
__device__ __forceinline__ float softplusf_(float x) { return fmaxf(x, 0.f) + log1pf(__expf(-fabsf(x))); }

namespace pg8 {
struct EpiStore {
    static constexpr bool PERM = true, AFTER_DRAIN = false;
    bf16_t* O; int ldc;
    __device__ __forceinline__ void operator()(const f32x4 (&acc)[2][2][4][2], const Unit& u, int wr, int wc, int fr, int fq) const {
        const int row0 = u.pm * BM + wr * 64 + fr, col0 = u.pn * BM + wc * 32 + 8 * fq;
#pragma unroll
        for (int ai = 0; ai < 2; ++ai)
#pragma unroll
            for (int m = 0; m < 4; ++m) { bf16_t* rowp = O + (size_t)(row0 + ai * HALF + m * 16) * ldc + col0;
#pragma unroll
                for (int bj = 0; bj < 2; ++bj) { const f32x4 v0 = acc[ai][bj][m][0], v1 = acc[ai][bj][m][1];
                    u32x4 w; w.x = cvt_pk_bf16(v0[0], v0[1]); w.y = cvt_pk_bf16(v0[2], v0[3]); w.z = cvt_pk_bf16(v1[0], v1[1]); w.w = cvt_pk_bf16(v1[2], v1[3]);
                    *(u32x4*)(rowp + bj * HALF) = w; } }
    }
};
struct EpiProj {
    static constexpr bool PERM = true, AFTER_DRAIN = false;
    bf16_t* O; int ldc; float* small;
    __device__ __forceinline__ void operator()(const f32x4 (&acc)[2][2][4][2], const Unit& u, int wr, int wc, int fr, int fq) const {
        const int row0 = u.pm * BM + wr * 64 + fr;
        if (u.pn == 28) {
            if (wc == 0) {
#pragma unroll
                for (int ai = 0; ai < 2; ++ai)
#pragma unroll
                    for (int m = 0; m < 4; ++m) { float* p = small + (size_t)(row0 + ai * HALF + m * 16) * 32 + 8 * fq;
                        *(f32x4*)p = acc[ai][0][m][0]; *(f32x4*)(p + 4) = acc[ai][0][m][1]; }
            }
            return;
        }
        const int col0 = u.pn * BM + wc * 32 + 8 * fq;
#pragma unroll
        for (int ai = 0; ai < 2; ++ai)
#pragma unroll
            for (int m = 0; m < 4; ++m) { bf16_t* rowp = O + (size_t)(row0 + ai * HALF + m * 16) * ldc + col0;
#pragma unroll
                for (int bj = 0; bj < 2; ++bj) { const f32x4 v0 = acc[ai][bj][m][0], v1 = acc[ai][bj][m][1];
                    u32x4 w; w.x = cvt_pk_bf16(v0[0], v0[1]); w.y = cvt_pk_bf16(v0[2], v0[3]); w.z = cvt_pk_bf16(v1[0], v1[1]); w.w = cvt_pk_bf16(v1[2], v1[3]);
                    *(u32x4*)(rowp + bj * HALF) = w; } }
    }
};
struct EpiSig {
    static constexpr bool PERM = true, AFTER_DRAIN = false;
    unsigned char* O0; unsigned char* O1; int ld0, ld1;
    __device__ __forceinline__ void operator()(const f32x4 (&acc)[2][2][4][2], const Unit& u, int wr, int wc, int fr, int fq) const {
        const int br = u.pn >> 3; unsigned char* O = br == 0 ? O0 : O1 + (size_t)(br - 1) * 2048; const int ldc = br == 0 ? ld0 : ld1;
        const int row0 = u.pm * BM + wr * 64 + fr, col0 = (u.pn & 7) * BM + wc * 32 + 8 * fq;
#pragma unroll
        for (int ai = 0; ai < 2; ++ai)
#pragma unroll
            for (int m = 0; m < 4; ++m) { unsigned char* rowp = O + (size_t)(row0 + ai * HALF + m * 16) * ldc + col0;
#pragma unroll
                for (int bj = 0; bj < 2; ++bj) { const f32x4 v0 = acc[ai][bj][m][0], v1 = acc[ai][bj][m][1]; unsigned q[8];
#pragma unroll
                    for (int e = 0; e < 4; ++e) { q[e] = (unsigned)(255.f * __builtin_amdgcn_rcpf(1.f + __builtin_amdgcn_exp2f(-1.4426950408889634f * v0[e])) + 0.5f);
                                                  q[4 + e] = (unsigned)(255.f * __builtin_amdgcn_rcpf(1.f + __builtin_amdgcn_exp2f(-1.4426950408889634f * v1[e])) + 0.5f); }
                    u32x2 w; w.x = q[0] | (q[1] << 8) | (q[2] << 16) | (q[3] << 24); w.y = q[4] | (q[5] << 8) | (q[6] << 16) | (q[7] << 24);
                    *(u32x2*)(rowp + bj * HALF) = w; } }
    }
};
template <bool FIRST> struct EpiGate {
    static constexpr bool PERM = true, AFTER_DRAIN = false;
    const unsigned char* G; int ldg; bf16_t* Y; int ldy;
    __device__ __forceinline__ void operator()(const f32x4 (&acc)[2][2][4][2], const Unit& u, int wr, int wc, int fr, int fq) const {
        const int row0 = u.pm * BM + wr * 64 + fr, col0 = u.pn * BM + wc * 32 + 8 * fq;
        constexpr float S = 1.f / 255.f;
#pragma unroll
        for (int ai = 0; ai < 2; ++ai)
#pragma unroll
            for (int m = 0; m < 4; ++m) { const size_t r = (size_t)(row0 + ai * HALF + m * 16);
#pragma unroll
                for (int bj = 0; bj < 2; ++bj) { const f32x4 v0 = acc[ai][bj][m][0], v1 = acc[ai][bj][m][1];
                    const u32x2 g = *(const u32x2*)(G + r * ldg + col0 + bj * HALF);
                    float o[8];
                    o[0] = v0[0] * ((float)(g.x & 0xffu) * S); o[1] = v0[1] * ((float)((g.x >> 8) & 0xffu) * S);
                    o[2] = v0[2] * ((float)((g.x >> 16) & 0xffu) * S); o[3] = v0[3] * ((float)(g.x >> 24) * S);
                    o[4] = v1[0] * ((float)(g.y & 0xffu) * S); o[5] = v1[1] * ((float)((g.y >> 8) & 0xffu) * S);
                    o[6] = v1[2] * ((float)((g.y >> 16) & 0xffu) * S); o[7] = v1[3] * ((float)(g.y >> 24) * S);
                    bf16_t* yp = Y + r * ldy + col0 + bj * HALF;
                    if (!FIRST) { const u32x4 y = *(const u32x4*)yp;
                        o[0] += __uint_as_float(y.x << 16); o[1] += __uint_as_float(y.x & 0xffff0000u);
                        o[2] += __uint_as_float(y.y << 16); o[3] += __uint_as_float(y.y & 0xffff0000u);
                        o[4] += __uint_as_float(y.z << 16); o[5] += __uint_as_float(y.z & 0xffff0000u);
                        o[6] += __uint_as_float(y.w << 16); o[7] += __uint_as_float(y.w & 0xffff0000u); }
                    u32x4 w; w.x = cvt_pk_bf16(o[0], o[1]); w.y = cvt_pk_bf16(o[2], o[3]); w.z = cvt_pk_bf16(o[4], o[5]); w.w = cvt_pk_bf16(o[6], o[7]);
                    *(u32x4*)yp = w; } }
    }
};
struct EpiRes1 {
    static constexpr bool PERM = false, AFTER_DRAIN = false;
    const float* X; bf16_t* XB; float* SSQ;
    __device__ __forceinline__ void operator()(const f32x4 (&acc)[2][2][4][2], const Unit& u, int wr, int wc, int fr, int fq) const {
        const int row0 = u.pm * BM + wr * 64 + fr, col0 = u.pn * BM + wc * 32 + 4 * fq;
#pragma unroll
        for (int ai = 0; ai < 2; ++ai)
#pragma unroll
            for (int m = 0; m < 4; ++m) { const int row = row0 + ai * HALF + m * 16; const size_t off = (size_t)row * 2048 + col0; float s = 0.f;
#pragma unroll
                for (int bj = 0; bj < 2; ++bj)
#pragma unroll
                    for (int n = 0; n < 2; ++n) { const size_t o = off + bj * HALF + n * 16; const f32x4 xv = *(const f32x4*)(X + o); const f32x4 v = xv + acc[ai][bj][m][n];
                        u32x2 w; w.x = cvt_pk_bf16(v[0], v[1]); w.y = cvt_pk_bf16(v[2], v[3]); *(u32x2*)(XB + o) = w;
                        s += (v[0] * v[0] + v[1] * v[1]) + (v[2] * v[2] + v[3] * v[3]); }
                s += __shfl_xor(s, 16); s += __shfl_xor(s, 32);
                if (fq == 0) SSQ[(size_t)(u.pn * 4 + wc) * 16384 + row] = s; }
    }
};
struct EpiFF1 {
    static constexpr bool PERM = true, AFTER_DRAIN = false;
    const float* RSTD; bf16_t* O; int ldc;
    __device__ __forceinline__ void operator()(const f32x4 (&acc)[2][2][4][2], const Unit& u, int wr, int wc, int fr, int fq) const {
        const int row0 = u.pm * BM + wr * 64 + fr, col0 = u.pn * BM + wc * 32 + 8 * fq;
        float rs[2][4];
#pragma unroll
        for (int ai = 0; ai < 2; ++ai)
#pragma unroll
            for (int m = 0; m < 4; ++m) rs[ai][m] = RSTD[row0 + ai * HALF + m * 16];
#pragma unroll
        for (int ai = 0; ai < 2; ++ai)
#pragma unroll
            for (int m = 0; m < 4; ++m) { const int row = row0 + ai * HALF + m * 16; const float rstd = rs[ai][m];
                bf16_t* rowp = O + (size_t)row * ldc + col0;
#pragma unroll
                for (int bj = 0; bj < 2; ++bj) { f32x4 v0 = acc[ai][bj][m][0] * rstd, v1 = acc[ai][bj][m][1] * rstd;
#pragma unroll
                    for (int e = 0; e < 4; ++e) { const float a = fmaxf(v0[e], 0.f), b = fmaxf(v1[e], 0.f); v0[e] = a * a; v1[e] = b * b; }
                    u32x4 w; w.x = cvt_pk_bf16(v0[0], v0[1]); w.y = cvt_pk_bf16(v0[2], v0[3]); w.z = cvt_pk_bf16(v1[0], v1[1]); w.w = cvt_pk_bf16(v1[2], v1[3]);
                    *(u32x4*)(rowp + bj * HALF) = w; } }
    }
};
struct EpiOut {
    static constexpr bool PERM = false, AFTER_DRAIN = false;
    const bf16_t* XB; float* OUT;
    __device__ __forceinline__ void operator()(const f32x4 (&acc)[2][2][4][2], const Unit& u, int wr, int wc, int fr, int fq) const {
        const int row0 = u.pm * BM + wr * 64 + fr, col0 = u.pn * BM + wc * 32 + 4 * fq;
#pragma unroll
        for (int ai = 0; ai < 2; ++ai)
#pragma unroll
            for (int m = 0; m < 4; ++m) { const size_t off = (size_t)(row0 + ai * HALF + m * 16) * 2048 + col0;
#pragma unroll
                for (int bj = 0; bj < 2; ++bj)
#pragma unroll
                    for (int n = 0; n < 2; ++n) { const size_t o = off + bj * HALF + n * 16; const u32x2 xb = *(const u32x2*)(XB + o);
                        f32x4 xv; xv[0] = __uint_as_float(xb.x << 16); xv[1] = __uint_as_float(xb.x & 0xffff0000u); xv[2] = __uint_as_float(xb.y << 16); xv[3] = __uint_as_float(xb.y & 0xffff0000u);
                        *(f32x4*)(OUT + o) = xv + acc[ai][bj][m][n]; } }
    }
};
}

struct Params {
    const float *x, *mem, *g_mix, *w_in, *conv_w, *a_log, *dt_bias, *gdn_norm_g, *fox_b_f, *fox_q_norm, *fox_k_norm, *g_mem, *w_mem_kv,
                *mem_q_norm, *mem_k_norm, *w_up_gdn, *w_up_fox, *w_up_mem, *w_out, *g_mlp, *w_ff1, *w_ff2;
    float* out; unsigned char* ws;
};

__device__ __forceinline__ float wave_sum(float v) {
#pragma unroll
    for (int o = 1; o < 64; o <<= 1) v += __shfl_xor(v, o);
    return v;
}

__device__ __forceinline__ void transpose_item(const float* W, int ldw, int n0src, bf16* WT, int K, int row0dst, const float* kscale,
                                               LAS float* scr, int kb, int nb, int lane) {
    const int k0 = 64 * kb, n0 = 32 * nb;
    float tv[32];
#pragma unroll
    for (int i = 0; i < 32; ++i) tv[i] = W[(size_t)(k0 + 2 * i + (lane >> 5)) * ldw + n0src + n0 + (lane & 31)];
#pragma unroll
    for (int i = 0; i < 32; ++i) { const int kk = 2 * i + (lane >> 5); float v = tv[i];
        if (kscale) v *= kscale[k0 + kk]; scr[kk * 33 + (lane & 31)] = v; }
    asm volatile("s_waitcnt lgkmcnt(0)" ::: "memory");
    const int c = lane & 7;
#pragma unroll
    for (int j = 0; j < 4; ++j) { const int n = (lane >> 3) + 8 * j; const LAS float* s = scr + (8 * c) * 33 + n;
        u32x4 o; o.x = pk2(s[0 * 33], s[1 * 33]); o.y = pk2(s[2 * 33], s[3 * 33]); o.z = pk2(s[4 * 33], s[5 * 33]); o.w = pk2(s[6 * 33], s[7 * 33]);
        *(u32x4*)(WT + (size_t)(row0dst + n0 + n) * K + k0 + 8 * c) = o; }
    asm volatile("s_waitcnt lgkmcnt(0)" ::: "memory");
}
__device__ __forceinline__ void transpose_job(const float* W, int ldw, int n0src, int K, int ncols, bf16* WT, int row0dst, const float* kscale,
                                              LAS float* scr, int gw, int ngw, int lane) {
    const int nblk = ncols / 32, nitems = (K / 64) * nblk;
    for (int it = gw; it < nitems; it += ngw) transpose_item(W, ldw, n0src, WT, K, row0dst, kscale, scr, it / nblk, it % nblk, lane);
}
__device__ __forceinline__ void rms_row_to_bf16(const float* xrow, const float* g, bf16* orow, int lane) {
    const f32x4* xr = (const f32x4*)xrow + lane; const f32x4* gr = (const f32x4*)g + lane;
    f32x4 v[8]; float s = 0.f;
#pragma unroll
    for (int j = 0; j < 8; ++j) { v[j] = xr[64 * j]; s += (v[j].x * v[j].x + v[j].y * v[j].y) + (v[j].z * v[j].z + v[j].w * v[j].w); }
    const float rstd = rsqrtf(wave_sum(s) * (1.f / 2048.f) + EPSN);
    u32x2* o8 = (u32x2*)orow + lane;
#pragma unroll
    for (int j = 0; j < 8; ++j) { const f32x4 gg = gr[64 * j]; u32x2 w; w.x = pk2(v[j].x * rstd * gg.x, v[j].y * rstd * gg.y); w.y = pk2(v[j].z * rstd * gg.z, v[j].w * rstd * gg.w); o8[64 * j] = w; }
}

__device__ __forceinline__ void phase0(const Params& P, unsigned char* lds, int tid, int lane, int wave) {
    unsigned char* ws = P.ws;
    bf16* W1T = (bf16*)(ws + WS_W1T); bf16* WFVT = (bf16*)(ws + WS_WFVT); bf16* WMKVT = (bf16*)(ws + WS_WMKVT); bf16* WGT = (bf16*)(ws + WS_WGT);
    bf16* WUPT = (bf16*)(ws + WS_WUPT); bf16* WOT = (bf16*)(ws + WS_WOT); bf16* WFF1T = (bf16*)(ws + WS_WFF1T); bf16* WFF2T = (bf16*)(ws + WS_WFF2T);
    LAS float* scr = (LAS float*)((LAS unsigned char*)lds + wave * 16384);
    const int G = gridDim.x, gw = blockIdx.x * 8 + wave, ngw = G * 8;
    bf16* H = (bf16*)((unsigned char*)P.out + DO_H);
    for (int m = gw; m < TOK; m += ngw) rms_row_to_bf16(P.x + (size_t)m * DM, P.g_mix, H + (size_t)m * DM, lane);
    bf16* MEMN = (bf16*)(ws + WS_MEMN);
    for (int m = gw; m < 512; m += ngw) rms_row_to_bf16(P.mem + (size_t)m * DM, P.g_mem, MEMN + (size_t)m * DM, lane);
    transpose_job(P.w_in, DIN, 0, 2048, 4096, W1T, 0, nullptr, scr, gw, ngw, lane);
    transpose_job(P.w_in, DIN, 5136, 2048, 1024, W1T, PC_FK, nullptr, scr, gw, ngw, lane);
    transpose_job(P.w_in, DIN, 4112, 2048, 1024, W1T, PC_FQ, nullptr, scr, gw, ngw, lane);
    transpose_job(P.w_in, DIN, 7192, 2048, 1024, W1T, PC_QM, nullptr, scr, gw, ngw, lane);
    transpose_job(P.w_in, DIN, 6160, 2048, 1024, WFVT, 0, nullptr, scr, gw, ngw, lane);
    transpose_job(P.w_in, DIN, 8216, 2048, 6144, WGT, 0, nullptr, scr, gw, ngw, lane);
    transpose_job(P.w_mem_kv, 2048, 0, 2048, 2048, WMKVT, 0, nullptr, scr, gw, ngw, lane);
    transpose_job(P.w_up_gdn, 2048, 0, 1024, 2048, WUPT, 0, nullptr, scr, gw, ngw, lane);
    transpose_job(P.w_up_fox, 2048, 0, 1024, 2048, WUPT + (size_t)2048 * 1024, 0, nullptr, scr, gw, ngw, lane);
    transpose_job(P.w_up_mem, 2048, 0, 1024, 2048, WUPT + (size_t)2 * 2048 * 1024, 0, nullptr, scr, gw, ngw, lane);
    transpose_job(P.w_out, 2048, 0, 2048, 2048, WOT, 0, nullptr, scr, gw, ngw, lane);
    transpose_job(P.w_ff1, 8192, 0, 2048, 8192, WFF1T, 0, P.g_mlp, scr, gw, ngw, lane);
    transpose_job(P.w_ff2, 2048, 0, 8192, 2048, WFF2T, 0, nullptr, scr, gw, ngw, lane);
    for (int idx = blockIdx.x * 512 + tid; idx < 256 * 2048; idx += G * 512) {
        const int row = idx >> 11, k = idx & 2047; float v = 0.f;
        if (row < 24) { const int col = row < 8 ? 4096 + row : (row < 16 ? 4104 + (row - 8) : 7184 + (row - 16)); v = P.w_in[(size_t)k * DIN + col]; }
        W1T[(size_t)(7168 + row) * 2048 + k] = (bf16)(pk2(v, 0.f) & 0xffffu);
    }
}


__device__ __forceinline__ void gdn_prep_unit(const Params& P, unsigned char* lds_, int bh, int n, int tid, int lane, int wave) {
    float* qs = (float*)lds_;
    float* ks = qs + 64 * 132;
    float* vs = ks + 64 * 132;
    float* Mm = vs + 64 * 132;
    float* QKd = Mm + 4096;
    float* gam = QKd + 4096;
    float* beta = gam + 64;
    float* egam = beta + 64;
    const int b = bh >> 3, h = bh & 7;
    const size_t r0 = (size_t)b * SEQ + (size_t)n * 64;
    const bf16* proj = (const bf16*)(P.ws + WS_PROJ);
    const float* small = (const float*)(P.ws + WS_SMALL);
    if (tid < 384) {
        const int c8 = tid % 48, tg = tid / 48, mat = c8 >> 4, ch0 = (c8 & 15) * 8, col = mat * 1024 + h * 128 + ch0, tb = tg * 8;
        u32x4 xr[11];
#pragma unroll
        for (int i = 0; i < 11; ++i) { const int tt = n * 64 + tb - 3 + i;
            xr[i] = tt >= 0 ? *(const u32x4*)(proj + (r0 + tb - 3 + i) * LDP + col) : u32x4{0u, 0u, 0u, 0u}; }
        f32x4 w0[4], w1[4];
#pragma unroll
        for (int i = 0; i < 4; ++i) { w0[i] = *(const f32x4*)(P.conv_w + i * 3072 + col); w1[i] = *(const f32x4*)(P.conv_w + i * 3072 + col + 4); }
        float* dstb = (mat == 0 ? qs : (mat == 1 ? ks : vs)) + tb * 132 + ch0;
#pragma unroll
        for (int t = 0; t < 8; ++t) {
            float y[8];
#pragma unroll
            for (int e = 0; e < 8; ++e) y[e] = 0.f;
#pragma unroll
            for (int i = 0; i < 4; ++i) { const u32x4 xv = xr[t + i];
                y[0] += bflo(xv.x) * w0[i].x; y[1] += bfhi(xv.x) * w0[i].y; y[2] += bflo(xv.y) * w0[i].z; y[3] += bfhi(xv.y) * w0[i].w;
                y[4] += bflo(xv.z) * w1[i].x; y[5] += bfhi(xv.z) * w1[i].y; y[6] += bflo(xv.w) * w1[i].z; y[7] += bfhi(xv.w) * w1[i].w; }
            f32x4 o0, o1;
            o0.x = y[0] * __builtin_amdgcn_rcpf(1.f + __builtin_amdgcn_exp2f(-LOG2E * y[0])); o0.y = y[1] * __builtin_amdgcn_rcpf(1.f + __builtin_amdgcn_exp2f(-LOG2E * y[1]));
            o0.z = y[2] * __builtin_amdgcn_rcpf(1.f + __builtin_amdgcn_exp2f(-LOG2E * y[2])); o0.w = y[3] * __builtin_amdgcn_rcpf(1.f + __builtin_amdgcn_exp2f(-LOG2E * y[3]));
            o1.x = y[4] * __builtin_amdgcn_rcpf(1.f + __builtin_amdgcn_exp2f(-LOG2E * y[4])); o1.y = y[5] * __builtin_amdgcn_rcpf(1.f + __builtin_amdgcn_exp2f(-LOG2E * y[5]));
            o1.z = y[6] * __builtin_amdgcn_rcpf(1.f + __builtin_amdgcn_exp2f(-LOG2E * y[6])); o1.w = y[7] * __builtin_amdgcn_rcpf(1.f + __builtin_amdgcn_exp2f(-LOG2E * y[7]));
            *(f32x4*)(dstb + t * 132) = o0; *(f32x4*)(dstb + t * 132 + 4) = o1;
        }
    }
    if (wave == 7) {
        const float av = small[(r0 + lane) * 32 + 8 + h], bv = small[(r0 + lane) * 32 + h];
        float g = -__expf(P.a_log[h]) * softplusf_(av + P.dt_bias[h]);
#pragma unroll
        for (int o = 1; o < 64; o <<= 1) { const float t_ = __shfl_up(g, o); if (lane >= o) g += t_; }
        gam[lane] = g; egam[lane] = __expf(g); beta[lane] = sigmoidf_(bv);
    }
    __syncthreads();
    for (int rr = wave * 16; rr < wave * 16 + 16; ++rr) {
        float* row = (rr < 64 ? qs + rr * 132 : ks + (rr - 64) * 132);
        const float a = row[lane], c = row[lane + 64];
        const float ss = wave_sum(a * a + c * c);
        const float sc = rsqrtf(ss + EPSN) * (rr < 64 ? 0.08838834764831845f : 1.f);
        row[lane] = a * sc; row[lane + 64] = c * sc;
    }
    __syncthreads();
    {
        const int mat = tid >> 8, tt = tid & 255, ti = tt >> 4, tj = tt & 15;
        const float* A = mat == 0 ? ks : qs;
        float acc[4][4];
#pragma unroll
        for (int a = 0; a < 4; ++a)
#pragma unroll
            for (int c = 0; c < 4; ++c) acc[a][c] = 0.f;
        for (int d = 0; d < 128; d += 4) {
            f32x4 ra[4], rb[4];
#pragma unroll
            for (int a = 0; a < 4; ++a) ra[a] = *(const f32x4*)(A + (ti + 16 * a) * 132 + d);
#pragma unroll
            for (int c = 0; c < 4; ++c) rb[c] = *(const f32x4*)(ks + (tj + 16 * c) * 132 + d);
#pragma unroll
            for (int a = 0; a < 4; ++a)
#pragma unroll
                for (int c = 0; c < 4; ++c) acc[a][c] += (ra[a].x * rb[c].x + ra[a].y * rb[c].y) + (ra[a].z * rb[c].z + ra[a].w * rb[c].w);
        }
#pragma unroll
        for (int a = 0; a < 4; ++a)
#pragma unroll
            for (int c = 0; c < 4; ++c) { const int i = ti + 16 * a, j = tj + 16 * c;
                const float e = __expf(fminf(gam[i] - gam[j], 0.f));
                if (mat == 0) Mm[j * 64 + i] = (j < i) ? beta[i] * acc[a][c] * e : 0.f;
                else QKd[i * 64 + j] = (j <= i) ? acc[a][c] * e : 0.f; }
    }
    __syncthreads();
    unsigned char* gout = P.ws + WS_GDN + (size_t)(bh * 128 + n) * GDN_CHUNK_BYTES;
    unsigned char* uout = P.ws + WS_UC + (size_t)(bh * 128 + n) * 16384;
    const float glast = gam[63];
    for (int p = tid; p < 2560; p += 512) {
        float v[8]; unsigned char* dst;
        if (p < 1024) {
            const int f = p >> 6, ln = p & 63, rt = f >> 3, kk = f & 7, row = 32 * rt + (ln & 31), hi = ln >> 5;
            const float* src = qs + row * 132 + 16 * kk; const float sc = egam[row];
#pragma unroll
            for (int j = 0; j < 8; ++j) v[j] = src[crow(j, hi)] * sc;
            dst = gout + 16384 + (size_t)p * 16;
        } else if (p < 1536) {
            const int q = p - 1024, f = q >> 6, ln = q & 63, rt = f >> 2, kk = f & 3, row = 32 * rt + (ln & 31), hi = ln >> 5;
#pragma unroll
            for (int j = 0; j < 8; ++j) v[j] = QKd[row * 64 + 16 * kk + crow(j, hi)];
            dst = gout + 32768 + (size_t)q * 16;
        } else {
            const int q = p - 1536, f = q >> 6, ln = q & 63, rt = f >> 2, kk = f & 3, dk = 32 * rt + (ln & 31), hi = ln >> 5;
#pragma unroll
            for (int j = 0; j < 8; ++j) { const int tk = 16 * kk + crow(j, hi); v[j] = ks[tk * 132 + dk] * __expf(fminf(glast - gam[tk], 0.f)); }
            dst = gout + 40960 + (size_t)q * 16;
        }
        u32x4 o; o.x = pk2(v[0], v[1]); o.y = pk2(v[2], v[3]); o.z = pk2(v[4], v[5]); o.w = pk2(v[6], v[7]);
        *(u32x4*)dst = o;
    }
    if (tid == 0) ((float*)(P.ws + WS_CDEC))[bh * 128 + n] = __expf(glast);
    __syncthreads();
    if (tid < 256) {
        float* col = (tid < 128 ? ks : vs) + (tid & 127);
        int zero; asm volatile("v_mov_b32 %0, 0" : "=v"(zero));
#pragma unroll 8
        for (int i = 0; i < 64; ++i) col[i * 132] *= beta[i + zero] * (tid < 128 ? egam[i + zero] : 1.f);
#pragma unroll 1
        for (int ib = 0; ib < 4; ++ib) {
            float acc[16];
#pragma unroll
            for (int r = 0; r < 16; ++r) acc[r] = col[(ib * 16 + r) * 132];
#pragma unroll 4
            for (int j = 0; j < ib * 16; ++j) {
                const float xj = col[j * 132]; const float* mr = Mm + zero + j * 64 + ib * 16;
                const f32x4 m0 = *(const f32x4*)mr, m1 = *(const f32x4*)(mr + 4), m2 = *(const f32x4*)(mr + 8), m3 = *(const f32x4*)(mr + 12);
                acc[0] -= m0.x * xj; acc[1] -= m0.y * xj; acc[2] -= m0.z * xj; acc[3] -= m0.w * xj;
                acc[4] -= m1.x * xj; acc[5] -= m1.y * xj; acc[6] -= m1.z * xj; acc[7] -= m1.w * xj;
                acc[8] -= m2.x * xj; acc[9] -= m2.y * xj; acc[10] -= m2.z * xj; acc[11] -= m2.w * xj;
                acc[12] -= m3.x * xj; acc[13] -= m3.y * xj; acc[14] -= m3.z * xj; acc[15] -= m3.w * xj;
            }
#pragma unroll
            for (int r2 = 0; r2 < 15; ++r2) {
                const float* mr = Mm + (ib * 16 + r2) * 64 + ib * 16; float mm[16];
#pragma unroll
                for (int q = 0; q < 4; ++q) { const f32x4 t4 = *(const f32x4*)(mr + 4 * q); mm[4 * q] = t4.x; mm[4 * q + 1] = t4.y; mm[4 * q + 2] = t4.z; mm[4 * q + 3] = t4.w; }
#pragma unroll
                for (int r = r2 + 1; r < 16; ++r) acc[r] -= mm[r] * acc[r2];
            }
#pragma unroll
            for (int r = 0; r < 16; ++r) col[(ib * 16 + r) * 132] = acc[r];
        }
    }
    __syncthreads();
    for (int p = tid; p < 2048; p += 512) {
        float v[8]; unsigned char* dst;
        if (p < 1024) {
            const int f = p >> 6, ln = p & 63, rt = f >> 3, kk = f & 7, row = 32 * rt + (ln & 31), hi = ln >> 5;
            const float* src = ks + row * 132 + 16 * kk;
#pragma unroll
            for (int j = 0; j < 8; ++j) v[j] = -src[crow(j, hi)];
            dst = gout + (size_t)p * 16;
        } else {
            const int q = p - 1024, half = q & 1, ln = (q >> 1) & 63, g2 = q >> 7, rt = g2 & 1, w4 = g2 >> 1, hi = ln >> 5;
#pragma unroll
            for (int j = 0; j < 8; ++j) v[j] = vs[(32 * rt + crow(8 * half + j, hi)) * 132 + 32 * w4 + (ln & 31)];
            dst = uout + (size_t)q * 16;
        }
        u32x4 o; o.x = pk2(v[0], v[1]); o.y = pk2(v[2], v[3]); o.z = pk2(v[4], v[5]); o.w = pk2(v[6], v[7]);
        *(u32x4*)dst = o;
    }
    __syncthreads();
}

template <int GL, int NB> __device__ __forceinline__ void norm8b(bf16* const (&p)[NB], const bool (&ok)[NB], const float* gain, float mult, float inv_n) {
    u32x4 xv[NB];
#pragma unroll
    for (int b = 0; b < NB; ++b) xv[b] = ok[b] ? *(const u32x4*)p[b] : u32x4{0u, 0u, 0u, 0u};
    const f32x4 g0 = *(const f32x4*)gain, g1 = *(const f32x4*)(gain + 4);
#pragma unroll
    for (int b = 0; b < NB; ++b) {
        float v[8] = {bflo(xv[b].x), bfhi(xv[b].x), bflo(xv[b].y), bfhi(xv[b].y), bflo(xv[b].z), bfhi(xv[b].z), bflo(xv[b].w), bfhi(xv[b].w)};
        float ss = 0.f;
#pragma unroll
        for (int e = 0; e < 8; ++e) ss += v[e] * v[e];
#pragma unroll
        for (int o = 1; o < GL; o <<= 1) ss += __shfl_xor(ss, o);
        const float sc = rsqrtf(ss * inv_n + EPSN) * mult;
        u32x4 o; o.x = pk2(v[0] * sc * g0.x, v[1] * sc * g0.y); o.y = pk2(v[2] * sc * g0.z, v[3] * sc * g0.w);
        o.z = pk2(v[4] * sc * g1.x, v[5] * sc * g1.y); o.w = pk2(v[6] * sc * g1.z, v[7] * sc * g1.w);
        if (ok[b]) *(u32x4*)p[b] = o;
    }
}

__device__ __forceinline__ void phase2(const Params& P, unsigned char* lds, int tid, int lane, int wave) {
    const int G = gridDim.x;
    bf16* proj = (bf16*)(P.ws + WS_PROJ);
    if (blockIdx.x < 16) {
        const int bh = blockIdx.x, b = bh >> 3, h = bh & 7;
        const float* small = (const float*)(P.ws + WS_SMALL);
        float* cum = (float*)(P.ws + WS_CUM) + (size_t)bh * SEQ;
        float* wtot = (float*)lds;
        const float bf = P.fox_b_f[h];
        float v[16]; float run = 0.f;
#pragma unroll
        for (int e = 0; e < 16; ++e) { const float xx = small[((size_t)b * SEQ + tid * 16 + e) * 32 + 16 + h] + bf; run += -softplusf_(-xx) * LOG2E; v[e] = run; }
        float inc = run;
#pragma unroll
        for (int o = 1; o < 64; o <<= 1) { const float t_ = __shfl_up(inc, o); if (lane >= o) inc += t_; }
        if (lane == 63) wtot[wave] = inc;
        { float gq = tid < 128 ? fabsf(P.fox_q_norm[tid]) : 0.f, gk = tid < 128 ? fabsf(P.fox_k_norm[tid]) : 0.f;
#pragma unroll
          for (int o = 1; o < 64; o <<= 1) { gq = fmaxf(gq, __shfl_xor(gq, o)); gk = fmaxf(gk, __shfl_xor(gk, o)); }
          if (lane == 0) { wtot[8 + wave] = gq; wtot[16 + wave] = gk; } }
        __syncthreads();
        if (bh == 0 && tid == 0) { float gq = 0.f, gk = 0.f; for (int w = 0; w < 8; ++w) { gq = fmaxf(gq, wtot[8 + w]); gk = fmaxf(gk, wtot[16 + w]); }
            ((float*)(P.ws + WS_CDEC + 16384))[0] = 150.f + 2.f * 1.03f * (128.f * 0.08838834764831845f * LOG2E) * gq * gk; }
        float off = inc - run;
        for (int w = 0; w < wave; ++w) off += wtot[w];
#pragma unroll
        for (int e = 0; e < 16; ++e) cum[tid * 16 + e] = v[e] + off;
        __syncthreads();
    }
    for (int u = blockIdx.x; u < 2048; u += G) gdn_prep_unit(P, lds, u >> 7, u & 127, tid, lane, wave);
    for (int it0 = blockIdx.x; it0 < TOK / 2; it0 += 4 * G) {
        const int cidx = (tid & 255) * 8, isq = cidx >= 1024, d = cidx & 127;
        bf16* pp[4]; bool ok[4];
#pragma unroll
        for (int b = 0; b < 4; ++b) { const int it = it0 + b * G; ok[b] = it < TOK / 2; pp[b] = proj + (size_t)((ok[b] ? it : 0) * 2 + (tid >> 8)) * LDP + PC_FK + cidx; }
        norm8b<16, 4>(pp, ok, (isq ? P.fox_q_norm : P.fox_k_norm) + d, isq ? 0.08838834764831845f * LOG2E : 1.f, 1.f / 128.f);
    }
    for (int it0 = blockIdx.x; it0 < TOK / 4; it0 += 4 * G) {
        const int cidx = (tid & 127) * 8, d = cidx & 255;
        bf16* pp[4]; bool ok[4];
#pragma unroll
        for (int b = 0; b < 4; ++b) { const int it = it0 + b * G; ok[b] = it < TOK / 4; pp[b] = proj + (size_t)((ok[b] ? it : 0) * 4 + (tid >> 7)) * LDP + PC_QM + cidx; }
        norm8b<32, 4>(pp, ok, P.mem_q_norm + d, 0.0625f * LOG2E, 1.f / 256.f);
    }
    bf16* kmem = (bf16*)(P.ws + WS_KMEM);
    for (int it = blockIdx.x; it < 512 / 4; it += G) {
        const int cidx = (tid & 127) * 8, d = cidx & 255;
        bf16* pp[1] = {kmem + (size_t)(it * 4 + (tid >> 7)) * 1024 + cidx}; const bool ok[1] = {true};
        norm8b<32, 1>(pp, ok, P.mem_k_norm + d, 1.f, 1.f / 256.f);
    }
}

template <int DQK, bool FOX>
__device__ __forceinline__ void attn_unit(unsigned char* lds_, const bf16* Q, int ldq, const bf16* K, int ldk, const bf16* VT, int ldvt, bf16* O, int ldo,
                                          const float* cum, float skip_lim, int t0, int ntiles, int tid, int lane, int wave, int& dbg_tiles, unsigned char* dbg_ws = nullptr) {
    asm volatile("" : "+v"(tid), "+v"(lane));
    constexpr int KS = DQK / 16, KPITCH = DQK * 2 + 16, VPITCH = 136, ND = FOX ? 4 : 2, NH = (DQK / 32) / ND, VCH = ND / 2;
    constexpr int KCH = 64 * DQK / 8 / 512;
    LAS unsigned char* lds = (LAS unsigned char*)lds_;
    LAS unsigned char* Ks = lds; LAS unsigned char* VTs = lds + 64 * KPITCH; LAS float* cbs = (LAS float*)(lds + 64 * KPITCH + 128 * VPITCH);
    const int c = lane & 31, hi = lane >> 5;
    const int qrow = t0 + wave * 32 + c;
    bf16x8 qf[KS];
    { const bf16* qp = Q + (size_t)qrow * ldq + 8 * hi;
#pragma unroll
      for (int k = 0; k < KS; ++k) qf[k] = *(const bf16x8*)(qp + 16 * k); }
    float cref = 0.f; int jmin = 0;
    if (FOX) {
        cref = cum[t0];
        LAS int* jm = (LAS int*)(cbs + 64);
        if (wave < 2) { const int j = wave * 64 + lane; bool need = false; if (j < ntiles) need = (cref - cum[64 * j + 63]) >= -skip_lim;
            const unsigned long long mk = __ballot(need); if (lane == 0) jm[wave] = mk ? (int)__builtin_ctzll(mk) + wave * 64 : (1 << 20); }
        __syncthreads();
        jmin = min(min(jm[0], jm[1]), ntiles - 1);
        jmin = __builtin_amdgcn_readfirstlane(jmin);
    }
    dbg_tiles = 0;
#ifdef PROBE_TS
    if (FOX && dbg_ws && blockIdx.x == 16 && tid == 0) { volatile unsigned long long* dg_ = (volatile unsigned long long*)(dbg_ws + WS_CTL + 32768); dg_[16] += (unsigned long long)(ntiles - jmin) * 375ull; }
#endif
#pragma unroll 1
    for (int half = 0; half < NH; ++half) {
        f32x16 o[ND]; float m = -1e30f, l = 0.f;
#pragma unroll
        for (int d = 0; d < ND; ++d) o[d] = f32x16{};
        constexpr bool PREF = (DQK == 128);
        u32x4 kpre[KCH], vpre[VCH]; float cpre = 0.f;
#define ATT_PREFETCH(j_) do { const int kv0_ = 64 * (j_); \
            _Pragma("unroll") for (int i = 0; i < KCH; ++i) { const int id = tid + 512 * i, row = id / (DQK / 8), cc = id % (DQK / 8); kpre[i] = *(const u32x4*)(K + (size_t)(kv0_ + row) * ldk + cc * 8); } \
            _Pragma("unroll") for (int i = 0; i < VCH; ++i) { const int id = tid + 512 * i, row = id >> 3, cc = id & 7; vpre[i] = *(const u32x4*)(VT + (size_t)(half * ND * 32 + row) * ldvt + kv0_ + cc * 8); } \
            if (FOX) { if (tid < 64) cpre = cum[kv0_ + tid] - cref; } } while (0)
        if (PREF) ATT_PREFETCH(jmin);
#pragma unroll 1
        for (int j = jmin; j < ntiles; ++j) {
            __syncthreads();
            if (!PREF) ATT_PREFETCH(j);
#pragma unroll
            for (int i = 0; i < KCH; ++i) { const int id = tid + 512 * i, row = id / (DQK / 8), cc = id % (DQK / 8); *(LAS u32x4*)(Ks + row * KPITCH + cc * 16) = kpre[i]; }
#pragma unroll
            for (int i = 0; i < VCH; ++i) { const int id = tid + 512 * i, row = id >> 3, cc = id & 7; LAS u32x2* d2 = (LAS u32x2*)(VTs + row * VPITCH + cc * 16);
                d2[0] = (u32x2){vpre[i].x, vpre[i].y}; d2[1] = (u32x2){vpre[i].z, vpre[i].w}; }
            if (FOX) { if (tid < 64) cbs[tid] = cpre; }
            __syncthreads();
            if (PREF && j + 1 < ntiles) ATT_PREFETCH(j + 1);
            const int kv0 = 64 * j;
            if (FOX && kv0 > t0 + wave * 32 + 31) continue;
            f32x16 p0 = f32x16{}, p1 = f32x16{};
            const LAS unsigned char* vb = VTs + c * VPITCH + hi * 8;
            u32x2 vlo[FOX ? 8 : 1], vhh[FOX ? 8 : 1];
            if constexpr (FOX) {
                const LAS unsigned char* kb = Ks + c * KPITCH + hi * 16;
                bf16x8 kf[2 * KS];
#pragma unroll
                for (int k = 0; k < KS; ++k) { kf[2 * k] = *(const LAS bf16x8*)(kb + k * 32); kf[2 * k + 1] = *(const LAS bf16x8*)(kb + 32 * KPITCH + k * 32); }
                __builtin_amdgcn_sched_barrier(0);
#pragma unroll
                for (int k = 0; k < KS; ++k) {
                    p0 = __builtin_amdgcn_mfma_f32_32x32x16_bf16(kf[2 * k], qf[k], p0, 0, 0, 0);
                    p1 = __builtin_amdgcn_mfma_f32_32x32x16_bf16(kf[2 * k + 1], qf[k], p1, 0, 0, 0); }
                __builtin_amdgcn_sched_barrier(0);
#pragma unroll
                for (int d = 0; d < 2; ++d)
#pragma unroll
                    for (int cc = 0; cc < 4; ++cc) { vlo[d * 4 + cc] = *(const LAS u32x2*)(vb + d * 32 * VPITCH + cc * 32); vhh[d * 4 + cc] = *(const LAS u32x2*)(vb + d * 32 * VPITCH + cc * 32 + 16); }
                __builtin_amdgcn_sched_barrier(0);
            } else {
                const LAS unsigned char* kb = Ks + c * KPITCH + hi * 16;
#pragma unroll
                for (int k = 0; k < KS; ++k) {
                    const bf16x8 a0 = *(const LAS bf16x8*)(kb + k * 32), a1 = *(const LAS bf16x8*)(kb + 32 * KPITCH + k * 32);
                    p0 = __builtin_amdgcn_mfma_f32_32x32x16_bf16(a0, qf[k], p0, 0, 0, 0);
                    p1 = __builtin_amdgcn_mfma_f32_32x32x16_bf16(a1, qf[k], p1, 0, 0, 0); }
            }
            if (FOX) {
#pragma unroll
                for (int r4 = 0; r4 < 4; ++r4) { const f32x4 b0 = *(const LAS f32x4*)(cbs + 8 * r4 + 4 * hi), b1 = *(const LAS f32x4*)(cbs + 32 + 8 * r4 + 4 * hi);
#pragma unroll
                    for (int e = 0; e < 4; ++e) { p0[4 * r4 + e] -= b0[e]; p1[4 * r4 + e] -= b1[e]; } }
                if (kv0 + 63 > t0 + wave * 32) {
#pragma unroll
                    for (int r = 0; r < 16; ++r) { const int kv = kv0 + crow(r, hi); if (kv > qrow) p0[r] = -INFINITY; if (kv + 32 > qrow) p1[r] = -INFINITY; }
                }
            }
            float mx = p0[0];
#pragma unroll
            for (int r = 1; r < 16; ++r) mx = fmaxf(mx, p0[r]);
#pragma unroll
            for (int r = 0; r < 16; ++r) mx = fmaxf(mx, p1[r]);
            mx = fmaxf(mx, __shfl_xor(mx, 32));
            const float mn = fmaxf(m, mx), alpha = __builtin_amdgcn_exp2f(m - mn); m = mn;
            float ps = 0.f;
#pragma unroll
            for (int r = 0; r < 16; ++r) { p0[r] = __builtin_amdgcn_exp2f(p0[r] - mn); p1[r] = __builtin_amdgcn_exp2f(p1[r] - mn); ps += p0[r] + p1[r]; }
            l = l * alpha + ps;
#pragma unroll
            for (int d = 0; d < ND; ++d)
#pragma unroll
                for (int r = 0; r < 16; ++r) o[d][r] *= alpha;
            bf16x8 pb[4];
#pragma unroll
            for (int cc = 0; cc < 4; ++cc) { u32x4 w;
                if (cc < 2) { w.x = pk2(p0[8 * cc + 0], p0[8 * cc + 1]); w.y = pk2(p0[8 * cc + 2], p0[8 * cc + 3]); w.z = pk2(p0[8 * cc + 4], p0[8 * cc + 5]); w.w = pk2(p0[8 * cc + 6], p0[8 * cc + 7]); }
                else { const int c2 = cc - 2; w.x = pk2(p1[8 * c2 + 0], p1[8 * c2 + 1]); w.y = pk2(p1[8 * c2 + 2], p1[8 * c2 + 3]); w.z = pk2(p1[8 * c2 + 4], p1[8 * c2 + 5]); w.w = pk2(p1[8 * c2 + 6], p1[8 * c2 + 7]); }
                pb[cc] = __builtin_bit_cast(bf16x8, w); }
            if constexpr (FOX) {
                u32x2 wlo[8], whh[8];
#pragma unroll
                for (int d = 0; d < 2; ++d)
#pragma unroll
                    for (int cc = 0; cc < 4; ++cc) { wlo[d * 4 + cc] = *(const LAS u32x2*)(vb + (d + 2) * 32 * VPITCH + cc * 32); whh[d * 4 + cc] = *(const LAS u32x2*)(vb + (d + 2) * 32 * VPITCH + cc * 32 + 16); }
                __builtin_amdgcn_sched_barrier(0);
#pragma unroll
                for (int cc = 0; cc < 4; ++cc)
#pragma unroll
                    for (int d = 0; d < 2; ++d) { const u32x4 av = (u32x4){vlo[d * 4 + cc].x, vlo[d * 4 + cc].y, vhh[d * 4 + cc].x, vhh[d * 4 + cc].y};
                        o[d] = __builtin_amdgcn_mfma_f32_32x32x16_bf16(__builtin_bit_cast(bf16x8, av), pb[cc], o[d], 0, 0, 0); }
                __builtin_amdgcn_sched_barrier(0);
#pragma unroll
                for (int cc = 0; cc < 4; ++cc)
#pragma unroll
                    for (int d = 0; d < 2; ++d) { const u32x4 av = (u32x4){wlo[d * 4 + cc].x, wlo[d * 4 + cc].y, whh[d * 4 + cc].x, whh[d * 4 + cc].y};
                        o[d + 2] = __builtin_amdgcn_mfma_f32_32x32x16_bf16(__builtin_bit_cast(bf16x8, av), pb[cc], o[d + 2], 0, 0, 0); }
            } else {
#pragma unroll
              for (int d = 0; d < ND; ++d)
#pragma unroll
                  for (int cc = 0; cc < 4; ++cc) {
                      const u32x2 lo = *(const LAS u32x2*)(vb + d * 32 * VPITCH + cc * 32), hh = *(const LAS u32x2*)(vb + d * 32 * VPITCH + cc * 32 + 16);
                      const u32x4 av = (u32x4){lo.x, lo.y, hh.x, hh.y};
                      o[d] = __builtin_amdgcn_mfma_f32_32x32x16_bf16(__builtin_bit_cast(bf16x8, av), pb[cc], o[d], 0, 0, 0); } }
        }
        l += __shfl_xor(l, 32);
        const float rl = 1.f / l;
        bf16* op = O + (size_t)qrow * ldo + half * ND * 32 + 4 * hi;
#pragma unroll
        for (int d = 0; d < ND; ++d)
#pragma unroll
            for (int r4 = 0; r4 < 4; ++r4) { u32x2 w; w.x = pk2(o[d][4 * r4 + 0] * rl, o[d][4 * r4 + 1] * rl); w.y = pk2(o[d][4 * r4 + 2] * rl, o[d][4 * r4 + 3] * rl);
                *(u32x2*)(op + 32 * d + 8 * r4) = w; }
    }
    __syncthreads();
}

__device__ __forceinline__ void gdn_scan_wg(const Params& P, unsigned char* lds_, int unit, int tid, int lane, int wave) {
    const int bh = unit >> 2, quart = unit & 3;
    LAS unsigned char* lds = (LAS unsigned char*)lds_;
    const int b = bh >> 3, h = bh & 7;
    const unsigned char* gsrc = P.ws + WS_GDN + (size_t)bh * 128 * GDN_CHUNK_BYTES;
    const unsigned char* usrc = P.ws + WS_UC + (size_t)bh * 128 * 16384;
    const float* cdec = (const float*)(P.ws + WS_CDEC) + bh * 128;
    bf16* proj = (bf16*)(P.ws + WS_PROJ);
#define SCAN_BAR() asm volatile("s_waitcnt lgkmcnt(0)\n\ts_barrier" ::: "memory")
    constexpr int OB = 114688;
    if (wave >= 4) {
        const int lt = tid - 256, tk = lt >> 2, q4 = lt & 3;
        const size_t rowb = (size_t)b * SEQ + tk;
        bf16* obase = proj + rowb * LDP + PC_OA + h * 128 + q4 * 32;
        u32x4 r[14];
#pragma unroll
        for (int k = 0; k < 14; ++k) r[k] = *(const u32x4*)(gsrc + (size_t)(lt + 256 * k) * 16);
#pragma unroll
        for (int k = 0; k < 14; ++k) *(LAS u32x4*)(lds + (lt + 256 * k) * 16) = r[k];
#pragma unroll
        for (int k = 0; k < 14; ++k) r[k] = *(const u32x4*)(gsrc + (size_t)GDN_CHUNK_BYTES + (size_t)(lt + 256 * k) * 16);
        __syncthreads();
#define GDN_NORM(CH) do { if (q4 == quart) { const LAS unsigned char* ob_ = lds + OB + ((CH) & 1) * 16384 + tk * 256 + q4 * 64; bf16* op_ = obase + (size_t)(CH) * 64 * LDP; \
            _Pragma("unroll") for (int i = 0; i < 4; ++i) { const u32x4 w_ = *(const LAS u32x4*)(ob_ + i * 16); *(u32x4*)(op_ + 8 * i) = w_; } } } while (0)
#pragma unroll 1
        for (int n = 0; n < 128; ++n) {
            if (n + 1 < 128) {
                LAS unsigned char* d = lds + ((n + 1) & 1) * GDN_CHUNK_BYTES;
#pragma unroll
                for (int k = 0; k < 14; ++k) *(LAS u32x4*)(d + (lt + 256 * k) * 16) = r[k];
            }
            if (n + 2 < 128) {
                const unsigned char* s2 = gsrc + (size_t)(n + 2) * GDN_CHUNK_BYTES;
#pragma unroll
                for (int k = 0; k < 14; ++k) r[k] = *(const u32x4*)(s2 + (size_t)(lt + 256 * k) * 16);
            }
            if (n > 0) GDN_NORM(n - 1);
            SCAN_BAR();
        }
        GDN_NORM(127);
#undef GDN_NORM
    } else if (wave >= 1) {
        __syncthreads();
#pragma unroll 1
        for (int n = 0; n < 128; ++n) SCAN_BAR();
    } else {
        const int w4 = quart, c = lane & 31, hi = lane >> 5;
        f32x16 S[4];
#pragma unroll
        for (int t = 0; t < 4; ++t) S[t] = f32x16{};
        bf16x8 Sb[8];
#pragma unroll
        for (int k = 0; k < 8; ++k) Sb[k] = bf16x8{};
        u32x4 ucn[4];
#pragma unroll
        for (int i = 0; i < 4; ++i) ucn[i] = *(const u32x4*)(usrc + (size_t)((w4 * 2 + (i >> 1)) * 64 + lane) * 32 + (i & 1) * 16);
        float cdn = cdec[0];
        __syncthreads();
#pragma unroll 1
        for (int n = 0; n < 128; ++n) {
            const LAS unsigned char* fb = lds + (n & 1) * GDN_CHUNK_BYTES + lane * 16;
            f32x16 U[2];
#pragma unroll
            for (int rt = 0; rt < 2; ++rt) { const u32x4 a = ucn[2 * rt], bq = ucn[2 * rt + 1];
                U[rt][0] = bflo(a.x); U[rt][1] = bfhi(a.x); U[rt][2] = bflo(a.y); U[rt][3] = bfhi(a.y); U[rt][4] = bflo(a.z); U[rt][5] = bfhi(a.z); U[rt][6] = bflo(a.w); U[rt][7] = bfhi(a.w);
                U[rt][8] = bflo(bq.x); U[rt][9] = bfhi(bq.x); U[rt][10] = bflo(bq.y); U[rt][11] = bfhi(bq.y); U[rt][12] = bflo(bq.z); U[rt][13] = bfhi(bq.z); U[rt][14] = bflo(bq.w); U[rt][15] = bfhi(bq.w); }
            const float cd = cdn;
            if (n + 1 < 128) {
                const unsigned char* us = usrc + (size_t)(n + 1) * 16384;
#pragma unroll
                for (int i = 0; i < 4; ++i) ucn[i] = *(const u32x4*)(us + (size_t)((w4 * 2 + (i >> 1)) * 64 + lane) * 32 + (i & 1) * 16);
                cdn = cdec[n + 1];
            }
#define FRAG(off) (*(const LAS bf16x8*)(fb + (off)))
#define SBAR() __builtin_amdgcn_sched_barrier(0)
            bf16x8 A0[8], A1[8];
#pragma unroll
            for (int i = 0; i < 8; ++i) A0[i] = FRAG(((i & 1) * 8 + (i >> 1)) * 1024);
            SBAR();
#pragma unroll
            for (int i = 0; i < 8; ++i) A1[i] = FRAG(((i & 1) * 8 + 4 + (i >> 1)) * 1024);
            SBAR();
#pragma unroll
            for (int i = 0; i < 8; ++i) U[i & 1] = __builtin_amdgcn_mfma_f32_32x32x16_bf16(A0[i], Sb[i >> 1], U[i & 1], 0, 0, 0);
            SBAR();
#pragma unroll
            for (int i = 0; i < 8; ++i) A0[i] = FRAG(16384 + ((i & 1) * 8 + (i >> 1)) * 1024);
            SBAR();
#pragma unroll
            for (int i = 0; i < 8; ++i) U[i & 1] = __builtin_amdgcn_mfma_f32_32x32x16_bf16(A1[i], Sb[4 + (i >> 1)], U[i & 1], 0, 0, 0);
            SBAR();
#pragma unroll
            for (int i = 0; i < 8; ++i) A1[i] = FRAG(16384 + ((i & 1) * 8 + 4 + (i >> 1)) * 1024);
            SBAR();
            f32x16 Ov[2]; Ov[0] = f32x16{}; Ov[1] = f32x16{};
#pragma unroll
            for (int i = 0; i < 8; ++i) Ov[i & 1] = __builtin_amdgcn_mfma_f32_32x32x16_bf16(A0[i], Sb[i >> 1], Ov[i & 1], 0, 0, 0);
            SBAR();
#pragma unroll
            for (int i = 0; i < 8; ++i) A0[i] = FRAG(32768 + ((i & 1) * 4 + (i >> 1)) * 1024);
            SBAR();
#pragma unroll
            for (int i = 0; i < 8; ++i) Ov[i & 1] = __builtin_amdgcn_mfma_f32_32x32x16_bf16(A1[i], Sb[4 + (i >> 1)], Ov[i & 1], 0, 0, 0);
            SBAR();
            bf16x8 Ub[4];
#pragma unroll
            for (int k2 = 0; k2 < 4; ++k2) { const f32x16& uu = U[k2 >> 1]; const int o8 = 8 * (k2 & 1); u32x4 w;
                w.x = pk2(uu[o8 + 0], uu[o8 + 1]); w.y = pk2(uu[o8 + 2], uu[o8 + 3]); w.z = pk2(uu[o8 + 4], uu[o8 + 5]); w.w = pk2(uu[o8 + 6], uu[o8 + 7]); Ub[k2] = __builtin_bit_cast(bf16x8, w); }
#pragma unroll
            for (int i = 0; i < 8; ++i) A1[i] = FRAG(40960 + ((i & 3) * 4 + (i >> 2)) * 1024);
            SBAR();
#pragma unroll
            for (int i = 0; i < 8; ++i) Ov[i & 1] = __builtin_amdgcn_mfma_f32_32x32x16_bf16(A0[i], Ub[i >> 1], Ov[i & 1], 0, 0, 0);
            SBAR();
#pragma unroll
            for (int i = 0; i < 8; ++i) A0[i] = FRAG(40960 + ((i & 3) * 4 + 2 + (i >> 2)) * 1024);
            SBAR();
#pragma unroll
            for (int t = 0; t < 4; ++t)
#pragma unroll
                for (int r = 0; r < 16; ++r) S[t][r] *= cd;
#pragma unroll
            for (int i = 0; i < 8; ++i) S[i & 3] = __builtin_amdgcn_mfma_f32_32x32x16_bf16(A1[i], Ub[i >> 2], S[i & 3], 0, 0, 0);
            SBAR();
#pragma unroll
            for (int i = 0; i < 8; ++i) S[i & 3] = __builtin_amdgcn_mfma_f32_32x32x16_bf16(A0[i], Ub[2 + (i >> 2)], S[i & 3], 0, 0, 0);
            SBAR();
            { LAS bf16* ob = (LAS bf16*)(lds + OB + (n & 1) * 16384);
#pragma unroll
              for (int rt = 0; rt < 2; ++rt)
#pragma unroll
                  for (int r = 0; r < 16; ++r) ob[(32 * rt + crow(r, hi)) * 128 + 32 * w4 + c] = (bf16)(pk2(Ov[rt][r], 0.f) & 0xffffu); }
#pragma unroll
            for (int k = 0; k < 8; ++k) { const f32x16& ss = S[k >> 1]; const int o8 = 8 * (k & 1); u32x4 w;
                w.x = pk2(ss[o8 + 0], ss[o8 + 1]); w.y = pk2(ss[o8 + 2], ss[o8 + 3]); w.z = pk2(ss[o8 + 4], ss[o8 + 5]); w.w = pk2(ss[o8 + 6], ss[o8 + 7]); Sb[k] = __builtin_bit_cast(bf16x8, w); }
#undef FRAG
#undef SBAR
            SCAN_BAR();
        }
    }
    __syncthreads();
}

__device__ __forceinline__ void phase3(const Params& P, unsigned char* lds, int tid, int lane, int wave) {
    bf16* proj = (bf16*)(P.ws + WS_PROJ);
#ifndef NO_SCAN
    if (blockIdx.x < 64) gdn_scan_wg(P, lds, blockIdx.x, tid, lane, wave);
#endif
#ifdef PROBE_TS
    if (blockIdx.x == 0 && tid == 0) ((volatile unsigned long long*)(P.ws + WS_CTL + 32768))[10] = __builtin_amdgcn_s_memrealtime();
#endif
    unsigned* ctr = (unsigned*)(P.ws + WS_CTL);
    LAS unsigned* sh = (LAS unsigned*)((LAS unsigned char*)lds + LDS_BYTES - 64);
    const bf16* foxvt = (const bf16*)((const unsigned char*)P.out + DO_FOXVT);
    const float* cum = (const float*)(P.ws + WS_CUM);
    const bf16* kmem = (const bf16*)(P.ws + WS_KMEM); const bf16* vmt = (const bf16*)(P.ws + WS_VMT);
#ifdef STATIC_P3
    for (unsigned idx_ = (blockIdx.x < 16 ? 100000u : blockIdx.x - 16u); idx_ < 768u; idx_ += 240u) {
        const unsigned idx = __builtin_amdgcn_readfirstlane(idx_);
#else
    for (;;) {
        if (tid == 0) sh[0] = atomicAdd(ctr, 1u);
        __syncthreads();
        const unsigned idx = __builtin_amdgcn_readfirstlane(sh[0]);
        __syncthreads();
        if (idx >= 512u + 256u) break;
#endif
        int dbg_t = 0;
#ifdef PROBE_TS
        if (blockIdx.x == 16 && tid == 0) ((volatile unsigned long long*)(P.ws + WS_CTL + 32768))[20] = __builtin_amdgcn_s_memrealtime();
#endif
        if (idx < 512u) {
#ifndef NO_FOXATT
            const int qb = 31 - (int)(idx >> 4), bh = idx & 15, b = bh >> 3, h = bh & 7;
            bf16* Qp = proj + (size_t)b * SEQ * LDP + PC_FQ + h * 128;
            const bf16* Kp = proj + (size_t)b * SEQ * LDP + PC_FK + h * 128;
            const bf16* Vp = foxvt + (size_t)(h * 128) * TOK + (size_t)b * SEQ;
            attn_unit<128, true>(lds, Qp, LDP, Kp, LDP, Vp, TOK, Qp, LDP, cum + (size_t)bh * SEQ, ((const float*)(P.ws + WS_CDEC + 16384))[0], qb * 256, (qb + 1) * 4, tid, lane, wave, dbg_t, P.ws);
#ifdef PROBE_TS
            if (blockIdx.x == 16 && tid == 0) { volatile unsigned long long* dg = (volatile unsigned long long*)(P.ws + WS_CTL + 32768); dg[14] += __builtin_amdgcn_s_memrealtime() - dg[20]; }
#endif
#endif
        } else {
#ifndef NO_MEMATT
            const int u = idx - 512, qb = u & 31, bh = u >> 5, b = bh >> 2, h = bh & 3;
            bf16* Qp = proj + (size_t)b * SEQ * LDP + PC_QM + h * 256;
            const bf16* Kp = kmem + (size_t)b * 256 * 1024 + h * 256;
            const bf16* Vp = vmt + (size_t)(h * 256) * 512 + b * 256;
            attn_unit<256, false>(lds, Qp, LDP, Kp, 1024, Vp, 512, Qp, LDP, nullptr, 0.f, qb * 256, 4, tid, lane, wave, dbg_t);
#ifdef PROBE_TS
            if (blockIdx.x == 16 && tid == 0) { volatile unsigned long long* dg = (volatile unsigned long long*)(P.ws + WS_CTL + 32768); dg[18] += __builtin_amdgcn_s_memrealtime() - dg[20]; }
#endif
#endif
        }
    }
#ifdef PROBE_TS
    if (blockIdx.x == 0 && tid == 0) ((volatile unsigned long long*)(P.ws + WS_CTL + 32768))[11] = __builtin_amdgcn_s_memrealtime();
#endif
}


__device__ __forceinline__ void gdn_gate_norm_pass(const Params& P, int tid) {
    bf16* proj = (bf16*)(P.ws + WS_PROJ);
    const int cidx = (tid & 127) * 8, d = cidx & 127;
    const f32x4 g0 = *(const f32x4*)(P.gdn_norm_g + d), g1 = *(const f32x4*)(P.gdn_norm_g + d + 4);
    const float gg[8] = {g0.x, g0.y, g0.z, g0.w, g1.x, g1.y, g1.z, g1.w};
    for (int it0 = blockIdx.x; it0 < TOK / 4; it0 += 4 * gridDim.x) {
        u32x4 ov[4], zv[4]; bool ok[4]; bf16* op[4];
#pragma unroll
        for (int b = 0; b < 4; ++b) { const int it = it0 + b * gridDim.x; ok[b] = it < TOK / 4; const size_t row = (size_t)((ok[b] ? it : 0) * 4 + (tid >> 7));
            op[b] = proj + row * LDP + PC_OA + cidx; ov[b] = *(const u32x4*)op[b]; zv[b] = *(const u32x4*)(proj + row * LDP + PC_Z + cidx); }
#pragma unroll
        for (int b = 0; b < 4; ++b) {
            const float v[8] = {bflo(ov[b].x), bfhi(ov[b].x), bflo(ov[b].y), bfhi(ov[b].y), bflo(ov[b].z), bfhi(ov[b].z), bflo(ov[b].w), bfhi(ov[b].w)};
            const float z[8] = {bflo(zv[b].x), bfhi(zv[b].x), bflo(zv[b].y), bfhi(zv[b].y), bflo(zv[b].z), bfhi(zv[b].z), bflo(zv[b].w), bfhi(zv[b].w)};
            float ss = 0.f;
#pragma unroll
            for (int e = 0; e < 8; ++e) ss += v[e] * v[e];
            ss += __shfl_xor(ss, 1); ss += __shfl_xor(ss, 2); ss += __shfl_xor(ss, 4); ss += __shfl_xor(ss, 8);
            const float rstd = rsqrtf(ss * (1.f / 128.f) + EPSN);
            float o[8];
#pragma unroll
            for (int e = 0; e < 8; ++e) o[e] = v[e] * rstd * gg[e] * (z[e] * __builtin_amdgcn_rcpf(1.f + __builtin_amdgcn_exp2f(-LOG2E * z[e])));
            u32x4 w; w.x = pk2(o[0], o[1]); w.y = pk2(o[2], o[3]); w.z = pk2(o[4], o[5]); w.w = pk2(o[6], o[7]);
            if (ok[b]) *(u32x4*)op[b] = w;
        }
    }
}

#define RLX_AGENT __ATOMIC_RELAXED, __HIP_MEMORY_SCOPE_AGENT
#define XB_TMO      128
#define XB_XCNT(j)  (256  + 64 * (j))
#define XB_XSUB(j)  (1280 + 64 * (j))
#define XB_XGEN(j)  (2304 + 64 * (j))
#define XB_TOP      3328
#define XB_TOPGEN   3392
#define XCD_BAR_WORDS 3456
#define XB_SPIN_CAP (1u << 22)

__device__ __forceinline__ unsigned xb_ld(unsigned* p)              { return __hip_atomic_load(p, __ATOMIC_RELAXED, __HIP_MEMORY_SCOPE_AGENT); }
__device__ __forceinline__ unsigned xb_add(unsigned* p, unsigned v) { return __hip_atomic_fetch_add(p, v, __ATOMIC_RELAXED, __HIP_MEMORY_SCOPE_AGENT); }
__device__ __forceinline__ unsigned xb_xcc_id() { return (unsigned)__builtin_amdgcn_s_getreg((3 << 11) | 20) & 0xFu; }
#define XB_SPIN(cond, bar) do { unsigned _sp = 0; while (cond) { __builtin_amdgcn_s_sleep(1); \
    if ((++_sp & 255u) == 0u) { if (xb_ld(&(bar)[XB_TMO])) break; if (_sp > XB_SPIN_CAP) { atomicAdd(&(bar)[XB_TMO], 1u); break; } } } } while (0)

struct XcdBarrier {
    unsigned* bar; unsigned x;
    volatile LAS unsigned* st;
};

__device__ __forceinline__ XcdBarrier xcd_barrier_post(unsigned* bar, volatile LAS unsigned* st) {
    XcdBarrier b; b.bar = bar; b.x = xb_xcc_id(); b.st = st;
    if (threadIdx.x == 0) (void)xb_add(&bar[XB_XCNT(b.x)], 1u);
    return b;
}
__device__ __forceinline__ void xcd_barrier_complete(unsigned* bar, unsigned x, unsigned& nloc, unsigned& nx) {
    const unsigned G = gridDim.x * gridDim.y * gridDim.z;
    unsigned sum, cnt, mine, sp = 0u;
    for (;;) {
        sum = 0u; cnt = 0u; mine = 0u;
#pragma unroll
        for (unsigned j = 0; j < 16; ++j) { const unsigned c = xb_ld(&bar[XB_XCNT(j)]); sum += c; cnt += (c > 0u) ? 1u : 0u; mine = (j == x) ? c : mine; }
        if (sum == G) break;
        __builtin_amdgcn_s_sleep(1);
        if ((++sp & 255u) == 0u) { if (xb_ld(&bar[XB_TMO])) break; if (sp > XB_SPIN_CAP) { atomicAdd(&bar[XB_TMO], 1u); break; } }
    }
    nloc = mine > 0u ? mine : 1u; nx = cnt > 0u ? cnt : 1u;
}

__device__ __forceinline__ void xcd_barrier(const XcdBarrier& b) {
    asm volatile("s_waitcnt vmcnt(0)" ::: "memory");
    __syncthreads();
    if (threadIdx.x == 0) {
        unsigned* bar = b.bar;
        __builtin_amdgcn_s_waitcnt(0);
        unsigned nloc = b.st[0], nx = b.st[1];
        if (nloc == 0u) { xcd_barrier_complete(bar, b.x, nloc, nx); b.st[0] = nloc; b.st[1] = nx; }
        const unsigned old = xb_add(&bar[XB_XSUB(b.x)], 1u);
        const unsigned gen = old / nloc;
        if (old + 1u == (gen + 1u) * nloc) {
            __builtin_amdgcn_fence(__ATOMIC_RELEASE, "agent");
            asm volatile("s_waitcnt vmcnt(0)" ::: "memory");
            const unsigned og = xb_add(&bar[XB_TOP], 1u);
            const unsigned tg = og / nx;
            if (og + 1u == (tg + 1u) * nx) xb_add(&bar[XB_TOPGEN], 1u);
            else XB_SPIN(xb_ld(&bar[XB_TOPGEN]) == tg, bar);
            __builtin_amdgcn_fence(__ATOMIC_ACQUIRE, "agent");
            xb_add(&bar[XB_XGEN(b.x)], 1u);
            asm volatile("s_waitcnt vmcnt(0)" ::: "memory");
        } else {
            XB_SPIN(xb_ld(&bar[XB_XGEN(b.x)]) == gen, bar);
            __builtin_amdgcn_fence(__ATOMIC_ACQUIRE, "agent");
            asm volatile("s_waitcnt vmcnt(0)" ::: "memory");
        }
    }
    __syncthreads();
}

__global__ void __launch_bounds__(512, 2) hybrid_fwd(Params P) {
    extern __shared__ __attribute__((aligned(16))) unsigned char lds[];
    cg::grid_group grid = cg::this_grid();
    const int tid = threadIdx.x, lane = tid & 63, wave = __builtin_amdgcn_readfirstlane(tid >> 6);
    const int G = gridDim.x, cb = blockIdx.x;
    unsigned char* ws = P.ws;
    LAS unsigned char* glds = (LAS unsigned char*)lds;
    bf16* H = (bf16*)((unsigned char*)P.out + DO_H);
    bf16* proj = (bf16*)(ws + WS_PROJ);
    volatile LAS unsigned* bst = (volatile LAS unsigned*)(glds + LDS_BYTES - 32);
    if (tid < 2) bst[tid] = 0u;
    __syncthreads();
    XcdBarrier bar = xcd_barrier_post((unsigned*)(ws + WS_CTL) + 1024, bst);
#ifdef PROBE_TS
    volatile unsigned long long* tsg_ = (volatile unsigned long long*)(ws + WS_CTL + 32768);
    if (blockIdx.x == 0 && tid == 0) tsg_[0] = __builtin_amdgcn_s_memrealtime();
#endif
    grid.sync();
#ifdef PROBE_TS
#define GRID_BAR(k_) do { xcd_barrier(bar); if (blockIdx.x == 0 && tid == 0) tsg_[k_] = __builtin_amdgcn_s_memrealtime(); } while (0)
#else
#define GRID_BAR(k_) xcd_barrier(bar)
#endif

#ifndef NO_P0
    phase0(P, lds, tid, lane, wave);
#endif
    GRID_BAR(1);
#ifndef NO_GEMM
    {
        pg8::Gemm g{H, (const bf16*)(ws + WS_W1T), TOK, 7424, 2048, 2048, 2048}; pg8::StaticOrder S; S.init(TOK, 7424, G, cb);
        pg8::EpiProj E{proj, LDP, (float*)(ws + WS_SMALL)};
        pg8::gemm_phase<pg8::EpiProj, pg8::StaticOrder, true, true>(glds, g, S, E);
    }
    {
        pg8::Gemm g{(const bf16*)(ws + WS_WFVT), H, 1024, TOK, 2048, 2048, 2048}; pg8::StaticOrder S; S.init(1024, TOK, G, cb);
        pg8::EpiStore E{(bf16*)((unsigned char*)P.out + DO_FOXVT), TOK};
        pg8::gemm_phase<pg8::EpiStore, pg8::StaticOrder, true, true>(glds, g, S, E);
    }
    {
        const int cr = (cb + G - 64) % G;
        pg8::Gemm g{(const bf16*)(ws + WS_MEMN), (const bf16*)(ws + WS_WMKVT), 512, 1024, 2048, 2048, 2048}; pg8::StaticOrder S; S.init(512, 1024, G, cr);
        pg8::EpiStore E{(bf16*)(ws + WS_KMEM), 1024};
        pg8::gemm_phase<pg8::EpiStore, pg8::StaticOrder, true, true>(glds, g, S, E);
        const int cr2 = (cb + G - 72) % G;
        pg8::Gemm g2{(const bf16*)(ws + WS_WMKVT) + (size_t)1024 * 2048, (const bf16*)(ws + WS_MEMN), 1024, 512, 2048, 2048, 2048}; pg8::StaticOrder S2; S2.init(1024, 512, G, cr2);
        pg8::EpiStore E2{(bf16*)(ws + WS_VMT), 512};
        pg8::gemm_phase<pg8::EpiStore, pg8::StaticOrder, true, true>(glds, g2, S2, E2);
    }
#endif
    GRID_BAR(2);
#ifndef NO_P2
    phase2(P, lds, tid, lane, wave);
#endif
    GRID_BAR(3);
#ifndef NO_P3
    phase3(P, lds, tid, lane, wave);
#endif
    GRID_BAR(4);
#ifndef NO_GEMM
    gdn_gate_norm_pass(P, tid);
    {
        pg8::Gemm g{H, (const bf16*)(ws + WS_WGT), TOK, 6144, 2048, 2048, 2048}; pg8::StaticOrder S; S.init(TOK, 6144, G, cb);
        pg8::EpiSig E{(unsigned char*)P.out + DO_GA, (unsigned char*)(proj + PC_GB), 2048, LDP * 2};
        pg8::gemm_phase<pg8::EpiSig, pg8::StaticOrder, true, true>(glds, g, S, E);
    }
    GRID_BAR(5);
    {
        bf16* Y = (bf16*)(ws + WS_Y); const bf16* WUPT = (const bf16*)(ws + WS_WUPT);
        pg8::StaticOrder S; S.init(TOK, 2048, G, cb);
        { pg8::Gemm g{proj + PC_OA, WUPT, TOK, 2048, 1024, LDP, 1024}; pg8::EpiGate<true> E{(const unsigned char*)P.out + DO_GA, 2048, Y, 2048};
          pg8::gemm_phase<pg8::EpiGate<true>, pg8::StaticOrder, true, true>(glds, g, S, E); }
        { pg8::Gemm g{proj + PC_OB, WUPT + (size_t)2048 * 1024, TOK, 2048, 1024, LDP, 1024}; pg8::EpiGate<false> E{(const unsigned char*)(proj + PC_GB), LDP * 2, Y, 2048};
          pg8::gemm_phase<pg8::EpiGate<false>, pg8::StaticOrder, true, true>(glds, g, S, E); }
        { pg8::Gemm g{proj + PC_OM, WUPT + (size_t)2 * 2048 * 1024, TOK, 2048, 1024, LDP, 1024}; pg8::EpiGate<false> E{(const unsigned char*)(proj + PC_GB) + 2048, LDP * 2, Y, 2048};
          pg8::gemm_phase<pg8::EpiGate<false>, pg8::StaticOrder, true, true>(glds, g, S, E); }
    }
    GRID_BAR(6);
    {
        pg8::Gemm g{(const bf16*)(ws + WS_Y), (const bf16*)(ws + WS_WOT), TOK, 2048, 2048, 2048, 2048}; pg8::StaticOrder S; S.init(TOK, 2048, G, cb);
        pg8::EpiRes1 E{P.x, (bf16*)(ws + WS_X1B), (float*)(ws + WS_SSQ)};
        pg8::gemm_phase<pg8::EpiRes1, pg8::StaticOrder, true, true>(glds, g, S, E);
    }
    GRID_BAR(7);
    {
        const float* SSQ = (const float*)(ws + WS_SSQ); float* RSTD = (float*)(ws + WS_RSTD);
        const int g = cb * 512 + tid;
        if (g < TOK * 8) { const int row = g >> 3, part = g & 7; float sq = 0.f;
#pragma unroll
            for (int q = 0; q < 4; ++q) sq += SSQ[(size_t)(part * 4 + q) * 16384 + row];
            sq += __shfl_xor(sq, 1); sq += __shfl_xor(sq, 2); sq += __shfl_xor(sq, 4);
            if (part == 0) RSTD[row] = rsqrtf(sq * (1.f / 2048.f) + 1e-6f); }
    }
    GRID_BAR(8);
    {
        pg8::Gemm g{(const bf16*)(ws + WS_X1B), (const bf16*)(ws + WS_WFF1T), TOK, 8192, 2048, 2048, 2048}; pg8::StaticOrder S; S.init(TOK, 8192, G, cb);
        pg8::EpiFF1 E{(const float*)(ws + WS_RSTD), (bf16*)(ws + WS_U), 8192};
        pg8::gemm_phase<pg8::EpiFF1, pg8::StaticOrder, true, true>(glds, g, S, E);
    }
    GRID_BAR(9);
    {
        pg8::Gemm g{(const bf16*)(ws + WS_U), (const bf16*)(ws + WS_WFF2T), TOK, 2048, 8192, 8192, 8192}; pg8::StaticOrder S; S.init(TOK, 2048, G, cb, 4);
        pg8::EpiOut E{(const bf16*)(ws + WS_X1B), P.out};
        pg8::gemm_phase<pg8::EpiOut, pg8::StaticOrder, true, true>(glds, g, S, E);
    }
#endif
#ifdef PROBE_TS
    if (blockIdx.x == 0 && tid == 0) {
        const unsigned long long tend = __builtin_amdgcn_s_memrealtime();
        tsg_[12] = tend;
        long long qa = ((long long)(tsg_[PROBE_A1] - tsg_[PROBE_A0]) + 1500) / 3000; if (qa > 35) qa = 35;
        long long qb = ((long long)(tsg_[PROBE_B1] - tsg_[PROBE_B0]) + 1500) / 3000; if (qb > 35) qb = 35;
        long long qc = ((long long)(tsg_[PROBE_C1] - tsg_[PROBE_C0]) + 1500) / 3000; if (qc > 35) qc = 35;
        const unsigned long long until = tend + (unsigned long long)(qa + 36 * qb + 1296 * qc) * 2000ull;
        while (__builtin_amdgcn_s_memrealtime() < until) __builtin_amdgcn_s_sleep(8);
    }
#endif
}

extern "C" void kernel_launch(void* const* d_in, const int* in_sizes, int n_in, void* d_out, int out_size, void* d_ws, size_t ws_size, hipStream_t stream) {
    static int grid = 0;
    if (grid == 0) {
        if (n_in != 22 || out_size != TOK * DM || ws_size < WS_END) { fprintf(stderr, "kernel_launch: unexpected shapes (n_in %d out %d ws %zu)\n", n_in, out_size, ws_size); grid = -1; return; }
        int dev = 0, cus = 0, per_cu = 0;
        hipGetDevice(&dev); hipDeviceGetAttribute(&cus, hipDeviceAttributeMultiprocessorCount, dev);
        if (hipFuncSetAttribute((const void*)hybrid_fwd, hipFuncAttributeMaxDynamicSharedMemorySize, LDS_BYTES) != hipSuccess) { fprintf(stderr, "kernel_launch: hipFuncSetAttribute failed\n"); grid = -1; return; }
        if (hipOccupancyMaxActiveBlocksPerMultiprocessor(&per_cu, (const void*)hybrid_fwd, 512, LDS_BYTES) != hipSuccess || per_cu < 1) { fprintf(stderr, "kernel_launch: occupancy query says %d\n", per_cu); per_cu = 1; }
        (void)hipGetLastError();
        grid = cus * 1;
        if (grid <= 0) grid = 256;
    }
    if (grid < 0) return;
    if (hipMemsetAsync((char*)d_ws + WS_CTL, 0, 65536, stream) != hipSuccess) { fprintf(stderr, "kernel_launch: memset failed\n"); return; }
    Params p{};
    const float** pp = (const float**)&p;
    for (int i = 0; i < 22; ++i) pp[i] = (const float*)d_in[i];
    p.out = (float*)d_out; p.ws = (unsigned char*)d_ws;
    void* args[] = {&p};
    hipError_t e = hipLaunchCooperativeKernel((const void*)hybrid_fwd, dim3(grid), dim3(512), args, LDS_BYTES, stream);
    if (e != hipSuccess) fprintf(stderr, "cooperative launch failed: %s (grid %d)\n", hipGetErrorString(e), grid);
}
```

```cpp
#include <hip/hip_runtime.h>
#include <hip/hip_cooperative_groups.h>
#include <cstdio>
#include <cstdint>
namespace cg = cooperative_groups;

namespace pg8 {
#define PG8_LAS __attribute__((address_space(3)))
typedef unsigned short bf16_t;
typedef short bf16x8 __attribute__((ext_vector_type(8)));
typedef float f32x4 __attribute__((ext_vector_type(4)));
typedef unsigned u32x4 __attribute__((ext_vector_type(4)));
constexpr int BM = 256, BK = 64, HALF = 128, HTB = HALF * BK * 2  , STAGE_BYTES = 8 * HTB, NXCD = 8, WGM = 8;

__host__ __device__ __forceinline__ int lds_byte(int r, int c) { const int st = (r >> 4) * 2 + (c >> 5), rr = r & 15, cc = c & 31, ob = rr * 64 + cc * 2; return st * 1024 + (ob ^ (((ob >> 9) & 1) << 5)); }
__host__ __device__ __forceinline__ void stage_rc(int b, int& R, int& C) { const int st = b / 1024, sb = b % 1024, swz = sb ^ (((sb >> 9) & 1) << 5); R = (st >> 1) * 16 + swz / 64; C = (st & 1) * 32 + (swz % 64) / 2; }
__host__ __device__ __forceinline__ int perm32(int rho) { const int n = rho >> 4, i = rho & 15; return 8 * (i >> 2) + 4 * n + (i & 3); }

struct Unit { int pm, pn; };
struct Gemm { const bf16_t* A; const bf16_t* Bt; int M, N, K, lda, ldb; };

struct StaticOrder {
    int nM, nN, nwg, G, c, wgm;
    __host__ __device__ void init(int M, int N, int G_, int c_, int wgm_ = WGM) { nM = M / BM; nN = N / BM; nwg = nM * nN; G = G_; c = c_; wgm = wgm_; }
    __host__ __device__ bool next(int i, Unit& u) const {
        const long L = (long)i * G + c; if (L >= nwg) return false;
        int wgid = (int)L; { const int q = nwg / NXCD, r = nwg % NXCD, xcd = wgid % NXCD, off = wgid / NXCD; wgid = (xcd < r ? xcd * (q + 1) : r * (q + 1) + (xcd - r) * q) + off; }
        const int nig = wgm * nN, gid = wgid / nig, fm = gid * wgm, gsz = (nM - fm) < wgm ? (nM - fm) : wgm;
        u.pm = fm + ((wgid % nig) % gsz); u.pn = (wgid % nig) / gsz; return true;
    }
    __device__ __forceinline__ void a_ready(const Unit&) const {}
    __device__ __forceinline__ void done(const Unit&) const {}
};

typedef float f32x2_cv __attribute__((ext_vector_type(2))); typedef __bf16 bf16x2_cv __attribute__((ext_vector_type(2)));
__device__ __forceinline__ unsigned cvt_pk_bf16(float lo, float hi) { f32x2_cv v = {lo, hi}; bf16x2_cv b = __builtin_convertvector(v, bf16x2_cv); return __builtin_bit_cast(unsigned, b); }
template <class Epi, class Sched, bool ALIGN_EPI = false, bool SP2 = false>
__device__ __forceinline__ void gemm_phase(PG8_LAS unsigned char* lds, const Gemm g, const Sched& S, const Epi& E) {
    int tid_ = threadIdx.x; asm volatile("" : "+v"(tid_));
    const int tid = tid_, wid = __builtin_amdgcn_readfirstlane(tid >> 6), lane = tid & 63, wr = wid >> 2, wc = wid & 3, fr = lane & 15, fq = lane >> 4;
    const int K = g.K, nt = K / BK;
    unsigned voffA[2], voffB[2];
#pragma unroll
    for (int i = 0; i < 2; ++i) { int R, C; stage_rc(tid * 16 + i * 8192, R, C); const int Rb = Epi::PERM ? ((R & ~31) + perm32(R & 31)) : R;
        voffA[i] = (unsigned)(R * g.lda + C) * 2u; voffB[i] = (unsigned)(Rb * g.ldb + C) * 2u; }
    const size_t kstep = (size_t)(BK * 2);
    const size_t hstepA = (size_t)HALF * g.lda * 2, hstepB = (size_t)HALF * g.ldb * 2;
    const size_t tstepA = 2 * hstepA, tstepB = 2 * hstepB;
    const unsigned ldsw = (unsigned)wid * 1024u;
    const int aoff = lds_byte(wr * 64 + fr, fq * 8), boff = lds_byte(wc * 32 + fr, fq * 8);
#define PG8_SA(b, h) (((b) * 2 + (h)) * HTB)
#define PG8_SB(b, h) ((4 + (b) * 2 + (h)) * HTB)
#define PG8_STAGE(bufoff, gbase, voff) do { _Pragma("unroll") for (int _i = 0; _i < 2; ++_i) \
        __builtin_amdgcn_global_load_lds((const unsigned*)((const char*)(gbase) + (voff)[_i]), (PG8_LAS unsigned*)(lds + (bufoff) + ldsw + _i * 8192), 16, 0, 0); } while (0)
#define PG8_LDA(dst, b, h) do { _Pragma("unroll") for (int m = 0; m < 4; ++m) _Pragma("unroll") for (int k = 0; k < 2; ++k) dst[m][k] = *(const PG8_LAS bf16x8*)(lds + PG8_SA(b, h) + aoff + m * 2048 + k * 1024); } while (0)
#define PG8_LDB(dst, b, h) do { _Pragma("unroll") for (int n = 0; n < 2; ++n) _Pragma("unroll") for (int k = 0; k < 2; ++k) dst[n][k] = *(const PG8_LAS bf16x8*)(lds + PG8_SB(b, h) + boff + n * 2048 + k * 1024); } while (0)
#define PG8_MMA(ai, bj, At, Bt) do { __builtin_amdgcn_s_setprio(1); _Pragma("unroll") for (int m = 0; m < 4; ++m) _Pragma("unroll") for (int n = 0; n < 2; ++n) _Pragma("unroll") for (int k = 0; k < 2; ++k) \
        acc[ai][bj][m][n] = __builtin_amdgcn_mfma_f32_16x16x32_bf16(Bt[n][k], At[m][k], acc[ai][bj][m][n], 0, 0, 0); __builtin_amdgcn_s_setprio(0); } while (0)
#define PG8_WAIT_V(n) asm volatile("s_waitcnt vmcnt(" #n ")" ::: "memory")
#define PG8_WAIT_L(n) asm volatile("s_waitcnt lgkmcnt(" #n ")" ::: "memory")
#define PG8_BAR __builtin_amdgcn_s_barrier()
#define PG8_SCHED __builtin_amdgcn_sched_barrier(0)
    Unit cur, nxt; int ui = 0;
    if (!S.next(0, cur)) return;
    f32x4 acc[2][2][4][2];
#pragma unroll
    for (int a = 0; a < 2; ++a)
#pragma unroll
        for (int b = 0; b < 2; ++b)
#pragma unroll
            for (int m = 0; m < 4; ++m)
#pragma unroll
                for (int n = 0; n < 2; ++n) acc[a][b][m][n] = (f32x4){0.f, 0.f, 0.f, 0.f};
    bf16x8 At[4][2], B0[2][2], B1[2][2];
    const char* cA = (const char*)g.A + (size_t)cur.pm * tstepA; const char* cB = (const char*)g.Bt + (size_t)cur.pn * tstepB;
    S.a_ready(cur);
    if constexpr (SP2) {
        PG8_STAGE(PG8_SB(0, 0), cB, voffB); PG8_STAGE(PG8_SB(0, 1), cB + hstepB, voffB); PG8_STAGE(PG8_SA(0, 0), cA, voffA); PG8_STAGE(PG8_SA(0, 1), cA + hstepA, voffA);
        if (wr == 1) PG8_BAR;
        PG8_WAIT_V(2); PG8_BAR;
        PG8_STAGE(PG8_SB(1, 0), cB + kstep, voffB); PG8_STAGE(PG8_SA(1, 0), cA + kstep, voffA); PG8_STAGE(PG8_SB(1, 1), cB + hstepB + kstep, voffB);
        PG8_WAIT_V(6); PG8_BAR;
    } else {
        PG8_STAGE(PG8_SB(0, 0), cB, voffB); PG8_STAGE(PG8_SA(0, 0), cA, voffA); PG8_STAGE(PG8_SB(0, 1), cB + hstepB, voffB); PG8_STAGE(PG8_SA(0, 1), cA + hstepA, voffA);
        if (wr == 1) PG8_BAR;
        PG8_WAIT_V(4); PG8_BAR;
        PG8_STAGE(PG8_SB(1, 0), cB + kstep, voffB); PG8_STAGE(PG8_SA(1, 0), cA + kstep, voffA); PG8_STAGE(PG8_SB(1, 1), cB + hstepB + kstep, voffB);
        PG8_WAIT_V(6); PG8_BAR;
    }
    for (;;) {
        const bool has_next = S.next(ui + 1, nxt);
        const char* nA = has_next ? (const char*)g.A + (size_t)nxt.pm * tstepA : cA; const char* nB = has_next ? (const char*)g.Bt + (size_t)nxt.pn * tstepB : cB;
        for (int t = 0; t < nt; t += 2) {
            const bool last = (t == nt - 2);
            const char* a1 = cA + (size_t)(t + 1) * kstep;
            const char* a2 = last ? nA : cA + (size_t)(t + 2) * kstep; const char* b2 = last ? nB : cB + (size_t)(t + 2) * kstep;
            const char* a3 = a2 + kstep; const char* b3 = b2 + kstep;
            if (last && has_next) S.a_ready(nxt);
            if constexpr (SP2) {
            PG8_LDB(B0, 0, 0); PG8_LDB(B1, 0, 1); PG8_SCHED; PG8_LDA(At, 0, 0); PG8_STAGE(PG8_SA(1, 1), a1 + hstepA, voffA);
            PG8_WAIT_V(8); PG8_WAIT_L(0); PG8_BAR; PG8_MMA(0, 0, At, B0); PG8_MMA(0, 1, At, B1); PG8_BAR; PG8_SCHED;
            PG8_LDA(At, 0, 1); PG8_STAGE(PG8_SB(0, 0), b2, voffB); PG8_STAGE(PG8_SB(0, 1), b2 + hstepB, voffB); PG8_STAGE(PG8_SA(0, 0), a2, voffA);
            PG8_WAIT_V(8); PG8_WAIT_L(0); PG8_BAR; PG8_MMA(1, 0, At, B0); PG8_MMA(1, 1, At, B1); PG8_BAR; PG8_SCHED;
            PG8_LDB(B0, 1, 0); PG8_LDB(B1, 1, 1); PG8_SCHED; PG8_LDA(At, 1, 0); PG8_STAGE(PG8_SA(0, 1), a2 + hstepA, voffA);
            PG8_WAIT_V(8); PG8_WAIT_L(0); PG8_BAR; PG8_MMA(0, 0, At, B0); PG8_MMA(0, 1, At, B1); PG8_BAR; PG8_SCHED;
            PG8_LDA(At, 1, 1); PG8_STAGE(PG8_SB(1, 0), b3, voffB); PG8_STAGE(PG8_SB(1, 1), b3 + hstepB, voffB); PG8_STAGE(PG8_SA(1, 0), a3, voffA);
            PG8_WAIT_V(8); PG8_WAIT_L(0); PG8_BAR; PG8_MMA(1, 0, At, B0); PG8_MMA(1, 1, At, B1); PG8_BAR; PG8_SCHED;
            } else {
            PG8_LDB(B0, 0, 0); PG8_SCHED; PG8_LDA(At, 0, 0); PG8_STAGE(PG8_SA(1, 1), a1 + hstepA, voffA);
            PG8_WAIT_L(8); PG8_BAR; PG8_WAIT_L(0); PG8_MMA(0, 0, At, B0); PG8_BAR; PG8_SCHED;
            PG8_LDB(B1, 0, 1); PG8_STAGE(PG8_SB(0, 0), b2, voffB);
            PG8_BAR; PG8_WAIT_L(0); PG8_MMA(0, 1, At, B1); PG8_BAR;
            PG8_LDA(At, 0, 1); PG8_STAGE(PG8_SA(0, 0), a2, voffA);
            PG8_BAR; PG8_WAIT_L(0); PG8_MMA(1, 0, At, B0); PG8_BAR; PG8_SCHED;
            PG8_STAGE(PG8_SB(0, 1), b2 + hstepB, voffB);
            PG8_WAIT_V(6); PG8_BAR; PG8_MMA(1, 1, At, B1); PG8_BAR;
            PG8_LDB(B0, 1, 0); PG8_SCHED; PG8_LDA(At, 1, 0); PG8_STAGE(PG8_SA(0, 1), a2 + hstepA, voffA);
            PG8_WAIT_L(8); PG8_BAR; PG8_WAIT_L(0); PG8_MMA(0, 0, At, B0); PG8_BAR; PG8_SCHED;
            PG8_LDB(B1, 1, 1); PG8_STAGE(PG8_SB(1, 0), b3, voffB);
            PG8_BAR; PG8_WAIT_L(0); PG8_MMA(0, 1, At, B1); PG8_BAR;
            PG8_LDA(At, 1, 1); PG8_STAGE(PG8_SA(1, 0), a3, voffA);
            PG8_BAR; PG8_WAIT_L(0); PG8_MMA(1, 0, At, B0); PG8_BAR; PG8_SCHED;
            PG8_STAGE(PG8_SB(1, 1), b3 + hstepB, voffB);
            PG8_WAIT_V(6); PG8_BAR; PG8_MMA(1, 1, At, B1); PG8_BAR;
            }
        }
        if constexpr (ALIGN_EPI) { if (wr == 0) PG8_BAR; }
        if constexpr (!Epi::AFTER_DRAIN) { E(acc, cur, wr, wc, fr, fq); S.done(cur); }
        if (!has_next) break;
#pragma unroll
        for (int a = 0; a < 2; ++a)
#pragma unroll
            for (int b = 0; b < 2; ++b)
#pragma unroll
                for (int m = 0; m < 4; ++m)
#pragma unroll
                    for (int n = 0; n < 2; ++n) acc[a][b][m][n] = (f32x4){0.f, 0.f, 0.f, 0.f};
        cur = nxt; cA = nA; cB = nB; ++ui;
        if constexpr (ALIGN_EPI) { if (wr == 1) PG8_BAR; }
    }
    PG8_WAIT_V(0);
    if constexpr (!ALIGN_EPI) { if (wr == 0) PG8_BAR; }
    PG8_BAR;
    if constexpr (Epi::AFTER_DRAIN) { E.fused(acc, cur, wr, wc, fr, fq, lds, wid, lane); S.done(cur); }
#undef PG8_SA
#undef PG8_SB
#undef PG8_STAGE
#undef PG8_LDA
#undef PG8_LDB
#undef PG8_MMA
#undef PG8_WAIT_V
#undef PG8_WAIT_L
#undef PG8_BAR
#undef PG8_SCHED
}
}

constexpr int TOK = 16384, SEQ = 8192, DM = 2048, DIN = 14360, DFF = 8192;
constexpr int LDP = 7168;
constexpr int PC_QA = 0, PC_KA = 1024, PC_VA = 2048, PC_Z = 3072, PC_FK = 4096, PC_FQ = 5120, PC_QM = 6144;
constexpr int PC_OA = 0, PC_OB = PC_FQ, PC_OM = PC_QM, PC_GB = 1024, PC_GM = 3072;
constexpr float EPSN = 1e-6f;
constexpr float LOG2E = 1.4426950408889634f;
constexpr size_t MiB = 1u << 20;
constexpr size_t WS_CTL = 0, WS_W1T = 1 * MiB, WS_WFVT = 30 * MiB, WS_WMKVT = 34 * MiB, WS_UC = 1 * MiB;
constexpr size_t WS_SMALL = 42 * MiB, WS_KMEM = 44 * MiB, WS_VMT = 45 * MiB, WS_CUM = 46 * MiB, WS_CDEC = 46 * MiB + 512 * 1024,
                 WS_MEMN = 47 * MiB, WS_SSQ = 49 * MiB, WS_RSTD = 51 * MiB;
constexpr size_t WS_WGT = 52 * MiB, WS_WUPT = 76 * MiB, WS_WOT = 88 * MiB, WS_WFF1T = 96 * MiB, WS_WFF2T = 128 * MiB;
constexpr size_t WS_PROJ = 160 * MiB, WS_GDN = 384 * MiB, WS_END = 496 * MiB;
constexpr int FOXVT_LD = TOK;
constexpr size_t WS_Y = 384 * MiB, WS_X1B = 160 * MiB, WS_U = 224 * MiB;
constexpr size_t DO_H = 0, DO_FOXVT = 64 * MiB, DO_GA = 64 * MiB;
constexpr int GDN_CHUNK_BYTES = 57344;
constexpr int LDS_BYTES = 163840;

#define LAS __attribute__((address_space(3)))
typedef unsigned short bf16;
typedef short bf16x8 __attribute__((ext_vector_type(8)));
typedef float f32x4 __attribute__((ext_vector_type(4)));
typedef float f32x16 __attribute__((ext_vector_type(16)));
typedef unsigned u32x4 __attribute__((ext_vector_type(4)));
typedef unsigned u32x2 __attribute__((ext_vector_type(2)));

__device__ __forceinline__ unsigned pk2(float lo, float hi) { return pg8::cvt_pk_bf16(lo, hi); }
__device__ __forceinline__ float bf2f(unsigned short v) { return __uint_as_float(((unsigned)v) << 16); }
__device__ __forceinline__ float bflo(unsigned w) { return __uint_as_float(w << 16); }
__device__ __forceinline__ float bfhi(unsigned w) { return __uint_as_float(w & 0xffff0000u); }
__device__ __forceinline__ int crow(int r, int hi) { return (r & 3) + 8 * (r >> 2) + 4 * hi; }
__device__ __forceinline__ float sigmoidf_(float x) { return 1.f / (1.f + __expf(-x)); }
__device__ __forceinline__ float softplusf_(float x) { return fmaxf(x, 0.f) + log1pf(__expf(-fabsf(x))); }

namespace pg8 {
struct EpiStore {
    static constexpr bool PERM = true, AFTER_DRAIN = false;
    bf16_t* O; int ldc;
    __device__ __forceinline__ void operator()(const f32x4 (&acc)[2][2][4][2], const Unit& u, int wr, int wc, int fr, int fq) const {
        const int row0 = u.pm * BM + wr * 64 + fr, col0 = u.pn * BM + wc * 32 + 8 * fq;
#pragma unroll
        for (int ai = 0; ai < 2; ++ai)
#pragma unroll
            for (int m = 0; m < 4; ++m) { bf16_t* rowp = O + (size_t)(row0 + ai * HALF + m * 16) * ldc + col0;
#pragma unroll
                for (int bj = 0; bj < 2; ++bj) { const f32x4 v0 = acc[ai][bj][m][0], v1 = acc[ai][bj][m][1];
                    u32x4 w; w.x = cvt_pk_bf16(v0[0], v0[1]); w.y = cvt_pk_bf16(v0[2], v0[3]); w.z = cvt_pk_bf16(v1[0], v1[1]); w.w = cvt_pk_bf16(v1[2], v1[3]);
                    *(u32x4*)(rowp + bj * HALF) = w; } }
    }
};
struct EpiProj {
    static constexpr bool PERM = true, AFTER_DRAIN = false;
    bf16_t* O; int ldc; float* small;
    __device__ __forceinline__ void operator()(const f32x4 (&acc)[2][2][4][2], const Unit& u, int wr, int wc, int fr, int fq) const {
        const int row0 = u.pm * BM + wr * 64 + fr;
        if (u.pn == 28) {
            if (wc == 0) {
#pragma unroll
                for (int ai = 0; ai < 2; ++ai)
#pragma unroll
                    for (int m = 0; m < 4; ++m) { float* p = small + (size_t)(row0 + ai * HALF + m * 16) * 32 + 8 * fq;
                        *(f32x4*)p = acc[ai][0][m][0]; *(f32x4*)(p + 4) = acc[ai][0][m][1]; }
            }
            return;
        }
        const int col0 = u.pn * BM + wc * 32 + 8 * fq;
#pragma unroll
        for (int ai = 0; ai < 2; ++ai)
#pragma unroll
            for (int m = 0; m < 4; ++m) { bf16_t* rowp = O + (size_t)(row0 + ai * HALF + m * 16) * ldc + col0;
#pragma unroll
                for (int bj = 0; bj < 2; ++bj) { const f32x4 v0 = acc[ai][bj][m][0], v1 = acc[ai][bj][m][1];
                    u32x4 w; w.x = cvt_pk_bf16(v0[0], v0[1]); w.y = cvt_pk_bf16(v0[2], v0[3]); w.z = cvt_pk_bf16(v1[0], v1[1]); w.w = cvt_pk_bf16(v1[2], v1[3]);
                    *(u32x4*)(rowp + bj * HALF) = w; } }
    }
};
struct EpiSig {
    static constexpr bool PERM = true, AFTER_DRAIN = false;
    unsigned char* O0; unsigned char* O1; int ld0, ld1;
    __device__ __forceinline__ void operator()(const f32x4 (&acc)[2][2][4][2], const Unit& u, int wr, int wc, int fr, int fq) const {
        const int br = u.pn >> 3; unsigned char* O = br == 0 ? O0 : O1 + (size_t)(br - 1) * 2048; const int ldc = br == 0 ? ld0 : ld1;
        const int row0 = u.pm * BM + wr * 64 + fr, col0 = (u.pn & 7) * BM + wc * 32 + 8 * fq;
#pragma unroll
        for (int ai = 0; ai < 2; ++ai)
#pragma unroll
            for (int m = 0; m < 4; ++m) { unsigned char* rowp = O + (size_t)(row0 + ai * HALF + m * 16) * ldc + col0;
#pragma unroll
                for (int bj = 0; bj < 2; ++bj) { const f32x4 v0 = acc[ai][bj][m][0], v1 = acc[ai][bj][m][1]; unsigned q[8];
#pragma unroll
                    for (int e = 0; e < 4; ++e) { q[e] = (unsigned)(255.f * __builtin_amdgcn_rcpf(1.f + __builtin_amdgcn_exp2f(-1.4426950408889634f * v0[e])) + 0.5f);
                                                  q[4 + e] = (unsigned)(255.f * __builtin_amdgcn_rcpf(1.f + __builtin_amdgcn_exp2f(-1.4426950408889634f * v1[e])) + 0.5f); }
                    u32x2 w; w.x = q[0] | (q[1] << 8) | (q[2] << 16) | (q[3] << 24); w.y = q[4] | (q[5] << 8) | (q[6] << 16) | (q[7] << 24);
                    *(u32x2*)(rowp + bj * HALF) = w; } }
    }
};
template <bool FIRST> struct EpiGate {
    static constexpr bool PERM = true, AFTER_DRAIN = false;
    const unsigned char* G; int ldg; bf16_t* Y; int ldy;
    __device__ __forceinline__ void operator()(const f32x4 (&acc)[2][2][4][2], const Unit& u, int wr, int wc, int fr, int fq) const {
        const int row0 = u.pm * BM + wr * 64 + fr, col0 = u.pn * BM + wc * 32 + 8 * fq;
        constexpr float S = 1.f / 255.f;
#pragma unroll
        for (int ai = 0; ai < 2; ++ai)
#pragma unroll
            for (int m = 0; m < 4; ++m) { const size_t r = (size_t)(row0 + ai * HALF + m * 16);
#pragma unroll
                for (int bj = 0; bj < 2; ++bj) { const f32x4 v0 = acc[ai][bj][m][0], v1 = acc[ai][bj][m][1];
                    const u32x2 g = *(const u32x2*)(G + r * ldg + col0 + bj * HALF);
                    float o[8];
                    o[0] = v0[0] * ((float)(g.x & 0xffu) * S); o[1] = v0[1] * ((float)((g.x >> 8) & 0xffu) * S);
                    o[2] = v0[2] * ((float)((g.x >> 16) & 0xffu) * S); o[3] = v0[3] * ((float)(g.x >> 24) * S);
                    o[4] = v1[0] * ((float)(g.y & 0xffu) * S); o[5] = v1[1] * ((float)((g.y >> 8) & 0xffu) * S);
                    o[6] = v1[2] * ((float)((g.y >> 16) & 0xffu) * S); o[7] = v1[3] * ((float)(g.y >> 24) * S);
                    bf16_t* yp = Y + r * ldy + col0 + bj * HALF;
                    if (!FIRST) { const u32x4 y = *(const u32x4*)yp;
                        o[0] += __uint_as_float(y.x << 16); o[1] += __uint_as_float(y.x & 0xffff0000u);
                        o[2] += __uint_as_float(y.y << 16); o[3] += __uint_as_float(y.y & 0xffff0000u);
                        o[4] += __uint_as_float(y.z << 16); o[5] += __uint_as_float(y.z & 0xffff0000u);
                        o[6] += __uint_as_float(y.w << 16); o[7] += __uint_as_float(y.w & 0xffff0000u); }
                    u32x4 w; w.x = cvt_pk_bf16(o[0], o[1]); w.y = cvt_pk_bf16(o[2], o[3]); w.z = cvt_pk_bf16(o[4], o[5]); w.w = cvt_pk_bf16(o[6], o[7]);
                    *(u32x4*)yp = w; } }
    }
};
struct EpiRes1 {
    static constexpr bool PERM = false, AFTER_DRAIN = false;
    const float* X; bf16_t* XB; float* SSQ;
    __device__ __forceinline__ void operator()(const f32x4 (&acc)[2][2][4][2], const Unit& u, int wr, int wc, int fr, int fq) const {
        const int row0 = u.pm * BM + wr * 64 + fr, col0 = u.pn * BM + wc * 32 + 4 * fq;
#pragma unroll
        for (int ai = 0; ai < 2; ++ai)
#pragma unroll
            for (int m = 0; m < 4; ++m) { const int row = row0 + ai * HALF + m * 16; const size_t off = (size_t)row * 2048 + col0; float s = 0.f;
#pragma unroll
                for (int bj = 0; bj < 2; ++bj)
#pragma unroll
                    for (int n = 0; n < 2; ++n) { const size_t o = off + bj * HALF + n * 16; const f32x4 xv = *(const f32x4*)(X + o); const f32x4 v = xv + acc[ai][bj][m][n];
                        u32x2 w; w.x = cvt_pk_bf16(v[0], v[1]); w.y = cvt_pk_bf16(v[2], v[3]); *(u32x2*)(XB + o) = w;
                        s += (v[0] * v[0] + v[1] * v[1]) + (v[2] * v[2] + v[3] * v[3]); }
                s += __shfl_xor(s, 16); s += __shfl_xor(s, 32);
                if (fq == 0) SSQ[(size_t)(u.pn * 4 + wc) * 16384 + row] = s; }
    }
};
struct EpiFF1 {
    static constexpr bool PERM = true, AFTER_DRAIN = false;
    const float* RSTD; bf16_t* O; int ldc;
    __device__ __forceinline__ void operator()(const f32x4 (&acc)[2][2][4][2], const Unit& u, int wr, int wc, int fr, int fq) const {
        const int row0 = u.pm * BM + wr * 64 + fr, col0 = u.pn * BM + wc * 32 + 8 * fq;
        float rs[2][4];
#pragma unroll
        for (int ai = 0; ai < 2; ++ai)
#pragma unroll
            for (int m = 0; m < 4; ++m) rs[ai][m] = RSTD[row0 + ai * HALF + m * 16];
#pragma unroll
        for (int ai = 0; ai < 2; ++ai)
#pragma unroll
            for (int m = 0; m < 4; ++m) { const int row = row0 + ai * HALF + m * 16; const float rstd = rs[ai][m];
                bf16_t* rowp = O + (size_t)row * ldc + col0;
#pragma unroll
                for (int bj = 0; bj < 2; ++bj) { f32x4 v0 = acc[ai][bj][m][0] * rstd, v1 = acc[ai][bj][m][1] * rstd;
#pragma unroll
                    for (int e = 0; e < 4; ++e) { const float a = fmaxf(v0[e], 0.f), b = fmaxf(v1[e], 0.f); v0[e] = a * a; v1[e] = b * b; }
                    u32x4 w; w.x = cvt_pk_bf16(v0[0], v0[1]); w.y = cvt_pk_bf16(v0[2], v0[3]); w.z = cvt_pk_bf16(v1[0], v1[1]); w.w = cvt_pk_bf16(v1[2], v1[3]);
                    *(u32x4*)(rowp + bj * HALF) = w; } }
    }
};
struct EpiOut {
    static constexpr bool PERM = false, AFTER_DRAIN = false;
    const bf16_t* XB; float* OUT;
    __device__ __forceinline__ void operator()(const f32x4 (&acc)[2][2][4][2], const Unit& u, int wr, int wc, int fr, int fq) const {
        const int row0 = u.pm * BM + wr * 64 + fr, col0 = u.pn * BM + wc * 32 + 4 * fq;
#pragma unroll
        for (int ai = 0; ai < 2; ++ai)
#pragma unroll
            for (int m = 0; m < 4; ++m) { const size_t off = (size_t)(row0 + ai * HALF + m * 16) * 2048 + col0;
#pragma unroll
                for (int bj = 0; bj < 2; ++bj)
#pragma unroll
                    for (int n = 0; n < 2; ++n) { const size_t o = off + bj * HALF + n * 16; const u32x2 xb = *(const u32x2*)(XB + o);
                        f32x4 xv; xv[0] = __uint_as_float(xb.x << 16); xv[1] = __uint_as_float(xb.x & 0xffff0000u); xv[2] = __uint_as_float(xb.y << 16); xv[3] = __uint_as_float(xb.y & 0xffff0000u);
                        *(f32x4*)(OUT + o) = xv + acc[ai][bj][m][n]; } }
    }
};
}

struct Params {
    const float *x, *mem, *g_mix, *w_in, *conv_w, *a_log, *dt_bias, *gdn_norm_g, *fox_b_f, *fox_q_norm, *fox_k_norm, *g_mem, *w_mem_kv,
                *mem_q_norm, *mem_k_norm, *w_up_gdn, *w_up_fox, *w_up_mem, *w_out, *g_mlp, *w_ff1, *w_ff2;
    float* out; unsigned char* ws;
};

__device__ __forceinline__ float wave_sum(float v) {
#pragma unroll
    for (int o = 1; o < 64; o <<= 1) v += __shfl_xor(v, o);
    return v;
}

__device__ __forceinline__ void transpose_item(const float* W, int ldw, int n0src, bf16* WT, int K, int row0dst, const float* kscale,
                                               LAS float* scr, int kb, int nb, int lane) {
    const int k0 = 64 * kb, n0 = 32 * nb;
    float tv[32];
#pragma unroll
    for (int i = 0; i < 32; ++i) tv[i] = W[(size_t)(k0 + 2 * i + (lane >> 5)) * ldw + n0src + n0 + (lane & 31)];
#pragma unroll
    for (int i = 0; i < 32; ++i) { const int kk = 2 * i + (lane >> 5); float v = tv[i];
        if (kscale) v *= kscale[k0 + kk]; scr[kk * 33 + (lane & 31)] = v; }
    asm volatile("s_waitcnt lgkmcnt(0)" ::: "memory");
    const int c = lane & 7;
#pragma unroll
    for (int j = 0; j < 4; ++j) { const int n = (lane >> 3) + 8 * j; const LAS float* s = scr + (8 * c) * 33 + n;
        u32x4 o; o.x = pk2(s[0 * 33], s[1 * 33]); o.y = pk2(s[2 * 33], s[3 * 33]); o.z = pk2(s[4 * 33], s[5 * 33]); o.w = pk2(s[6 * 33], s[7 * 33]);
        *(u32x4*)(WT + (size_t)(row0dst + n0 + n) * K + k0 + 8 * c) = o; }
    asm volatile("s_waitcnt lgkmcnt(0)" ::: "memory");
}
__device__ __forceinline__ void transpose_job(const float* W, int ldw, int n0src, int K, int ncols, bf16* WT, int row0dst, const float* kscale,
                                              LAS float* scr, int gw, int ngw, int lane) {
    const int nblk = ncols / 32, nitems = (K / 64) * nblk;
    for (int it = gw; it < nitems; it += ngw) transpose_item(W, ldw, n0src, WT, K, row0dst, kscale, scr, it / nblk, it % nblk, lane);
}
__device__ __forceinline__ void rms_row_to_bf16(const float* xrow, const float* g, bf16* orow, int lane) {
    const f32x4* xr = (const f32x4*)xrow + lane; const f32x4* gr = (const f32x4*)g + lane;
    f32x4 v[8]; float s = 0.f;
#pragma unroll
    for (int j = 0; j < 8; ++j) { v[j] = xr[64 * j]; s += (v[j].x * v[j].x + v[j].y * v[j].y) + (v[j].z * v[j].z + v[j].w * v[j].w); }
    const float rstd = rsqrtf(wave_sum(s) * (1.f / 2048.f) + EPSN);
    u32x2* o8 = (u32x2*)orow + lane;
#pragma unroll
    for (int j = 0; j < 8; ++j) { const f32x4 gg = gr[64 * j]; u32x2 w; w.x = pk2(v[j].x * rstd * gg.x, v[j].y * rstd * gg.y); w.y = pk2(v[j].z * rstd * gg.z, v[j].w * rstd * gg.w); o8[64 * j] = w; }
}

__device__ __forceinline__ void phase0(const Params& P, unsigned char* lds, int tid, int lane, int wave) {
    unsigned char* ws = P.ws;
    bf16* W1T = (bf16*)(ws + WS_W1T); bf16* WFVT = (bf16*)(ws + WS_WFVT); bf16* WMKVT = (bf16*)(ws + WS_WMKVT); bf16* WGT = (bf16*)(ws + WS_WGT);
    bf16* WUPT = (bf16*)(ws + WS_WUPT); bf16* WOT = (bf16*)(ws + WS_WOT); bf16* WFF1T = (bf16*)(ws + WS_WFF1T); bf16* WFF2T = (bf16*)(ws + WS_WFF2T);
    LAS float* scr = (LAS float*)((LAS unsigned char*)lds + wave * 16384);
    const int G = gridDim.x, gw = blockIdx.x * 8 + wave, ngw = G * 8;
    bf16* H = (bf16*)((unsigned char*)P.out + DO_H);
    for (int m = gw; m < TOK; m += ngw) rms_row_to_bf16(P.x + (size_t)m * DM, P.g_mix, H + (size_t)m * DM, lane);
    bf16* MEMN = (bf16*)(ws + WS_MEMN);
    for (int m = gw; m < 512; m += ngw) rms_row_to_bf16(P.mem + (size_t)m * DM, P.g_mem, MEMN + (size_t)m * DM, lane);
    transpose_job(P.w_in, DIN, 0, 2048, 4096, W1T, 0, nullptr, scr, gw, ngw, lane);
    transpose_job(P.w_in, DIN, 5136, 2048, 1024, W1T, PC_FK, nullptr, scr, gw, ngw, lane);
    transpose_job(P.w_in, DIN, 4112, 2048, 1024, W1T, PC_FQ, nullptr, scr, gw, ngw, lane);
    transpose_job(P.w_in, DIN, 7192, 2048, 1024, W1T, PC_QM, nullptr, scr, gw, ngw, lane);
    transpose_job(P.w_in, DIN, 6160, 2048, 1024, WFVT, 0, nullptr, scr, gw, ngw, lane);
    transpose_job(P.w_in, DIN, 8216, 2048, 6144, WGT, 0, nullptr, scr, gw, ngw, lane);
    transpose_job(P.w_mem_kv, 2048, 0, 2048, 2048, WMKVT, 0, nullptr, scr, gw, ngw, lane);
    transpose_job(P.w_up_gdn, 2048, 0, 1024, 2048, WUPT, 0, nullptr, scr, gw, ngw, lane);
    transpose_job(P.w_up_fox, 2048, 0, 1024, 2048, WUPT + (size_t)2048 * 1024, 0, nullptr, scr, gw, ngw, lane);
    transpose_job(P.w_up_mem, 2048, 0, 1024, 2048, WUPT + (size_t)2 * 2048 * 1024, 0, nullptr, scr, gw, ngw, lane);
    transpose_job(P.w_out, 2048, 0, 2048, 2048, WOT, 0, nullptr, scr, gw, ngw, lane);
    transpose_job(P.w_ff1, 8192, 0, 2048, 8192, WFF1T, 0, P.g_mlp, scr, gw, ngw, lane);
    transpose_job(P.w_ff2, 2048, 0, 8192, 2048, WFF2T, 0, nullptr, scr, gw, ngw, lane);
    for (int idx = blockIdx.x * 512 + tid; idx < 256 * 2048; idx += G * 512) {
        const int row = idx >> 11, k = idx & 2047; float v = 0.f;
        if (row < 24) { const int col = row < 8 ? 4096 + row : (row < 16 ? 4104 + (row - 8) : 7184 + (row - 16)); v = P.w_in[(size_t)k * DIN + col]; }
        W1T[(size_t)(7168 + row) * 2048 + k] = (bf16)(pk2(v, 0.f) & 0xffffu);
    }
}


__device__ __forceinline__ void gdn_prep_unit(const Params& P, unsigned char* lds_, int bh, int n, int tid, int lane, int wave) {
    float* qs = (float*)lds_;
    float* ks = qs + 64 * 132;
    float* vs = ks + 64 * 132;
    float* Mm = vs + 64 * 132;
    float* QKd = Mm + 4096;
    float* gam = QKd + 4096;
    float* beta = gam + 64;
    float* egam = beta + 64;
    const int b = bh >> 3, h = bh & 7;
    const size_t r0 = (size_t)b * SEQ + (size_t)n * 64;
    const bf16* proj = (const bf16*)(P.ws + WS_PROJ);
    const float* small = (const float*)(P.ws + WS_SMALL);
    if (tid < 384) {
        const int c8 = tid % 48, tg = tid / 48, mat = c8 >> 4, ch0 = (c8 & 15) * 8, col = mat * 1024 + h * 128 + ch0, tb = tg * 8;
        u32x4 xr[11];
#pragma unroll
        for (int i = 0; i < 11; ++i) { const int tt = n * 64 + tb - 3 + i;
            xr[i] = tt >= 0 ? *(const u32x4*)(proj + (r0 + tb - 3 + i) * LDP + col) : u32x4{0u, 0u, 0u, 0u}; }
        f32x4 w0[4], w1[4];
#pragma unroll
        for (int i = 0; i < 4; ++i) { w0[i] = *(const f32x4*)(P.conv_w + i * 3072 + col); w1[i] = *(const f32x4*)(P.conv_w + i * 3072 + col + 4); }
        float* dstb = (mat == 0 ? qs : (mat == 1 ? ks : vs)) + tb * 132 + ch0;
#pragma unroll
        for (int t = 0; t < 8; ++t) {
            float y[8];
#pragma unroll
            for (int e = 0; e < 8; ++e) y[e] = 0.f;
#pragma unroll
            for (int i = 0; i < 4; ++i) { const u32x4 xv = xr[t + i];
                y[0] += bflo(xv.x) * w0[i].x; y[1] += bfhi(xv.x) * w0[i].y; y[2] += bflo(xv.y) * w0[i].z; y[3] += bfhi(xv.y) * w0[i].w;
                y[4] += bflo(xv.z) * w1[i].x; y[5] += bfhi(xv.z) * w1[i].y; y[6] += bflo(xv.w) * w1[i].z; y[7] += bfhi(xv.w) * w1[i].w; }
            f32x4 o0, o1;
            o0.x = y[0] * __builtin_amdgcn_rcpf(1.f + __builtin_amdgcn_exp2f(-LOG2E * y[0])); o0.y = y[1] * __builtin_amdgcn_rcpf(1.f + __builtin_amdgcn_exp2f(-LOG2E * y[1]));
            o0.z = y[2] * __builtin_amdgcn_rcpf(1.f + __builtin_amdgcn_exp2f(-LOG2E * y[2])); o0.w = y[3] * __builtin_amdgcn_rcpf(1.f + __builtin_amdgcn_exp2f(-LOG2E * y[3]));
            o1.x = y[4] * __builtin_amdgcn_rcpf(1.f + __builtin_amdgcn_exp2f(-LOG2E * y[4])); o1.y = y[5] * __builtin_amdgcn_rcpf(1.f + __builtin_amdgcn_exp2f(-LOG2E * y[5]));
            o1.z = y[6] * __builtin_amdgcn_rcpf(1.f + __builtin_amdgcn_exp2f(-LOG2E * y[6])); o1.w = y[7] * __builtin_amdgcn_rcpf(1.f + __builtin_amdgcn_exp2f(-LOG2E * y[7]));
            *(f32x4*)(dstb + t * 132) = o0; *(f32x4*)(dstb + t * 132 + 4) = o1;
        }
    }
    if (wave == 7) {
        const float av = small[(r0 + lane) * 32 + 8 + h], bv = small[(r0 + lane) * 32 + h];
        float g = -__expf(P.a_log[h]) * softplusf_(av + P.dt_bias[h]);
#pragma unroll
        for (int o = 1; o < 64; o <<= 1) { const float t_ = __shfl_up(g, o); if (lane >= o) g += t_; }
        gam[lane] = g; egam[lane] = __expf(g); beta[lane] = sigmoidf_(bv);
    }
    __syncthreads();
    for (int rr = wave * 16; rr < wave * 16 + 16; ++rr) {
        float* row = (rr < 64 ? qs + rr * 132 : ks + (rr - 64) * 132);
        const float a = row[lane], c = row[lane + 64];
        const float ss = wave_sum(a * a + c * c);
        const float sc = rsqrtf(ss + EPSN) * (rr < 64 ? 0.08838834764831845f : 1.f);
        row[lane] = a * sc; row[lane + 64] = c * sc;
    }
    __syncthreads();
    {
        const int mat = wave >> 2, ti = (wave >> 1) & 1, tj = wave & 1, c = lane & 31, hi = lane >> 5;
        const float* Arow = (mat == 0 ? ks : qs) + (32 * ti + c) * 132 + 8 * hi;
        const float* Brow = ks + (32 * tj + c) * 132 + 8 * hi;
        f32x16 acc = f32x16{};
#pragma unroll
        for (int k = 0; k < 8; ++k) {
            const f32x4 a0 = *(const f32x4*)(Arow + 16 * k), a1 = *(const f32x4*)(Arow + 16 * k + 4);
            const f32x4 b0 = *(const f32x4*)(Brow + 16 * k), b1 = *(const f32x4*)(Brow + 16 * k + 4);
            u32x4 aw, bw;
            aw.x = pk2(a0.x, a0.y); aw.y = pk2(a0.z, a0.w); aw.z = pk2(a1.x, a1.y); aw.w = pk2(a1.z, a1.w);
            bw.x = pk2(b0.x, b0.y); bw.y = pk2(b0.z, b0.w); bw.z = pk2(b1.x, b1.y); bw.w = pk2(b1.z, b1.w);
            acc = __builtin_amdgcn_mfma_f32_32x32x16_bf16(__builtin_bit_cast(bf16x8, aw), __builtin_bit_cast(bf16x8, bw), acc, 0, 0, 0);
        }
        const int jj = 32 * tj + c; const float gj = gam[jj];
        float* dbase = mat == 0 ? Mm + jj * 64 : QKd + jj; const int dstep = mat == 0 ? 1 : 64; const int strict = mat == 0 ? 1 : 0;
#pragma unroll
        for (int r = 0; r < 16; ++r) { const int ii = 32 * ti + crow(r, hi);
            const float e = __expf(fminf(gam[ii] - gj, 0.f));
            const float sc = mat == 0 ? beta[ii] : 1.f;
            dbase[ii * dstep] = (jj + strict <= ii) ? sc * acc[r] * e : 0.f; }
    }
    __syncthreads();
    unsigned char* gout = P.ws + WS_GDN + (size_t)(bh * 128 + n) * GDN_CHUNK_BYTES;
    unsigned char* uout = P.ws + WS_UC + (size_t)(bh * 128 + n) * 16384;
    const float glast = gam[63];
    for (int p = tid; p < 2560; p += 512) {
        float v[8]; unsigned char* dst;
        if (p < 1024) {
            const int f = p >> 6, ln = p & 63, rt = f >> 3, kk = f & 7, row = 32 * rt + (ln & 31), hi = ln >> 5;
            const float* src = qs + row * 132 + 16 * kk; const float sc = egam[row];
#pragma unroll
            for (int j = 0; j < 8; ++j) v[j] = src[crow(j, hi)] * sc;
            dst = gout + 16384 + (size_t)p * 16;
        } else if (p < 1536) {
            const int q = p - 1024, f = q >> 6, ln = q & 63, rt = f >> 2, kk = f & 3, row = 32 * rt + (ln & 31), hi = ln >> 5;
#pragma unroll
            for (int j = 0; j < 8; ++j) v[j] = QKd[row * 64 + 16 * kk + crow(j, hi)];
            dst = gout + 32768 + (size_t)q * 16;
        } else {
            const int q = p - 1536, f = q >> 6, ln = q & 63, rt = f >> 2, kk = f & 3, dk = 32 * rt + (ln & 31), hi = ln >> 5;
#pragma unroll
            for (int j = 0; j < 8; ++j) { const int tk = 16 * kk + crow(j, hi); v[j] = ks[tk * 132 + dk] * __expf(fminf(glast - gam[tk], 0.f)); }
            dst = gout + 40960 + (size_t)q * 16;
        }
        u32x4 o; o.x = pk2(v[0], v[1]); o.y = pk2(v[2], v[3]); o.z = pk2(v[4], v[5]); o.w = pk2(v[6], v[7]);
        *(u32x4*)dst = o;
    }
    if (tid == 0) ((float*)(P.ws + WS_CDEC))[bh * 128 + n] = __expf(glast);
    __syncthreads();
    if (tid < 256) {
        float* col = (tid < 128 ? ks : vs) + (tid & 127);
        int zero; asm volatile("v_mov_b32 %0, 0" : "=v"(zero));
#pragma unroll 8
        for (int i = 0; i < 64; ++i) col[i * 132] *= beta[i + zero] * (tid < 128 ? egam[i + zero] : 1.f);
#pragma unroll 1
        for (int ib = 0; ib < 4; ++ib) {
            float acc[16];
#pragma unroll
            for (int r = 0; r < 16; ++r) acc[r] = col[(ib * 16 + r) * 132];
#pragma unroll 4
            for (int j = 0; j < ib * 16; ++j) {
                const float xj = col[j * 132]; const float* mr = Mm + zero + j * 64 + ib * 16;
                const f32x4 m0 = *(const f32x4*)mr, m1 = *(const f32x4*)(mr + 4), m2 = *(const f32x4*)(mr + 8), m3 = *(const f32x4*)(mr + 12);
                acc[0] -= m0.x * xj; acc[1] -= m0.y * xj; acc[2] -= m0.z * xj; acc[3] -= m0.w * xj;
                acc[4] -= m1.x * xj; acc[5] -= m1.y * xj; acc[6] -= m1.z * xj; acc[7] -= m1.w * xj;
                acc[8] -= m2.x * xj; acc[9] -= m2.y * xj; acc[10] -= m2.z * xj; acc[11] -= m2.w * xj;
                acc[12] -= m3.x * xj; acc[13] -= m3.y * xj; acc[14] -= m3.z * xj; acc[15] -= m3.w * xj;
            }
#pragma unroll
            for (int r2 = 0; r2 < 15; ++r2) {
                const float* mr = Mm + (ib * 16 + r2) * 64 + ib * 16; float mm[16];
#pragma unroll
                for (int q = 0; q < 4; ++q) { const f32x4 t4 = *(const f32x4*)(mr + 4 * q); mm[4 * q] = t4.x; mm[4 * q + 1] = t4.y; mm[4 * q + 2] = t4.z; mm[4 * q + 3] = t4.w; }
#pragma unroll
                for (int r = r2 + 1; r < 16; ++r) acc[r] -= mm[r] * acc[r2];
            }
#pragma unroll
            for (int r = 0; r < 16; ++r) col[(ib * 16 + r) * 132] = acc[r];
        }
    }
    __syncthreads();
    for (int p = tid; p < 2048; p += 512) {
        float v[8]; unsigned char* dst;
        if (p < 1024) {
            const int f = p >> 6, ln = p & 63, rt = f >> 3, kk = f & 7, row = 32 * rt + (ln & 31), hi = ln >> 5;
            const float* src = ks + row * 132 + 16 * kk;
#pragma unroll
            for (int j = 0; j < 8; ++j) v[j] = -src[crow(j, hi)];
            dst = gout + (size_t)p * 16;
        } else {
            const int q = p - 1024, half = q & 1, ln = (q >> 1) & 63, g2 = q >> 7, rt = g2 & 1, w4 = g2 >> 1, hi = ln >> 5;
#pragma unroll
            for (int j = 0; j < 8; ++j) v[j] = vs[(32 * rt + crow(8 * half + j, hi)) * 132 + 32 * w4 + (ln & 31)];
            dst = uout + (size_t)q * 16;
        }
        u32x4 o; o.x = pk2(v[0], v[1]); o.y = pk2(v[2], v[3]); o.z = pk2(v[4], v[5]); o.w = pk2(v[6], v[7]);
        *(u32x4*)dst = o;
    }
    __syncthreads();
}

template <int GL, int NB> __device__ __forceinline__ void norm8b(bf16* const (&p)[NB], const bool (&ok)[NB], const float* gain, float mult, float inv_n) {
    u32x4 xv[NB];
#pragma unroll
    for (int b = 0; b < NB; ++b) xv[b] = ok[b] ? *(const u32x4*)p[b] : u32x4{0u, 0u, 0u, 0u};
    const f32x4 g0 = *(const f32x4*)gain, g1 = *(const f32x4*)(gain + 4);
#pragma unroll
    for (int b = 0; b < NB; ++b) {
        float v[8] = {bflo(xv[b].x), bfhi(xv[b].x), bflo(xv[b].y), bfhi(xv[b].y), bflo(xv[b].z), bfhi(xv[b].z), bflo(xv[b].w), bfhi(xv[b].w)};
        float ss = 0.f;
#pragma unroll
        for (int e = 0; e < 8; ++e) ss += v[e] * v[e];
#pragma unroll
        for (int o = 1; o < GL; o <<= 1) ss += __shfl_xor(ss, o);
        const float sc = rsqrtf(ss * inv_n + EPSN) * mult;
        u32x4 o; o.x = pk2(v[0] * sc * g0.x, v[1] * sc * g0.y); o.y = pk2(v[2] * sc * g0.z, v[3] * sc * g0.w);
        o.z = pk2(v[4] * sc * g1.x, v[5] * sc * g1.y); o.w = pk2(v[6] * sc * g1.z, v[7] * sc * g1.w);
        if (ok[b]) *(u32x4*)p[b] = o;
    }
}

__device__ __forceinline__ void phase2(const Params& P, unsigned char* lds, int tid, int lane, int wave) {
    const int G = gridDim.x;
    bf16* proj = (bf16*)(P.ws + WS_PROJ);
    if (blockIdx.x < 16) {
        const int bh = blockIdx.x, b = bh >> 3, h = bh & 7;
        const float* small = (const float*)(P.ws + WS_SMALL);
        float* cum = (float*)(P.ws + WS_CUM) + (size_t)bh * SEQ;
        float* wtot = (float*)lds;
        const float bf = P.fox_b_f[h];
        float v[16]; float run = 0.f;
#pragma unroll
        for (int e = 0; e < 16; ++e) { const float xx = small[((size_t)b * SEQ + tid * 16 + e) * 32 + 16 + h] + bf; run += -softplusf_(-xx) * LOG2E; v[e] = run; }
        float inc = run;
#pragma unroll
        for (int o = 1; o < 64; o <<= 1) { const float t_ = __shfl_up(inc, o); if (lane >= o) inc += t_; }
        if (lane == 63) wtot[wave] = inc;
        { float gq = tid < 128 ? fabsf(P.fox_q_norm[tid]) : 0.f, gk = tid < 128 ? fabsf(P.fox_k_norm[tid]) : 0.f;
#pragma unroll
          for (int o = 1; o < 64; o <<= 1) { gq = fmaxf(gq, __shfl_xor(gq, o)); gk = fmaxf(gk, __shfl_xor(gk, o)); }
          if (lane == 0) { wtot[8 + wave] = gq; wtot[16 + wave] = gk; } }
        __syncthreads();
        if (bh == 0 && tid == 0) { float gq = 0.f, gk = 0.f; for (int w = 0; w < 8; ++w) { gq = fmaxf(gq, wtot[8 + w]); gk = fmaxf(gk, wtot[16 + w]); }
            ((float*)(P.ws + WS_CDEC + 16384))[0] = 150.f + 2.f * 1.03f * (128.f * 0.08838834764831845f * LOG2E) * gq * gk; }
        float off = inc - run;
        for (int w = 0; w < wave; ++w) off += wtot[w];
#pragma unroll
        for (int e = 0; e < 16; ++e) cum[tid * 16 + e] = v[e] + off;
        __syncthreads();
    }
    for (int u = blockIdx.x; u < 2048; u += G) gdn_prep_unit(P, lds, u >> 7, u & 127, tid, lane, wave);
    for (int it0 = blockIdx.x; it0 < TOK / 2; it0 += 4 * G) {
        const int cidx = (tid & 255) * 8, isq = cidx >= 1024, d = cidx & 127;
        bf16* pp[4]; bool ok[4];
#pragma unroll
        for (int b = 0; b < 4; ++b) { const int it = it0 + b * G; ok[b] = it < TOK / 2; pp[b] = proj + (size_t)((ok[b] ? it : 0) * 2 + (tid >> 8)) * LDP + PC_FK + cidx; }
        norm8b<16, 4>(pp, ok, (isq ? P.fox_q_norm : P.fox_k_norm) + d, isq ? 0.08838834764831845f * LOG2E : 1.f, 1.f / 128.f);
    }
    for (int it0 = blockIdx.x; it0 < TOK / 4; it0 += 4 * G) {
        const int cidx = (tid & 127) * 8, d = cidx & 255;
        bf16* pp[4]; bool ok[4];
#pragma unroll
        for (int b = 0; b < 4; ++b) { const int it = it0 + b * G; ok[b] = it < TOK / 4; pp[b] = proj + (size_t)((ok[b] ? it : 0) * 4 + (tid >> 7)) * LDP + PC_QM + cidx; }
        norm8b<32, 4>(pp, ok, P.mem_q_norm + d, 0.0625f * LOG2E, 1.f / 256.f);
    }
    bf16* kmem = (bf16*)(P.ws + WS_KMEM);
    for (int it = blockIdx.x; it < 512 / 4; it += G) {
        const int cidx = (tid & 127) * 8, d = cidx & 255;
        bf16* pp[1] = {kmem + (size_t)(it * 4 + (tid >> 7)) * 1024 + cidx}; const bool ok[1] = {true};
        norm8b<32, 1>(pp, ok, P.mem_k_norm + d, 1.f, 1.f / 256.f);
    }
}

template <int DQK, bool FOX>
__device__ __forceinline__ void attn_unit(unsigned char* lds_, const bf16* Q, int ldq, const bf16* K, int ldk, const bf16* VT, int ldvt, bf16* O, int ldo,
                                          const float* cum, float skip_lim, int t0, int ntiles, int tid, int lane, int wave, int& dbg_tiles, unsigned char* dbg_ws = nullptr) {
    asm volatile("" : "+v"(tid), "+v"(lane));
    constexpr int KS = DQK / 16, KPITCH = DQK * 2 + 16, VPITCH = 136, ND = FOX ? 4 : 2, NH = (DQK / 32) / ND, VCH = ND / 2;
    constexpr int KCH = 64 * DQK / 8 / 512;
    LAS unsigned char* lds = (LAS unsigned char*)lds_;
    LAS unsigned char* Ks = lds; LAS unsigned char* VTs = lds + 64 * KPITCH; LAS float* cbs = (LAS float*)(lds + 64 * KPITCH + 128 * VPITCH);
    const int c = lane & 31, hi = lane >> 5;
    const int qrow = t0 + wave * 32 + c;
    bf16x8 qf[KS];
    { const bf16* qp = Q + (size_t)qrow * ldq + 8 * hi;
#pragma unroll
      for (int k = 0; k < KS; ++k) qf[k] = *(const bf16x8*)(qp + 16 * k); }
    float cref = 0.f; int jmin = 0;
    if (FOX) {
        cref = cum[t0];
        LAS int* jm = (LAS int*)(cbs + 64);
        if (wave < 2) { const int j = wave * 64 + lane; bool need = false; if (j < ntiles) need = (cref - cum[64 * j + 63]) >= -skip_lim;
            const unsigned long long mk = __ballot(need); if (lane == 0) jm[wave] = mk ? (int)__builtin_ctzll(mk) + wave * 64 : (1 << 20); }
        __syncthreads();
        jmin = min(min(jm[0], jm[1]), ntiles - 1);
        jmin = __builtin_amdgcn_readfirstlane(jmin);
    }
    dbg_tiles = 0;
#ifdef PROBE_TS
    if (FOX && dbg_ws && blockIdx.x == 16 && tid == 0) { volatile unsigned long long* dg_ = (volatile unsigned long long*)(dbg_ws + WS_CTL + 32768); dg_[16] += (unsigned long long)(ntiles - jmin) * 375ull; }
#endif
#pragma unroll 1
    for (int half = 0; half < NH; ++half) {
        f32x16 o[ND]; float m = -1e30f, l = 0.f;
#pragma unroll
        for (int d = 0; d < ND; ++d) o[d] = f32x16{};
        constexpr bool PREF = (DQK == 128);
        u32x4 kpre[KCH], vpre[VCH]; float cpre = 0.f;
#define ATT_PREFETCH(j_) do { const int kv0_ = 64 * (j_); \
            _Pragma("unroll") for (int i = 0; i < KCH; ++i) { const int id = tid + 512 * i, row = id / (DQK / 8), cc = id % (DQK / 8); kpre[i] = *(const u32x4*)(K + (size_t)(kv0_ + row) * ldk + cc * 8); } \
            _Pragma("unroll") for (int i = 0; i < VCH; ++i) { const int id = tid + 512 * i, row = id >> 3, cc = id & 7; vpre[i] = *(const u32x4*)(VT + (size_t)(half * ND * 32 + row) * ldvt + kv0_ + cc * 8); } \
            if (FOX) { if (tid < 64) cpre = cum[kv0_ + tid] - cref; } } while (0)
        if (PREF) ATT_PREFETCH(jmin);
#pragma unroll 1
        for (int j = jmin; j < ntiles; ++j) {
            __syncthreads();
            if (!PREF) ATT_PREFETCH(j);
#pragma unroll
            for (int i = 0; i < KCH; ++i) { const int id = tid + 512 * i, row = id / (DQK / 8), cc = id % (DQK / 8); *(LAS u32x4*)(Ks + row * KPITCH + cc * 16) = kpre[i]; }
#pragma unroll
            for (int i = 0; i < VCH; ++i) { const int id = tid + 512 * i, row = id >> 3, cc = id & 7; LAS u32x2* d2 = (LAS u32x2*)(VTs + row * VPITCH + cc * 16);
                d2[0] = (u32x2){vpre[i].x, vpre[i].y}; d2[1] = (u32x2){vpre[i].z, vpre[i].w}; }
            if (FOX) { if (tid < 64) cbs[tid] = cpre; }
            __syncthreads();
            if (PREF && j + 1 < ntiles) ATT_PREFETCH(j + 1);
            const int kv0 = 64 * j;
            if (FOX && kv0 > t0 + wave * 32 + 31) continue;
            f32x16 p0 = f32x16{}, p1 = f32x16{};
            const LAS unsigned char* vb = VTs + c * VPITCH + hi * 8;
            u32x2 vlo[FOX ? 8 : 1], vhh[FOX ? 8 : 1];
            if constexpr (FOX) {
                const LAS unsigned char* kb = Ks + c * KPITCH + hi * 16;
                bf16x8 kf[2 * KS];
#pragma unroll
                for (int k = 0; k < KS; ++k) { kf[2 * k] = *(const LAS bf16x8*)(kb + k * 32); kf[2 * k + 1] = *(const LAS bf16x8*)(kb + 32 * KPITCH + k * 32); }
                __builtin_amdgcn_sched_barrier(0);
#pragma unroll
                for (int k = 0; k < KS; ++k) {
                    p0 = __builtin_amdgcn_mfma_f32_32x32x16_bf16(kf[2 * k], qf[k], p0, 0, 0, 0);
                    p1 = __builtin_amdgcn_mfma_f32_32x32x16_bf16(kf[2 * k + 1], qf[k], p1, 0, 0, 0); }
                __builtin_amdgcn_sched_barrier(0);
#pragma unroll
                for (int d = 0; d < 2; ++d)
#pragma unroll
                    for (int cc = 0; cc < 4; ++cc) { vlo[d * 4 + cc] = *(const LAS u32x2*)(vb + d * 32 * VPITCH + cc * 32); vhh[d * 4 + cc] = *(const LAS u32x2*)(vb + d * 32 * VPITCH + cc * 32 + 16); }
                __builtin_amdgcn_sched_barrier(0);
            } else {
                const LAS unsigned char* kb = Ks + c * KPITCH + hi * 16;
#pragma unroll
                for (int k = 0; k < KS; ++k) {
                    const bf16x8 a0 = *(const LAS bf16x8*)(kb + k * 32), a1 = *(const LAS bf16x8*)(kb + 32 * KPITCH + k * 32);
                    p0 = __builtin_amdgcn_mfma_f32_32x32x16_bf16(a0, qf[k], p0, 0, 0, 0);
                    p1 = __builtin_amdgcn_mfma_f32_32x32x16_bf16(a1, qf[k], p1, 0, 0, 0); }
            }
            if (FOX) {
#pragma unroll
                for (int r4 = 0; r4 < 4; ++r4) { const f32x4 b0 = *(const LAS f32x4*)(cbs + 8 * r4 + 4 * hi), b1 = *(const LAS f32x4*)(cbs + 32 + 8 * r4 + 4 * hi);
#pragma unroll
                    for (int e = 0; e < 4; ++e) { p0[4 * r4 + e] -= b0[e]; p1[4 * r4 + e] -= b1[e]; } }
                if (kv0 + 63 > t0 + wave * 32) {
#pragma unroll
                    for (int r = 0; r < 16; ++r) { const int kv = kv0 + crow(r, hi); if (kv > qrow) p0[r] = -INFINITY; if (kv + 32 > qrow) p1[r] = -INFINITY; }
                }
            }
            float mx = p0[0];
#pragma unroll
            for (int r = 1; r < 16; ++r) mx = fmaxf(mx, p0[r]);
#pragma unroll
            for (int r = 0; r < 16; ++r) mx = fmaxf(mx, p1[r]);
            mx = fmaxf(mx, __shfl_xor(mx, 32));
            const float mn = fmaxf(m, mx), alpha = __builtin_amdgcn_exp2f(m - mn); m = mn;
            float ps = 0.f;
#pragma unroll
            for (int r = 0; r < 16; ++r) { p0[r] = __builtin_amdgcn_exp2f(p0[r] - mn); p1[r] = __builtin_amdgcn_exp2f(p1[r] - mn); ps += p0[r] + p1[r]; }
            l = l * alpha + ps;
#pragma unroll
            for (int d = 0; d < ND; ++d)
#pragma unroll
                for (int r = 0; r < 16; ++r) o[d][r] *= alpha;
            bf16x8 pb[4];
#pragma unroll
            for (int cc = 0; cc < 4; ++cc) { u32x4 w;
                if (cc < 2) { w.x = pk2(p0[8 * cc + 0], p0[8 * cc + 1]); w.y = pk2(p0[8 * cc + 2], p0[8 * cc + 3]); w.z = pk2(p0[8 * cc + 4], p0[8 * cc + 5]); w.w = pk2(p0[8 * cc + 6], p0[8 * cc + 7]); }
                else { const int c2 = cc - 2; w.x = pk2(p1[8 * c2 + 0], p1[8 * c2 + 1]); w.y = pk2(p1[8 * c2 + 2], p1[8 * c2 + 3]); w.z = pk2(p1[8 * c2 + 4], p1[8 * c2 + 5]); w.w = pk2(p1[8 * c2 + 6], p1[8 * c2 + 7]); }
                pb[cc] = __builtin_bit_cast(bf16x8, w); }
            if constexpr (FOX) {
                u32x2 wlo[8], whh[8];
#pragma unroll
                for (int d = 0; d < 2; ++d)
#pragma unroll
                    for (int cc = 0; cc < 4; ++cc) { wlo[d * 4 + cc] = *(const LAS u32x2*)(vb + (d + 2) * 32 * VPITCH + cc * 32); whh[d * 4 + cc] = *(const LAS u32x2*)(vb + (d + 2) * 32 * VPITCH + cc * 32 + 16); }
                __builtin_amdgcn_sched_barrier(0);
#pragma unroll
                for (int cc = 0; cc < 4; ++cc)
#pragma unroll
                    for (int d = 0; d < 2; ++d) { const u32x4 av = (u32x4){vlo[d * 4 + cc].x, vlo[d * 4 + cc].y, vhh[d * 4 + cc].x, vhh[d * 4 + cc].y};
                        o[d] = __builtin_amdgcn_mfma_f32_32x32x16_bf16(__builtin_bit_cast(bf16x8, av), pb[cc], o[d], 0, 0, 0); }
                __builtin_amdgcn_sched_barrier(0);
#pragma unroll
                for (int cc = 0; cc < 4; ++cc)
#pragma unroll
                    for (int d = 0; d < 2; ++d) { const u32x4 av = (u32x4){wlo[d * 4 + cc].x, wlo[d * 4 + cc].y, whh[d * 4 + cc].x, whh[d * 4 + cc].y};
                        o[d + 2] = __builtin_amdgcn_mfma_f32_32x32x16_bf16(__builtin_bit_cast(bf16x8, av), pb[cc], o[d + 2], 0, 0, 0); }
            } else {
#pragma unroll
              for (int d = 0; d < ND; ++d)
#pragma unroll
                  for (int cc = 0; cc < 4; ++cc) {
                      const u32x2 lo = *(const LAS u32x2*)(vb + d * 32 * VPITCH + cc * 32), hh = *(const LAS u32x2*)(vb + d * 32 * VPITCH + cc * 32 + 16);
                      const u32x4 av = (u32x4){lo.x, lo.y, hh.x, hh.y};
                      o[d] = __builtin_amdgcn_mfma_f32_32x32x16_bf16(__builtin_bit_cast(bf16x8, av), pb[cc], o[d], 0, 0, 0); } }
        }
        l += __shfl_xor(l, 32);
        const float rl = 1.f / l;
        bf16* op = O + (size_t)qrow * ldo + half * ND * 32 + 4 * hi;
#pragma unroll
        for (int d = 0; d < ND; ++d)
#pragma unroll
            for (int r4 = 0; r4 < 4; ++r4) { u32x2 w; w.x = pk2(o[d][4 * r4 + 0] * rl, o[d][4 * r4 + 1] * rl); w.y = pk2(o[d][4 * r4 + 2] * rl, o[d][4 * r4 + 3] * rl);
                *(u32x2*)(op + 32 * d + 8 * r4) = w; }
    }
    __syncthreads();
}

__device__ __forceinline__ void gdn_scan_wg(const Params& P, unsigned char* lds_, int unit, int tid, int lane, int wave) {
    const int bh = unit >> 2, quart = unit & 3;
    LAS unsigned char* lds = (LAS unsigned char*)lds_;
    const int b = bh >> 3, h = bh & 7;
    const unsigned char* gsrc = P.ws + WS_GDN + (size_t)bh * 128 * GDN_CHUNK_BYTES;
    const unsigned char* usrc = P.ws + WS_UC + (size_t)bh * 128 * 16384;
    const float* cdec = (const float*)(P.ws + WS_CDEC) + bh * 128;
    bf16* proj = (bf16*)(P.ws + WS_PROJ);
#define SCAN_BAR() asm volatile("s_waitcnt lgkmcnt(0)\n\ts_barrier" ::: "memory")
    constexpr int OB = 114688;
    if (wave >= 4) {
        const int lt = tid - 256, tk = lt >> 2, q4 = lt & 3;
        const size_t rowb = (size_t)b * SEQ + tk;
        bf16* obase = proj + rowb * LDP + PC_OA + h * 128 + q4 * 32;
        u32x4 r[14];
#pragma unroll
        for (int k = 0; k < 14; ++k) r[k] = *(const u32x4*)(gsrc + (size_t)(lt + 256 * k) * 16);
#pragma unroll
        for (int k = 0; k < 14; ++k) *(LAS u32x4*)(lds + (lt + 256 * k) * 16) = r[k];
#pragma unroll
        for (int k = 0; k < 14; ++k) r[k] = *(const u32x4*)(gsrc + (size_t)GDN_CHUNK_BYTES + (size_t)(lt + 256 * k) * 16);
        __syncthreads();
#define GDN_NORM(CH) do { if (q4 == quart) { const LAS unsigned char* ob_ = lds + OB + ((CH) & 1) * 16384 + tk * 256 + q4 * 64; bf16* op_ = obase + (size_t)(CH) * 64 * LDP; \
            _Pragma("unroll") for (int i = 0; i < 4; ++i) { const u32x4 w_ = *(const LAS u32x4*)(ob_ + i * 16); *(u32x4*)(op_ + 8 * i) = w_; } } } while (0)
#pragma unroll 1
        for (int n = 0; n < 128; ++n) {
            if (n + 1 < 128) {
                LAS unsigned char* d = lds + ((n + 1) & 1) * GDN_CHUNK_BYTES;
#pragma unroll
                for (int k = 0; k < 14; ++k) *(LAS u32x4*)(d + (lt + 256 * k) * 16) = r[k];
            }
            if (n + 2 < 128) {
                const unsigned char* s2 = gsrc + (size_t)(n + 2) * GDN_CHUNK_BYTES;
#pragma unroll
                for (int k = 0; k < 14; ++k) r[k] = *(const u32x4*)(s2 + (size_t)(lt + 256 * k) * 16);
            }
            if (n > 0) GDN_NORM(n - 1);
            SCAN_BAR();
        }
        GDN_NORM(127);
#undef GDN_NORM
    } else if (wave >= 1) {
        __syncthreads();
#pragma unroll 1
        for (int n = 0; n < 128; ++n) SCAN_BAR();
    } else {
        const int w4 = quart, c = lane & 31, hi = lane >> 5;
        f32x16 S[4];
#pragma unroll
        for (int t = 0; t < 4; ++t) S[t] = f32x16{};
        bf16x8 Sb[8];
#pragma unroll
        for (int k = 0; k < 8; ++k) Sb[k] = bf16x8{};
        u32x4 ucn[4];
#pragma unroll
        for (int i = 0; i < 4; ++i) ucn[i] = *(const u32x4*)(usrc + (size_t)((w4 * 2 + (i >> 1)) * 64 + lane) * 32 + (i & 1) * 16);
        float cdn = cdec[0];
        __syncthreads();
#pragma unroll 1
        for (int n = 0; n < 128; ++n) {
            const LAS unsigned char* fb = lds + (n & 1) * GDN_CHUNK_BYTES + lane * 16;
            f32x16 U[2];
#pragma unroll
            for (int rt = 0; rt < 2; ++rt) { const u32x4 a = ucn[2 * rt], bq = ucn[2 * rt + 1];
                U[rt][0] = bflo(a.x); U[rt][1] = bfhi(a.x); U[rt][2] = bflo(a.y); U[rt][3] = bfhi(a.y); U[rt][4] = bflo(a.z); U[rt][5] = bfhi(a.z); U[rt][6] = bflo(a.w); U[rt][7] = bfhi(a.w);
                U[rt][8] = bflo(bq.x); U[rt][9] = bfhi(bq.x); U[rt][10] = bflo(bq.y); U[rt][11] = bfhi(bq.y); U[rt][12] = bflo(bq.z); U[rt][13] = bfhi(bq.z); U[rt][14] = bflo(bq.w); U[rt][15] = bfhi(bq.w); }
            const float cd = cdn;
            if (n + 1 < 128) {
                const unsigned char* us = usrc + (size_t)(n + 1) * 16384;
#pragma unroll
                for (int i = 0; i < 4; ++i) ucn[i] = *(const u32x4*)(us + (size_t)((w4 * 2 + (i >> 1)) * 64 + lane) * 32 + (i & 1) * 16);
                cdn = cdec[n + 1];
            }
#define FRAG(off) (*(const LAS bf16x8*)(fb + (off)))
#define SBAR() __builtin_amdgcn_sched_barrier(0)
            bf16x8 A0[8], A1[8];
#pragma unroll
            for (int i = 0; i < 8; ++i) A0[i] = FRAG(((i & 1) * 8 + (i >> 1)) * 1024);
            SBAR();
#pragma unroll
            for (int i = 0; i < 8; ++i) A1[i] = FRAG(((i & 1) * 8 + 4 + (i >> 1)) * 1024);
            SBAR();
#pragma unroll
            for (int i = 0; i < 8; ++i) U[i & 1] = __builtin_amdgcn_mfma_f32_32x32x16_bf16(A0[i], Sb[i >> 1], U[i & 1], 0, 0, 0);
            SBAR();
#pragma unroll
            for (int i = 0; i < 8; ++i) A0[i] = FRAG(16384 + ((i & 1) * 8 + (i >> 1)) * 1024);
            SBAR();
#pragma unroll
            for (int i = 0; i < 8; ++i) U[i & 1] = __builtin_amdgcn_mfma_f32_32x32x16_bf16(A1[i], Sb[4 + (i >> 1)], U[i & 1], 0, 0, 0);
            SBAR();
#pragma unroll
            for (int i = 0; i < 8; ++i) A1[i] = FRAG(16384 + ((i & 1) * 8 + 4 + (i >> 1)) * 1024);
            SBAR();
            f32x16 Ov[2]; Ov[0] = f32x16{}; Ov[1] = f32x16{};
#pragma unroll
            for (int i = 0; i < 8; ++i) Ov[i & 1] = __builtin_amdgcn_mfma_f32_32x32x16_bf16(A0[i], Sb[i >> 1], Ov[i & 1], 0, 0, 0);
            SBAR();
#pragma unroll
            for (int i = 0; i < 8; ++i) A0[i] = FRAG(32768 + ((i & 1) * 4 + (i >> 1)) * 1024);
            SBAR();
#pragma unroll
            for (int i = 0; i < 8; ++i) Ov[i & 1] = __builtin_amdgcn_mfma_f32_32x32x16_bf16(A1[i], Sb[4 + (i >> 1)], Ov[i & 1], 0, 0, 0);
            SBAR();
            bf16x8 Ub[4];
#pragma unroll
            for (int k2 = 0; k2 < 4; ++k2) { const f32x16& uu = U[k2 >> 1]; const int o8 = 8 * (k2 & 1); u32x4 w;
                w.x = pk2(uu[o8 + 0], uu[o8 + 1]); w.y = pk2(uu[o8 + 2], uu[o8 + 3]); w.z = pk2(uu[o8 + 4], uu[o8 + 5]); w.w = pk2(uu[o8 + 6], uu[o8 + 7]); Ub[k2] = __builtin_bit_cast(bf16x8, w); }
#pragma unroll
            for (int i = 0; i < 8; ++i) A1[i] = FRAG(40960 + ((i & 3) * 4 + (i >> 2)) * 1024);
            SBAR();
#pragma unroll
            for (int i = 0; i < 8; ++i) Ov[i & 1] = __builtin_amdgcn_mfma_f32_32x32x16_bf16(A0[i], Ub[i >> 1], Ov[i & 1], 0, 0, 0);
            SBAR();
#pragma unroll
            for (int i = 0; i < 8; ++i) A0[i] = FRAG(40960 + ((i & 3) * 4 + 2 + (i >> 2)) * 1024);
            SBAR();
#pragma unroll
            for (int t = 0; t < 4; ++t)
#pragma unroll
                for (int r = 0; r < 16; ++r) S[t][r] *= cd;
#pragma unroll
            for (int i = 0; i < 8; ++i) S[i & 3] = __builtin_amdgcn_mfma_f32_32x32x16_bf16(A1[i], Ub[i >> 2], S[i & 3], 0, 0, 0);
            SBAR();
#pragma unroll
            for (int i = 0; i < 8; ++i) S[i & 3] = __builtin_amdgcn_mfma_f32_32x32x16_bf16(A0[i], Ub[2 + (i >> 2)], S[i & 3], 0, 0, 0);
            SBAR();
            { LAS bf16* ob = (LAS bf16*)(lds + OB + (n & 1) * 16384);
#pragma unroll
              for (int rt = 0; rt < 2; ++rt)
#pragma unroll
                  for (int r = 0; r < 16; ++r) ob[(32 * rt + crow(r, hi)) * 128 + 32 * w4 + c] = (bf16)(pk2(Ov[rt][r], 0.f) & 0xffffu); }
#pragma unroll
            for (int k = 0; k < 8; ++k) { const f32x16& ss = S[k >> 1]; const int o8 = 8 * (k & 1); u32x4 w;
                w.x = pk2(ss[o8 + 0], ss[o8 + 1]); w.y = pk2(ss[o8 + 2], ss[o8 + 3]); w.z = pk2(ss[o8 + 4], ss[o8 + 5]); w.w = pk2(ss[o8 + 6], ss[o8 + 7]); Sb[k] = __builtin_bit_cast(bf16x8, w); }
#undef FRAG
#undef SBAR
            SCAN_BAR();
        }
    }
    __syncthreads();
}

__device__ __forceinline__ void phase3(const Params& P, unsigned char* lds, int tid, int lane, int wave) {
    bf16* proj = (bf16*)(P.ws + WS_PROJ);
#ifndef NO_SCAN
    if (blockIdx.x < 64) gdn_scan_wg(P, lds, blockIdx.x, tid, lane, wave);
#endif
#ifdef PROBE_TS
    if (blockIdx.x == 0 && tid == 0) ((volatile unsigned long long*)(P.ws + WS_CTL + 32768))[10] = __builtin_amdgcn_s_memrealtime();
#endif
    unsigned* ctr = (unsigned*)(P.ws + WS_CTL);
    LAS unsigned* sh = (LAS unsigned*)((LAS unsigned char*)lds + LDS_BYTES - 64);
    const bf16* foxvt = (const bf16*)((const unsigned char*)P.out + DO_FOXVT);
    const float* cum = (const float*)(P.ws + WS_CUM);
    const bf16* kmem = (const bf16*)(P.ws + WS_KMEM); const bf16* vmt = (const bf16*)(P.ws + WS_VMT);
#ifdef STATIC_P3
    for (unsigned idx_ = (blockIdx.x < 16 ? 100000u : blockIdx.x - 16u); idx_ < 768u; idx_ += 240u) {
        const unsigned idx = __builtin_amdgcn_readfirstlane(idx_);
#else
    for (;;) {
        if (tid == 0) sh[0] = atomicAdd(ctr, 1u);
        __syncthreads();
        const unsigned idx = __builtin_amdgcn_readfirstlane(sh[0]);
        __syncthreads();
        if (idx >= 512u + 256u) break;
#endif
        int dbg_t = 0;
#ifdef PROBE_TS
        if (blockIdx.x == 16 && tid == 0) ((volatile unsigned long long*)(P.ws + WS_CTL + 32768))[20] = __builtin_amdgcn_s_memrealtime();
#endif
        if (idx < 512u) {
#ifndef NO_FOXATT
            const int qb = 31 - (int)(idx >> 4), bh = idx & 15, b = bh >> 3, h = bh & 7;
            bf16* Qp = proj + (size_t)b * SEQ * LDP + PC_FQ + h * 128;
            const bf16* Kp = proj + (size_t)b * SEQ * LDP + PC_FK + h * 128;
            const bf16* Vp = foxvt + (size_t)(h * 128) * TOK + (size_t)b * SEQ;
            attn_unit<128, true>(lds, Qp, LDP, Kp, LDP, Vp, TOK, Qp, LDP, cum + (size_t)bh * SEQ, ((const float*)(P.ws + WS_CDEC + 16384))[0], qb * 256, (qb + 1) * 4, tid, lane, wave, dbg_t, P.ws);
#ifdef PROBE_TS
            if (blockIdx.x == 16 && tid == 0) { volatile unsigned long long* dg = (volatile unsigned long long*)(P.ws + WS_CTL + 32768); dg[14] += __builtin_amdgcn_s_memrealtime() - dg[20]; }
#endif
#endif
        } else {
#ifndef NO_MEMATT
            const int u = idx - 512, qb = u & 31, bh = u >> 5, b = bh >> 2, h = bh & 3;
            bf16* Qp = proj + (size_t)b * SEQ * LDP + PC_QM + h * 256;
            const bf16* Kp = kmem + (size_t)b * 256 * 1024 + h * 256;
            const bf16* Vp = vmt + (size_t)(h * 256) * 512 + b * 256;
            attn_unit<256, false>(lds, Qp, LDP, Kp, 1024, Vp, 512, Qp, LDP, nullptr, 0.f, qb * 256, 4, tid, lane, wave, dbg_t);
#ifdef PROBE_TS
            if (blockIdx.x == 16 && tid == 0) { volatile unsigned long long* dg = (volatile unsigned long long*)(P.ws + WS_CTL + 32768); dg[18] += __builtin_amdgcn_s_memrealtime() - dg[20]; }
#endif
#endif
        }
    }
#ifdef PROBE_TS
    if (blockIdx.x == 0 && tid == 0) ((volatile unsigned long long*)(P.ws + WS_CTL + 32768))[11] = __builtin_amdgcn_s_memrealtime();
#endif
}


__device__ __forceinline__ void gdn_gate_norm_pass(const Params& P, int tid) {
    bf16* proj = (bf16*)(P.ws + WS_PROJ);
    const int cidx = (tid & 127) * 8, d = cidx & 127;
    const f32x4 g0 = *(const f32x4*)(P.gdn_norm_g + d), g1 = *(const f32x4*)(P.gdn_norm_g + d + 4);
    const float gg[8] = {g0.x, g0.y, g0.z, g0.w, g1.x, g1.y, g1.z, g1.w};
    for (int it0 = blockIdx.x; it0 < TOK / 4; it0 += 4 * gridDim.x) {
        u32x4 ov[4], zv[4]; bool ok[4]; bf16* op[4];
#pragma unroll
        for (int b = 0; b < 4; ++b) { const int it = it0 + b * gridDim.x; ok[b] = it < TOK / 4; const size_t row = (size_t)((ok[b] ? it : 0) * 4 + (tid >> 7));
            op[b] = proj + row * LDP + PC_OA + cidx; ov[b] = *(const u32x4*)op[b]; zv[b] = *(const u32x4*)(proj + row * LDP + PC_Z + cidx); }
#pragma unroll
        for (int b = 0; b < 4; ++b) {
            const float v[8] = {bflo(ov[b].x), bfhi(ov[b].x), bflo(ov[b].y), bfhi(ov[b].y), bflo(ov[b].z), bfhi(ov[b].z), bflo(ov[b].w), bfhi(ov[b].w)};
            const float z[8] = {bflo(zv[b].x), bfhi(zv[b].x), bflo(zv[b].y), bfhi(zv[b].y), bflo(zv[b].z), bfhi(zv[b].z), bflo(zv[b].w), bfhi(zv[b].w)};
            float ss = 0.f;
#pragma unroll
            for (int e = 0; e < 8; ++e) ss += v[e] * v[e];
            ss += __shfl_xor(ss, 1); ss += __shfl_xor(ss, 2); ss += __shfl_xor(ss, 4); ss += __shfl_xor(ss, 8);
            const float rstd = rsqrtf(ss * (1.f / 128.f) + EPSN);
            float o[8];
#pragma unroll
            for (int e = 0; e < 8; ++e) o[e] = v[e] * rstd * gg[e] * (z[e] * __builtin_amdgcn_rcpf(1.f + __builtin_amdgcn_exp2f(-LOG2E * z[e])));
            u32x4 w; w.x = pk2(o[0], o[1]); w.y = pk2(o[2], o[3]); w.z = pk2(o[4], o[5]); w.w = pk2(o[6], o[7]);
            if (ok[b]) *(u32x4*)op[b] = w;
        }
    }
}

#define RLX_AGENT __ATOMIC_RELAXED, __HIP_MEMORY_SCOPE_AGENT
#define XB_TMO      128
#define XB_XCNT(j)  (256  + 64 * (j))
#define XB_XSUB(j)  (1280 + 64 * (j))
#define XB_XGEN(j)  (2304 + 64 * (j))
#define XB_TOP      3328
#define XB_TOPGEN   3392
#define XCD_BAR_WORDS 3456
#define XB_SPIN_CAP (1u << 22)

__device__ __forceinline__ unsigned xb_ld(unsigned* p)              { return __hip_atomic_load(p, __ATOMIC_RELAXED, __HIP_MEMORY_SCOPE_AGENT); }
__device__ __forceinline__ unsigned xb_add(unsigned* p, unsigned v) { return __hip_atomic_fetch_add(p, v, __ATOMIC_RELAXED, __HIP_MEMORY_SCOPE_AGENT); }
__device__ __forceinline__ unsigned xb_xcc_id() { return (unsigned)__builtin_amdgcn_s_getreg((3 << 11) | 20) & 0xFu; }
#define XB_SPIN(cond, bar) do { unsigned _sp = 0; while (cond) { __builtin_amdgcn_s_sleep(1); \
    if ((++_sp & 255u) == 0u) { if (xb_ld(&(bar)[XB_TMO])) break; if (_sp > XB_SPIN_CAP) { atomicAdd(&(bar)[XB_TMO], 1u); break; } } } } while (0)

struct XcdBarrier {
    unsigned* bar; unsigned x;
    volatile LAS unsigned* st;
};

__device__ __forceinline__ XcdBarrier xcd_barrier_post(unsigned* bar, volatile LAS unsigned* st) {
    XcdBarrier b; b.bar = bar; b.x = xb_xcc_id(); b.st = st;
    if (threadIdx.x == 0) (void)xb_add(&bar[XB_XCNT(b.x)], 1u);
    return b;
}
__device__ __forceinline__ void xcd_barrier_complete(unsigned* bar, unsigned x, unsigned& nloc, unsigned& nx) {
    const unsigned G = gridDim.x * gridDim.y * gridDim.z;
    unsigned sum, cnt, mine, sp = 0u;
    for (;;) {
        sum = 0u; cnt = 0u; mine = 0u;
#pragma unroll
        for (unsigned j = 0; j < 16; ++j) { const unsigned c = xb_ld(&bar[XB_XCNT(j)]); sum += c; cnt += (c > 0u) ? 1u : 0u; mine = (j == x) ? c : mine; }
        if (sum == G) break;
        __builtin_amdgcn_s_sleep(1);
        if ((++sp & 255u) == 0u) { if (xb_ld(&bar[XB_TMO])) break; if (sp > XB_SPIN_CAP) { atomicAdd(&bar[XB_TMO], 1u); break; } }
    }
    nloc = mine > 0u ? mine : 1u; nx = cnt > 0u ? cnt : 1u;
}

__device__ __forceinline__ void xcd_barrier(const XcdBarrier& b) {
    asm volatile("s_waitcnt vmcnt(0)" ::: "memory");
    __syncthreads();
    if (threadIdx.x == 0) {
        unsigned* bar = b.bar;
        __builtin_amdgcn_s_waitcnt(0);
        unsigned nloc = b.st[0], nx = b.st[1];
        if (nloc == 0u) { xcd_barrier_complete(bar, b.x, nloc, nx); b.st[0] = nloc; b.st[1] = nx; }
        const unsigned old = xb_add(&bar[XB_XSUB(b.x)], 1u);
        const unsigned gen = old / nloc;
        if (old + 1u == (gen + 1u) * nloc) {
            __builtin_amdgcn_fence(__ATOMIC_RELEASE, "agent");
            asm volatile("s_waitcnt vmcnt(0)" ::: "memory");
            const unsigned og = xb_add(&bar[XB_TOP], 1u);
            const unsigned tg = og / nx;
            if (og + 1u == (tg + 1u) * nx) xb_add(&bar[XB_TOPGEN], 1u);
            else XB_SPIN(xb_ld(&bar[XB_TOPGEN]) == tg, bar);
            __builtin_amdgcn_fence(__ATOMIC_ACQUIRE, "agent");
            xb_add(&bar[XB_XGEN(b.x)], 1u);
            asm volatile("s_waitcnt vmcnt(0)" ::: "memory");
        } else {
            XB_SPIN(xb_ld(&bar[XB_XGEN(b.x)]) == gen, bar);
            __builtin_amdgcn_fence(__ATOMIC_ACQUIRE, "agent");
            asm volatile("s_waitcnt vmcnt(0)" ::: "memory");
        }
    }
    __syncthreads();
}

__global__ void __launch_bounds__(512, 2) hybrid_fwd(Params P) {
    extern __shared__ __attribute__((aligned(16))) unsigned char lds[];
    cg::grid_group grid = cg::this_grid();
    const int tid = threadIdx.x, lane = tid & 63, wave = __builtin_amdgcn_readfirstlane(tid >> 6);
    const int G = gridDim.x, cb = blockIdx.x;
    unsigned char* ws = P.ws;
    LAS unsigned char* glds = (LAS unsigned char*)lds;
    bf16* H = (bf16*)((unsigned char*)P.out + DO_H);
    bf16* proj = (bf16*)(ws + WS_PROJ);
    volatile LAS unsigned* bst = (volatile LAS unsigned*)(glds + LDS_BYTES - 32);
    if (tid < 2) bst[tid] = 0u;
    __syncthreads();
    XcdBarrier bar = xcd_barrier_post((unsigned*)(ws + WS_CTL) + 1024, bst);
#ifdef PROBE_TS
    volatile unsigned long long* tsg_ = (volatile unsigned long long*)(ws + WS_CTL + 32768);
    if (blockIdx.x == 0 && tid == 0) tsg_[0] = __builtin_amdgcn_s_memrealtime();
#endif
    grid.sync();
#ifdef PROBE_TS
#define GRID_BAR(k_) do { xcd_barrier(bar); if (blockIdx.x == 0 && tid == 0) tsg_[k_] = __builtin_amdgcn_s_memrealtime(); } while (0)
#else
#define GRID_BAR(k_) xcd_barrier(bar)
#endif

#ifndef NO_P0
    phase0(P, lds, tid, lane, wave);
#endif
    GRID_BAR(1);
#ifndef NO_GEMM
    {
        pg8::Gemm g{H, (const bf16*)(ws + WS_W1T), TOK, 7424, 2048, 2048, 2048}; pg8::StaticOrder S; S.init(TOK, 7424, G, cb);
        pg8::EpiProj E{proj, LDP, (float*)(ws + WS_SMALL)};
        pg8::gemm_phase<pg8::EpiProj, pg8::StaticOrder, true, true>(glds, g, S, E);
    }
    {
        pg8::Gemm g{(const bf16*)(ws + WS_WFVT), H, 1024, TOK, 2048, 2048, 2048}; pg8::StaticOrder S; S.init(1024, TOK, G, cb);
        pg8::EpiStore E{(bf16*)((unsigned char*)P.out + DO_FOXVT), TOK};
        pg8::gemm_phase<pg8::EpiStore, pg8::StaticOrder, true, true>(glds, g, S, E);
    }
    {
        const int cr = (cb + G - 64) % G;
        pg8::Gemm g{(const bf16*)(ws + WS_MEMN), (const bf16*)(ws + WS_WMKVT), 512, 1024, 2048, 2048, 2048}; pg8::StaticOrder S; S.init(512, 1024, G, cr);
        pg8::EpiStore E{(bf16*)(ws + WS_KMEM), 1024};
        pg8::gemm_phase<pg8::EpiStore, pg8::StaticOrder, true, true>(glds, g, S, E);
        const int cr2 = (cb + G - 72) % G;
        pg8::Gemm g2{(const bf16*)(ws + WS_WMKVT) + (size_t)1024 * 2048, (const bf16*)(ws + WS_MEMN), 1024, 512, 2048, 2048, 2048}; pg8::StaticOrder S2; S2.init(1024, 512, G, cr2);
        pg8::EpiStore E2{(bf16*)(ws + WS_VMT), 512};
        pg8::gemm_phase<pg8::EpiStore, pg8::StaticOrder, true, true>(glds, g2, S2, E2);
    }
#endif
    GRID_BAR(2);
#ifndef NO_P2
    phase2(P, lds, tid, lane, wave);
#endif
    GRID_BAR(3);
#ifndef NO_P3
    phase3(P, lds, tid, lane, wave);
#endif
    GRID_BAR(4);
#ifndef NO_GEMM
    gdn_gate_norm_pass(P, tid);
    {
        pg8::Gemm g{H, (const bf16*)(ws + WS_WGT), TOK, 6144, 2048, 2048, 2048}; pg8::StaticOrder S; S.init(TOK, 6144, G, cb);
        pg8::EpiSig E{(unsigned char*)P.out + DO_GA, (unsigned char*)(proj + PC_GB), 2048, LDP * 2};
        pg8::gemm_phase<pg8::EpiSig, pg8::StaticOrder, true, true>(glds, g, S, E);
    }
    GRID_BAR(5);
    {
        bf16* Y = (bf16*)(ws + WS_Y); const bf16* WUPT = (const bf16*)(ws + WS_WUPT);
        pg8::StaticOrder S; S.init(TOK, 2048, G, cb);
        { pg8::Gemm g{proj + PC_OA, WUPT, TOK, 2048, 1024, LDP, 1024}; pg8::EpiGate<true> E{(const unsigned char*)P.out + DO_GA, 2048, Y, 2048};
          pg8::gemm_phase<pg8::EpiGate<true>, pg8::StaticOrder, true, true>(glds, g, S, E); }
        { pg8::Gemm g{proj + PC_OB, WUPT + (size_t)2048 * 1024, TOK, 2048, 1024, LDP, 1024}; pg8::EpiGate<false> E{(const unsigned char*)(proj + PC_GB), LDP * 2, Y, 2048};
          pg8::gemm_phase<pg8::EpiGate<false>, pg8::StaticOrder, true, true>(glds, g, S, E); }
        { pg8::Gemm g{proj + PC_OM, WUPT + (size_t)2 * 2048 * 1024, TOK, 2048, 1024, LDP, 1024}; pg8::EpiGate<false> E{(const unsigned char*)(proj + PC_GB) + 2048, LDP * 2, Y, 2048};
          pg8::gemm_phase<pg8::EpiGate<false>, pg8::StaticOrder, true, true>(glds, g, S, E); }
    }
    GRID_BAR(6);
    {
        pg8::Gemm g{(const bf16*)(ws + WS_Y), (const bf16*)(ws + WS_WOT), TOK, 2048, 2048, 2048, 2048}; pg8::StaticOrder S; S.init(TOK, 2048, G, cb);
        pg8::EpiRes1 E{P.x, (bf16*)(ws + WS_X1B), (float*)(ws + WS_SSQ)};
        pg8::gemm_phase<pg8::EpiRes1, pg8::StaticOrder, true, true>(glds, g, S, E);
    }
    GRID_BAR(7);
    {
        const float* SSQ = (const float*)(ws + WS_SSQ); float* RSTD = (float*)(ws + WS_RSTD);
        const int g = cb * 512 + tid;
        if (g < TOK * 8) { const int row = g >> 3, part = g & 7; float sq = 0.f;
#pragma unroll
            for (int q = 0; q < 4; ++q) sq += SSQ[(size_t)(part * 4 + q) * 16384 + row];
            sq += __shfl_xor(sq, 1); sq += __shfl_xor(sq, 2); sq += __shfl_xor(sq, 4);
            if (part == 0) RSTD[row] = rsqrtf(sq * (1.f / 2048.f) + 1e-6f); }
    }
    GRID_BAR(8);
    {
        pg8::Gemm g{(const bf16*)(ws + WS_X1B), (const bf16*)(ws + WS_WFF1T), TOK, 8192, 2048, 2048, 2048}; pg8::StaticOrder S; S.init(TOK, 8192, G, cb);
        pg8::EpiFF1 E{(const float*)(ws + WS_RSTD), (bf16*)(ws + WS_U), 8192};
        pg8::gemm_phase<pg8::EpiFF1, pg8::StaticOrder, true, true>(glds, g, S, E);
    }
    GRID_BAR(9);
    {
        pg8::Gemm g{(const bf16*)(ws + WS_U), (const bf16*)(ws + WS_WFF2T), TOK, 2048, 8192, 8192, 8192}; pg8::StaticOrder S; S.init(TOK, 2048, G, cb, 4);
        pg8::EpiOut E{(const bf16*)(ws + WS_X1B), P.out};
        pg8::gemm_phase<pg8::EpiOut, pg8::StaticOrder, true, true>(glds, g, S, E);
    }
#endif
#ifdef PROBE_TS
    if (blockIdx.x == 0 && tid == 0) {
        const unsigned long long tend = __builtin_amdgcn_s_memrealtime();
        tsg_[12] = tend;
        long long qa = ((long long)(tsg_[PROBE_A1] - tsg_[PROBE_A0]) + 1500) / 3000; if (qa > 35) qa = 35;
        long long qb = ((long long)(tsg_[PROBE_B1] - tsg_[PROBE_B0]) + 1500) / 3000; if (qb > 35) qb = 35;
        long long qc = ((long long)(tsg_[PROBE_C1] - tsg_[PROBE_C0]) + 1500) / 3000; if (qc > 35) qc = 35;
        const unsigned long long until = tend + (unsigned long long)(qa + 36 * qb + 1296 * qc) * 2000ull;
        while (__builtin_amdgcn_s_memrealtime() < until) __builtin_amdgcn_s_sleep(8);
    }
#endif
}

extern "C" void kernel_launch(void* const* d_in, const int* in_sizes, int n_in, void* d_out, int out_size, void* d_ws, size_t ws_size, hipStream_t stream) {
    static int grid = 0;
    if (grid == 0) {
        if (n_in != 22 || out_size != TOK * DM || ws_size < WS_END) { fprintf(stderr, "kernel_launch: unexpected shapes (n_in %d out %d ws %zu)\n", n_in, out_size, ws_size); grid = -1; return; }
        int dev = 0, cus = 0, per_cu = 0;
        hipGetDevice(&dev); hipDeviceGetAttribute(&cus, hipDeviceAttributeMultiprocessorCount, dev);
        if (hipFuncSetAttribute((const void*)hybrid_fwd, hipFuncAttributeMaxDynamicSharedMemorySize, LDS_BYTES) != hipSuccess) { fprintf(stderr, "kernel_launch: hipFuncSetAttribute failed\n"); grid = -1; return; }
        if (hipOccupancyMaxActiveBlocksPerMultiprocessor(&per_cu, (const void*)hybrid_fwd, 512, LDS_BYTES) != hipSuccess || per_cu < 1) { fprintf(stderr, "kernel_launch: occupancy query says %d\n", per_cu); per_cu = 1; }
        (void)hipGetLastError();
        grid = cus * 1;
        if (grid <= 0) grid = 256;
    }
    if (grid < 0) return;
    if (hipMemsetAsync((char*)d_ws + WS_CTL, 0, 65536, stream) != hipSuccess) { fprintf(stderr, "kernel_launch: memset failed\n"); return; }
    Params p{};
    const float** pp = (const float**)&p;
    for (int i = 0; i < 22; ++i) pp[i] = (const float*)d_in[i];
    p.out = (float*)d_out; p.ws = (unsigned char*)d_ws;
    void* args[] = {&p};
    hipError_t e = hipLaunchCooperativeKernel((const void*)hybrid_fwd, dim3(grid), dim3(512), args, LDS_BYTES, stream);
    if (e != hipSuccess) fprintf(stderr, "cooperative launch failed: %s (grid %d)\n", hipGetErrorString(e), grid);
}
```

```cpp
#include <hip/hip_runtime.h>
#include <hip/hip_cooperative_groups.h>
#include <cstdio>
#include <cstdint>
namespace cg = cooperative_groups;

namespace pg8 {
#define PG8_LAS __attribute__((address_space(3)))
typedef unsigned short bf16_t;
typedef short bf16x8 __attribute__((ext_vector_type(8)));
typedef float f32x4 __attribute__((ext_vector_type(4)));
typedef unsigned u32x4 __attribute__((ext_vector_type(4)));
constexpr int BM = 256, BK = 64, HALF = 128, HTB = HALF * BK * 2  , STAGE_BYTES = 8 * HTB, NXCD = 8, WGM = 8;

__host__ __device__ __forceinline__ int lds_byte(int r, int c) { const int st = (r >> 4) * 2 + (c >> 5), rr = r & 15, cc = c & 31, ob = rr * 64 + cc * 2; return st * 1024 + (ob ^ (((ob >> 9) & 1) << 5)); }
__host__ __device__ __forceinline__ void stage_rc(int b, int& R, int& C) { const int st = b / 1024, sb = b % 1024, swz = sb ^ (((sb >> 9) & 1) << 5); R = (st >> 1) * 16 + swz / 64; C = (st & 1) * 32 + (swz % 64) / 2; }
__host__ __device__ __forceinline__ int perm32(int rho) { const int n = rho >> 4, i = rho & 15; return 8 * (i >> 2) + 4 * n + (i & 3); }

struct Unit { int pm, pn; };
struct Gemm { const bf16_t* A; const bf16_t* Bt; int M, N, K, lda, ldb; };

struct StaticOrder {
    int nM, nN, nwg, G, c, wgm;
    __host__ __device__ void init(int M, int N, int G_, int c_, int wgm_ = WGM) { nM = M / BM; nN = N / BM; nwg = nM * nN; G = G_; c = c_; wgm = wgm_; }
    __host__ __device__ bool next(int i, Unit& u) const {
        const long L = (long)i * G + c; if (L >= nwg) return false;
        int wgid = (int)L; { const int q = nwg / NXCD, r = nwg % NXCD, xcd = wgid % NXCD, off = wgid / NXCD; wgid = (xcd < r ? xcd * (q + 1) : r * (q + 1) + (xcd - r) * q) + off; }
        const int nig = wgm * nN, gid = wgid / nig, fm = gid * wgm, gsz = (nM - fm) < wgm ? (nM - fm) : wgm;
        u.pm = fm + ((wgid % nig) % gsz); u.pn = (wgid % nig) / gsz; return true;
    }
    __device__ __forceinline__ void a_ready(const Unit&) const {}
    __device__ __forceinline__ void done(const Unit&) const {}
};

typedef float f32x2_cv __attribute__((ext_vector_type(2))); typedef __bf16 bf16x2_cv __attribute__((ext_vector_type(2)));
__device__ __forceinline__ unsigned cvt_pk_bf16(float lo, float hi) { f32x2_cv v = {lo, hi}; bf16x2_cv b = __builtin_convertvector(v, bf16x2_cv); return __builtin_bit_cast(unsigned, b); }
template <class Epi, class Sched, bool ALIGN_EPI = false, bool SP2 = false>
__device__ __forceinline__ void gemm_phase(PG8_LAS unsigned char* lds, const Gemm g, const Sched& S, const Epi& E) {
    int tid_ = threadIdx.x; asm volatile("" : "+v"(tid_));
    const int tid = tid_, wid = __builtin_amdgcn_readfirstlane(tid >> 6), lane = tid & 63, wr = wid >> 2, wc = wid & 3, fr = lane & 15, fq = lane >> 4;
    const int K = g.K, nt = K / BK;
    unsigned voffA[2], voffB[2];
#pragma unroll
    for (int i = 0; i < 2; ++i) { int R, C; stage_rc(tid * 16 + i * 8192, R, C); const int Rb = Epi::PERM ? ((R & ~31) + perm32(R & 31)) : R;
        voffA[i] = (unsigned)(R * g.lda + C) * 2u; voffB[i] = (unsigned)(Rb * g.ldb + C) * 2u; }
    const size_t kstep = (size_t)(BK * 2);
    const size_t hstepA = (size_t)HALF * g.lda * 2, hstepB = (size_t)HALF * g.ldb * 2;
    const size_t tstepA = 2 * hstepA, tstepB = 2 * hstepB;
    const unsigned ldsw = (unsigned)wid * 1024u;
    const int aoff = lds_byte(wr * 64 + fr, fq * 8), boff = lds_byte(wc * 32 + fr, fq * 8);
#define PG8_SA(b, h) (((b) * 2 + (h)) * HTB)
#define PG8_SB(b, h) ((4 + (b) * 2 + (h)) * HTB)
#define PG8_STAGE(bufoff, gbase, voff) do { _Pragma("unroll") for (int _i = 0; _i < 2; ++_i) \
        __builtin_amdgcn_global_load_lds((const unsigned*)((const char*)(gbase) + (voff)[_i]), (PG8_LAS unsigned*)(lds + (bufoff) + ldsw + _i * 8192), 16, 0, 0); } while (0)
#define PG8_LDA(dst, b, h) do { _Pragma("unroll") for (int m = 0; m < 4; ++m) _Pragma("unroll") for (int k = 0; k < 2; ++k) dst[m][k] = *(const PG8_LAS bf16x8*)(lds + PG8_SA(b, h) + aoff + m * 2048 + k * 1024); } while (0)
#define PG8_LDB(dst, b, h) do { _Pragma("unroll") for (int n = 0; n < 2; ++n) _Pragma("unroll") for (int k = 0; k < 2; ++k) dst[n][k] = *(const PG8_LAS bf16x8*)(lds + PG8_SB(b, h) + boff + n * 2048 + k * 1024); } while (0)
#define PG8_MMA(ai, bj, At, Bt) do { __builtin_amdgcn_s_setprio(1); _Pragma("unroll") for (int m = 0; m < 4; ++m) _Pragma("unroll") for (int n = 0; n < 2; ++n) _Pragma("unroll") for (int k = 0; k < 2; ++k) \
        acc[ai][bj][m][n] = __builtin_amdgcn_mfma_f32_16x16x32_bf16(Bt[n][k], At[m][k], acc[ai][bj][m][n], 0, 0, 0); __builtin_amdgcn_s_setprio(0); } while (0)
#define PG8_WAIT_V(n) asm volatile("s_waitcnt vmcnt(" #n ")" ::: "memory")
#define PG8_WAIT_L(n) asm volatile("s_waitcnt lgkmcnt(" #n ")" ::: "memory")
#define PG8_BAR __builtin_amdgcn_s_barrier()
#define PG8_SCHED __builtin_amdgcn_sched_barrier(0)
    Unit cur, nxt; int ui = 0;
    if (!S.next(0, cur)) return;
    f32x4 acc[2][2][4][2];
#pragma unroll
    for (int a = 0; a < 2; ++a)
#pragma unroll
        for (int b = 0; b < 2; ++b)
#pragma unroll
            for (int m = 0; m < 4; ++m)
#pragma unroll
                for (int n = 0; n < 2; ++n) acc[a][b][m][n] = (f32x4){0.f, 0.f, 0.f, 0.f};
    bf16x8 At[4][2], B0[2][2], B1[2][2];
    const char* cA = (const char*)g.A + (size_t)cur.pm * tstepA; const char* cB = (const char*)g.Bt + (size_t)cur.pn * tstepB;
    S.a_ready(cur);
    if constexpr (SP2) {
        PG8_STAGE(PG8_SB(0, 0), cB, voffB); PG8_STAGE(PG8_SB(0, 1), cB + hstepB, voffB); PG8_STAGE(PG8_SA(0, 0), cA, voffA); PG8_STAGE(PG8_SA(0, 1), cA + hstepA, voffA);
        if (wr == 1) PG8_BAR;
        PG8_WAIT_V(2); PG8_BAR;
        PG8_STAGE(PG8_SB(1, 0), cB + kstep, voffB); PG8_STAGE(PG8_SA(1, 0), cA + kstep, voffA); PG8_STAGE(PG8_SB(1, 1), cB + hstepB + kstep, voffB);
        PG8_WAIT_V(6); PG8_BAR;
    } else {
        PG8_STAGE(PG8_SB(0, 0), cB, voffB); PG8_STAGE(PG8_SA(0, 0), cA, voffA); PG8_STAGE(PG8_SB(0, 1), cB + hstepB, voffB); PG8_STAGE(PG8_SA(0, 1), cA + hstepA, voffA);
        if (wr == 1) PG8_BAR;
        PG8_WAIT_V(4); PG8_BAR;
        PG8_STAGE(PG8_SB(1, 0), cB + kstep, voffB); PG8_STAGE(PG8_SA(1, 0), cA + kstep, voffA); PG8_STAGE(PG8_SB(1, 1), cB + hstepB + kstep, voffB);
        PG8_WAIT_V(6); PG8_BAR;
    }
    for (;;) {
        const bool has_next = S.next(ui + 1, nxt);
        const char* nA = has_next ? (const char*)g.A + (size_t)nxt.pm * tstepA : cA; const char* nB = has_next ? (const char*)g.Bt + (size_t)nxt.pn * tstepB : cB;
        for (int t = 0; t < nt; t += 2) {
            const bool last = (t == nt - 2);
            const char* a1 = cA + (size_t)(t + 1) * kstep;
            const char* a2 = last ? nA : cA + (size_t)(t + 2) * kstep; const char* b2 = last ? nB : cB + (size_t)(t + 2) * kstep;
            const char* a3 = a2 + kstep; const char* b3 = b2 + kstep;
            if (last && has_next) S.a_ready(nxt);
            if constexpr (SP2) {
            PG8_LDB(B0, 0, 0); PG8_LDB(B1, 0, 1); PG8_SCHED; PG8_LDA(At, 0, 0); PG8_STAGE(PG8_SA(1, 1), a1 + hstepA, voffA);
            PG8_WAIT_V(8); PG8_WAIT_L(0); PG8_BAR; PG8_MMA(0, 0, At, B0); PG8_MMA(0, 1, At, B1); PG8_BAR; PG8_SCHED;
            PG8_LDA(At, 0, 1); PG8_STAGE(PG8_SB(0, 0), b2, voffB); PG8_STAGE(PG8_SB(0, 1), b2 + hstepB, voffB); PG8_STAGE(PG8_SA(0, 0), a2, voffA);
            PG8_WAIT_V(8); PG8_WAIT_L(0); PG8_BAR; PG8_MMA(1, 0, At, B0); PG8_MMA(1, 1, At, B1); PG8_BAR; PG8_SCHED;
            PG8_LDB(B0, 1, 0); PG8_LDB(B1, 1, 1); PG8_SCHED; PG8_LDA(At, 1, 0); PG8_STAGE(PG8_SA(0, 1), a2 + hstepA, voffA);
            PG8_WAIT_V(8); PG8_WAIT_L(0); PG8_BAR; PG8_MMA(0, 0, At, B0); PG8_MMA(0, 1, At, B1); PG8_BAR; PG8_SCHED;
            PG8_LDA(At, 1, 1); PG8_STAGE(PG8_SB(1, 0), b3, voffB); PG8_STAGE(PG8_SB(1, 1), b3 + hstepB, voffB); PG8_STAGE(PG8_SA(1, 0), a3, voffA);
            PG8_WAIT_V(8); PG8_WAIT_L(0); PG8_BAR; PG8_MMA(1, 0, At, B0); PG8_MMA(1, 1, At, B1); PG8_BAR; PG8_SCHED;
            } else {
            PG8_LDB(B0, 0, 0); PG8_SCHED; PG8_LDA(At, 0, 0); PG8_STAGE(PG8_SA(1, 1), a1 + hstepA, voffA);
            PG8_WAIT_L(8); PG8_BAR; PG8_WAIT_L(0); PG8_MMA(0, 0, At, B0); PG8_BAR; PG8_SCHED;
            PG8_LDB(B1, 0, 1); PG8_STAGE(PG8_SB(0, 0), b2, voffB);
            PG8_BAR; PG8_WAIT_L(0); PG8_MMA(0, 1, At, B1); PG8_BAR;
            PG8_LDA(At, 0, 1); PG8_STAGE(PG8_SA(0, 0), a2, voffA);
            PG8_BAR; PG8_WAIT_L(0); PG8_MMA(1, 0, At, B0); PG8_BAR; PG8_SCHED;
            PG8_STAGE(PG8_SB(0, 1), b2 + hstepB, voffB);
            PG8_WAIT_V(6); PG8_BAR; PG8_MMA(1, 1, At, B1); PG8_BAR;
            PG8_LDB(B0, 1, 0); PG8_SCHED; PG8_LDA(At, 1, 0); PG8_STAGE(PG8_SA(0, 1), a2 + hstepA, voffA);
            PG8_WAIT_L(8); PG8_BAR; PG8_WAIT_L(0); PG8_MMA(0, 0, At, B0); PG8_BAR; PG8_SCHED;
            PG8_LDB(B1, 1, 1); PG8_STAGE(PG8_SB(1, 0), b3, voffB);
            PG8_BAR; PG8_WAIT_L(0); PG8_MMA(0, 1, At, B1); PG8_BAR;
            PG8_LDA(At, 1, 1); PG8_STAGE(PG8_SA(1, 0), a3, voffA);
            PG8_BAR; PG8_WAIT_L(0); PG8_MMA(1, 0, At, B0); PG8_BAR; PG8_SCHED;
            PG8_STAGE(PG8_SB(1, 1), b3 + hstepB, voffB);
            PG8_WAIT_V(6); PG8_BAR; PG8_MMA(1, 1, At, B1); PG8_BAR;
            }
        }
        if constexpr (ALIGN_EPI) { if (wr == 0) PG8_BAR; }
        if constexpr (!Epi::AFTER_DRAIN) { E(acc, cur, wr, wc, fr, fq); S.done(cur); }
        if (!has_next) break;
#pragma unroll
        for (int a = 0; a < 2; ++a)
#pragma unroll
            for (int b = 0; b < 2; ++b)
#pragma unroll
                for (int m = 0; m < 4; ++m)
#pragma unroll
                    for (int n = 0; n < 2; ++n) acc[a][b][m][n] = (f32x4){0.f, 0.f, 0.f, 0.f};
        cur = nxt; cA = nA; cB = nB; ++ui;
        if constexpr (ALIGN_EPI) { if (wr == 1) PG8_BAR; }
    }
    PG8_WAIT_V(0);
    if constexpr (!ALIGN_EPI) { if (wr == 0) PG8_BAR; }
    PG8_BAR;
    if constexpr (Epi::AFTER_DRAIN) { E.fused(acc, cur, wr, wc, fr, fq, lds, wid, lane); S.done(cur); }
#undef PG8_SA
#undef PG8_SB
#undef PG8_STAGE
#undef PG8_LDA
#undef PG8_LDB
#undef PG8_MMA
#undef PG8_WAIT_V
#undef PG8_WAIT_L
#undef PG8_BAR
#undef PG8_SCHED
}
}

constexpr int TOK = 16384, SEQ = 8192, DM = 2048, DIN = 14360, DFF = 8192;
constexpr int LDP = 7168;
constexpr int PC_QA = 0, PC_KA = 1024, PC_VA = 2048, PC_Z = 3072, PC_FK = 4096, PC_FQ = 5120, PC_QM = 6144;
constexpr int PC_OA = 0, PC_OB = PC_FQ, PC_OM = PC_QM, PC_GB = 1024, PC_GM = 3072;
constexpr float EPSN = 1e-6f;
constexpr float LOG2E = 1.4426950408889634f;
constexpr size_t MiB = 1u << 20;
constexpr size_t WS_CTL = 0, WS_W1T = 1 * MiB, WS_WFVT = 30 * MiB, WS_WMKVT = 34 * MiB, WS_UC = 1 * MiB;
constexpr size_t WS_SMALL = 42 * MiB, WS_KMEM = 44 * MiB, WS_VMT = 45 * MiB, WS_CUM = 46 * MiB, WS_CDEC = 46 * MiB + 512 * 1024,
                 WS_MEMN = 47 * MiB, WS_SSQ = 49 * MiB, WS_RSTD = 51 * MiB;
constexpr size_t WS_WGT = 52 * MiB, WS_WUPT = 76 * MiB, WS_WOT = 88 * MiB, WS_WFF1T = 96 * MiB, WS_WFF2T = 128 * MiB;
constexpr size_t WS_PROJ = 160 * MiB, WS_GDN = 384 * MiB, WS_END = 496 * MiB;
constexpr int FOXVT_LD = TOK;
constexpr size_t WS_Y = 384 * MiB, WS_X1B = 160 * MiB, WS_U = 224 * MiB;
constexpr size_t DO_H = 0, DO_FOXVT = 64 * MiB, DO_GA = 64 * MiB;
constexpr int GDN_CHUNK_BYTES = 57344;
constexpr int LDS_BYTES = 163840;

#define LAS __attribute__((address_space(3)))
typedef unsigned short bf16;
typedef short bf16x8 __attribute__((ext_vector_type(8)));
typedef float f32x4 __attribute__((ext_vector_type(4)));
typedef float f32x16 __attribute__((ext_vector_type(16)));
typedef unsigned u32x4 __attribute__((ext_vector_type(4)));
typedef unsigned u32x2 __attribute__((ext_vector_type(2)));

__device__ __forceinline__ unsigned pk2(float lo, float hi) { return pg8::cvt_pk_bf16(lo, hi); }
__device__ __forceinline__ float bf2f(unsigned short v) { return __uint_as_float(((unsigned)v) << 16); }
__device__ __forceinline__ float bflo(unsigned w) { return __uint_as_float(w << 16); }
__device__ __forceinline__ float bfhi(unsigned w) { return __uint_as_float(w & 0xffff0000u); }
__device__ __forceinline__ int crow(int r, int hi) { return (r & 3) + 8 * (r >> 2) + 4 * hi; }
__device__ __forceinline__ float sigmoidf_(float x) { return 1.f / (1.f + __expf(-x)); }
__device__ __forceinline__ float softplusf_(float x) { return fmaxf(x, 0.f) + log1pf(__expf(-fabsf(x))); }

namespace pg8 {
struct EpiStore {
    static constexpr bool PERM = true, AFTER_DRAIN = false;
    bf16_t* O; int ldc;
    __device__ __forceinline__ void operator()(const f32x4 (&acc)[2][2][4][2], const Unit& u, int wr, int wc, int fr, int fq) const {
        const int row0 = u.pm * BM + wr * 64 + fr, col0 = u.pn * BM + wc * 32 + 8 * fq;
#pragma unroll
        for (int ai = 0; ai < 2; ++ai)
#pragma unroll
            for (int m = 0; m < 4; ++m) { bf16_t* rowp = O + (size_t)(row0 + ai * HALF + m * 16) * ldc + col0;
#pragma unroll
                for (int bj = 0; bj < 2; ++bj) { const f32x4 v0 = acc[ai][bj][m][0], v1 = acc[ai][bj][m][1];
                    u32x4 w; w.x = cvt_pk_bf16(v0[0], v0[1]); w.y = cvt_pk_bf16(v0[2], v0[3]); w.z = cvt_pk_bf16(v1[0], v1[1]); w.w = cvt_pk_bf16(v1[2], v1[3]);
                    *(u32x4*)(rowp + bj * HALF) = w; } }
    }
};
struct EpiProj {
    static constexpr bool PERM = true, AFTER_DRAIN = false;
    bf16_t* O; int ldc; float* small;
    __device__ __forceinline__ void operator()(const f32x4 (&acc)[2][2][4][2], const Unit& u, int wr, int wc, int fr, int fq) const {
        const int row0 = u.pm * BM + wr * 64 + fr;
        if (u.pn == 28) {
            if (wc == 0) {
#pragma unroll
                for (int ai = 0; ai < 2; ++ai)
#pragma unroll
                    for (int m = 0; m < 4; ++m) { float* p = small + (size_t)(row0 + ai * HALF + m * 16) * 32 + 8 * fq;
                        *(f32x4*)p = acc[ai][0][m][0]; *(f32x4*)(p + 4) = acc[ai][0][m][1]; }
            }
            return;
        }
        const int col0 = u.pn * BM + wc * 32 + 8 * fq;
#pragma unroll
        for (int ai = 0; ai < 2; ++ai)
#pragma unroll
            for (int m = 0; m < 4; ++m) { bf16_t* rowp = O + (size_t)(row0 + ai * HALF + m * 16) * ldc + col0;
#pragma unroll
                for (int bj = 0; bj < 2; ++bj) { const f32x4 v0 = acc[ai][bj][m][0], v1 = acc[ai][bj][m][1];
                    u32x4 w; w.x = cvt_pk_bf16(v0[0], v0[1]); w.y = cvt_pk_bf16(v0[2], v0[3]); w.z = cvt_pk_bf16(v1[0], v1[1]); w.w = cvt_pk_bf16(v1[2], v1[3]);
                    *(u32x4*)(rowp + bj * HALF) = w; } }
    }
};
struct EpiSig {
    static constexpr bool PERM = true, AFTER_DRAIN = false;
    unsigned char* O0; unsigned char* O1; int ld0, ld1;
    __device__ __forceinline__ void operator()(const f32x4 (&acc)[2][2][4][2], const Unit& u, int wr, int wc, int fr, int fq) const {
        const int br = u.pn >> 3; unsigned char* O = br == 0 ? O0 : O1 + (size_t)(br - 1) * 2048; const int ldc = br == 0 ? ld0 : ld1;
        const int row0 = u.pm * BM + wr * 64 + fr, col0 = (u.pn & 7) * BM + wc * 32 + 8 * fq;
#pragma unroll
        for (int ai = 0; ai < 2; ++ai)
#pragma unroll
            for (int m = 0; m < 4; ++m) { unsigned char* rowp = O + (size_t)(row0 + ai * HALF + m * 16) * ldc + col0;
#pragma unroll
                for (int bj = 0; bj < 2; ++bj) { const f32x4 v0 = acc[ai][bj][m][0], v1 = acc[ai][bj][m][1]; unsigned q[8];
#pragma unroll
                    for (int e = 0; e < 4; ++e) { q[e] = (unsigned)(255.f * __builtin_amdgcn_rcpf(1.f + __builtin_amdgcn_exp2f(-1.4426950408889634f * v0[e])) + 0.5f);
                                                  q[4 + e] = (unsigned)(255.f * __builtin_amdgcn_rcpf(1.f + __builtin_amdgcn_exp2f(-1.4426950408889634f * v1[e])) + 0.5f); }
                    u32x2 w; w.x = q[0] | (q[1] << 8) | (q[2] << 16) | (q[3] << 24); w.y = q[4] | (q[5] << 8) | (q[6] << 16) | (q[7] << 24);
                    *(u32x2*)(rowp + bj * HALF) = w; } }
    }
};
template <bool FIRST> struct EpiGate {
    static constexpr bool PERM = true, AFTER_DRAIN = false;
    const unsigned char* G; int ldg; bf16_t* Y; int ldy;
    __device__ __forceinline__ void operator()(const f32x4 (&acc)[2][2][4][2], const Unit& u, int wr, int wc, int fr, int fq) const {
        const int row0 = u.pm * BM + wr * 64 + fr, col0 = u.pn * BM + wc * 32 + 8 * fq;
        constexpr float S = 1.f / 255.f;
#pragma unroll
        for (int ai = 0; ai < 2; ++ai)
#pragma unroll
            for (int m = 0; m < 4; ++m) { const size_t r = (size_t)(row0 + ai * HALF + m * 16);
#pragma unroll
                for (int bj = 0; bj < 2; ++bj) { const f32x4 v0 = acc[ai][bj][m][0], v1 = acc[ai][bj][m][1];
                    const u32x2 g = *(const u32x2*)(G + r * ldg + col0 + bj * HALF);
                    float o[8];
                    o[0] = v0[0] * ((float)(g.x & 0xffu) * S); o[1] = v0[1] * ((float)((g.x >> 8) & 0xffu) * S);
                    o[2] = v0[2] * ((float)((g.x >> 16) & 0xffu) * S); o[3] = v0[3] * ((float)(g.x >> 24) * S);
                    o[4] = v1[0] * ((float)(g.y & 0xffu) * S); o[5] = v1[1] * ((float)((g.y >> 8) & 0xffu) * S);
                    o[6] = v1[2] * ((float)((g.y >> 16) & 0xffu) * S); o[7] = v1[3] * ((float)(g.y >> 24) * S);
                    bf16_t* yp = Y + r * ldy + col0 + bj * HALF;
                    if (!FIRST) { const u32x4 y = *(const u32x4*)yp;
                        o[0] += __uint_as_float(y.x << 16); o[1] += __uint_as_float(y.x & 0xffff0000u);
                        o[2] += __uint_as_float(y.y << 16); o[3] += __uint_as_float(y.y & 0xffff0000u);
                        o[4] += __uint_as_float(y.z << 16); o[5] += __uint_as_float(y.z & 0xffff0000u);
                        o[6] += __uint_as_float(y.w << 16); o[7] += __uint_as_float(y.w & 0xffff0000u); }
                    u32x4 w; w.x = cvt_pk_bf16(o[0], o[1]); w.y = cvt_pk_bf16(o[2], o[3]); w.z = cvt_pk_bf16(o[4], o[5]); w.w = cvt_pk_bf16(o[6], o[7]);
                    *(u32x4*)yp = w; } }
    }
};
struct EpiRes1 {
    static constexpr bool PERM = false, AFTER_DRAIN = false;
    const float* X; bf16_t* XB; float* SSQ;
    __device__ __forceinline__ void operator()(const f32x4 (&acc)[2][2][4][2], const Unit& u, int wr, int wc, int fr, int fq) const {
        const int row0 = u.pm * BM + wr * 64 + fr, col0 = u.pn * BM + wc * 32 + 4 * fq;
#pragma unroll
        for (int ai = 0; ai < 2; ++ai)
#pragma unroll
            for (int m = 0; m < 4; ++m) { const int row = row0 + ai * HALF + m * 16; const size_t off = (size_t)row * 2048 + col0; float s = 0.f;
#pragma unroll
                for (int bj = 0; bj < 2; ++bj)
#pragma unroll
                    for (int n = 0; n < 2; ++n) { const size_t o = off + bj * HALF + n * 16; const f32x4 xv = *(const f32x4*)(X + o); const f32x4 v = xv + acc[ai][bj][m][n];
                        u32x2 w; w.x = cvt_pk_bf16(v[0], v[1]); w.y = cvt_pk_bf16(v[2], v[3]); *(u32x2*)(XB + o) = w;
                        s += (v[0] * v[0] + v[1] * v[1]) + (v[2] * v[2] + v[3] * v[3]); }
                s += __shfl_xor(s, 16); s += __shfl_xor(s, 32);
                if (fq == 0) SSQ[(size_t)(u.pn * 4 + wc) * 16384 + row] = s; }
    }
};
struct EpiFF1 {
    static constexpr bool PERM = true, AFTER_DRAIN = false;
    const float* RSTD; bf16_t* O; int ldc;
    __device__ __forceinline__ void operator()(const f32x4 (&acc)[2][2][4][2], const Unit& u, int wr, int wc, int fr, int fq) const {
        const int row0 = u.pm * BM + wr * 64 + fr, col0 = u.pn * BM + wc * 32 + 8 * fq;
        float rs[2][4];
#pragma unroll
        for (int ai = 0; ai < 2; ++ai)
#pragma unroll
            for (int m = 0; m < 4; ++m) rs[ai][m] = RSTD[row0 + ai * HALF + m * 16];
#pragma unroll
        for (int ai = 0; ai < 2; ++ai)
#pragma unroll
            for (int m = 0; m < 4; ++m) { const int row = row0 + ai * HALF + m * 16; const float rstd = rs[ai][m];
                bf16_t* rowp = O + (size_t)row * ldc + col0;
#pragma unroll
                for (int bj = 0; bj < 2; ++bj) { f32x4 v0 = acc[ai][bj][m][0] * rstd, v1 = acc[ai][bj][m][1] * rstd;
#pragma unroll
                    for (int e = 0; e < 4; ++e) { const float a = fmaxf(v0[e], 0.f), b = fmaxf(v1[e], 0.f); v0[e] = a * a; v1[e] = b * b; }
                    u32x4 w; w.x = cvt_pk_bf16(v0[0], v0[1]); w.y = cvt_pk_bf16(v0[2], v0[3]); w.z = cvt_pk_bf16(v1[0], v1[1]); w.w = cvt_pk_bf16(v1[2], v1[3]);
                    *(u32x4*)(rowp + bj * HALF) = w; } }
    }
};
struct EpiOut {
    static constexpr bool PERM = false, AFTER_DRAIN = false;
    const bf16_t* XB; float* OUT;
    __device__ __forceinline__ void operator()(const f32x4 (&acc)[2][2][4][2], const Unit& u, int wr, int wc, int fr, int fq) const {
        const int row0 = u.pm * BM + wr * 64 + fr, col0 = u.pn * BM + wc * 32 + 4 * fq;
#pragma unroll
        for (int ai = 0; ai < 2; ++ai)
#pragma unroll
            for (int m = 0; m < 4; ++m) { const size_t off = (size_t)(row0 + ai * HALF + m * 16) * 2048 + col0;
#pragma unroll
                for (int bj = 0; bj < 2; ++bj)
#pragma unroll
                    for (int n = 0; n < 2; ++n) { const size_t o = off + bj * HALF + n * 16; const u32x2 xb = *(const u32x2*)(XB + o);
                        f32x4 xv; xv[0] = __uint_as_float(xb.x << 16); xv[1] = __uint_as_float(xb.x & 0xffff0000u); xv[2] = __uint_as_float(xb.y << 16); xv[3] = __uint_as_float(xb.y & 0xffff0000u);
                        *(f32x4*)(OUT + o) = xv + acc[ai][bj][m][n]; } }
    }
};
}

struct Params {
    const float *x, *mem, *g_mix, *w_in, *conv_w, *a_log, *dt_bias, *gdn_norm_g, *fox_b_f, *fox_q_norm, *fox_k_norm, *g_mem, *w_mem_kv,
                *mem_q_norm, *mem_k_norm, *w_up_gdn, *w_up_fox, *w_up_mem, *w_out, *g_mlp, *w_ff1, *w_ff2;
    float* out; unsigned char* ws;
};

__device__ __forceinline__ float wave_sum(float v) {
#pragma unroll
    for (int o = 1; o < 64; o <<= 1) v += __shfl_xor(v, o);
    return v;
}

__device__ __forceinline__ void transpose_item(const float* W, int ldw, int n0src, bf16* WT, int K, int row0dst, const float* kscale,
                                               LAS float* scr, int kb, int nb, int lane) {
    const int k0 = 64 * kb, n0 = 32 * nb;
    float tv[32];
#pragma unroll
    for (int i = 0; i < 32; ++i) tv[i] = W[(size_t)(k0 + 2 * i + (lane >> 5)) * ldw + n0src + n0 + (lane & 31)];
#pragma unroll
    for (int i = 0; i < 32; ++i) { const int kk = 2 * i + (lane >> 5); float v = tv[i];
        if (kscale) v *= kscale[k0 + kk]; scr[kk * 33 + (lane & 31)] = v; }
    asm volatile("s_waitcnt lgkmcnt(0)" ::: "memory");
    const int c = lane & 7;
#pragma unroll
    for (int j = 0; j < 4; ++j) { const int n = (lane >> 3) + 8 * j; const LAS float* s = scr + (8 * c) * 33 + n;
        u32x4 o; o.x = pk2(s[0 * 33], s[1 * 33]); o.y = pk2(s[2 * 33], s[3 * 33]); o.z = pk2(s[4 * 33], s[5 * 33]); o.w = pk2(s[6 * 33], s[7 * 33]);
        *(u32x4*)(WT + (size_t)(row0dst + n0 + n) * K + k0 + 8 * c) = o; }
    asm volatile("s_waitcnt lgkmcnt(0)" ::: "memory");
}
__device__ __forceinline__ void transpose_job(const float* W, int ldw, int n0src, int K, int ncols, bf16* WT, int row0dst, const float* kscale,
                                              LAS float* scr, int gw, int ngw, int lane) {
    const int nblk = ncols / 32, nitems = (K / 64) * nblk;
    for (int it = gw; it < nitems; it += ngw) transpose_item(W, ldw, n0src, WT, K, row0dst, kscale, scr, it / nblk, it % nblk, lane);
}
__device__ __forceinline__ void rms_row_to_bf16(const float* xrow, const float* g, bf16* orow, int lane) {
    const f32x4* xr = (const f32x4*)xrow + lane; const f32x4* gr = (const f32x4*)g + lane;
    f32x4 v[8]; float s = 0.f;
#pragma unroll
    for (int j = 0; j < 8; ++j) { v[j] = xr[64 * j]; s += (v[j].x * v[j].x + v[j].y * v[j].y) + (v[j].z * v[j].z + v[j].w * v[j].w); }
    const float rstd = rsqrtf(wave_sum(s) * (1.f / 2048.f) + EPSN);
    u32x2* o8 = (u32x2*)orow + lane;
#pragma unroll
    for (int j = 0; j < 8; ++j) { const f32x4 gg = gr[64 * j]; u32x2 w; w.x = pk2(v[j].x * rstd * gg.x, v[j].y * rstd * gg.y); w.y = pk2(v[j].z * rstd * gg.z, v[j].w * rstd * gg.w); o8[64 * j] = w; }
}

__device__ __forceinline__ void phase0(const Params& P, unsigned char* lds, int tid, int lane, int wave) {
    unsigned char* ws = P.ws;
    bf16* W1T = (bf16*)(ws + WS_W1T); bf16* WFVT = (bf16*)(ws + WS_WFVT); bf16* WMKVT = (bf16*)(ws + WS_WMKVT); bf16* WGT = (bf16*)(ws + WS_WGT);
    bf16* WUPT = (bf16*)(ws + WS_WUPT); bf16* WOT = (bf16*)(ws + WS_WOT); bf16* WFF1T = (bf16*)(ws + WS_WFF1T); bf16* WFF2T = (bf16*)(ws + WS_WFF2T);
    LAS float* scr = (LAS float*)((LAS unsigned char*)lds + wave * 16384);
    const int G = gridDim.x, gw = blockIdx.x * 8 + wave, ngw = G * 8;
    bf16* H = (bf16*)((unsigned char*)P.out + DO_H);
    for (int m = gw; m < TOK; m += ngw) rms_row_to_bf16(P.x + (size_t)m * DM, P.g_mix, H + (size_t)m * DM, lane);
    bf16* MEMN = (bf16*)(ws + WS_MEMN);
    for (int m = gw; m < 512; m += ngw) rms_row_to_bf16(P.mem + (size_t)m * DM, P.g_mem, MEMN + (size_t)m * DM, lane);
    transpose_job(P.w_in, DIN, 0, 2048, 4096, W1T, 0, nullptr, scr, gw, ngw, lane);
    transpose_job(P.w_in, DIN, 5136, 2048, 1024, W1T, PC_FK, nullptr, scr, gw, ngw, lane);
    transpose_job(P.w_in, DIN, 4112, 2048, 1024, W1T, PC_FQ, nullptr, scr, gw, ngw, lane);
    transpose_job(P.w_in, DIN, 7192, 2048, 1024, W1T, PC_QM, nullptr, scr, gw, ngw, lane);
    transpose_job(P.w_in, DIN, 6160, 2048, 1024, WFVT, 0, nullptr, scr, gw, ngw, lane);
    transpose_job(P.w_in, DIN, 8216, 2048, 6144, WGT, 0, nullptr, scr, gw, ngw, lane);
    transpose_job(P.w_mem_kv, 2048, 0, 2048, 2048, WMKVT, 0, nullptr, scr, gw, ngw, lane);
    transpose_job(P.w_up_gdn, 2048, 0, 1024, 2048, WUPT, 0, nullptr, scr, gw, ngw, lane);
    transpose_job(P.w_up_fox, 2048, 0, 1024, 2048, WUPT + (size_t)2048 * 1024, 0, nullptr, scr, gw, ngw, lane);
    transpose_job(P.w_up_mem, 2048, 0, 1024, 2048, WUPT + (size_t)2 * 2048 * 1024, 0, nullptr, scr, gw, ngw, lane);
    transpose_job(P.w_out, 2048, 0, 2048, 2048, WOT, 0, nullptr, scr, gw, ngw, lane);
    transpose_job(P.w_ff1, 8192, 0, 2048, 8192, WFF1T, 0, P.g_mlp, scr, gw, ngw, lane);
    transpose_job(P.w_ff2, 2048, 0, 8192, 2048, WFF2T, 0, nullptr, scr, gw, ngw, lane);
    for (int idx = blockIdx.x * 512 + tid; idx < 256 * 2048; idx += G * 512) {
        const int row = idx >> 11, k = idx & 2047; float v = 0.f;
        if (row < 24) { const int col = row < 8 ? 4096 + row : (row < 16 ? 4104 + (row - 8) : 7184 + (row - 16)); v = P.w_in[(size_t)k * DIN + col]; }
        W1T[(size_t)(7168 + row) * 2048 + k] = (bf16)(pk2(v, 0.f) & 0xffffu);
    }
}


__device__ __forceinline__ void gdn_prep_unit(const Params& P, unsigned char* lds_, int bh, int n, int tid, int lane, int wave) {
    float* qs = (float*)lds_;
    float* ks = qs + 64 * 132;
    float* vs = ks + 64 * 132;
    float* Mm = vs + 64 * 132;
    float* QKd = Mm + 4096;
    float* gam = QKd + 4096;
    float* beta = gam + 64;
    float* egam = beta + 64;
    const int b = bh >> 3, h = bh & 7;
    const size_t r0 = (size_t)b * SEQ + (size_t)n * 64;
    const bf16* proj = (const bf16*)(P.ws + WS_PROJ);
    const float* small = (const float*)(P.ws + WS_SMALL);
    if (tid < 384) {
        const int c8 = tid % 48, tg = tid / 48, mat = c8 >> 4, ch0 = (c8 & 15) * 8, col = mat * 1024 + h * 128 + ch0, tb = tg * 8;
        u32x4 xr[11];
#pragma unroll
        for (int i = 0; i < 11; ++i) { const int tt = n * 64 + tb - 3 + i;
            xr[i] = tt >= 0 ? *(const u32x4*)(proj + (r0 + tb - 3 + i) * LDP + col) : u32x4{0u, 0u, 0u, 0u}; }
        f32x4 w0[4], w1[4];
#pragma unroll
        for (int i = 0; i < 4; ++i) { w0[i] = *(const f32x4*)(P.conv_w + i * 3072 + col); w1[i] = *(const f32x4*)(P.conv_w + i * 3072 + col + 4); }
        float* dstb = (mat == 0 ? qs : (mat == 1 ? ks : vs)) + tb * 132 + ch0;
#pragma unroll
        for (int t = 0; t < 8; ++t) {
            float y[8];
#pragma unroll
            for (int e = 0; e < 8; ++e) y[e] = 0.f;
#pragma unroll
            for (int i = 0; i < 4; ++i) { const u32x4 xv = xr[t + i];
                y[0] += bflo(xv.x) * w0[i].x; y[1] += bfhi(xv.x) * w0[i].y; y[2] += bflo(xv.y) * w0[i].z; y[3] += bfhi(xv.y) * w0[i].w;
                y[4] += bflo(xv.z) * w1[i].x; y[5] += bfhi(xv.z) * w1[i].y; y[6] += bflo(xv.w) * w1[i].z; y[7] += bfhi(xv.w) * w1[i].w; }
            f32x4 o0, o1;
            o0.x = y[0] * __builtin_amdgcn_rcpf(1.f + __builtin_amdgcn_exp2f(-LOG2E * y[0])); o0.y = y[1] * __builtin_amdgcn_rcpf(1.f + __builtin_amdgcn_exp2f(-LOG2E * y[1]));
            o0.z = y[2] * __builtin_amdgcn_rcpf(1.f + __builtin_amdgcn_exp2f(-LOG2E * y[2])); o0.w = y[3] * __builtin_amdgcn_rcpf(1.f + __builtin_amdgcn_exp2f(-LOG2E * y[3]));
            o1.x = y[4] * __builtin_amdgcn_rcpf(1.f + __builtin_amdgcn_exp2f(-LOG2E * y[4])); o1.y = y[5] * __builtin_amdgcn_rcpf(1.f + __builtin_amdgcn_exp2f(-LOG2E * y[5]));
            o1.z = y[6] * __builtin_amdgcn_rcpf(1.f + __builtin_amdgcn_exp2f(-LOG2E * y[6])); o1.w = y[7] * __builtin_amdgcn_rcpf(1.f + __builtin_amdgcn_exp2f(-LOG2E * y[7]));
            *(f32x4*)(dstb + t * 132) = o0; *(f32x4*)(dstb + t * 132 + 4) = o1;
        }
    }
    if (wave == 7) {
        const float av = small[(r0 + lane) * 32 + 8 + h], bv = small[(r0 + lane) * 32 + h];
        float g = -__expf(P.a_log[h]) * softplusf_(av + P.dt_bias[h]);
#pragma unroll
        for (int o = 1; o < 64; o <<= 1) { const float t_ = __shfl_up(g, o); if (lane >= o) g += t_; }
        gam[lane] = g; egam[lane] = __expf(g); beta[lane] = sigmoidf_(bv);
    }
    __syncthreads();
    for (int rb = wave * 16; rb < wave * 16 + 16; rb += 4) {
        float* rowp[4]; float av[4], cv[4], ss[4];
#pragma unroll
        for (int q = 0; q < 4; ++q) { const int rr = rb + q; rowp[q] = (rr < 64 ? qs + rr * 132 : ks + (rr - 64) * 132); av[q] = rowp[q][lane]; cv[q] = rowp[q][lane + 64]; ss[q] = av[q] * av[q] + cv[q] * cv[q]; }
#pragma unroll
        for (int o = 1; o < 64; o <<= 1)
#pragma unroll
            for (int q = 0; q < 4; ++q) ss[q] += __shfl_xor(ss[q], o);
#pragma unroll
        for (int q = 0; q < 4; ++q) { const float sc = rsqrtf(ss[q] + EPSN) * (rb < 64 ? 0.08838834764831845f : 1.f); rowp[q][lane] = av[q] * sc; rowp[q][lane + 64] = cv[q] * sc; }
    }
    __syncthreads();
    {
        const int mat = wave >> 2, ti = (wave >> 1) & 1, tj = wave & 1, c = lane & 31, hi = lane >> 5;
        const float* Arow = (mat == 0 ? ks : qs) + (32 * ti + c) * 132 + 8 * hi;
        const float* Brow = ks + (32 * tj + c) * 132 + 8 * hi;
        f32x16 acc = f32x16{};
#pragma unroll
        for (int k = 0; k < 8; ++k) {
            const f32x4 a0 = *(const f32x4*)(Arow + 16 * k), a1 = *(const f32x4*)(Arow + 16 * k + 4);
            const f32x4 b0 = *(const f32x4*)(Brow + 16 * k), b1 = *(const f32x4*)(Brow + 16 * k + 4);
            u32x4 aw, bw;
            aw.x = pk2(a0.x, a0.y); aw.y = pk2(a0.z, a0.w); aw.z = pk2(a1.x, a1.y); aw.w = pk2(a1.z, a1.w);
            bw.x = pk2(b0.x, b0.y); bw.y = pk2(b0.z, b0.w); bw.z = pk2(b1.x, b1.y); bw.w = pk2(b1.z, b1.w);
            acc = __builtin_amdgcn_mfma_f32_32x32x16_bf16(__builtin_bit_cast(bf16x8, aw), __builtin_bit_cast(bf16x8, bw), acc, 0, 0, 0);
        }
        const int jj = 32 * tj + c; const float gj = gam[jj];
        float* dbase = mat == 0 ? Mm + jj * 64 : QKd + jj; const int dstep = mat == 0 ? 1 : 64; const int strict = mat == 0 ? 1 : 0;
#pragma unroll
        for (int r = 0; r < 16; ++r) { const int ii = 32 * ti + crow(r, hi);
            const float e = __expf(fminf(gam[ii] - gj, 0.f));
            const float sc = mat == 0 ? beta[ii] : 1.f;
            dbase[ii * dstep] = (jj + strict <= ii) ? sc * acc[r] * e : 0.f; }
    }
    __syncthreads();
    unsigned char* gout = P.ws + WS_GDN + (size_t)(bh * 128 + n) * GDN_CHUNK_BYTES;
    unsigned char* uout = P.ws + WS_UC + (size_t)(bh * 128 + n) * 16384;
    const float glast = gam[63];
    for (int p = tid; p < 2560; p += 512) {
        float v[8]; unsigned char* dst;
        if (p < 1024) {
            const int f = p >> 6, ln = p & 63, rt = f >> 3, kk = f & 7, row = 32 * rt + (ln & 31), hi = ln >> 5;
            const float* src = qs + row * 132 + 16 * kk; const float sc = egam[row];
#pragma unroll
            for (int j = 0; j < 8; ++j) v[j] = src[crow(j, hi)] * sc;
            dst = gout + 16384 + (size_t)p * 16;
        } else if (p < 1536) {
            const int q = p - 1024, f = q >> 6, ln = q & 63, rt = f >> 2, kk = f & 3, row = 32 * rt + (ln & 31), hi = ln >> 5;
#pragma unroll
            for (int j = 0; j < 8; ++j) v[j] = QKd[row * 64 + 16 * kk + crow(j, hi)];
            dst = gout + 32768 + (size_t)q * 16;
        } else {
            const int q = p - 1536, f = q >> 6, ln = q & 63, rt = f >> 2, kk = f & 3, dk = 32 * rt + (ln & 31), hi = ln >> 5;
#pragma unroll
            for (int j = 0; j < 8; ++j) { const int tk = 16 * kk + crow(j, hi); v[j] = ks[tk * 132 + dk] * __expf(fminf(glast - gam[tk], 0.f)); }
            dst = gout + 40960 + (size_t)q * 16;
        }
        u32x4 o; o.x = pk2(v[0], v[1]); o.y = pk2(v[2], v[3]); o.z = pk2(v[4], v[5]); o.w = pk2(v[6], v[7]);
        *(u32x4*)dst = o;
    }
    if (tid == 0) ((float*)(P.ws + WS_CDEC))[bh * 128 + n] = __expf(glast);
    __syncthreads();
    if (tid < 256) {
        float* col = (tid < 128 ? ks : vs) + (tid & 127);
        int zero; asm volatile("v_mov_b32 %0, 0" : "=v"(zero));
        const float* bz = beta + zero; const float* ez = egam + zero;
#pragma unroll 1
        for (int ib = 0; ib < 4; ++ib) {
            float acc[16];
#pragma unroll
            for (int r = 0; r < 16; ++r) acc[r] = col[(ib * 16 + r) * 132] * (bz[ib * 16 + r] * (tid < 128 ? ez[ib * 16 + r] : 1.f));
#pragma unroll 8
            for (int j = 0; j < ib * 16; ++j) {
                const float xj = col[j * 132]; const float* mr = Mm + zero + j * 64 + ib * 16;
                const f32x4 m0 = *(const f32x4*)mr, m1 = *(const f32x4*)(mr + 4), m2 = *(const f32x4*)(mr + 8), m3 = *(const f32x4*)(mr + 12);
                acc[0] -= m0.x * xj; acc[1] -= m0.y * xj; acc[2] -= m0.z * xj; acc[3] -= m0.w * xj;
                acc[4] -= m1.x * xj; acc[5] -= m1.y * xj; acc[6] -= m1.z * xj; acc[7] -= m1.w * xj;
                acc[8] -= m2.x * xj; acc[9] -= m2.y * xj; acc[10] -= m2.z * xj; acc[11] -= m2.w * xj;
                acc[12] -= m3.x * xj; acc[13] -= m3.y * xj; acc[14] -= m3.z * xj; acc[15] -= m3.w * xj;
            }
#pragma unroll
            for (int r2 = 0; r2 < 15; ++r2) {
                const float* mr = Mm + (ib * 16 + r2) * 64 + ib * 16; float mm[16];
#pragma unroll
                for (int q = 0; q < 4; ++q) { const f32x4 t4 = *(const f32x4*)(mr + 4 * q); mm[4 * q] = t4.x; mm[4 * q + 1] = t4.y; mm[4 * q + 2] = t4.z; mm[4 * q + 3] = t4.w; }
#pragma unroll
                for (int r = r2 + 1; r < 16; ++r) acc[r] -= mm[r] * acc[r2];
            }
#pragma unroll
            for (int r = 0; r < 16; ++r) col[(ib * 16 + r) * 132] = acc[r];
        }
    }
    __syncthreads();
    for (int p = tid; p < 2048; p += 512) {
        float v[8]; unsigned char* dst;
        if (p < 1024) {
            const int f = p >> 6, ln = p & 63, rt = f >> 3, kk = f & 7, row = 32 * rt + (ln & 31), hi = ln >> 5;
            const float* src = ks + row * 132 + 16 * kk;
#pragma unroll
            for (int j = 0; j < 8; ++j) v[j] = -src[crow(j, hi)];
            dst = gout + (size_t)p * 16;
        } else {
            const int q = p - 1024, half = q & 1, ln = (q >> 1) & 63, g2 = q >> 7, rt = g2 & 1, w4 = g2 >> 1, hi = ln >> 5;
#pragma unroll
            for (int j = 0; j < 8; ++j) v[j] = vs[(32 * rt + crow(8 * half + j, hi)) * 132 + 32 * w4 + (ln & 31)];
            dst = uout + (size_t)q * 16;
        }
        u32x4 o; o.x = pk2(v[0], v[1]); o.y = pk2(v[2], v[3]); o.z = pk2(v[4], v[5]); o.w = pk2(v[6], v[7]);
        *(u32x4*)dst = o;
    }
    __syncthreads();
}

template <int GL, int NB> __device__ __forceinline__ void norm8b(bf16* const (&p)[NB], const bool (&ok)[NB], const float* gain, float mult, float inv_n) {
    u32x4 xv[NB];
#pragma unroll
    for (int b = 0; b < NB; ++b) xv[b] = ok[b] ? *(const u32x4*)p[b] : u32x4{0u, 0u, 0u, 0u};
    const f32x4 g0 = *(const f32x4*)gain, g1 = *(const f32x4*)(gain + 4);
#pragma unroll
    for (int b = 0; b < NB; ++b) {
        float v[8] = {bflo(xv[b].x), bfhi(xv[b].x), bflo(xv[b].y), bfhi(xv[b].y), bflo(xv[b].z), bfhi(xv[b].z), bflo(xv[b].w), bfhi(xv[b].w)};
        float ss = 0.f;
#pragma unroll
        for (int e = 0; e < 8; ++e) ss += v[e] * v[e];
#pragma unroll
        for (int o = 1; o < GL; o <<= 1) ss += __shfl_xor(ss, o);
        const float sc = rsqrtf(ss * inv_n + EPSN) * mult;
        u32x4 o; o.x = pk2(v[0] * sc * g0.x, v[1] * sc * g0.y); o.y = pk2(v[2] * sc * g0.z, v[3] * sc * g0.w);
        o.z = pk2(v[4] * sc * g1.x, v[5] * sc * g1.y); o.w = pk2(v[6] * sc * g1.z, v[7] * sc * g1.w);
        if (ok[b]) *(u32x4*)p[b] = o;
    }
}

__device__ __forceinline__ void phase2(const Params& P, unsigned char* lds, int tid, int lane, int wave) {
    const int G = gridDim.x;
    bf16* proj = (bf16*)(P.ws + WS_PROJ);
    if (blockIdx.x < 16) {
        const int bh = blockIdx.x, b = bh >> 3, h = bh & 7;
        const float* small = (const float*)(P.ws + WS_SMALL);
        float* cum = (float*)(P.ws + WS_CUM) + (size_t)bh * SEQ;
        float* wtot = (float*)lds;
        const float bf = P.fox_b_f[h];
        float v[16]; float run = 0.f;
#pragma unroll
        for (int e = 0; e < 16; ++e) { const float xx = small[((size_t)b * SEQ + tid * 16 + e) * 32 + 16 + h] + bf; run += -softplusf_(-xx) * LOG2E; v[e] = run; }
        float inc = run;
#pragma unroll
        for (int o = 1; o < 64; o <<= 1) { const float t_ = __shfl_up(inc, o); if (lane >= o) inc += t_; }
        if (lane == 63) wtot[wave] = inc;
        { float gq = tid < 128 ? fabsf(P.fox_q_norm[tid]) : 0.f, gk = tid < 128 ? fabsf(P.fox_k_norm[tid]) : 0.f;
#pragma unroll
          for (int o = 1; o < 64; o <<= 1) { gq = fmaxf(gq, __shfl_xor(gq, o)); gk = fmaxf(gk, __shfl_xor(gk, o)); }
          if (lane == 0) { wtot[8 + wave] = gq; wtot[16 + wave] = gk; } }
        __syncthreads();
        if (bh == 0 && tid == 0) { float gq = 0.f, gk = 0.f; for (int w = 0; w < 8; ++w) { gq = fmaxf(gq, wtot[8 + w]); gk = fmaxf(gk, wtot[16 + w]); }
            ((float*)(P.ws + WS_CDEC + 16384))[0] = 150.f + 2.f * 1.03f * (128.f * 0.08838834764831845f * LOG2E) * gq * gk; }
        float off = inc - run;
        for (int w = 0; w < wave; ++w) off += wtot[w];
#pragma unroll
        for (int e = 0; e < 16; ++e) cum[tid * 16 + e] = v[e] + off;
        __syncthreads();
    }
    for (int u = blockIdx.x; u < 2048; u += G) gdn_prep_unit(P, lds, u >> 7, u & 127, tid, lane, wave);
    for (int it0 = blockIdx.x; it0 < TOK / 2; it0 += 4 * G) {
        const int cidx = (tid & 255) * 8, isq = cidx >= 1024, d = cidx & 127;
        bf16* pp[4]; bool ok[4];
#pragma unroll
        for (int b = 0; b < 4; ++b) { const int it = it0 + b * G; ok[b] = it < TOK / 2; pp[b] = proj + (size_t)((ok[b] ? it : 0) * 2 + (tid >> 8)) * LDP + PC_FK + cidx; }
        norm8b<16, 4>(pp, ok, (isq ? P.fox_q_norm : P.fox_k_norm) + d, isq ? 0.08838834764831845f * LOG2E : 1.f, 1.f / 128.f);
    }
    for (int it0 = blockIdx.x; it0 < TOK / 4; it0 += 4 * G) {
        const int cidx = (tid & 127) * 8, d = cidx & 255;
        bf16* pp[4]; bool ok[4];
#pragma unroll
        for (int b = 0; b < 4; ++b) { const int it = it0 + b * G; ok[b] = it < TOK / 4; pp[b] = proj + (size_t)((ok[b] ? it : 0) * 4 + (tid >> 7)) * LDP + PC_QM + cidx; }
        norm8b<32, 4>(pp, ok, P.mem_q_norm + d, 0.0625f * LOG2E, 1.f / 256.f);
    }
    bf16* kmem = (bf16*)(P.ws + WS_KMEM);
    for (int it = blockIdx.x; it < 512 / 4; it += G) {
        const int cidx = (tid & 127) * 8, d = cidx & 255;
        bf16* pp[1] = {kmem + (size_t)(it * 4 + (tid >> 7)) * 1024 + cidx}; const bool ok[1] = {true};
        norm8b<32, 1>(pp, ok, P.mem_k_norm + d, 1.f, 1.f / 256.f);
    }
}

template <int DQK, bool FOX>
__device__ __forceinline__ void attn_unit(unsigned char* lds_, const bf16* Q, int ldq, const bf16* K, int ldk, const bf16* VT, int ldvt, bf16* O, int ldo,
                                          const float* cum, float skip_lim, int t0, int ntiles, int tid, int lane, int wave, int& dbg_tiles, unsigned char* dbg_ws = nullptr) {
    asm volatile("" : "+v"(tid), "+v"(lane));
    constexpr int KS = DQK / 16, KPITCH = DQK * 2 + 16, VPITCH = 136, ND = FOX ? 4 : 2, NH = (DQK / 32) / ND, VCH = ND / 2;
    constexpr int KCH = 64 * DQK / 8 / 512;
    LAS unsigned char* lds = (LAS unsigned char*)lds_;
    LAS unsigned char* Ks = lds; LAS unsigned char* VTs = lds + 64 * KPITCH; LAS float* cbs = (LAS float*)(lds + 64 * KPITCH + 128 * VPITCH);
    const int c = lane & 31, hi = lane >> 5;
    const int qrow = t0 + wave * 32 + c;
    bf16x8 qf[KS];
    { const bf16* qp = Q + (size_t)qrow * ldq + 8 * hi;
#pragma unroll
      for (int k = 0; k < KS; ++k) qf[k] = *(const bf16x8*)(qp + 16 * k); }
    float cref = 0.f; int jmin = 0;
    if (FOX) {
        cref = cum[t0];
        LAS int* jm = (LAS int*)(cbs + 64);
        if (wave < 2) { const int j = wave * 64 + lane; bool need = false; if (j < ntiles) need = (cref - cum[64 * j + 63]) >= -skip_lim;
            const unsigned long long mk = __ballot(need); if (lane == 0) jm[wave] = mk ? (int)__builtin_ctzll(mk) + wave * 64 : (1 << 20); }
        __syncthreads();
        jmin = min(min(jm[0], jm[1]), ntiles - 1);
        jmin = __builtin_amdgcn_readfirstlane(jmin);
    }
    dbg_tiles = 0;
#ifdef PROBE_TS
    if (FOX && dbg_ws && blockIdx.x == 16 && tid == 0) { volatile unsigned long long* dg_ = (volatile unsigned long long*)(dbg_ws + WS_CTL + 32768); dg_[16] += (unsigned long long)(ntiles - jmin) * 375ull; }
#endif
#pragma unroll 1
    for (int half = 0; half < NH; ++half) {
        f32x16 o[ND]; float m = -1e30f, l = 0.f;
#pragma unroll
        for (int d = 0; d < ND; ++d) o[d] = f32x16{};
        constexpr bool PREF = (DQK == 128);
        u32x4 kpre[KCH], vpre[VCH]; float cpre = 0.f;
#define ATT_PREFETCH(j_) do { const int kv0_ = 64 * (j_); \
            _Pragma("unroll") for (int i = 0; i < KCH; ++i) { const int id = tid + 512 * i, row = id / (DQK / 8), cc = id % (DQK / 8); kpre[i] = *(const u32x4*)(K + (size_t)(kv0_ + row) * ldk + cc * 8); } \
            _Pragma("unroll") for (int i = 0; i < VCH; ++i) { const int id = tid + 512 * i, row = id >> 3, cc = id & 7; vpre[i] = *(const u32x4*)(VT + (size_t)(half * ND * 32 + row) * ldvt + kv0_ + cc * 8); } \
            if (FOX) { if (tid < 64) cpre = cum[kv0_ + tid] - cref; } } while (0)
        if (PREF) ATT_PREFETCH(jmin);
#pragma unroll 1
        for (int j = jmin; j < ntiles; ++j) {
            __syncthreads();
            if (!PREF) ATT_PREFETCH(j);
#pragma unroll
            for (int i = 0; i < KCH; ++i) { const int id = tid + 512 * i, row = id / (DQK / 8), cc = id % (DQK / 8); *(LAS u32x4*)(Ks + row * KPITCH + cc * 16) = kpre[i]; }
#pragma unroll
            for (int i = 0; i < VCH; ++i) { const int id = tid + 512 * i, row = id >> 3, cc = id & 7; LAS u32x2* d2 = (LAS u32x2*)(VTs + row * VPITCH + cc * 16);
                d2[0] = (u32x2){vpre[i].x, vpre[i].y}; d2[1] = (u32x2){vpre[i].z, vpre[i].w}; }
            if (FOX) { if (tid < 64) cbs[tid] = cpre; }
            __syncthreads();
            if (PREF && j + 1 < ntiles) ATT_PREFETCH(j + 1);
            const int kv0 = 64 * j;
            if (FOX && kv0 > t0 + wave * 32 + 31) continue;
            f32x16 p0 = f32x16{}, p1 = f32x16{};
            const LAS unsigned char* vb = VTs + c * VPITCH + hi * 8;
            u32x2 vlo[FOX ? 8 : 1], vhh[FOX ? 8 : 1];
            if constexpr (FOX) {
                const LAS unsigned char* kb = Ks + c * KPITCH + hi * 16;
                bf16x8 kf[2 * KS];
#pragma unroll
                for (int k = 0; k < KS; ++k) { kf[2 * k] = *(const LAS bf16x8*)(kb + k * 32); kf[2 * k + 1] = *(const LAS bf16x8*)(kb + 32 * KPITCH + k * 32); }
                __builtin_amdgcn_sched_barrier(0);
#pragma unroll
                for (int k = 0; k < KS; ++k) {
                    p0 = __builtin_amdgcn_mfma_f32_32x32x16_bf16(kf[2 * k], qf[k], p0, 0, 0, 0);
                    p1 = __builtin_amdgcn_mfma_f32_32x32x16_bf16(kf[2 * k + 1], qf[k], p1, 0, 0, 0); }
                __builtin_amdgcn_sched_barrier(0);
#pragma unroll
                for (int d = 0; d < 2; ++d)
#pragma unroll
                    for (int cc = 0; cc < 4; ++cc) { vlo[d * 4 + cc] = *(const LAS u32x2*)(vb + d * 32 * VPITCH + cc * 32); vhh[d * 4 + cc] = *(const LAS u32x2*)(vb + d * 32 * VPITCH + cc * 32 + 16); }
                __builtin_amdgcn_sched_barrier(0);
            } else {
                const LAS unsigned char* kb = Ks + c * KPITCH + hi * 16;
#pragma unroll
                for (int k = 0; k < KS; ++k) {
                    const bf16x8 a0 = *(const LAS bf16x8*)(kb + k * 32), a1 = *(const LAS bf16x8*)(kb + 32 * KPITCH + k * 32);
                    p0 = __builtin_amdgcn_mfma_f32_32x32x16_bf16(a0, qf[k], p0, 0, 0, 0);
                    p1 = __builtin_amdgcn_mfma_f32_32x32x16_bf16(a1, qf[k], p1, 0, 0, 0); }
            }
            if (FOX) {
#pragma unroll
                for (int r4 = 0; r4 < 4; ++r4) { const f32x4 b0 = *(const LAS f32x4*)(cbs + 8 * r4 + 4 * hi), b1 = *(const LAS f32x4*)(cbs + 32 + 8 * r4 + 4 * hi);
#pragma unroll
                    for (int e = 0; e < 4; ++e) { p0[4 * r4 + e] -= b0[e]; p1[4 * r4 + e] -= b1[e]; } }
                if (kv0 + 63 > t0 + wave * 32) {
#pragma unroll
                    for (int r = 0; r < 16; ++r) { const int kv = kv0 + crow(r, hi); if (kv > qrow) p0[r] = -INFINITY; if (kv + 32 > qrow) p1[r] = -INFINITY; }
                }
            }
            float mx = p0[0];
#pragma unroll
            for (int r = 1; r < 16; ++r) mx = fmaxf(mx, p0[r]);
#pragma unroll
            for (int r = 0; r < 16; ++r) mx = fmaxf(mx, p1[r]);
            mx = fmaxf(mx, __shfl_xor(mx, 32));
            const float mn = fmaxf(m, mx), alpha = __builtin_amdgcn_exp2f(m - mn); m = mn;
            float ps = 0.f;
#pragma unroll
            for (int r = 0; r < 16; ++r) { p0[r] = __builtin_amdgcn_exp2f(p0[r] - mn); p1[r] = __builtin_amdgcn_exp2f(p1[r] - mn); ps += p0[r] + p1[r]; }
            l = l * alpha + ps;
#pragma unroll
            for (int d = 0; d < ND; ++d)
#pragma unroll
                for (int r = 0; r < 16; ++r) o[d][r] *= alpha;
            bf16x8 pb[4];
#pragma unroll
            for (int cc = 0; cc < 4; ++cc) { u32x4 w;
                if (cc < 2) { w.x = pk2(p0[8 * cc + 0], p0[8 * cc + 1]); w.y = pk2(p0[8 * cc + 2], p0[8 * cc + 3]); w.z = pk2(p0[8 * cc + 4], p0[8 * cc + 5]); w.w = pk2(p0[8 * cc + 6], p0[8 * cc + 7]); }
                else { const int c2 = cc - 2; w.x = pk2(p1[8 * c2 + 0], p1[8 * c2 + 1]); w.y = pk2(p1[8 * c2 + 2], p1[8 * c2 + 3]); w.z = pk2(p1[8 * c2 + 4], p1[8 * c2 + 5]); w.w = pk2(p1[8 * c2 + 6], p1[8 * c2 + 7]); }
                pb[cc] = __builtin_bit_cast(bf16x8, w); }
            if constexpr (FOX) {
                u32x2 wlo[8], whh[8];
#pragma unroll
                for (int d = 0; d < 2; ++d)
#pragma unroll
                    for (int cc = 0; cc < 4; ++cc) { wlo[d * 4 + cc] = *(const LAS u32x2*)(vb + (d + 2) * 32 * VPITCH + cc * 32); whh[d * 4 + cc] = *(const LAS u32x2*)(vb + (d + 2) * 32 * VPITCH + cc * 32 + 16); }
                __builtin_amdgcn_sched_barrier(0);
#pragma unroll
                for (int cc = 0; cc < 4; ++cc)
#pragma unroll
                    for (int d = 0; d < 2; ++d) { const u32x4 av = (u32x4){vlo[d * 4 + cc].x, vlo[d * 4 + cc].y, vhh[d * 4 + cc].x, vhh[d * 4 + cc].y};
                        o[d] = __builtin_amdgcn_mfma_f32_32x32x16_bf16(__builtin_bit_cast(bf16x8, av), pb[cc], o[d], 0, 0, 0); }
                __builtin_amdgcn_sched_barrier(0);
#pragma unroll
                for (int cc = 0; cc < 4; ++cc)
#pragma unroll
                    for (int d = 0; d < 2; ++d) { const u32x4 av = (u32x4){wlo[d * 4 + cc].x, wlo[d * 4 + cc].y, whh[d * 4 + cc].x, whh[d * 4 + cc].y};
                        o[d + 2] = __builtin_amdgcn_mfma_f32_32x32x16_bf16(__builtin_bit_cast(bf16x8, av), pb[cc], o[d + 2], 0, 0, 0); }
            } else {
#pragma unroll
              for (int d = 0; d < ND; ++d)
#pragma unroll
                  for (int cc = 0; cc < 4; ++cc) {
                      const u32x2 lo = *(const LAS u32x2*)(vb + d * 32 * VPITCH + cc * 32), hh = *(const LAS u32x2*)(vb + d * 32 * VPITCH + cc * 32 + 16);
                      const u32x4 av = (u32x4){lo.x, lo.y, hh.x, hh.y};
                      o[d] = __builtin_amdgcn_mfma_f32_32x32x16_bf16(__builtin_bit_cast(bf16x8, av), pb[cc], o[d], 0, 0, 0); } }
        }
        l += __shfl_xor(l, 32);
        const float rl = 1.f / l;
        bf16* op = O + (size_t)qrow * ldo + half * ND * 32 + 4 * hi;
#pragma unroll
        for (int d = 0; d < ND; ++d)
#pragma unroll
            for (int r4 = 0; r4 < 4; ++r4) { u32x2 w; w.x = pk2(o[d][4 * r4 + 0] * rl, o[d][4 * r4 + 1] * rl); w.y = pk2(o[d][4 * r4 + 2] * rl, o[d][4 * r4 + 3] * rl);
                *(u32x2*)(op + 32 * d + 8 * r4) = w; }
    }
    __syncthreads();
}

__device__ __forceinline__ void gdn_scan_wg(const Params& P, unsigned char* lds_, int unit, int tid, int lane, int wave) {
    const int bh = unit >> 2, quart = unit & 3;
    LAS unsigned char* lds = (LAS unsigned char*)lds_;
    const int b = bh >> 3, h = bh & 7;
    const unsigned char* gsrc = P.ws + WS_GDN + (size_t)bh * 128 * GDN_CHUNK_BYTES;
    const unsigned char* usrc = P.ws + WS_UC + (size_t)bh * 128 * 16384;
    const float* cdec = (const float*)(P.ws + WS_CDEC) + bh * 128;
    bf16* proj = (bf16*)(P.ws + WS_PROJ);
#define SCAN_BAR() asm volatile("s_waitcnt lgkmcnt(0)\n\ts_barrier" ::: "memory")
    constexpr int OB = 114688;
    if (wave >= 4) {
        const int lt = tid - 256, tk = lt >> 2, q4 = lt & 3;
        const size_t rowb = (size_t)b * SEQ + tk;
        bf16* obase = proj + rowb * LDP + PC_OA + h * 128 + q4 * 32;
        u32x4 r[14];
#pragma unroll
        for (int k = 0; k < 14; ++k) r[k] = *(const u32x4*)(gsrc + (size_t)(lt + 256 * k) * 16);
#pragma unroll
        for (int k = 0; k < 14; ++k) *(LAS u32x4*)(lds + (lt + 256 * k) * 16) = r[k];
#pragma unroll
        for (int k = 0; k < 14; ++k) r[k] = *(const u32x4*)(gsrc + (size_t)GDN_CHUNK_BYTES + (size_t)(lt + 256 * k) * 16);
        __syncthreads();
#define GDN_NORM(CH) do { if (q4 == quart) { const LAS unsigned char* ob_ = lds + OB + ((CH) & 1) * 16384 + tk * 256 + q4 * 64; bf16* op_ = obase + (size_t)(CH) * 64 * LDP; \
            _Pragma("unroll") for (int i = 0; i < 4; ++i) { const u32x4 w_ = *(const LAS u32x4*)(ob_ + i * 16); *(u32x4*)(op_ + 8 * i) = w_; } } } while (0)
#pragma unroll 1
        for (int n = 0; n < 128; ++n) {
            if (n + 1 < 128) {
                LAS unsigned char* d = lds + ((n + 1) & 1) * GDN_CHUNK_BYTES;
#pragma unroll
                for (int k = 0; k < 14; ++k) *(LAS u32x4*)(d + (lt + 256 * k) * 16) = r[k];
            }
            if (n + 2 < 128) {
                const unsigned char* s2 = gsrc + (size_t)(n + 2) * GDN_CHUNK_BYTES;
#pragma unroll
                for (int k = 0; k < 14; ++k) r[k] = *(const u32x4*)(s2 + (size_t)(lt + 256 * k) * 16);
            }
            if (n > 0) GDN_NORM(n - 1);
            SCAN_BAR();
        }
        GDN_NORM(127);
#undef GDN_NORM
    } else if (wave >= 1) {
        __syncthreads();
#pragma unroll 1
        for (int n = 0; n < 128; ++n) SCAN_BAR();
    } else {
        const int w4 = quart, c = lane & 31, hi = lane >> 5;
        f32x16 S[4];
#pragma unroll
        for (int t = 0; t < 4; ++t) S[t] = f32x16{};
        bf16x8 Sb[8];
#pragma unroll
        for (int k = 0; k < 8; ++k) Sb[k] = bf16x8{};
        u32x4 ucn[4];
#pragma unroll
        for (int i = 0; i < 4; ++i) ucn[i] = *(const u32x4*)(usrc + (size_t)((w4 * 2 + (i >> 1)) * 64 + lane) * 32 + (i & 1) * 16);
        float cdn = cdec[0];
        __syncthreads();
#pragma unroll 1
        for (int n = 0; n < 128; ++n) {
            const LAS unsigned char* fb = lds + (n & 1) * GDN_CHUNK_BYTES + lane * 16;
            f32x16 U[2];
#pragma unroll
            for (int rt = 0; rt < 2; ++rt) { const u32x4 a = ucn[2 * rt], bq = ucn[2 * rt + 1];
                U[rt][0] = bflo(a.x); U[rt][1] = bfhi(a.x); U[rt][2] = bflo(a.y); U[rt][3] = bfhi(a.y); U[rt][4] = bflo(a.z); U[rt][5] = bfhi(a.z); U[rt][6] = bflo(a.w); U[rt][7] = bfhi(a.w);
                U[rt][8] = bflo(bq.x); U[rt][9] = bfhi(bq.x); U[rt][10] = bflo(bq.y); U[rt][11] = bfhi(bq.y); U[rt][12] = bflo(bq.z); U[rt][13] = bfhi(bq.z); U[rt][14] = bflo(bq.w); U[rt][15] = bfhi(bq.w); }
            const float cd = cdn;
            if (n + 1 < 128) {
                const unsigned char* us = usrc + (size_t)(n + 1) * 16384;
#pragma unroll
                for (int i = 0; i < 4; ++i) ucn[i] = *(const u32x4*)(us + (size_t)((w4 * 2 + (i >> 1)) * 64 + lane) * 32 + (i & 1) * 16);
                cdn = cdec[n + 1];
            }
#define FRAG(off) (*(const LAS bf16x8*)(fb + (off)))
#define SBAR() __builtin_amdgcn_sched_barrier(0)
            bf16x8 A0[8], A1[8];
#pragma unroll
            for (int i = 0; i < 8; ++i) A0[i] = FRAG(((i & 1) * 8 + (i >> 1)) * 1024);
            SBAR();
#pragma unroll
            for (int i = 0; i < 8; ++i) A1[i] = FRAG(((i & 1) * 8 + 4 + (i >> 1)) * 1024);
            SBAR();
#pragma unroll
            for (int i = 0; i < 8; ++i) U[i & 1] = __builtin_amdgcn_mfma_f32_32x32x16_bf16(A0[i], Sb[i >> 1], U[i & 1], 0, 0, 0);
            SBAR();
#pragma unroll
            for (int i = 0; i < 8; ++i) A0[i] = FRAG(16384 + ((i & 1) * 8 + (i >> 1)) * 1024);
            SBAR();
#pragma unroll
            for (int i = 0; i < 8; ++i) U[i & 1] = __builtin_amdgcn_mfma_f32_32x32x16_bf16(A1[i], Sb[4 + (i >> 1)], U[i & 1], 0, 0, 0);
            SBAR();
#pragma unroll
            for (int i = 0; i < 8; ++i) A1[i] = FRAG(16384 + ((i & 1) * 8 + 4 + (i >> 1)) * 1024);
            SBAR();
            f32x16 Ov[2]; Ov[0] = f32x16{}; Ov[1] = f32x16{};
#pragma unroll
            for (int i = 0; i < 8; ++i) Ov[i & 1] = __builtin_amdgcn_mfma_f32_32x32x16_bf16(A0[i], Sb[i >> 1], Ov[i & 1], 0, 0, 0);
            SBAR();
#pragma unroll
            for (int i = 0; i < 8; ++i) A0[i] = FRAG(32768 + ((i & 1) * 4 + (i >> 1)) * 1024);
            SBAR();
#pragma unroll
            for (int i = 0; i < 8; ++i) Ov[i & 1] = __builtin_amdgcn_mfma_f32_32x32x16_bf16(A1[i], Sb[4 + (i >> 1)], Ov[i & 1], 0, 0, 0);
            SBAR();
            bf16x8 Ub[4];
#pragma unroll
            for (int k2 = 0; k2 < 4; ++k2) { const f32x16& uu = U[k2 >> 1]; const int o8 = 8 * (k2 & 1); u32x4 w;
                w.x = pk2(uu[o8 + 0], uu[o8 + 1]); w.y = pk2(uu[o8 + 2], uu[o8 + 3]); w.z = pk2(uu[o8 + 4], uu[o8 + 5]); w.w = pk2(uu[o8 + 6], uu[o8 + 7]); Ub[k2] = __builtin_bit_cast(bf16x8, w); }
#pragma unroll
            for (int i = 0; i < 8; ++i) A1[i] = FRAG(40960 + ((i & 3) * 4 + (i >> 2)) * 1024);
            SBAR();
#pragma unroll
            for (int i = 0; i < 8; ++i) Ov[i & 1] = __builtin_amdgcn_mfma_f32_32x32x16_bf16(A0[i], Ub[i >> 1], Ov[i & 1], 0, 0, 0);
            SBAR();
#pragma unroll
            for (int i = 0; i < 8; ++i) A0[i] = FRAG(40960 + ((i & 3) * 4 + 2 + (i >> 2)) * 1024);
            SBAR();
#pragma unroll
            for (int t = 0; t < 4; ++t)
#pragma unroll
                for (int r = 0; r < 16; ++r) S[t][r] *= cd;
#pragma unroll
            for (int i = 0; i < 8; ++i) S[i & 3] = __builtin_amdgcn_mfma_f32_32x32x16_bf16(A1[i], Ub[i >> 2], S[i & 3], 0, 0, 0);
            SBAR();
#pragma unroll
            for (int i = 0; i < 8; ++i) S[i & 3] = __builtin_amdgcn_mfma_f32_32x32x16_bf16(A0[i], Ub[2 + (i >> 2)], S[i & 3], 0, 0, 0);
            SBAR();
            { LAS bf16* ob = (LAS bf16*)(lds + OB + (n & 1) * 16384);
#pragma unroll
              for (int rt = 0; rt < 2; ++rt)
#pragma unroll
                  for (int r = 0; r < 16; ++r) ob[(32 * rt + crow(r, hi)) * 128 + 32 * w4 + c] = (bf16)(pk2(Ov[rt][r], 0.f) & 0xffffu); }
#pragma unroll
            for (int k = 0; k < 8; ++k) { const f32x16& ss = S[k >> 1]; const int o8 = 8 * (k & 1); u32x4 w;
                w.x = pk2(ss[o8 + 0], ss[o8 + 1]); w.y = pk2(ss[o8 + 2], ss[o8 + 3]); w.z = pk2(ss[o8 + 4], ss[o8 + 5]); w.w = pk2(ss[o8 + 6], ss[o8 + 7]); Sb[k] = __builtin_bit_cast(bf16x8, w); }
#undef FRAG
#undef SBAR
            SCAN_BAR();
        }
    }
    __syncthreads();
}

__device__ __forceinline__ void phase3(const Params& P, unsigned char* lds, int tid, int lane, int wave) {
    bf16* proj = (bf16*)(P.ws + WS_PROJ);
#ifndef NO_SCAN
    if (blockIdx.x < 64) gdn_scan_wg(P, lds, blockIdx.x, tid, lane, wave);
#endif
#ifdef PROBE_TS
    if (blockIdx.x == 0 && tid == 0) ((volatile unsigned long long*)(P.ws + WS_CTL + 32768))[10] = __builtin_amdgcn_s_memrealtime();
#endif
    unsigned* ctr = (unsigned*)(P.ws + WS_CTL);
    LAS unsigned* sh = (LAS unsigned*)((LAS unsigned char*)lds + LDS_BYTES - 64);
    const bf16* foxvt = (const bf16*)((const unsigned char*)P.out + DO_FOXVT);
    const float* cum = (const float*)(P.ws + WS_CUM);
    const bf16* kmem = (const bf16*)(P.ws + WS_KMEM); const bf16* vmt = (const bf16*)(P.ws + WS_VMT);
#ifdef STATIC_P3
    for (unsigned idx_ = (blockIdx.x < 16 ? 100000u : blockIdx.x - 16u); idx_ < 768u; idx_ += 240u) {
        const unsigned idx = __builtin_amdgcn_readfirstlane(idx_);
#else
    for (;;) {
        if (tid == 0) sh[0] = atomicAdd(ctr, 1u);
        __syncthreads();
        const unsigned idx = __builtin_amdgcn_readfirstlane(sh[0]);
        __syncthreads();
        if (idx >= 512u + 256u) break;
#endif
        int dbg_t = 0;
#ifdef PROBE_TS
        if (blockIdx.x == 16 && tid == 0) ((volatile unsigned long long*)(P.ws + WS_CTL + 32768))[20] = __builtin_amdgcn_s_memrealtime();
#endif
        if (idx < 512u) {
#ifndef NO_FOXATT
            const int qb = 31 - (int)(idx >> 4), bh = idx & 15, b = bh >> 3, h = bh & 7;
            bf16* Qp = proj + (size_t)b * SEQ * LDP + PC_FQ + h * 128;
            const bf16* Kp = proj + (size_t)b * SEQ * LDP + PC_FK + h * 128;
            const bf16* Vp = foxvt + (size_t)(h * 128) * TOK + (size_t)b * SEQ;
            attn_unit<128, true>(lds, Qp, LDP, Kp, LDP, Vp, TOK, Qp, LDP, cum + (size_t)bh * SEQ, ((const float*)(P.ws + WS_CDEC + 16384))[0], qb * 256, (qb + 1) * 4, tid, lane, wave, dbg_t, P.ws);
#ifdef PROBE_TS
            if (blockIdx.x == 16 && tid == 0) { volatile unsigned long long* dg = (volatile unsigned long long*)(P.ws + WS_CTL + 32768); dg[14] += __builtin_amdgcn_s_memrealtime() - dg[20]; }
#endif
#endif
        } else {
#ifndef NO_MEMATT
            const int u = idx - 512, qb = u & 31, bh = u >> 5, b = bh >> 2, h = bh & 3;
            bf16* Qp = proj + (size_t)b * SEQ * LDP + PC_QM + h * 256;
            const bf16* Kp = kmem + (size_t)b * 256 * 1024 + h * 256;
            const bf16* Vp = vmt + (size_t)(h * 256) * 512 + b * 256;
            attn_unit<256, false>(lds, Qp, LDP, Kp, 1024, Vp, 512, Qp, LDP, nullptr, 0.f, qb * 256, 4, tid, lane, wave, dbg_t);
#ifdef PROBE_TS
            if (blockIdx.x == 16 && tid == 0) { volatile unsigned long long* dg = (volatile unsigned long long*)(P.ws + WS_CTL + 32768); dg[18] += __builtin_amdgcn_s_memrealtime() - dg[20]; }
#endif
#endif
        }
    }
#ifdef PROBE_TS
    if (blockIdx.x == 0 && tid == 0) ((volatile unsigned long long*)(P.ws + WS_CTL + 32768))[11] = __builtin_amdgcn_s_memrealtime();
#endif
}


__device__ __forceinline__ void gdn_gate_norm_pass(const Params& P, int tid) {
    bf16* proj = (bf16*)(P.ws + WS_PROJ);
    const int cidx = (tid & 127) * 8, d = cidx & 127;
    const f32x4 g0 = *(const f32x4*)(P.gdn_norm_g + d), g1 = *(const f32x4*)(P.gdn_norm_g + d + 4);
    const float gg[8] = {g0.x, g0.y, g0.z, g0.w, g1.x, g1.y, g1.z, g1.w};
    for (int it0 = blockIdx.x; it0 < TOK / 4; it0 += 4 * gridDim.x) {
        u32x4 ov[4], zv[4]; bool ok[4]; bf16* op[4];
#pragma unroll
        for (int b = 0; b < 4; ++b) { const int it = it0 + b * gridDim.x; ok[b] = it < TOK / 4; const size_t row = (size_t)((ok[b] ? it : 0) * 4 + (tid >> 7));
            op[b] = proj + row * LDP + PC_OA + cidx; ov[b] = *(const u32x4*)op[b]; zv[b] = *(const u32x4*)(proj + row * LDP + PC_Z + cidx); }
#pragma unroll
        for (int b = 0; b < 4; ++b) {
            const float v[8] = {bflo(ov[b].x), bfhi(ov[b].x), bflo(ov[b].y), bfhi(ov[b].y), bflo(ov[b].z), bfhi(ov[b].z), bflo(ov[b].w), bfhi(ov[b].w)};
            const float z[8] = {bflo(zv[b].x), bfhi(zv[b].x), bflo(zv[b].y), bfhi(zv[b].y), bflo(zv[b].z), bfhi(zv[b].z), bflo(zv[b].w), bfhi(zv[b].w)};
            float ss = 0.f;
#pragma unroll
            for (int e = 0; e < 8; ++e) ss += v[e] * v[e];
            ss += __shfl_xor(ss, 1); ss += __shfl_xor(ss, 2); ss += __shfl_xor(ss, 4); ss += __shfl_xor(ss, 8);
            const float rstd = rsqrtf(ss * (1.f / 128.f) + EPSN);
            float o[8];
#pragma unroll
            for (int e = 0; e < 8; ++e) o[e] = v[e] * rstd * gg[e] * (z[e] * __builtin_amdgcn_rcpf(1.f + __builtin_amdgcn_exp2f(-LOG2E * z[e])));
            u32x4 w; w.x = pk2(o[0], o[1]); w.y = pk2(o[2], o[3]); w.z = pk2(o[4], o[5]); w.w = pk2(o[6], o[7]);
            if (ok[b]) *(u32x4*)op[b] = w;
        }
    }
}

#define RLX_AGENT __ATOMIC_RELAXED, __HIP_MEMORY_SCOPE_AGENT
#define XB_TMO      128
#define XB_XCNT(j)  (256  + 64 * (j))
#define XB_XSUB(j)  (1280 + 64 * (j))
#define XB_XGEN(j)  (2304 + 64 * (j))
#define XB_TOP      3328
#define XB_TOPGEN   3392
#define XCD_BAR_WORDS 3456
#define XB_SPIN_CAP (1u << 22)

__device__ __forceinline__ unsigned xb_ld(unsigned* p)              { return __hip_atomic_load(p, __ATOMIC_RELAXED, __HIP_MEMORY_SCOPE_AGENT); }
__device__ __forceinline__ unsigned xb_add(unsigned* p, unsigned v) { return __hip_atomic_fetch_add(p, v, __ATOMIC_RELAXED, __HIP_MEMORY_SCOPE_AGENT); }
__device__ __forceinline__ unsigned xb_xcc_id() { return (unsigned)__builtin_amdgcn_s_getreg((3 << 11) | 20) & 0xFu; }
#define XB_SPIN(cond, bar) do { unsigned _sp = 0; while (cond) { __builtin_amdgcn_s_sleep(1); \
    if ((++_sp & 255u) == 0u) { if (xb_ld(&(bar)[XB_TMO])) break; if (_sp > XB_SPIN_CAP) { atomicAdd(&(bar)[XB_TMO], 1u); break; } } } } while (0)

struct XcdBarrier {
    unsigned* bar; unsigned x;
    volatile LAS unsigned* st;
};

__device__ __forceinline__ XcdBarrier xcd_barrier_post(unsigned* bar, volatile LAS unsigned* st) {
    XcdBarrier b; b.bar = bar; b.x = xb_xcc_id(); b.st = st;
    if (threadIdx.x == 0) (void)xb_add(&bar[XB_XCNT(b.x)], 1u);
    return b;
}
__device__ __forceinline__ void xcd_barrier_complete(unsigned* bar, unsigned x, unsigned& nloc, unsigned& nx) {
    const unsigned G = gridDim.x * gridDim.y * gridDim.z;
    unsigned sum, cnt, mine, sp = 0u;
    for (;;) {
        sum = 0u; cnt = 0u; mine = 0u;
#pragma unroll
        for (unsigned j = 0; j < 16; ++j) { const unsigned c = xb_ld(&bar[XB_XCNT(j)]); sum += c; cnt += (c > 0u) ? 1u : 0u; mine = (j == x) ? c : mine; }
        if (sum == G) break;
        __builtin_amdgcn_s_sleep(1);
        if ((++sp & 255u) == 0u) { if (xb_ld(&bar[XB_TMO])) break; if (sp > XB_SPIN_CAP) { atomicAdd(&bar[XB_TMO], 1u); break; } }
    }
    nloc = mine > 0u ? mine : 1u; nx = cnt > 0u ? cnt : 1u;
}

__device__ __forceinline__ void xcd_barrier(const XcdBarrier& b) {
    asm volatile("s_waitcnt vmcnt(0)" ::: "memory");
    __syncthreads();
    if (threadIdx.x == 0) {
        unsigned* bar = b.bar;
        __builtin_amdgcn_s_waitcnt(0);
        unsigned nloc = b.st[0], nx = b.st[1];
        if (nloc == 0u) { xcd_barrier_complete(bar, b.x, nloc, nx); b.st[0] = nloc; b.st[1] = nx; }
        const unsigned old = xb_add(&bar[XB_XSUB(b.x)], 1u);
        const unsigned gen = old / nloc;
        if (old + 1u == (gen + 1u) * nloc) {
            __builtin_amdgcn_fence(__ATOMIC_RELEASE, "agent");
            asm volatile("s_waitcnt vmcnt(0)" ::: "memory");
            const unsigned og = xb_add(&bar[XB_TOP], 1u);
            const unsigned tg = og / nx;
            if (og + 1u == (tg + 1u) * nx) xb_add(&bar[XB_TOPGEN], 1u);
            else XB_SPIN(xb_ld(&bar[XB_TOPGEN]) == tg, bar);
            __builtin_amdgcn_fence(__ATOMIC_ACQUIRE, "agent");
            xb_add(&bar[XB_XGEN(b.x)], 1u);
            asm volatile("s_waitcnt vmcnt(0)" ::: "memory");
        } else {
            XB_SPIN(xb_ld(&bar[XB_XGEN(b.x)]) == gen, bar);
            __builtin_amdgcn_fence(__ATOMIC_ACQUIRE, "agent");
            asm volatile("s_waitcnt vmcnt(0)" ::: "memory");
        }
    }
    __syncthreads();
}

__global__ void __launch_bounds__(512, 2) hybrid_fwd(Params P) {
    extern __shared__ __attribute__((aligned(16))) unsigned char lds[];
    cg::grid_group grid = cg::this_grid();
    const int tid = threadIdx.x, lane = tid & 63, wave = __builtin_amdgcn_readfirstlane(tid >> 6);
    const int G = gridDim.x, cb = blockIdx.x;
    unsigned char* ws = P.ws;
    LAS unsigned char* glds = (LAS unsigned char*)lds;
    bf16* H = (bf16*)((unsigned char*)P.out + DO_H);
    bf16* proj = (bf16*)(ws + WS_PROJ);
    volatile LAS unsigned* bst = (volatile LAS unsigned*)(glds + LDS_BYTES - 32);
    if (tid < 2) bst[tid] = 0u;
    __syncthreads();
    XcdBarrier bar = xcd_barrier_post((unsigned*)(ws + WS_CTL) + 1024, bst);
#ifdef PROBE_TS
    volatile unsigned long long* tsg_ = (volatile unsigned long long*)(ws + WS_CTL + 32768);
    if (blockIdx.x == 0 && tid == 0) tsg_[0] = __builtin_amdgcn_s_memrealtime();
#endif
    grid.sync();
#ifdef PROBE_TS
#define GRID_BAR(k_) do { xcd_barrier(bar); if (blockIdx.x == 0 && tid == 0) tsg_[k_] = __builtin_amdgcn_s_memrealtime(); } while (0)
#else
#define GRID_BAR(k_) xcd_barrier(bar)
#endif

#ifndef NO_P0
    phase0(P, lds, tid, lane, wave);
#endif
    GRID_BAR(1);
#ifndef NO_GEMM
    {
        pg8::Gemm g{H, (const bf16*)(ws + WS_W1T), TOK, 7424, 2048, 2048, 2048}; pg8::StaticOrder S; S.init(TOK, 7424, G, cb);
        pg8::EpiProj E{proj, LDP, (float*)(ws + WS_SMALL)};
        pg8::gemm_phase<pg8::EpiProj, pg8::StaticOrder, true, true>(glds, g, S, E);
    }
    {
        pg8::Gemm g{(const bf16*)(ws + WS_WFVT), H, 1024, TOK, 2048, 2048, 2048}; pg8::StaticOrder S; S.init(1024, TOK, G, cb);
        pg8::EpiStore E{(bf16*)((unsigned char*)P.out + DO_FOXVT), TOK};
        pg8::gemm_phase<pg8::EpiStore, pg8::StaticOrder, true, true>(glds, g, S, E);
    }
    {
        const int cr = (cb + G - 64) % G;
        pg8::Gemm g{(const bf16*)(ws + WS_MEMN), (const bf16*)(ws + WS_WMKVT), 512, 1024, 2048, 2048, 2048}; pg8::StaticOrder S; S.init(512, 1024, G, cr);
        pg8::EpiStore E{(bf16*)(ws + WS_KMEM), 1024};
        pg8::gemm_phase<pg8::EpiStore, pg8::StaticOrder, true, true>(glds, g, S, E);
        const int cr2 = (cb + G - 72) % G;
        pg8::Gemm g2{(const bf16*)(ws + WS_WMKVT) + (size_t)1024 * 2048, (const bf16*)(ws + WS_MEMN), 1024, 512, 2048, 2048, 2048}; pg8::StaticOrder S2; S2.init(1024, 512, G, cr2);
        pg8::EpiStore E2{(bf16*)(ws + WS_VMT), 512};
        pg8::gemm_phase<pg8::EpiStore, pg8::StaticOrder, true, true>(glds, g2, S2, E2);
    }
#endif
    GRID_BAR(2);
#ifndef NO_P2
    phase2(P, lds, tid, lane, wave);
#endif
    GRID_BAR(3);
#ifndef NO_P3
    phase3(P, lds, tid, lane, wave);
#endif
    GRID_BAR(4);
#ifndef NO_GEMM
    gdn_gate_norm_pass(P, tid);
    {
        pg8::Gemm g{H, (const bf16*)(ws + WS_WGT), TOK, 6144, 2048, 2048, 2048}; pg8::StaticOrder S; S.init(TOK, 6144, G, cb);
        pg8::EpiSig E{(unsigned char*)P.out + DO_GA, (unsigned char*)(proj + PC_GB), 2048, LDP * 2};
        pg8::gemm_phase<pg8::EpiSig, pg8::StaticOrder, true, true>(glds, g, S, E);
    }
    GRID_BAR(5);
    {
        bf16* Y = (bf16*)(ws + WS_Y); const bf16* WUPT = (const bf16*)(ws + WS_WUPT);
        pg8::StaticOrder S; S.init(TOK, 2048, G, cb);
        { pg8::Gemm g{proj + PC_OA, WUPT, TOK, 2048, 1024, LDP, 1024}; pg8::EpiGate<true> E{(const unsigned char*)P.out + DO_GA, 2048, Y, 2048};
          pg8::gemm_phase<pg8::EpiGate<true>, pg8::StaticOrder, true, true>(glds, g, S, E); }
        { pg8::Gemm g{proj + PC_OB, WUPT + (size_t)2048 * 1024, TOK, 2048, 1024, LDP, 1024}; pg8::EpiGate<false> E{(const unsigned char*)(proj + PC_GB), LDP * 2, Y, 2048};
          pg8::gemm_phase<pg8::EpiGate<false>, pg8::StaticOrder, true, true>(glds, g, S, E); }
        { pg8::Gemm g{proj + PC_OM, WUPT + (size_t)2 * 2048 * 1024, TOK, 2048, 1024, LDP, 1024}; pg8::EpiGate<false> E{(const unsigned char*)(proj + PC_GB) + 2048, LDP * 2, Y, 2048};
          pg8::gemm_phase<pg8::EpiGate<false>, pg8::StaticOrder, true, true>(glds, g, S, E); }
    }
    GRID_BAR(6);
    {
        pg8::Gemm g{(const bf16*)(ws + WS_Y), (const bf16*)(ws + WS_WOT), TOK, 2048, 2048, 2048, 2048}; pg8::StaticOrder S; S.init(TOK, 2048, G, cb);
        pg8::EpiRes1 E{P.x, (bf16*)(ws + WS_X1B), (float*)(ws + WS_SSQ)};
        pg8::gemm_phase<pg8::EpiRes1, pg8::StaticOrder, true, true>(glds, g, S, E);
    }
    GRID_BAR(7);
    {
        const float* SSQ = (const float*)(ws + WS_SSQ); float* RSTD = (float*)(ws + WS_RSTD);
        const int g = cb * 512 + tid;
        if (g < TOK * 8) { const int row = g >> 3, part = g & 7; float sq = 0.f;
#pragma unroll
            for (int q = 0; q < 4; ++q) sq += SSQ[(size_t)(part * 4 + q) * 16384 + row];
            sq += __shfl_xor(sq, 1); sq += __shfl_xor(sq, 2); sq += __shfl_xor(sq, 4);
            if (part == 0) RSTD[row] = rsqrtf(sq * (1.f / 2048.f) + 1e-6f); }
    }
    GRID_BAR(8);
    {
        pg8::Gemm g{(const bf16*)(ws + WS_X1B), (const bf16*)(ws + WS_WFF1T), TOK, 8192, 2048, 2048, 2048}; pg8::StaticOrder S; S.init(TOK, 8192, G, cb);
        pg8::EpiFF1 E{(const float*)(ws + WS_RSTD), (bf16*)(ws + WS_U), 8192};
        pg8::gemm_phase<pg8::EpiFF1, pg8::StaticOrder, true, true>(glds, g, S, E);
    }
    GRID_BAR(9);
    {
        pg8::Gemm g{(const bf16*)(ws + WS_U), (const bf16*)(ws + WS_WFF2T), TOK, 2048, 8192, 8192, 8192}; pg8::StaticOrder S; S.init(TOK, 2048, G, cb, 4);
        pg8::EpiOut E{(const bf16*)(ws + WS_X1B), P.out};
        pg8::gemm_phase<pg8::EpiOut, pg8::StaticOrder, true, true>(glds, g, S, E);
    }
#endif
#ifdef PROBE_TS
    if (blockIdx.x == 0 && tid == 0) {
        const unsigned long long tend = __builtin_amdgcn_s_memrealtime();
        tsg_[12] = tend;
        long long qa = ((long long)(tsg_[PROBE_A1] - tsg_[PROBE_A0]) + 1500) / 3000; if (qa > 35) qa = 35;
        long long qb = ((long long)(tsg_[PROBE_B1] - tsg_[PROBE_B0]) + 1500) / 3000; if (qb > 35) qb = 35;
        long long qc = ((long long)(tsg_[PROBE_C1] - tsg_[PROBE_C0]) + 1500) / 3000; if (qc > 35) qc = 35;
        const unsigned long long until = tend + (unsigned long long)(qa + 36 * qb + 1296 * qc) * 2000ull;
        while (__builtin_amdgcn_s_memrealtime() < until) __builtin_amdgcn_s_sleep(8);
    }
#endif
}

extern "C" void kernel_launch(void* const* d_in, const int* in_sizes, int n_in, void* d_out, int out_size, void* d_ws, size_t ws_size, hipStream_t stream) {
    static int grid = 0;
    if (grid == 0) {
        if (n_in != 22 || out_size != TOK * DM || ws_size < WS_END) { fprintf(stderr, "kernel_launch: unexpected shapes (n_in %d out %d ws %zu)\n", n_in, out_size, ws_size); grid = -1; return; }
        int dev = 0, cus = 0, per_cu = 0;
        hipGetDevice(&dev); hipDeviceGetAttribute(&cus, hipDeviceAttributeMultiprocessorCount, dev);
        if (hipFuncSetAttribute((const void*)hybrid_fwd, hipFuncAttributeMaxDynamicSharedMemorySize, LDS_BYTES) != hipSuccess) { fprintf(stderr, "kernel_launch: hipFuncSetAttribute failed\n"); grid = -1; return; }
        if (hipOccupancyMaxActiveBlocksPerMultiprocessor(&per_cu, (const void*)hybrid_fwd, 512, LDS_BYTES) != hipSuccess || per_cu < 1) { fprintf(stderr, "kernel_launch: occupancy query says %d\n", per_cu); per_cu = 1; }
        (void)hipGetLastError();
        grid = cus * 1;
        if (grid <= 0) grid = 256;
    }
    if (grid < 0) return;
    if (hipMemsetAsync((char*)d_ws + WS_CTL, 0, 65536, stream) != hipSuccess) { fprintf(stderr, "kernel_launch: memset failed\n"); return; }
    Params p{};
    const float** pp = (const float**)&p;
    for (int i = 0; i < 22; ++i) pp[i] = (const float*)d_in[i];
    p.out = (float*)d_out; p.ws = (unsigned char*)d_ws;
    void* args[] = {&p};
    hipError_t e = hipLaunchCooperativeKernel((const void*)hybrid_fwd, dim3(grid), dim3(512), args, LDS_BYTES, stream);
    if (e != hipSuccess) fprintf(stderr, "cooperative launch failed: %s (grid %d)\n", hipGetErrorString(e), grid);
}
```

```cpp
#include <hip/hip_runtime.h>
#include <hip/hip_cooperative_groups.h>
#include <cstdio>
#include <cstdint>
namespace cg = cooperative_groups;

namespace pg8 {
#define PG8_LAS __attribute__((address_space(3)))
typedef unsigned short bf16_t;
typedef short bf16x8 __attribute__((ext_vector_type(8)));
typedef float f32x4 __attribute__((ext_vector_type(4)));
typedef unsigned u32x4 __attribute__((ext_vector_type(4)));
constexpr int BM = 256, BK = 64, HALF = 128, HTB = HALF * BK * 2  , STAGE_BYTES = 8 * HTB, NXCD = 8, WGM = 8;

__host__ __device__ __forceinline__ int lds_byte(int r, int c) { const int st = (r >> 4) * 2 + (c >> 5), rr = r & 15, cc = c & 31, ob = rr * 64 + cc * 2; return st * 1024 + (ob ^ (((ob >> 9) & 1) << 5)); }
__host__ __device__ __forceinline__ void stage_rc(int b, int& R, int& C) { const int st = b / 1024, sb = b % 1024, swz = sb ^ (((sb >> 9) & 1) << 5); R = (st >> 1) * 16 + swz / 64; C = (st & 1) * 32 + (swz % 64) / 2; }
__host__ __device__ __forceinline__ int perm32(int rho) { const int n = rho >> 4, i = rho & 15; return 8 * (i >> 2) + 4 * n + (i & 3); }

struct Unit { int pm, pn; };
struct Gemm { const bf16_t* A; const bf16_t* Bt; int M, N, K, lda, ldb; };

struct StaticOrder {
    int nM, nN, nwg, G, c, wgm;
    __host__ __device__ void init(int M, int N, int G_, int c_, int wgm_ = WGM) { nM = M / BM; nN = N / BM; nwg = nM * nN; G = G_; c = c_; wgm = wgm_; }
    __host__ __device__ bool next(int i, Unit& u) const {
        const long L = (long)i * G + c; if (L >= nwg) return false;
        int wgid = (int)L; { const int q = nwg / NXCD, r = nwg % NXCD, xcd = wgid % NXCD, off = wgid / NXCD; wgid = (xcd < r ? xcd * (q + 1) : r * (q + 1) + (xcd - r) * q) + off; }
        const int nig = wgm * nN, gid = wgid / nig, fm = gid * wgm, gsz = (nM - fm) < wgm ? (nM - fm) : wgm;
        u.pm = fm + ((wgid % nig) % gsz); u.pn = (wgid % nig) / gsz; return true;
    }
    __device__ __forceinline__ void a_ready(const Unit&) const {}
    __device__ __forceinline__ void done(const Unit&) const {}
};

typedef float f32x2_cv __attribute__((ext_vector_type(2))); typedef __bf16 bf16x2_cv __attribute__((ext_vector_type(2)));
__device__ __forceinline__ unsigned cvt_pk_bf16(float lo, float hi) { f32x2_cv v = {lo, hi}; bf16x2_cv b = __builtin_convertvector(v, bf16x2_cv); return __builtin_bit_cast(unsigned, b); }
template <class Epi, class Sched, bool ALIGN_EPI = false, bool SP2 = false>
__device__ __forceinline__ void gemm_phase(PG8_LAS unsigned char* lds, const Gemm g, const Sched& S, const Epi& E) {
    int tid_ = threadIdx.x; asm volatile("" : "+v"(tid_));
    const int tid = tid_, wid = __builtin_amdgcn_readfirstlane(tid >> 6), lane = tid & 63, wr = wid >> 2, wc = wid & 3, fr = lane & 15, fq = lane >> 4;
    const int K = g.K, nt = K / BK;
    unsigned voffA[2], voffB[2];
#pragma unroll
    for (int i = 0; i < 2; ++i) { int R, C; stage_rc(tid * 16 + i * 8192, R, C); const int Rb = Epi::PERM ? ((R & ~31) + perm32(R & 31)) : R;
        voffA[i] = (unsigned)(R * g.lda + C) * 2u; voffB[i] = (unsigned)(Rb * g.ldb + C) * 2u; }
    const size_t kstep = (size_t)(BK * 2);
    const size_t hstepA = (size_t)HALF * g.lda * 2, hstepB = (size_t)HALF * g.ldb * 2;
    const size_t tstepA = 2 * hstepA, tstepB = 2 * hstepB;
    const unsigned ldsw = (unsigned)wid * 1024u;
    const int aoff = lds_byte(wr * 64 + fr, fq * 8), boff = lds_byte(wc * 32 + fr, fq * 8);
#define PG8_SA(b, h) (((b) * 2 + (h)) * HTB)
#define PG8_SB(b, h) ((4 + (b) * 2 + (h)) * HTB)
#define PG8_STAGE(bufoff, gbase, voff) do { _Pragma("unroll") for (int _i = 0; _i < 2; ++_i) \
        __builtin_amdgcn_global_load_lds((const unsigned*)((const char*)(gbase) + (voff)[_i]), (PG8_LAS unsigned*)(lds + (bufoff) + ldsw + _i * 8192), 16, 0, 0); } while (0)
#define PG8_LDA(dst, b, h) do { _Pragma("unroll") for (int m = 0; m < 4; ++m) _Pragma("unroll") for (int k = 0; k < 2; ++k) dst[m][k] = *(const PG8_LAS bf16x8*)(lds + PG8_SA(b, h) + aoff + m * 2048 + k * 1024); } while (0)
#define PG8_LDB(dst, b, h) do { _Pragma("unroll") for (int n = 0; n < 2; ++n) _Pragma("unroll") for (int k = 0; k < 2; ++k) dst[n][k] = *(const PG8_LAS bf16x8*)(lds + PG8_SB(b, h) + boff + n * 2048 + k * 1024); } while (0)
#define PG8_MMA(ai, bj, At, Bt) do { __builtin_amdgcn_s_setprio(1); _Pragma("unroll") for (int m = 0; m < 4; ++m) _Pragma("unroll") for (int n = 0; n < 2; ++n) _Pragma("unroll") for (int k = 0; k < 2; ++k) \
        acc[ai][bj][m][n] = __builtin_amdgcn_mfma_f32_16x16x32_bf16(Bt[n][k], At[m][k], acc[ai][bj][m][n], 0, 0, 0); __builtin_amdgcn_s_setprio(0); } while (0)
#define PG8_WAIT_V(n) asm volatile("s_waitcnt vmcnt(" #n ")" ::: "memory")
#define PG8_WAIT_L(n) asm volatile("s_waitcnt lgkmcnt(" #n ")" ::: "memory")
#define PG8_BAR __builtin_amdgcn_s_barrier()
#define PG8_SCHED __builtin_amdgcn_sched_barrier(0)
    Unit cur, nxt; int ui = 0;
    if (!S.next(0, cur)) return;
    f32x4 acc[2][2][4][2];
#pragma unroll
    for (int a = 0; a < 2; ++a)
#pragma unroll
        for (int b = 0; b < 2; ++b)
#pragma unroll
            for (int m = 0; m < 4; ++m)
#pragma unroll
                for (int n = 0; n < 2; ++n) acc[a][b][m][n] = (f32x4){0.f, 0.f, 0.f, 0.f};
    bf16x8 At[4][2], B0[2][2], B1[2][2];
    const char* cA = (const char*)g.A + (size_t)cur.pm * tstepA; const char* cB = (const char*)g.Bt + (size_t)cur.pn * tstepB;
    S.a_ready(cur);
    if constexpr (SP2) {
        PG8_STAGE(PG8_SB(0, 0), cB, voffB); PG8_STAGE(PG8_SB(0, 1), cB + hstepB, voffB); PG8_STAGE(PG8_SA(0, 0), cA, voffA); PG8_STAGE(PG8_SA(0, 1), cA + hstepA, voffA);
        if (wr == 1) PG8_BAR;
        PG8_WAIT_V(2); PG8_BAR;
        PG8_STAGE(PG8_SB(1, 0), cB + kstep, voffB); PG8_STAGE(PG8_SA(1, 0), cA + kstep, voffA); PG8_STAGE(PG8_SB(1, 1), cB + hstepB + kstep, voffB);
        PG8_WAIT_V(6); PG8_BAR;
    } else {
        PG8_STAGE(PG8_SB(0, 0), cB, voffB); PG8_STAGE(PG8_SA(0, 0), cA, voffA); PG8_STAGE(PG8_SB(0, 1), cB + hstepB, voffB); PG8_STAGE(PG8_SA(0, 1), cA + hstepA, voffA);
        if (wr == 1) PG8_BAR;
        PG8_WAIT_V(4); PG8_BAR;
        PG8_STAGE(PG8_SB(1, 0), cB + kstep, voffB); PG8_STAGE(PG8_SA(1, 0), cA + kstep, voffA); PG8_STAGE(PG8_SB(1, 1), cB + hstepB + kstep, voffB);
        PG8_WAIT_V(6); PG8_BAR;
    }
    for (;;) {
        const bool has_next = S.next(ui + 1, nxt);
        const char* nA = has_next ? (const char*)g.A + (size_t)nxt.pm * tstepA : cA; const char* nB = has_next ? (const char*)g.Bt + (size_t)nxt.pn * tstepB : cB;
        for (int t = 0; t < nt; t += 2) {
            const bool last = (t == nt - 2);
            const char* a1 = cA + (size_t)(t + 1) * kstep;
            const char* a2 = last ? nA : cA + (size_t)(t + 2) * kstep; const char* b2 = last ? nB : cB + (size_t)(t + 2) * kstep;
            const char* a3 = a2 + kstep; const char* b3 = b2 + kstep;
            if (last && has_next) S.a_ready(nxt);
            if constexpr (SP2) {
            PG8_LDB(B0, 0, 0); PG8_LDB(B1, 0, 1); PG8_SCHED; PG8_LDA(At, 0, 0); PG8_STAGE(PG8_SA(1, 1), a1 + hstepA, voffA);
            PG8_WAIT_V(8); PG8_WAIT_L(0); PG8_BAR; PG8_MMA(0, 0, At, B0); PG8_MMA(0, 1, At, B1); PG8_BAR; PG8_SCHED;
            PG8_LDA(At, 0, 1); PG8_STAGE(PG8_SB(0, 0), b2, voffB); PG8_STAGE(PG8_SB(0, 1), b2 + hstepB, voffB); PG8_STAGE(PG8_SA(0, 0), a2, voffA);
            PG8_WAIT_V(8); PG8_WAIT_L(0); PG8_BAR; PG8_MMA(1, 0, At, B0); PG8_MMA(1, 1, At, B1); PG8_BAR; PG8_SCHED;
            PG8_LDB(B0, 1, 0); PG8_LDB(B1, 1, 1); PG8_SCHED; PG8_LDA(At, 1, 0); PG8_STAGE(PG8_SA(0, 1), a2 + hstepA, voffA);
            PG8_WAIT_V(8); PG8_WAIT_L(0); PG8_BAR; PG8_MMA(0, 0, At, B0); PG8_MMA(0, 1, At, B1); PG8_BAR; PG8_SCHED;
            PG8_LDA(At, 1, 1); PG8_STAGE(PG8_SB(1, 0), b3, voffB); PG8_STAGE(PG8_SB(1, 1), b3 + hstepB, voffB); PG8_STAGE(PG8_SA(1, 0), a3, voffA);
            PG8_WAIT_V(8); PG8_WAIT_L(0); PG8_BAR; PG8_MMA(1, 0, At, B0); PG8_MMA(1, 1, At, B1); PG8_BAR; PG8_SCHED;
            } else {
            PG8_LDB(B0, 0, 0); PG8_SCHED; PG8_LDA(At, 0, 0); PG8_STAGE(PG8_SA(1, 1), a1 + hstepA, voffA);
            PG8_WAIT_L(8); PG8_BAR; PG8_WAIT_L(0); PG8_MMA(0, 0, At, B0); PG8_BAR; PG8_SCHED;
            PG8_LDB(B1, 0, 1); PG8_STAGE(PG8_SB(0, 0), b2, voffB);
            PG8_BAR; PG8_WAIT_L(0); PG8_MMA(0, 1, At, B1); PG8_BAR;
            PG8_LDA(At, 0, 1); PG8_STAGE(PG8_SA(0, 0), a2, voffA);
            PG8_BAR; PG8_WAIT_L(0); PG8_MMA(1, 0, At, B0); PG8_BAR; PG8_SCHED;
            PG8_STAGE(PG8_SB(0, 1), b2 + hstepB, voffB);
            PG8_WAIT_V(6); PG8_BAR; PG8_MMA(1, 1, At, B1); PG8_BAR;
            PG8_LDB(B0, 1, 0); PG8_SCHED; PG8_LDA(At, 1, 0); PG8_STAGE(PG8_SA(0, 1), a2 + hstepA, voffA);
            PG8_WAIT_L(8); PG8_BAR; PG8_WAIT_L(0); PG8_MMA(0, 0, At, B0); PG8_BAR; PG8_SCHED;
            PG8_LDB(B1, 1, 1); PG8_STAGE(PG8_SB(1, 0), b3, voffB);
            PG8_BAR; PG8_WAIT_L(0); PG8_MMA(0, 1, At, B1); PG8_BAR;
            PG8_LDA(At, 1, 1); PG8_STAGE(PG8_SA(1, 0), a3, voffA);
            PG8_BAR; PG8_WAIT_L(0); PG8_MMA(1, 0, At, B0); PG8_BAR; PG8_SCHED;
            PG8_STAGE(PG8_SB(1, 1), b3 + hstepB, voffB);
            PG8_WAIT_V(6); PG8_BAR; PG8_MMA(1, 1, At, B1); PG8_BAR;
            }
        }
        if constexpr (ALIGN_EPI) { if (wr == 0) PG8_BAR; }
        if constexpr (!Epi::AFTER_DRAIN) { E(acc, cur, wr, wc, fr, fq); S.done(cur); }
        if (!has_next) break;
#pragma unroll
        for (int a = 0; a < 2; ++a)
#pragma unroll
            for (int b = 0; b < 2; ++b)
#pragma unroll
                for (int m = 0; m < 4; ++m)
#pragma unroll
                    for (int n = 0; n < 2; ++n) acc[a][b][m][n] = (f32x4){0.f, 0.f, 0.f, 0.f};
        cur = nxt; cA = nA; cB = nB; ++ui;
        if constexpr (ALIGN_EPI) { if (wr == 1) PG8_BAR; }
    }
    PG8_WAIT_V(0);
    if constexpr (!ALIGN_EPI) { if (wr == 0) PG8_BAR; }
    PG8_BAR;
    if constexpr (Epi::AFTER_DRAIN) { E.fused(acc, cur, wr, wc, fr, fq, lds, wid, lane); S.done(cur); }
#undef PG8_SA
#undef PG8_SB
#undef PG8_STAGE
#undef PG8_LDA
#undef PG8_LDB
#undef PG8_MMA
#undef PG8_WAIT_V
#undef PG8_WAIT_L
#undef PG8_BAR
#undef PG8_SCHED
}
}

constexpr int TOK = 16384, SEQ = 8192, DM = 2048, DIN = 14360, DFF = 8192;
constexpr int LDP = 7168;
constexpr int PC_QA = 0, PC_KA = 1024, PC_VA = 2048, PC_Z = 3072, PC_FK = 4096, PC_FQ = 5120, PC_QM = 6144;
constexpr int PC_OA = 0, PC_OB = PC_FQ, PC_OM = PC_QM, PC_GB = 1024, PC_GM = 3072;
constexpr float EPSN = 1e-6f;
constexpr float LOG2E = 1.4426950408889634f;
constexpr size_t MiB = 1u << 20;
constexpr size_t WS_CTL = 0, WS_W1T = 1 * MiB, WS_WFVT = 30 * MiB, WS_WMKVT = 34 * MiB, WS_UC = 1 * MiB;
constexpr size_t WS_SMALL = 42 * MiB, WS_KMEM = 44 * MiB, WS_VMT = 45 * MiB, WS_CUM = 46 * MiB, WS_CDEC = 46 * MiB + 512 * 1024,
                 WS_MEMN = 47 * MiB, WS_SSQ = 49 * MiB, WS_RSTD = 51 * MiB;
constexpr size_t WS_WGT = 52 * MiB, WS_WUPT = 76 * MiB, WS_WOT = 88 * MiB, WS_WFF1T = 96 * MiB, WS_WFF2T = 128 * MiB;
constexpr size_t WS_PROJ = 160 * MiB, WS_GDN = 384 * MiB, WS_END = 496 * MiB;
constexpr int FOXVT_LD = TOK;
constexpr size_t WS_Y = 384 * MiB, WS_X1B = 160 * MiB, WS_U = 224 * MiB;
constexpr size_t DO_H = 0, DO_FOXVT = 64 * MiB, DO_GA = 64 * MiB;
constexpr int GDN_CHUNK_BYTES = 57344;
constexpr int LDS_BYTES = 163840;

#define LAS __attribute__((address_space(3)))
typedef unsigned short bf16;
typedef short bf16x8 __attribute__((ext_vector_type(8)));
typedef float f32x4 __attribute__((ext_vector_type(4)));
typedef float f32x16 __attribute__((ext_vector_type(16)));
typedef unsigned u32x4 __attribute__((ext_vector_type(4)));
typedef unsigned u32x2 __attribute__((ext_vector_type(2)));

__device__ __forceinline__ unsigned pk2(float lo, float hi) { return pg8::cvt_pk_bf16(lo, hi); }
__device__ __forceinline__ float bf2f(unsigned short v) { return __uint_as_float(((unsigned)v) << 16); }
__device__ __forceinline__ float bflo(unsigned w) { return __uint_as_float(w << 16); }
__device__ __forceinline__ float bfhi(unsigned w) { return __uint_as_float(w & 0xffff0000u); }
__device__ __forceinline__ int crow(int r, int hi) { return (r & 3) + 8 * (r >> 2) + 4 * hi; }
__device__ __forceinline__ float sigmoidf_(float x) { return 1.f / (1.f + __expf(-x)); }
__device__ __forceinline__ float softplusf_(float x) { return fmaxf(x, 0.f) + log1pf(__expf(-fabsf(x))); }

namespace pg8 {
struct EpiStore {
    static constexpr bool PERM = true, AFTER_DRAIN = false;
    bf16_t* O; int ldc;
    __device__ __forceinline__ void operator()(const f32x4 (&acc)[2][2][4][2], const Unit& u, int wr, int wc, int fr, int fq) const {
        const int row0 = u.pm * BM + wr * 64 + fr, col0 = u.pn * BM + wc * 32 + 8 * fq;
#pragma unroll
        for (int ai = 0; ai < 2; ++ai)
#pragma unroll
            for (int m = 0; m < 4; ++m) { bf16_t* rowp = O + (size_t)(row0 + ai * HALF + m * 16) * ldc + col0;
#pragma unroll
                for (int bj = 0; bj < 2; ++bj) { const f32x4 v0 = acc[ai][bj][m][0], v1 = acc[ai][bj][m][1];
                    u32x4 w; w.x = cvt_pk_bf16(v0[0], v0[1]); w.y = cvt_pk_bf16(v0[2], v0[3]); w.z = cvt_pk_bf16(v1[0], v1[1]); w.w = cvt_pk_bf16(v1[2], v1[3]);
                    *(u32x4*)(rowp + bj * HALF) = w; } }
    }
};
struct EpiProj {
    static constexpr bool PERM = true, AFTER_DRAIN = false;
    bf16_t* O; int ldc; float* small;
    __device__ __forceinline__ void operator()(const f32x4 (&acc)[2][2][4][2], const Unit& u, int wr, int wc, int fr, int fq) const {
        const int row0 = u.pm * BM + wr * 64 + fr;
        if (u.pn == 28) {
            if (wc == 0) {
#pragma unroll
                for (int ai = 0; ai < 2; ++ai)
#pragma unroll
                    for (int m = 0; m < 4; ++m) { float* p = small + (size_t)(row0 + ai * HALF + m * 16) * 32 + 8 * fq;
                        *(f32x4*)p = acc[ai][0][m][0]; *(f32x4*)(p + 4) = acc[ai][0][m][1]; }
            }
            return;
        }
        const int col0 = u.pn * BM + wc * 32 + 8 * fq;
#pragma unroll
        for (int ai = 0; ai < 2; ++ai)
#pragma unroll
            for (int m = 0; m < 4; ++m) { bf16_t* rowp = O + (size_t)(row0 + ai * HALF + m * 16) * ldc + col0;
#pragma unroll
                for (int bj = 0; bj < 2; ++bj) { const f32x4 v0 = acc[ai][bj][m][0], v1 = acc[ai][bj][m][1];
                    u32x4 w; w.x = cvt_pk_bf16(v0[0], v0[1]); w.y = cvt_pk_bf16(v0[2], v0[3]); w.z = cvt_pk_bf16(v1[0], v1[1]); w.w = cvt_pk_bf16(v1[2], v1[3]);
                    *(u32x4*)(rowp + bj * HALF) = w; } }
    }
};
struct EpiSig {
    static constexpr bool PERM = true, AFTER_DRAIN = false;
    unsigned char* O0; unsigned char* O1; int ld0, ld1;
    __device__ __forceinline__ void operator()(const f32x4 (&acc)[2][2][4][2], const Unit& u, int wr, int wc, int fr, int fq) const {
        const int br = u.pn >> 3; unsigned char* O = br == 0 ? O0 : O1 + (size_t)(br - 1) * 2048; const int ldc = br == 0 ? ld0 : ld1;
        const int row0 = u.pm * BM + wr * 64 + fr, col0 = (u.pn & 7) * BM + wc * 32 + 8 * fq;
#pragma unroll
        for (int ai = 0; ai < 2; ++ai)
#pragma unroll
            for (int m = 0; m < 4; ++m) { unsigned char* rowp = O + (size_t)(row0 + ai * HALF + m * 16) * ldc + col0;
#pragma unroll
                for (int bj = 0; bj < 2; ++bj) { const f32x4 v0 = acc[ai][bj][m][0], v1 = acc[ai][bj][m][1]; unsigned q[8];
#pragma unroll
                    for (int e = 0; e < 4; ++e) { q[e] = (unsigned)(255.f * __builtin_amdgcn_rcpf(1.f + __builtin_amdgcn_exp2f(-1.4426950408889634f * v0[e])) + 0.5f);
                                                  q[4 + e] = (unsigned)(255.f * __builtin_amdgcn_rcpf(1.f + __builtin_amdgcn_exp2f(-1.4426950408889634f * v1[e])) + 0.5f); }
                    u32x2 w; w.x = q[0] | (q[1] << 8) | (q[2] << 16) | (q[3] << 24); w.y = q[4] | (q[5] << 8) | (q[6] << 16) | (q[7] << 24);
                    *(u32x2*)(rowp + bj * HALF) = w; } }
    }
};
template <bool FIRST> struct EpiGate {
    static constexpr bool PERM = true, AFTER_DRAIN = false;
    const unsigned char* G; int ldg; bf16_t* Y; int ldy;
    __device__ __forceinline__ void operator()(const f32x4 (&acc)[2][2][4][2], const Unit& u, int wr, int wc, int fr, int fq) const {
        const int row0 = u.pm * BM + wr * 64 + fr, col0 = u.pn * BM + wc * 32 + 8 * fq;
        constexpr float S = 1.f / 255.f;
#pragma unroll
        for (int ai = 0; ai < 2; ++ai)
#pragma unroll
            for (int m = 0; m < 4; ++m) { const size_t r = (size_t)(row0 + ai * HALF + m * 16);
#pragma unroll
                for (int bj = 0; bj < 2; ++bj) { const f32x4 v0 = acc[ai][bj][m][0], v1 = acc[ai][bj][m][1];
                    const u32x2 g = *(const u32x2*)(G + r * ldg + col0 + bj * HALF);
                    float o[8];
                    o[0] = v0[0] * ((float)(g.x & 0xffu) * S); o[1] = v0[1] * ((float)((g.x >> 8) & 0xffu) * S);
                    o[2] = v0[2] * ((float)((g.x >> 16) & 0xffu) * S); o[3] = v0[3] * ((float)(g.x >> 24) * S);
                    o[4] = v1[0] * ((float)(g.y & 0xffu) * S); o[5] = v1[1] * ((float)((g.y >> 8) & 0xffu) * S);
                    o[6] = v1[2] * ((float)((g.y >> 16) & 0xffu) * S); o[7] = v1[3] * ((float)(g.y >> 24) * S);
                    bf16_t* yp = Y + r * ldy + col0 + bj * HALF;
                    if (!FIRST) { const u32x4 y = *(const u32x4*)yp;
                        o[0] += __uint_as_float(y.x << 16); o[1] += __uint_as_float(y.x & 0xffff0000u);
                        o[2] += __uint_as_float(y.y << 16); o[3] += __uint_as_float(y.y & 0xffff0000u);
                        o[4] += __uint_as_float(y.z << 16); o[5] += __uint_as_float(y.z & 0xffff0000u);
                        o[6] += __uint_as_float(y.w << 16); o[7] += __uint_as_float(y.w & 0xffff0000u); }
                    u32x4 w; w.x = cvt_pk_bf16(o[0], o[1]); w.y = cvt_pk_bf16(o[2], o[3]); w.z = cvt_pk_bf16(o[4], o[5]); w.w = cvt_pk_bf16(o[6], o[7]);
                    *(u32x4*)yp = w; } }
    }
};
struct EpiRes1 {
    static constexpr bool PERM = false, AFTER_DRAIN = false;
    const float* X; bf16_t* XB; float* SSQ;
    __device__ __forceinline__ void operator()(const f32x4 (&acc)[2][2][4][2], const Unit& u, int wr, int wc, int fr, int fq) const {
        const int row0 = u.pm * BM + wr * 64 + fr, col0 = u.pn * BM + wc * 32 + 4 * fq;
#pragma unroll
        for (int ai = 0; ai < 2; ++ai)
#pragma unroll
            for (int m = 0; m < 4; ++m) { const int row = row0 + ai * HALF + m * 16; const size_t off = (size_t)row * 2048 + col0; float s = 0.f;
#pragma unroll
                for (int bj = 0; bj < 2; ++bj)
#pragma unroll
                    for (int n = 0; n < 2; ++n) { const size_t o = off + bj * HALF + n * 16; const f32x4 xv = *(const f32x4*)(X + o); const f32x4 v = xv + acc[ai][bj][m][n];
                        u32x2 w; w.x = cvt_pk_bf16(v[0], v[1]); w.y = cvt_pk_bf16(v[2], v[3]); *(u32x2*)(XB + o) = w;
                        s += (v[0] * v[0] + v[1] * v[1]) + (v[2] * v[2] + v[3] * v[3]); }
                s += __shfl_xor(s, 16); s += __shfl_xor(s, 32);
                if (fq == 0) SSQ[(size_t)(u.pn * 4 + wc) * 16384 + row] = s; }
    }
};
struct EpiFF1 {
    static constexpr bool PERM = true, AFTER_DRAIN = false;
    const float* RSTD; bf16_t* O; int ldc;
    __device__ __forceinline__ void operator()(const f32x4 (&acc)[2][2][4][2], const Unit& u, int wr, int wc, int fr, int fq) const {
        const int row0 = u.pm * BM + wr * 64 + fr, col0 = u.pn * BM + wc * 32 + 8 * fq;
        float rs[2][4];
#pragma unroll
        for (int ai = 0; ai < 2; ++ai)
#pragma unroll
            for (int m = 0; m < 4; ++m) rs[ai][m] = RSTD[row0 + ai * HALF + m * 16];
#pragma unroll
        for (int ai = 0; ai < 2; ++ai)
#pragma unroll
            for (int m = 0; m < 4; ++m) { const int row = row0 + ai * HALF + m * 16; const float rstd = rs[ai][m];
                bf16_t* rowp = O + (size_t)row * ldc + col0;
#pragma unroll
                for (int bj = 0; bj < 2; ++bj) { f32x4 v0 = acc[ai][bj][m][0] * rstd, v1 = acc[ai][bj][m][1] * rstd;
#pragma unroll
                    for (int e = 0; e < 4; ++e) { const float a = fmaxf(v0[e], 0.f), b = fmaxf(v1[e], 0.f); v0[e] = a * a; v1[e] = b * b; }
                    u32x4 w; w.x = cvt_pk_bf16(v0[0], v0[1]); w.y = cvt_pk_bf16(v0[2], v0[3]); w.z = cvt_pk_bf16(v1[0], v1[1]); w.w = cvt_pk_bf16(v1[2], v1[3]);
                    *(u32x4*)(rowp + bj * HALF) = w; } }
    }
};
struct EpiOut {
    static constexpr bool PERM = false, AFTER_DRAIN = false;
    const bf16_t* XB; float* OUT;
    __device__ __forceinline__ void operator()(const f32x4 (&acc)[2][2][4][2], const Unit& u, int wr, int wc, int fr, int fq) const {
        const int row0 = u.pm * BM + wr * 64 + fr, col0 = u.pn * BM + wc * 32 + 4 * fq;
#pragma unroll
        for (int ai = 0; ai < 2; ++ai)
#pragma unroll
            for (int m = 0; m < 4; ++m) { const size_t off = (size_t)(row0 + ai * HALF + m * 16) * 2048 + col0;
#pragma unroll
                for (int bj = 0; bj < 2; ++bj)
#pragma unroll
                    for (int n = 0; n < 2; ++n) { const size_t o = off + bj * HALF + n * 16; const u32x2 xb = *(const u32x2*)(XB + o);
                        f32x4 xv; xv[0] = __uint_as_float(xb.x << 16); xv[1] = __uint_as_float(xb.x & 0xffff0000u); xv[2] = __uint_as_float(xb.y << 16); xv[3] = __uint_as_float(xb.y & 0xffff0000u);
                        *(f32x4*)(OUT + o) = xv + acc[ai][bj][m][n]; } }
    }
};
}

struct Params {
    const float *x, *mem, *g_mix, *w_in, *conv_w, *a_log, *dt_bias, *gdn_norm_g, *fox_b_f, *fox_q_norm, *fox_k_norm, *g_mem, *w_mem_kv,
                *mem_q_norm, *mem_k_norm, *w_up_gdn, *w_up_fox, *w_up_mem, *w_out, *g_mlp, *w_ff1, *w_ff2;
    float* out; unsigned char* ws;
};

__device__ __forceinline__ float wave_sum(float v) {
#pragma unroll
    for (int o = 1; o < 64; o <<= 1) v += __shfl_xor(v, o);
    return v;
}

__device__ __forceinline__ void transpose_item(const float* W, int ldw, int n0src, bf16* WT, int K, int row0dst, const float* kscale,
                                               LAS float* scr, int kb, int nb, int lane) {
    const int k0 = 64 * kb, n0 = 32 * nb;
    float tv[32];
#pragma unroll
    for (int i = 0; i < 32; ++i) tv[i] = W[(size_t)(k0 + 2 * i + (lane >> 5)) * ldw + n0src + n0 + (lane & 31)];
#pragma unroll
    for (int i = 0; i < 32; ++i) { const int kk = 2 * i + (lane >> 5); float v = tv[i];
        if (kscale) v *= kscale[k0 + kk]; scr[kk * 33 + (lane & 31)] = v; }
    asm volatile("s_waitcnt lgkmcnt(0)" ::: "memory");
    const int c = lane & 7;
#pragma unroll
    for (int j = 0; j < 4; ++j) { const int n = (lane >> 3) + 8 * j; const LAS float* s = scr + (8 * c) * 33 + n;
        u32x4 o; o.x = pk2(s[0 * 33], s[1 * 33]); o.y = pk2(s[2 * 33], s[3 * 33]); o.z = pk2(s[4 * 33], s[5 * 33]); o.w = pk2(s[6 * 33], s[7 * 33]);
        *(u32x4*)(WT + (size_t)(row0dst + n0 + n) * K + k0 + 8 * c) = o; }
    asm volatile("s_waitcnt lgkmcnt(0)" ::: "memory");
}
__device__ __forceinline__ void transpose_job(const float* W, int ldw, int n0src, int K, int ncols, bf16* WT, int row0dst, const float* kscale,
                                              LAS float* scr, int gw, int ngw, int lane) {
    const int nblk = ncols / 32, nitems = (K / 64) * nblk;
    for (int it = gw; it < nitems; it += ngw) transpose_item(W, ldw, n0src, WT, K, row0dst, kscale, scr, it / nblk, it % nblk, lane);
}
__device__ __forceinline__ void rms_row_to_bf16(const float* xrow, const float* g, bf16* orow, int lane) {
    const f32x4* xr = (const f32x4*)xrow + lane; const f32x4* gr = (const f32x4*)g + lane;
    f32x4 v[8]; float s = 0.f;
#pragma unroll
    for (int j = 0; j < 8; ++j) { v[j] = xr[64 * j]; s += (v[j].x * v[j].x + v[j].y * v[j].y) + (v[j].z * v[j].z + v[j].w * v[j].w); }
    const float rstd = rsqrtf(wave_sum(s) * (1.f / 2048.f) + EPSN);
    u32x2* o8 = (u32x2*)orow + lane;
#pragma unroll
    for (int j = 0; j < 8; ++j) { const f32x4 gg = gr[64 * j]; u32x2 w; w.x = pk2(v[j].x * rstd * gg.x, v[j].y * rstd * gg.y); w.y = pk2(v[j].z * rstd * gg.z, v[j].w * rstd * gg.w); o8[64 * j] = w; }
}

__device__ __forceinline__ void phase0(const Params& P, unsigned char* lds, int tid, int lane, int wave) {
    unsigned char* ws = P.ws;
    bf16* W1T = (bf16*)(ws + WS_W1T); bf16* WFVT = (bf16*)(ws + WS_WFVT); bf16* WMKVT = (bf16*)(ws + WS_WMKVT); bf16* WGT = (bf16*)(ws + WS_WGT);
    bf16* WUPT = (bf16*)(ws + WS_WUPT); bf16* WOT = (bf16*)(ws + WS_WOT); bf16* WFF1T = (bf16*)(ws + WS_WFF1T); bf16* WFF2T = (bf16*)(ws + WS_WFF2T);
    LAS float* scr = (LAS float*)((LAS unsigned char*)lds + wave * 16384);
    const int G = gridDim.x, gw = blockIdx.x * 8 + wave, ngw = G * 8;
    bf16* H = (bf16*)((unsigned char*)P.out + DO_H);
    for (int m = gw; m < TOK; m += ngw) rms_row_to_bf16(P.x + (size_t)m * DM, P.g_mix, H + (size_t)m * DM, lane);
    bf16* MEMN = (bf16*)(ws + WS_MEMN);
    for (int m = gw; m < 512; m += ngw) rms_row_to_bf16(P.mem + (size_t)m * DM, P.g_mem, MEMN + (size_t)m * DM, lane);
    transpose_job(P.w_in, DIN, 0, 2048, 4096, W1T, 0, nullptr, scr, gw, ngw, lane);
    transpose_job(P.w_in, DIN, 5136, 2048, 1024, W1T, PC_FK, nullptr, scr, gw, ngw, lane);
    transpose_job(P.w_in, DIN, 4112, 2048, 1024, W1T, PC_FQ, nullptr, scr, gw, ngw, lane);
    transpose_job(P.w_in, DIN, 7192, 2048, 1024, W1T, PC_QM, nullptr, scr, gw, ngw, lane);
    transpose_job(P.w_in, DIN, 6160, 2048, 1024, WFVT, 0, nullptr, scr, gw, ngw, lane);
    transpose_job(P.w_in, DIN, 8216, 2048, 6144, WGT, 0, nullptr, scr, gw, ngw, lane);
    transpose_job(P.w_mem_kv, 2048, 0, 2048, 2048, WMKVT, 0, nullptr, scr, gw, ngw, lane);
    transpose_job(P.w_up_gdn, 2048, 0, 1024, 2048, WUPT, 0, nullptr, scr, gw, ngw, lane);
    transpose_job(P.w_up_fox, 2048, 0, 1024, 2048, WUPT + (size_t)2048 * 1024, 0, nullptr, scr, gw, ngw, lane);
    transpose_job(P.w_up_mem, 2048, 0, 1024, 2048, WUPT + (size_t)2 * 2048 * 1024, 0, nullptr, scr, gw, ngw, lane);
    transpose_job(P.w_out, 2048, 0, 2048, 2048, WOT, 0, nullptr, scr, gw, ngw, lane);
    transpose_job(P.w_ff1, 8192, 0, 2048, 8192, WFF1T, 0, P.g_mlp, scr, gw, ngw, lane);
    transpose_job(P.w_ff2, 2048, 0, 8192, 2048, WFF2T, 0, nullptr, scr, gw, ngw, lane);
    for (int idx = blockIdx.x * 512 + tid; idx < 256 * 2048; idx += G * 512) {
        const int row = idx >> 11, k = idx & 2047; float v = 0.f;
        if (row < 24) { const int col = row < 8 ? 4096 + row : (row < 16 ? 4104 + (row - 8) : 7184 + (row - 16)); v = P.w_in[(size_t)k * DIN + col]; }
        W1T[(size_t)(7168 + row) * 2048 + k] = (bf16)(pk2(v, 0.f) & 0xffffu);
    }
}


__device__ __forceinline__ void gdn_prep_unit(const Params& P, unsigned char* lds_, int bh, int n, int tid, int lane, int wave) {
    float* qs = (float*)lds_;
    float* ks = qs + 64 * 132;
    float* vs = ks + 64 * 132;
    float* Mm = vs + 64 * 132;
    float* QKd = Mm + 4096;
    float* gam = QKd + 4096;
    float* beta = gam + 64;
    float* egam = beta + 64;
    const int b = bh >> 3, h = bh & 7;
    const size_t r0 = (size_t)b * SEQ + (size_t)n * 64;
    const bf16* proj = (const bf16*)(P.ws + WS_PROJ);
    const float* small = (const float*)(P.ws + WS_SMALL);
    if (tid < 384) {
        const int c8 = tid % 48, tg = tid / 48, mat = c8 >> 4, ch0 = (c8 & 15) * 8, col = mat * 1024 + h * 128 + ch0, tb = tg * 8;
        u32x4 xr[11];
#pragma unroll
        for (int i = 0; i < 11; ++i) { const int tt = n * 64 + tb - 3 + i;
            xr[i] = tt >= 0 ? *(const u32x4*)(proj + (r0 + tb - 3 + i) * LDP + col) : u32x4{0u, 0u, 0u, 0u}; }
        f32x4 w0[4], w1[4];
#pragma unroll
        for (int i = 0; i < 4; ++i) { w0[i] = *(const f32x4*)(P.conv_w + i * 3072 + col); w1[i] = *(const f32x4*)(P.conv_w + i * 3072 + col + 4); }
        float* dstb = (mat == 0 ? qs : (mat == 1 ? ks : vs)) + tb * 132 + ch0;
#pragma unroll
        for (int t = 0; t < 8; ++t) {
            float y[8];
#pragma unroll
            for (int e = 0; e < 8; ++e) y[e] = 0.f;
#pragma unroll
            for (int i = 0; i < 4; ++i) { const u32x4 xv = xr[t + i];
                y[0] += bflo(xv.x) * w0[i].x; y[1] += bfhi(xv.x) * w0[i].y; y[2] += bflo(xv.y) * w0[i].z; y[3] += bfhi(xv.y) * w0[i].w;
                y[4] += bflo(xv.z) * w1[i].x; y[5] += bfhi(xv.z) * w1[i].y; y[6] += bflo(xv.w) * w1[i].z; y[7] += bfhi(xv.w) * w1[i].w; }
            f32x4 o0, o1;
            o0.x = y[0] * __builtin_amdgcn_rcpf(1.f + __builtin_amdgcn_exp2f(-LOG2E * y[0])); o0.y = y[1] * __builtin_amdgcn_rcpf(1.f + __builtin_amdgcn_exp2f(-LOG2E * y[1]));
            o0.z = y[2] * __builtin_amdgcn_rcpf(1.f + __builtin_amdgcn_exp2f(-LOG2E * y[2])); o0.w = y[3] * __builtin_amdgcn_rcpf(1.f + __builtin_amdgcn_exp2f(-LOG2E * y[3]));
            o1.x = y[4] * __builtin_amdgcn_rcpf(1.f + __builtin_amdgcn_exp2f(-LOG2E * y[4])); o1.y = y[5] * __builtin_amdgcn_rcpf(1.f + __builtin_amdgcn_exp2f(-LOG2E * y[5]));
            o1.z = y[6] * __builtin_amdgcn_rcpf(1.f + __builtin_amdgcn_exp2f(-LOG2E * y[6])); o1.w = y[7] * __builtin_amdgcn_rcpf(1.f + __builtin_amdgcn_exp2f(-LOG2E * y[7]));
            *(f32x4*)(dstb + t * 132) = o0; *(f32x4*)(dstb + t * 132 + 4) = o1;
        }
    }
    if (wave == 7) {
        const float av = small[(r0 + lane) * 32 + 8 + h], bv = small[(r0 + lane) * 32 + h];
        float g = -__expf(P.a_log[h]) * softplusf_(av + P.dt_bias[h]);
#pragma unroll
        for (int o = 1; o < 64; o <<= 1) { const float t_ = __shfl_up(g, o); if (lane >= o) g += t_; }
        gam[lane] = g; egam[lane] = __expf(g); beta[lane] = sigmoidf_(bv);
    }
    __syncthreads();
    for (int rb = wave * 16; rb < wave * 16 + 16; rb += 4) {
        float* rowp[4]; float av[4], cv[4], ss[4];
#pragma unroll
        for (int q = 0; q < 4; ++q) { const int rr = rb + q; rowp[q] = (rr < 64 ? qs + rr * 132 : ks + (rr - 64) * 132); av[q] = rowp[q][lane]; cv[q] = rowp[q][lane + 64]; ss[q] = av[q] * av[q] + cv[q] * cv[q]; }
#pragma unroll
        for (int o = 1; o < 64; o <<= 1)
#pragma unroll
            for (int q = 0; q < 4; ++q) ss[q] += __shfl_xor(ss[q], o);
#pragma unroll
        for (int q = 0; q < 4; ++q) { const float sc = rsqrtf(ss[q] + EPSN) * (rb < 64 ? 0.08838834764831845f : 1.f); rowp[q][lane] = av[q] * sc; rowp[q][lane + 64] = cv[q] * sc; }
    }
    __syncthreads();
    {
        const int mat = wave >> 2, ti = (wave >> 1) & 1, tj = wave & 1, c = lane & 31, hi = lane >> 5;
        const float* Arow = (mat == 0 ? ks : qs) + (32 * ti + c) * 132 + 8 * hi;
        const float* Brow = ks + (32 * tj + c) * 132 + 8 * hi;
        f32x16 acc = f32x16{};
#pragma unroll
        for (int k = 0; k < 8; ++k) {
            const f32x4 a0 = *(const f32x4*)(Arow + 16 * k), a1 = *(const f32x4*)(Arow + 16 * k + 4);
            const f32x4 b0 = *(const f32x4*)(Brow + 16 * k), b1 = *(const f32x4*)(Brow + 16 * k + 4);
            u32x4 aw, bw;
            aw.x = pk2(a0.x, a0.y); aw.y = pk2(a0.z, a0.w); aw.z = pk2(a1.x, a1.y); aw.w = pk2(a1.z, a1.w);
            bw.x = pk2(b0.x, b0.y); bw.y = pk2(b0.z, b0.w); bw.z = pk2(b1.x, b1.y); bw.w = pk2(b1.z, b1.w);
            acc = __builtin_amdgcn_mfma_f32_32x32x16_bf16(__builtin_bit_cast(bf16x8, aw), __builtin_bit_cast(bf16x8, bw), acc, 0, 0, 0);
        }
        const int jj = 32 * tj + c; const float gj = gam[jj];
        float* dbase = mat == 0 ? Mm + jj * 64 : QKd + jj; const int dstep = mat == 0 ? 1 : 64; const int strict = mat == 0 ? 1 : 0;
#pragma unroll
        for (int r = 0; r < 16; ++r) { const int ii = 32 * ti + crow(r, hi);
            const float e = __expf(fminf(gam[ii] - gj, 0.f));
            const float sc = mat == 0 ? beta[ii] : 1.f;
            dbase[ii * dstep] = (jj + strict <= ii) ? sc * acc[r] * e : 0.f; }
    }
    __syncthreads();
    unsigned char* gout = P.ws + WS_GDN + (size_t)(bh * 128 + n) * GDN_CHUNK_BYTES;
    unsigned char* uout = P.ws + WS_UC + (size_t)(bh * 128 + n) * 16384;
    const float glast = gam[63];
    for (int p = tid; p < 2560; p += 512) {
        float v[8]; unsigned char* dst;
        if (p < 1024) {
            const int f = p >> 6, ln = p & 63, rt = f >> 3, kk = f & 7, row = 32 * rt + (ln & 31), hi = ln >> 5;
            const float* src = qs + row * 132 + 16 * kk; const float sc = egam[row];
#pragma unroll
            for (int j = 0; j < 8; ++j) v[j] = src[crow(j, hi)] * sc;
            dst = gout + 16384 + (size_t)p * 16;
        } else if (p < 1536) {
            const int q = p - 1024, f = q >> 6, ln = q & 63, rt = f >> 2, kk = f & 3, row = 32 * rt + (ln & 31), hi = ln >> 5;
#pragma unroll
            for (int j = 0; j < 8; ++j) v[j] = QKd[row * 64 + 16 * kk + crow(j, hi)];
            dst = gout + 32768 + (size_t)q * 16;
        } else {
            const int q = p - 1536, f = q >> 6, ln = q & 63, rt = f >> 2, kk = f & 3, dk = 32 * rt + (ln & 31), hi = ln >> 5;
#pragma unroll
            for (int j = 0; j < 8; ++j) { const int tk = 16 * kk + crow(j, hi); v[j] = ks[tk * 132 + dk] * __expf(fminf(glast - gam[tk], 0.f)); }
            dst = gout + 40960 + (size_t)q * 16;
        }
        u32x4 o; o.x = pk2(v[0], v[1]); o.y = pk2(v[2], v[3]); o.z = pk2(v[4], v[5]); o.w = pk2(v[6], v[7]);
        *(u32x4*)dst = o;
    }
    if (tid == 0) ((float*)(P.ws + WS_CDEC))[bh * 128 + n] = __expf(glast);
    __syncthreads();
    if (tid < 256) {
        float* col = (tid < 128 ? ks : vs) + (tid & 127);
        int zero; asm volatile("v_mov_b32 %0, 0" : "=v"(zero));
        const float* bz = beta + zero; const float* ez = egam + zero;
#pragma unroll 1
        for (int ib = 0; ib < 4; ++ib) {
            float acc[16];
#pragma unroll
            for (int r = 0; r < 16; ++r) acc[r] = col[(ib * 16 + r) * 132] * (bz[ib * 16 + r] * (tid < 128 ? ez[ib * 16 + r] : 1.f));
#pragma unroll 8
            for (int j = 0; j < ib * 16; ++j) {
                const float xj = col[j * 132]; const float* mr = Mm + zero + j * 64 + ib * 16;
                const f32x4 m0 = *(const f32x4*)mr, m1 = *(const f32x4*)(mr + 4), m2 = *(const f32x4*)(mr + 8), m3 = *(const f32x4*)(mr + 12);
                acc[0] -= m0.x * xj; acc[1] -= m0.y * xj; acc[2] -= m0.z * xj; acc[3] -= m0.w * xj;
                acc[4] -= m1.x * xj; acc[5] -= m1.y * xj; acc[6] -= m1.z * xj; acc[7] -= m1.w * xj;
                acc[8] -= m2.x * xj; acc[9] -= m2.y * xj; acc[10] -= m2.z * xj; acc[11] -= m2.w * xj;
                acc[12] -= m3.x * xj; acc[13] -= m3.y * xj; acc[14] -= m3.z * xj; acc[15] -= m3.w * xj;
            }
#pragma unroll
            for (int r2 = 0; r2 < 15; ++r2) {
                const float* mr = Mm + (ib * 16 + r2) * 64 + ib * 16; float mm[16];
#pragma unroll
                for (int q = 0; q < 4; ++q) { const f32x4 t4 = *(const f32x4*)(mr + 4 * q); mm[4 * q] = t4.x; mm[4 * q + 1] = t4.y; mm[4 * q + 2] = t4.z; mm[4 * q + 3] = t4.w; }
#pragma unroll
                for (int r = r2 + 1; r < 16; ++r) acc[r] -= mm[r] * acc[r2];
            }
#pragma unroll
            for (int r = 0; r < 16; ++r) col[(ib * 16 + r) * 132] = acc[r];
        }
    }
    __syncthreads();
    for (int p = tid; p < 2048; p += 512) {
        float v[8]; unsigned char* dst;
        if (p < 1024) {
            const int f = p >> 6, ln = p & 63, rt = f >> 3, kk = f & 7, row = 32 * rt + (ln & 31), hi = ln >> 5;
            const float* src = ks + row * 132 + 16 * kk;
#pragma unroll
            for (int j = 0; j < 8; ++j) v[j] = -src[crow(j, hi)];
            dst = gout + (size_t)p * 16;
        } else {
            const int q = p - 1024, half = q & 1, ln = (q >> 1) & 63, g2 = q >> 7, rt = g2 & 1, w4 = g2 >> 1, hi = ln >> 5;
#pragma unroll
            for (int j = 0; j < 8; ++j) v[j] = vs[(32 * rt + crow(8 * half + j, hi)) * 132 + 32 * w4 + (ln & 31)];
            dst = uout + (size_t)q * 16;
        }
        u32x4 o; o.x = pk2(v[0], v[1]); o.y = pk2(v[2], v[3]); o.z = pk2(v[4], v[5]); o.w = pk2(v[6], v[7]);
        *(u32x4*)dst = o;
    }
    __syncthreads();
}

template <int GL, int NB> __device__ __forceinline__ void norm8b(bf16* const (&p)[NB], const bool (&ok)[NB], const float* gain, float mult, float inv_n) {
    u32x4 xv[NB];
#pragma unroll
    for (int b = 0; b < NB; ++b) xv[b] = ok[b] ? *(const u32x4*)p[b] : u32x4{0u, 0u, 0u, 0u};
    const f32x4 g0 = *(const f32x4*)gain, g1 = *(const f32x4*)(gain + 4);
#pragma unroll
    for (int b = 0; b < NB; ++b) {
        float v[8] = {bflo(xv[b].x), bfhi(xv[b].x), bflo(xv[b].y), bfhi(xv[b].y), bflo(xv[b].z), bfhi(xv[b].z), bflo(xv[b].w), bfhi(xv[b].w)};
        float ss = 0.f;
#pragma unroll
        for (int e = 0; e < 8; ++e) ss += v[e] * v[e];
#pragma unroll
        for (int o = 1; o < GL; o <<= 1) ss += __shfl_xor(ss, o);
        const float sc = rsqrtf(ss * inv_n + EPSN) * mult;
        u32x4 o; o.x = pk2(v[0] * sc * g0.x, v[1] * sc * g0.y); o.y = pk2(v[2] * sc * g0.z, v[3] * sc * g0.w);
        o.z = pk2(v[4] * sc * g1.x, v[5] * sc * g1.y); o.w = pk2(v[6] * sc * g1.z, v[7] * sc * g1.w);
        if (ok[b]) *(u32x4*)p[b] = o;
    }
}

__device__ __forceinline__ void phase2(const Params& P, unsigned char* lds, int tid, int lane, int wave) {
    const int G = gridDim.x;
    bf16* proj = (bf16*)(P.ws + WS_PROJ);
    if (blockIdx.x < 16) {
        const int bh = blockIdx.x, b = bh >> 3, h = bh & 7;
        const float* small = (const float*)(P.ws + WS_SMALL);
        float* cum = (float*)(P.ws + WS_CUM) + (size_t)bh * SEQ;
        float* wtot = (float*)lds;
        const float bf = P.fox_b_f[h];
        float v[16]; float run = 0.f;
#pragma unroll
        for (int e = 0; e < 16; ++e) { const float xx = small[((size_t)b * SEQ + tid * 16 + e) * 32 + 16 + h] + bf; run += -softplusf_(-xx) * LOG2E; v[e] = run; }
        float inc = run;
#pragma unroll
        for (int o = 1; o < 64; o <<= 1) { const float t_ = __shfl_up(inc, o); if (lane >= o) inc += t_; }
        if (lane == 63) wtot[wave] = inc;
        { float gq = tid < 128 ? fabsf(P.fox_q_norm[tid]) : 0.f, gk = tid < 128 ? fabsf(P.fox_k_norm[tid]) : 0.f;
#pragma unroll
          for (int o = 1; o < 64; o <<= 1) { gq = fmaxf(gq, __shfl_xor(gq, o)); gk = fmaxf(gk, __shfl_xor(gk, o)); }
          if (lane == 0) { wtot[8 + wave] = gq; wtot[16 + wave] = gk; } }
        __syncthreads();
        if (bh == 0 && tid == 0) { float gq = 0.f, gk = 0.f; for (int w = 0; w < 8; ++w) { gq = fmaxf(gq, wtot[8 + w]); gk = fmaxf(gk, wtot[16 + w]); }
            ((float*)(P.ws + WS_CDEC + 16384))[0] = 150.f + 2.f * 1.03f * (128.f * 0.08838834764831845f * LOG2E) * gq * gk; }
        float off = inc - run;
        for (int w = 0; w < wave; ++w) off += wtot[w];
#pragma unroll
        for (int e = 0; e < 16; ++e) cum[tid * 16 + e] = v[e] + off;
        __syncthreads();
    }
    for (int u = blockIdx.x; u < 2048; u += G) gdn_prep_unit(P, lds, u >> 7, u & 127, tid, lane, wave);
    for (int it0 = blockIdx.x; it0 < TOK / 2; it0 += 8 * G) {
        const int cidx = (tid & 255) * 8, isq = cidx >= 1024, d = cidx & 127;
        bf16* pp[8]; bool ok[8];
#pragma unroll
        for (int b = 0; b < 8; ++b) { const int it = it0 + b * G; ok[b] = it < TOK / 2; pp[b] = proj + (size_t)((ok[b] ? it : 0) * 2 + (tid >> 8)) * LDP + PC_FK + cidx; }
        norm8b<16, 8>(pp, ok, (isq ? P.fox_q_norm : P.fox_k_norm) + d, isq ? 0.08838834764831845f * LOG2E : 1.f, 1.f / 128.f);
    }
    for (int it0 = blockIdx.x; it0 < TOK / 4; it0 += 8 * G) {
        const int cidx = (tid & 127) * 8, d = cidx & 255;
        bf16* pp[8]; bool ok[8];
#pragma unroll
        for (int b = 0; b < 8; ++b) { const int it = it0 + b * G; ok[b] = it < TOK / 4; pp[b] = proj + (size_t)((ok[b] ? it : 0) * 4 + (tid >> 7)) * LDP + PC_QM + cidx; }
        norm8b<32, 8>(pp, ok, P.mem_q_norm + d, 0.0625f * LOG2E, 1.f / 256.f);
    }
    bf16* kmem = (bf16*)(P.ws + WS_KMEM);
    for (int it = blockIdx.x; it < 512 / 4; it += G) {
        const int cidx = (tid & 127) * 8, d = cidx & 255;
        bf16* pp[1] = {kmem + (size_t)(it * 4 + (tid >> 7)) * 1024 + cidx}; const bool ok[1] = {true};
        norm8b<32, 1>(pp, ok, P.mem_k_norm + d, 1.f, 1.f / 256.f);
    }
}

template <int DQK, bool FOX>
__device__ __forceinline__ void attn_unit(unsigned char* lds_, const bf16* Q, int ldq, const bf16* K, int ldk, const bf16* VT, int ldvt, bf16* O, int ldo,
                                          const float* cum, float skip_lim, int t0, int ntiles, int tid, int lane, int wave, int& dbg_tiles, unsigned char* dbg_ws = nullptr) {
    asm volatile("" : "+v"(tid), "+v"(lane));
    constexpr int KS = DQK / 16, KPITCH = DQK * 2 + 16, VPITCH = 136, ND = FOX ? 4 : 2, NH = (DQK / 32) / ND, VCH = ND / 2;
    constexpr int KCH = 64 * DQK / 8 / 512;
    LAS unsigned char* lds = (LAS unsigned char*)lds_;
    LAS unsigned char* Ks = lds; LAS unsigned char* VTs = lds + 64 * KPITCH; LAS float* cbs = (LAS float*)(lds + 64 * KPITCH + 128 * VPITCH);
    const int c = lane & 31, hi = lane >> 5;
    const int qrow = t0 + wave * 32 + c;
    bf16x8 qf[KS];
    { const bf16* qp = Q + (size_t)qrow * ldq + 8 * hi;
#pragma unroll
      for (int k = 0; k < KS; ++k) qf[k] = *(const bf16x8*)(qp + 16 * k); }
    float cref = 0.f; int jmin = 0;
    if (FOX) {
        cref = cum[t0];
        LAS int* jm = (LAS int*)(cbs + 64);
        if (wave < 2) { const int j = wave * 64 + lane; bool need = false; if (j < ntiles) need = (cref - cum[64 * j + 63]) >= -skip_lim;
            const unsigned long long mk = __ballot(need); if (lane == 0) jm[wave] = mk ? (int)__builtin_ctzll(mk) + wave * 64 : (1 << 20); }
        __syncthreads();
        jmin = min(min(jm[0], jm[1]), ntiles - 1);
        jmin = __builtin_amdgcn_readfirstlane(jmin);
    }
    dbg_tiles = 0;
#ifdef PROBE_TS
    if (FOX && dbg_ws && blockIdx.x == 16 && tid == 0) { volatile unsigned long long* dg_ = (volatile unsigned long long*)(dbg_ws + WS_CTL + 32768); dg_[16] += (unsigned long long)(ntiles - jmin) * 375ull; }
#endif
#pragma unroll 1
    for (int half = 0; half < NH; ++half) {
        f32x16 o[ND]; float m = -1e30f, l = 0.f;
#pragma unroll
        for (int d = 0; d < ND; ++d) o[d] = f32x16{};
        constexpr bool PREF = (DQK == 128);
        u32x4 kpre[KCH], vpre[VCH]; float cpre = 0.f;
#define ATT_PREFETCH(j_) do { const int kv0_ = 64 * (j_); \
            _Pragma("unroll") for (int i = 0; i < KCH; ++i) { const int id = tid + 512 * i, row = id / (DQK / 8), cc = id % (DQK / 8); kpre[i] = *(const u32x4*)(K + (size_t)(kv0_ + row) * ldk + cc * 8); } \
            _Pragma("unroll") for (int i = 0; i < VCH; ++i) { const int id = tid + 512 * i, row = id >> 3, cc = id & 7; vpre[i] = *(const u32x4*)(VT + (size_t)(half * ND * 32 + row) * ldvt + kv0_ + cc * 8); } \
            if (FOX) { if (tid < 64) cpre = cum[kv0_ + tid] - cref; } } while (0)
        if (PREF) ATT_PREFETCH(jmin);
#pragma unroll 1
        for (int j = jmin; j < ntiles; ++j) {
            __syncthreads();
            if (!PREF) ATT_PREFETCH(j);
#pragma unroll
            for (int i = 0; i < KCH; ++i) { const int id = tid + 512 * i, row = id / (DQK / 8), cc = id % (DQK / 8); *(LAS u32x4*)(Ks + row * KPITCH + cc * 16) = kpre[i]; }
#pragma unroll
            for (int i = 0; i < VCH; ++i) { const int id = tid + 512 * i, row = id >> 3, cc = id & 7; LAS u32x2* d2 = (LAS u32x2*)(VTs + row * VPITCH + cc * 16);
                d2[0] = (u32x2){vpre[i].x, vpre[i].y}; d2[1] = (u32x2){vpre[i].z, vpre[i].w}; }
            if (FOX) { if (tid < 64) cbs[tid] = cpre; }
            __syncthreads();
            if (PREF && j + 1 < ntiles) ATT_PREFETCH(j + 1);
            const int kv0 = 64 * j;
            if (FOX && kv0 > t0 + wave * 32 + 31) continue;
            f32x16 p0 = f32x16{}, p1 = f32x16{};
            const LAS unsigned char* vb = VTs + c * VPITCH + hi * 8;
            u32x2 vlo[FOX ? 8 : 1], vhh[FOX ? 8 : 1];
            if constexpr (FOX) {
                const LAS unsigned char* kb = Ks + c * KPITCH + hi * 16;
                bf16x8 kf[2 * KS];
#pragma unroll
                for (int k = 0; k < KS; ++k) { kf[2 * k] = *(const LAS bf16x8*)(kb + k * 32); kf[2 * k + 1] = *(const LAS bf16x8*)(kb + 32 * KPITCH + k * 32); }
                __builtin_amdgcn_sched_barrier(0);
#pragma unroll
                for (int k = 0; k < KS; ++k) {
                    p0 = __builtin_amdgcn_mfma_f32_32x32x16_bf16(kf[2 * k], qf[k], p0, 0, 0, 0);
                    p1 = __builtin_amdgcn_mfma_f32_32x32x16_bf16(kf[2 * k + 1], qf[k], p1, 0, 0, 0); }
                __builtin_amdgcn_sched_barrier(0);
#pragma unroll
                for (int d = 0; d < 2; ++d)
#pragma unroll
                    for (int cc = 0; cc < 4; ++cc) { vlo[d * 4 + cc] = *(const LAS u32x2*)(vb + d * 32 * VPITCH + cc * 32); vhh[d * 4 + cc] = *(const LAS u32x2*)(vb + d * 32 * VPITCH + cc * 32 + 16); }
                __builtin_amdgcn_sched_barrier(0);
            } else {
                const LAS unsigned char* kb = Ks + c * KPITCH + hi * 16;
#pragma unroll
                for (int k = 0; k < KS; ++k) {
                    const bf16x8 a0 = *(const LAS bf16x8*)(kb + k * 32), a1 = *(const LAS bf16x8*)(kb + 32 * KPITCH + k * 32);
                    p0 = __builtin_amdgcn_mfma_f32_32x32x16_bf16(a0, qf[k], p0, 0, 0, 0);
                    p1 = __builtin_amdgcn_mfma_f32_32x32x16_bf16(a1, qf[k], p1, 0, 0, 0); }
            }
            if (FOX) {
#pragma unroll
                for (int r4 = 0; r4 < 4; ++r4) { const f32x4 b0 = *(const LAS f32x4*)(cbs + 8 * r4 + 4 * hi), b1 = *(const LAS f32x4*)(cbs + 32 + 8 * r4 + 4 * hi);
#pragma unroll
                    for (int e = 0; e < 4; ++e) { p0[4 * r4 + e] -= b0[e]; p1[4 * r4 + e] -= b1[e]; } }
                if (kv0 + 63 > t0 + wave * 32) {
#pragma unroll
                    for (int r = 0; r < 16; ++r) { const int kv = kv0 + crow(r, hi); if (kv > qrow) p0[r] = -INFINITY; if (kv + 32 > qrow) p1[r] = -INFINITY; }
                }
            }
            float mx = p0[0];
#pragma unroll
            for (int r = 1; r < 16; ++r) mx = fmaxf(mx, p0[r]);
#pragma unroll
            for (int r = 0; r < 16; ++r) mx = fmaxf(mx, p1[r]);
            mx = fmaxf(mx, __shfl_xor(mx, 32));
            const float mn = fmaxf(m, mx), alpha = __builtin_amdgcn_exp2f(m - mn); m = mn;
            float ps = 0.f;
#pragma unroll
            for (int r = 0; r < 16; ++r) { p0[r] = __builtin_amdgcn_exp2f(p0[r] - mn); p1[r] = __builtin_amdgcn_exp2f(p1[r] - mn); ps += p0[r] + p1[r]; }
            l = l * alpha + ps;
#pragma unroll
            for (int d = 0; d < ND; ++d)
#pragma unroll
                for (int r = 0; r < 16; ++r) o[d][r] *= alpha;
            bf16x8 pb[4];
#pragma unroll
            for (int cc = 0; cc < 4; ++cc) { u32x4 w;
                if (cc < 2) { w.x = pk2(p0[8 * cc + 0], p0[8 * cc + 1]); w.y = pk2(p0[8 * cc + 2], p0[8 * cc + 3]); w.z = pk2(p0[8 * cc + 4], p0[8 * cc + 5]); w.w = pk2(p0[8 * cc + 6], p0[8 * cc + 7]); }
                else { const int c2 = cc - 2; w.x = pk2(p1[8 * c2 + 0], p1[8 * c2 + 1]); w.y = pk2(p1[8 * c2 + 2], p1[8 * c2 + 3]); w.z = pk2(p1[8 * c2 + 4], p1[8 * c2 + 5]); w.w = pk2(p1[8 * c2 + 6], p1[8 * c2 + 7]); }
                pb[cc] = __builtin_bit_cast(bf16x8, w); }
            if constexpr (FOX) {
                u32x2 wlo[8], whh[8];
#pragma unroll
                for (int d = 0; d < 2; ++d)
#pragma unroll
                    for (int cc = 0; cc < 4; ++cc) { wlo[d * 4 + cc] = *(const LAS u32x2*)(vb + (d + 2) * 32 * VPITCH + cc * 32); whh[d * 4 + cc] = *(const LAS u32x2*)(vb + (d + 2) * 32 * VPITCH + cc * 32 + 16); }
                __builtin_amdgcn_sched_barrier(0);
#pragma unroll
                for (int cc = 0; cc < 4; ++cc)
#pragma unroll
                    for (int d = 0; d < 2; ++d) { const u32x4 av = (u32x4){vlo[d * 4 + cc].x, vlo[d * 4 + cc].y, vhh[d * 4 + cc].x, vhh[d * 4 + cc].y};
                        o[d] = __builtin_amdgcn_mfma_f32_32x32x16_bf16(__builtin_bit_cast(bf16x8, av), pb[cc], o[d], 0, 0, 0); }
                __builtin_amdgcn_sched_barrier(0);
#pragma unroll
                for (int cc = 0; cc < 4; ++cc)
#pragma unroll
                    for (int d = 0; d < 2; ++d) { const u32x4 av = (u32x4){wlo[d * 4 + cc].x, wlo[d * 4 + cc].y, whh[d * 4 + cc].x, whh[d * 4 + cc].y};
                        o[d + 2] = __builtin_amdgcn_mfma_f32_32x32x16_bf16(__builtin_bit_cast(bf16x8, av), pb[cc], o[d + 2], 0, 0, 0); }
            } else {
#pragma unroll
              for (int d = 0; d < ND; ++d)
#pragma unroll
                  for (int cc = 0; cc < 4; ++cc) {
                      const u32x2 lo = *(const LAS u32x2*)(vb + d * 32 * VPITCH + cc * 32), hh = *(const LAS u32x2*)(vb + d * 32 * VPITCH + cc * 32 + 16);
                      const u32x4 av = (u32x4){lo.x, lo.y, hh.x, hh.y};
                      o[d] = __builtin_amdgcn_mfma_f32_32x32x16_bf16(__builtin_bit_cast(bf16x8, av), pb[cc], o[d], 0, 0, 0); } }
        }
        l += __shfl_xor(l, 32);
        const float rl = 1.f / l;
        bf16* op = O + (size_t)qrow * ldo + half * ND * 32 + 4 * hi;
#pragma unroll
        for (int d = 0; d < ND; ++d)
#pragma unroll
            for (int r4 = 0; r4 < 4; ++r4) { u32x2 w; w.x = pk2(o[d][4 * r4 + 0] * rl, o[d][4 * r4 + 1] * rl); w.y = pk2(o[d][4 * r4 + 2] * rl, o[d][4 * r4 + 3] * rl);
                *(u32x2*)(op + 32 * d + 8 * r4) = w; }
    }
    __syncthreads();
}

__device__ __forceinline__ void gdn_scan_wg(const Params& P, unsigned char* lds_, int unit, int tid, int lane, int wave) {
    const int bh = unit >> 2, quart = unit & 3;
    LAS unsigned char* lds = (LAS unsigned char*)lds_;
    const int b = bh >> 3, h = bh & 7;
    const unsigned char* gsrc = P.ws + WS_GDN + (size_t)bh * 128 * GDN_CHUNK_BYTES;
    const unsigned char* usrc = P.ws + WS_UC + (size_t)bh * 128 * 16384;
    const float* cdec = (const float*)(P.ws + WS_CDEC) + bh * 128;
    bf16* proj = (bf16*)(P.ws + WS_PROJ);
#define SCAN_BAR() asm volatile("s_waitcnt lgkmcnt(0)\n\ts_barrier" ::: "memory")
    constexpr int OB = 114688;
    if (wave >= 4) {
        const int lt = tid - 256, tk = lt >> 2, q4 = lt & 3;
        const size_t rowb = (size_t)b * SEQ + tk;
        bf16* obase = proj + rowb * LDP + PC_OA + h * 128 + q4 * 32;
        u32x4 r[14];
#pragma unroll
        for (int k = 0; k < 14; ++k) r[k] = *(const u32x4*)(gsrc + (size_t)(lt + 256 * k) * 16);
#pragma unroll
        for (int k = 0; k < 14; ++k) *(LAS u32x4*)(lds + (lt + 256 * k) * 16) = r[k];
#pragma unroll
        for (int k = 0; k < 14; ++k) r[k] = *(const u32x4*)(gsrc + (size_t)GDN_CHUNK_BYTES + (size_t)(lt + 256 * k) * 16);
        __syncthreads();
#define GDN_NORM(CH) do { if (q4 == quart) { const LAS unsigned char* ob_ = lds + OB + ((CH) & 1) * 16384 + tk * 256 + q4 * 64; bf16* op_ = obase + (size_t)(CH) * 64 * LDP; \
            _Pragma("unroll") for (int i = 0; i < 4; ++i) { const u32x4 w_ = *(const LAS u32x4*)(ob_ + i * 16); *(u32x4*)(op_ + 8 * i) = w_; } } } while (0)
#pragma unroll 1
        for (int n = 0; n < 128; ++n) {
            if (n + 1 < 128) {
                LAS unsigned char* d = lds + ((n + 1) & 1) * GDN_CHUNK_BYTES;
#pragma unroll
                for (int k = 0; k < 14; ++k) *(LAS u32x4*)(d + (lt + 256 * k) * 16) = r[k];
            }
            if (n + 2 < 128) {
                const unsigned char* s2 = gsrc + (size_t)(n + 2) * GDN_CHUNK_BYTES;
#pragma unroll
                for (int k = 0; k < 14; ++k) r[k] = *(const u32x4*)(s2 + (size_t)(lt + 256 * k) * 16);
            }
            if (n > 0) GDN_NORM(n - 1);
            SCAN_BAR();
        }
        GDN_NORM(127);
#undef GDN_NORM
    } else if (wave >= 1) {
        __syncthreads();
#pragma unroll 1
        for (int n = 0; n < 128; ++n) SCAN_BAR();
    } else {
        const int w4 = quart, c = lane & 31, hi = lane >> 5;
        f32x16 S[4];
#pragma unroll
        for (int t = 0; t < 4; ++t) S[t] = f32x16{};
        bf16x8 Sb[8];
#pragma unroll
        for (int k = 0; k < 8; ++k) Sb[k] = bf16x8{};
        u32x4 ucn[4];
#pragma unroll
        for (int i = 0; i < 4; ++i) ucn[i] = *(const u32x4*)(usrc + (size_t)((w4 * 2 + (i >> 1)) * 64 + lane) * 32 + (i & 1) * 16);
        float cdn = cdec[0];
        __syncthreads();
#pragma unroll 1
        for (int n = 0; n < 128; ++n) {
            const LAS unsigned char* fb = lds + (n & 1) * GDN_CHUNK_BYTES + lane * 16;
            f32x16 U[2];
#pragma unroll
            for (int rt = 0; rt < 2; ++rt) { const u32x4 a = ucn[2 * rt], bq = ucn[2 * rt + 1];
                U[rt][0] = bflo(a.x); U[rt][1] = bfhi(a.x); U[rt][2] = bflo(a.y); U[rt][3] = bfhi(a.y); U[rt][4] = bflo(a.z); U[rt][5] = bfhi(a.z); U[rt][6] = bflo(a.w); U[rt][7] = bfhi(a.w);
                U[rt][8] = bflo(bq.x); U[rt][9] = bfhi(bq.x); U[rt][10] = bflo(bq.y); U[rt][11] = bfhi(bq.y); U[rt][12] = bflo(bq.z); U[rt][13] = bfhi(bq.z); U[rt][14] = bflo(bq.w); U[rt][15] = bfhi(bq.w); }
            const float cd = cdn;
            if (n + 1 < 128) {
                const unsigned char* us = usrc + (size_t)(n + 1) * 16384;
#pragma unroll
                for (int i = 0; i < 4; ++i) ucn[i] = *(const u32x4*)(us + (size_t)((w4 * 2 + (i >> 1)) * 64 + lane) * 32 + (i & 1) * 16);
                cdn = cdec[n + 1];
            }
#define FRAG(off) (*(const LAS bf16x8*)(fb + (off)))
#define SBAR() __builtin_amdgcn_sched_barrier(0)
            bf16x8 A0[8], A1[8];
#pragma unroll
            for (int i = 0; i < 8; ++i) A0[i] = FRAG(((i & 1) * 8 + (i >> 1)) * 1024);
            SBAR();
#pragma unroll
            for (int i = 0; i < 8; ++i) A1[i] = FRAG(((i & 1) * 8 + 4 + (i >> 1)) * 1024);
            SBAR();
#pragma unroll
            for (int i = 0; i < 8; ++i) U[i & 1] = __builtin_amdgcn_mfma_f32_32x32x16_bf16(A0[i], Sb[i >> 1], U[i & 1], 0, 0, 0);
            SBAR();
#pragma unroll
            for (int i = 0; i < 8; ++i) A0[i] = FRAG(16384 + ((i & 1) * 8 + (i >> 1)) * 1024);
            SBAR();
#pragma unroll
            for (int i = 0; i < 8; ++i) U[i & 1] = __builtin_amdgcn_mfma_f32_32x32x16_bf16(A1[i], Sb[4 + (i >> 1)], U[i & 1], 0, 0, 0);
            SBAR();
#pragma unroll
            for (int i = 0; i < 8; ++i) A1[i] = FRAG(16384 + ((i & 1) * 8 + 4 + (i >> 1)) * 1024);
            SBAR();
            f32x16 Ov[2]; Ov[0] = f32x16{}; Ov[1] = f32x16{};
#pragma unroll
            for (int i = 0; i < 8; ++i) Ov[i & 1] = __builtin_amdgcn_mfma_f32_32x32x16_bf16(A0[i], Sb[i >> 1], Ov[i & 1], 0, 0, 0);
            SBAR();
#pragma unroll
            for (int i = 0; i < 8; ++i) A0[i] = FRAG(32768 + ((i & 1) * 4 + (i >> 1)) * 1024);
            SBAR();
#pragma unroll
            for (int i = 0; i < 8; ++i) Ov[i & 1] = __builtin_amdgcn_mfma_f32_32x32x16_bf16(A1[i], Sb[4 + (i >> 1)], Ov[i & 1], 0, 0, 0);
            SBAR();
            bf16x8 Ub[4];
#pragma unroll
            for (int k2 = 0; k2 < 4; ++k2) { const f32x16& uu = U[k2 >> 1]; const int o8 = 8 * (k2 & 1); u32x4 w;
                w.x = pk2(uu[o8 + 0], uu[o8 + 1]); w.y = pk2(uu[o8 + 2], uu[o8 + 3]); w.z = pk2(uu[o8 + 4], uu[o8 + 5]); w.w = pk2(uu[o8 + 6], uu[o8 + 7]); Ub[k2] = __builtin_bit_cast(bf16x8, w); }
#pragma unroll
            for (int i = 0; i < 8; ++i) A1[i] = FRAG(40960 + ((i & 3) * 4 + (i >> 2)) * 1024);
            SBAR();
#pragma unroll
            for (int i = 0; i < 8; ++i) Ov[i & 1] = __builtin_amdgcn_mfma_f32_32x32x16_bf16(A0[i], Ub[i >> 1], Ov[i & 1], 0, 0, 0);
            SBAR();
#pragma unroll
            for (int i = 0; i < 8; ++i) A0[i] = FRAG(40960 + ((i & 3) * 4 + 2 + (i >> 2)) * 1024);
            SBAR();
#pragma unroll
            for (int t = 0; t < 4; ++t)
#pragma unroll
                for (int r = 0; r < 16; ++r) S[t][r] *= cd;
#pragma unroll
            for (int i = 0; i < 8; ++i) S[i & 3] = __builtin_amdgcn_mfma_f32_32x32x16_bf16(A1[i], Ub[i >> 2], S[i & 3], 0, 0, 0);
            SBAR();
#pragma unroll
            for (int i = 0; i < 8; ++i) S[i & 3] = __builtin_amdgcn_mfma_f32_32x32x16_bf16(A0[i], Ub[2 + (i >> 2)], S[i & 3], 0, 0, 0);
            SBAR();
            { LAS bf16* ob = (LAS bf16*)(lds + OB + (n & 1) * 16384);
#pragma unroll
              for (int rt = 0; rt < 2; ++rt)
#pragma unroll
                  for (int r = 0; r < 16; ++r) ob[(32 * rt + crow(r, hi)) * 128 + 32 * w4 + c] = (bf16)(pk2(Ov[rt][r], 0.f) & 0xffffu); }
#pragma unroll
            for (int k = 0; k < 8; ++k) { const f32x16& ss = S[k >> 1]; const int o8 = 8 * (k & 1); u32x4 w;
                w.x = pk2(ss[o8 + 0], ss[o8 + 1]); w.y = pk2(ss[o8 + 2], ss[o8 + 3]); w.z = pk2(ss[o8 + 4], ss[o8 + 5]); w.w = pk2(ss[o8 + 6], ss[o8 + 7]); Sb[k] = __builtin_bit_cast(bf16x8, w); }
#undef FRAG
#undef SBAR
            SCAN_BAR();
        }
    }
    __syncthreads();
}

__device__ __forceinline__ void phase3(const Params& P, unsigned char* lds, int tid, int lane, int wave) {
    bf16* proj = (bf16*)(P.ws + WS_PROJ);
#ifndef NO_SCAN
    if (blockIdx.x < 64) gdn_scan_wg(P, lds, blockIdx.x, tid, lane, wave);
#endif
#ifdef PROBE_TS
    if (blockIdx.x == 0 && tid == 0) ((volatile unsigned long long*)(P.ws + WS_CTL + 32768))[10] = __builtin_amdgcn_s_memrealtime();
#endif
    unsigned* ctr = (unsigned*)(P.ws + WS_CTL);
    LAS unsigned* sh = (LAS unsigned*)((LAS unsigned char*)lds + LDS_BYTES - 64);
    const bf16* foxvt = (const bf16*)((const unsigned char*)P.out + DO_FOXVT);
    const float* cum = (const float*)(P.ws + WS_CUM);
    const bf16* kmem = (const bf16*)(P.ws + WS_KMEM); const bf16* vmt = (const bf16*)(P.ws + WS_VMT);
#ifdef STATIC_P3
    for (unsigned idx_ = (blockIdx.x < 16 ? 100000u : blockIdx.x - 16u); idx_ < 768u; idx_ += 240u) {
        const unsigned idx = __builtin_amdgcn_readfirstlane(idx_);
#else
    for (;;) {
        if (tid == 0) sh[0] = atomicAdd(ctr, 1u);
        __syncthreads();
        const unsigned idx = __builtin_amdgcn_readfirstlane(sh[0]);
        __syncthreads();
        if (idx >= 512u + 256u) break;
#endif
        int dbg_t = 0;
#ifdef PROBE_TS
        if (blockIdx.x == 16 && tid == 0) ((volatile unsigned long long*)(P.ws + WS_CTL + 32768))[20] = __builtin_amdgcn_s_memrealtime();
#endif
        if (idx < 512u) {
#ifndef NO_FOXATT
            const int qb = 31 - (int)(idx >> 4), bh = idx & 15, b = bh >> 3, h = bh & 7;
            bf16* Qp = proj + (size_t)b * SEQ * LDP + PC_FQ + h * 128;
            const bf16* Kp = proj + (size_t)b * SEQ * LDP + PC_FK + h * 128;
            const bf16* Vp = foxvt + (size_t)(h * 128) * TOK + (size_t)b * SEQ;
            attn_unit<128, true>(lds, Qp, LDP, Kp, LDP, Vp, TOK, Qp, LDP, cum + (size_t)bh * SEQ, ((const float*)(P.ws + WS_CDEC + 16384))[0], qb * 256, (qb + 1) * 4, tid, lane, wave, dbg_t, P.ws);
#ifdef PROBE_TS
            if (blockIdx.x == 16 && tid == 0) { volatile unsigned long long* dg = (volatile unsigned long long*)(P.ws + WS_CTL + 32768); dg[14] += __builtin_amdgcn_s_memrealtime() - dg[20]; }
#endif
#endif
        } else {
#ifndef NO_MEMATT
            const int u = idx - 512, qb = u & 31, bh = u >> 5, b = bh >> 2, h = bh & 3;
            bf16* Qp = proj + (size_t)b * SEQ * LDP + PC_QM + h * 256;
            const bf16* Kp = kmem + (size_t)b * 256 * 1024 + h * 256;
            const bf16* Vp = vmt + (size_t)(h * 256) * 512 + b * 256;
            attn_unit<256, false>(lds, Qp, LDP, Kp, 1024, Vp, 512, Qp, LDP, nullptr, 0.f, qb * 256, 4, tid, lane, wave, dbg_t);
#ifdef PROBE_TS
            if (blockIdx.x == 16 && tid == 0) { volatile unsigned long long* dg = (volatile unsigned long long*)(P.ws + WS_CTL + 32768); dg[18] += __builtin_amdgcn_s_memrealtime() - dg[20]; }
#endif
#endif
        }
    }
#ifdef PROBE_TS
    if (blockIdx.x == 0 && tid == 0) ((volatile unsigned long long*)(P.ws + WS_CTL + 32768))[11] = __builtin_amdgcn_s_memrealtime();
#endif
}


__device__ __forceinline__ void gdn_gate_norm_pass(const Params& P, int tid) {
    bf16* proj = (bf16*)(P.ws + WS_PROJ);
    const int cidx = (tid & 127) * 8, d = cidx & 127;
    const f32x4 g0 = *(const f32x4*)(P.gdn_norm_g + d), g1 = *(const f32x4*)(P.gdn_norm_g + d + 4);
    const float gg[8] = {g0.x, g0.y, g0.z, g0.w, g1.x, g1.y, g1.z, g1.w};
    for (int it0 = blockIdx.x; it0 < TOK / 4; it0 += 4 * gridDim.x) {
        u32x4 ov[4], zv[4]; bool ok[4]; bf16* op[4];
#pragma unroll
        for (int b = 0; b < 4; ++b) { const int it = it0 + b * gridDim.x; ok[b] = it < TOK / 4; const size_t row = (size_t)((ok[b] ? it : 0) * 4 + (tid >> 7));
            op[b] = proj + row * LDP + PC_OA + cidx; ov[b] = *(const u32x4*)op[b]; zv[b] = *(const u32x4*)(proj + row * LDP + PC_Z + cidx); }
#pragma unroll
        for (int b = 0; b < 4; ++b) {
            const float v[8] = {bflo(ov[b].x), bfhi(ov[b].x), bflo(ov[b].y), bfhi(ov[b].y), bflo(ov[b].z), bfhi(ov[b].z), bflo(ov[b].w), bfhi(ov[b].w)};
            const float z[8] = {bflo(zv[b].x), bfhi(zv[b].x), bflo(zv[b].y), bfhi(zv[b].y), bflo(zv[b].z), bfhi(zv[b].z), bflo(zv[b].w), bfhi(zv[b].w)};
            float ss = 0.f;
#pragma unroll
            for (int e = 0; e < 8; ++e) ss += v[e] * v[e];
            ss += __shfl_xor(ss, 1); ss += __shfl_xor(ss, 2); ss += __shfl_xor(ss, 4); ss += __shfl_xor(ss, 8);
            const float rstd = rsqrtf(ss * (1.f / 128.f) + EPSN);
            float o[8];
#pragma unroll
            for (int e = 0; e < 8; ++e) o[e] = v[e] * rstd * gg[e] * (z[e] * __builtin_amdgcn_rcpf(1.f + __builtin_amdgcn_exp2f(-LOG2E * z[e])));
            u32x4 w; w.x = pk2(o[0], o[1]); w.y = pk2(o[2], o[3]); w.z = pk2(o[4], o[5]); w.w = pk2(o[6], o[7]);
            if (ok[b]) *(u32x4*)op[b] = w;
        }
    }
}

#define RLX_AGENT __ATOMIC_RELAXED, __HIP_MEMORY_SCOPE_AGENT
#define XB_TMO      128
#define XB_XCNT(j)  (256  + 64 * (j))
#define XB_XSUB(j)  (1280 + 64 * (j))
#define XB_XGEN(j)  (2304 + 64 * (j))
#define XB_TOP      3328
#define XB_TOPGEN   3392
#define XCD_BAR_WORDS 3456
#define XB_SPIN_CAP (1u << 22)

__device__ __forceinline__ unsigned xb_ld(unsigned* p)              { return __hip_atomic_load(p, __ATOMIC_RELAXED, __HIP_MEMORY_SCOPE_AGENT); }
__device__ __forceinline__ unsigned xb_add(unsigned* p, unsigned v) { return __hip_atomic_fetch_add(p, v, __ATOMIC_RELAXED, __HIP_MEMORY_SCOPE_AGENT); }
__device__ __forceinline__ unsigned xb_xcc_id() { return (unsigned)__builtin_amdgcn_s_getreg((3 << 11) | 20) & 0xFu; }
#define XB_SPIN(cond, bar) do { unsigned _sp = 0; while (cond) { __builtin_amdgcn_s_sleep(1); \
    if ((++_sp & 255u) == 0u) { if (xb_ld(&(bar)[XB_TMO])) break; if (_sp > XB_SPIN_CAP) { atomicAdd(&(bar)[XB_TMO], 1u); break; } } } } while (0)

struct XcdBarrier {
    unsigned* bar; unsigned x;
    volatile LAS unsigned* st;
};

__device__ __forceinline__ XcdBarrier xcd_barrier_post(unsigned* bar, volatile LAS unsigned* st) {
    XcdBarrier b; b.bar = bar; b.x = xb_xcc_id(); b.st = st;
    if (threadIdx.x == 0) (void)xb_add(&bar[XB_XCNT(b.x)], 1u);
    return b;
}
__device__ __forceinline__ void xcd_barrier_complete(unsigned* bar, unsigned x, unsigned& nloc, unsigned& nx) {
    const unsigned G = gridDim.x * gridDim.y * gridDim.z;
    unsigned sum, cnt, mine, sp = 0u;
    for (;;) {
        sum = 0u; cnt = 0u; mine = 0u;
#pragma unroll
        for (unsigned j = 0; j < 16; ++j) { const unsigned c = xb_ld(&bar[XB_XCNT(j)]); sum += c; cnt += (c > 0u) ? 1u : 0u; mine = (j == x) ? c : mine; }
        if (sum == G) break;
        __builtin_amdgcn_s_sleep(1);
        if ((++sp & 255u) == 0u) { if (xb_ld(&bar[XB_TMO])) break; if (sp > XB_SPIN_CAP) { atomicAdd(&bar[XB_TMO], 1u); break; } }
    }
    nloc = mine > 0u ? mine : 1u; nx = cnt > 0u ? cnt : 1u;
}

__device__ __forceinline__ void xcd_barrier(const XcdBarrier& b) {
    asm volatile("s_waitcnt vmcnt(0)" ::: "memory");
    __syncthreads();
    if (threadIdx.x == 0) {
        unsigned* bar = b.bar;
        __builtin_amdgcn_s_waitcnt(0);
        unsigned nloc = b.st[0], nx = b.st[1];
        if (nloc == 0u) { xcd_barrier_complete(bar, b.x, nloc, nx); b.st[0] = nloc; b.st[1] = nx; }
        const unsigned old = xb_add(&bar[XB_XSUB(b.x)], 1u);
        const unsigned gen = old / nloc;
        if (old + 1u == (gen + 1u) * nloc) {
            __builtin_amdgcn_fence(__ATOMIC_RELEASE, "agent");
            asm volatile("s_waitcnt vmcnt(0)" ::: "memory");
            const unsigned og = xb_add(&bar[XB_TOP], 1u);
            const unsigned tg = og / nx;
            if (og + 1u == (tg + 1u) * nx) xb_add(&bar[XB_TOPGEN], 1u);
            else XB_SPIN(xb_ld(&bar[XB_TOPGEN]) == tg, bar);
            __builtin_amdgcn_fence(__ATOMIC_ACQUIRE, "agent");
            xb_add(&bar[XB_XGEN(b.x)], 1u);
            asm volatile("s_waitcnt vmcnt(0)" ::: "memory");
        } else {
            XB_SPIN(xb_ld(&bar[XB_XGEN(b.x)]) == gen, bar);
            __builtin_amdgcn_fence(__ATOMIC_ACQUIRE, "agent");
            asm volatile("s_waitcnt vmcnt(0)" ::: "memory");
        }
    }
    __syncthreads();
}

__global__ void __launch_bounds__(512, 2) hybrid_fwd(Params P) {
    extern __shared__ __attribute__((aligned(16))) unsigned char lds[];
    cg::grid_group grid = cg::this_grid();
    const int tid = threadIdx.x, lane = tid & 63, wave = __builtin_amdgcn_readfirstlane(tid >> 6);
    const int G = gridDim.x, cb = blockIdx.x;
    unsigned char* ws = P.ws;
    LAS unsigned char* glds = (LAS unsigned char*)lds;
    bf16* H = (bf16*)((unsigned char*)P.out + DO_H);
    bf16* proj = (bf16*)(ws + WS_PROJ);
    volatile LAS unsigned* bst = (volatile LAS unsigned*)(glds + LDS_BYTES - 32);
    if (tid < 2) bst[tid] = 0u;
    __syncthreads();
    XcdBarrier bar = xcd_barrier_post((unsigned*)(ws + WS_CTL) + 1024, bst);
#ifdef PROBE_TS
    volatile unsigned long long* tsg_ = (volatile unsigned long long*)(ws + WS_CTL + 32768);
    if (blockIdx.x == 0 && tid == 0) tsg_[0] = __builtin_amdgcn_s_memrealtime();
#endif
    grid.sync();
#ifdef PROBE_TS
#define GRID_BAR(k_) do { xcd_barrier(bar); if (blockIdx.x == 0 && tid == 0) tsg_[k_] = __builtin_amdgcn_s_memrealtime(); } while (0)
#else
#define GRID_BAR(k_) xcd_barrier(bar)
#endif

#ifndef NO_P0
    phase0(P, lds, tid, lane, wave);
#endif
    GRID_BAR(1);
#ifndef NO_GEMM
    {
        pg8::Gemm g{H, (const bf16*)(ws + WS_W1T), TOK, 7424, 2048, 2048, 2048}; pg8::StaticOrder S; S.init(TOK, 7424, G, cb);
        pg8::EpiProj E{proj, LDP, (float*)(ws + WS_SMALL)};
        pg8::gemm_phase<pg8::EpiProj, pg8::StaticOrder, true, true>(glds, g, S, E);
    }
    {
        pg8::Gemm g{(const bf16*)(ws + WS_WFVT), H, 1024, TOK, 2048, 2048, 2048}; pg8::StaticOrder S; S.init(1024, TOK, G, cb);
        pg8::EpiStore E{(bf16*)((unsigned char*)P.out + DO_FOXVT), TOK};
        pg8::gemm_phase<pg8::EpiStore, pg8::StaticOrder, true, true>(glds, g, S, E);
    }
    {
        const int cr = (cb + G - 64) % G;
        pg8::Gemm g{(const bf16*)(ws + WS_MEMN), (const bf16*)(ws + WS_WMKVT), 512, 1024, 2048, 2048, 2048}; pg8::StaticOrder S; S.init(512, 1024, G, cr);
        pg8::EpiStore E{(bf16*)(ws + WS_KMEM), 1024};
        pg8::gemm_phase<pg8::EpiStore, pg8::StaticOrder, true, true>(glds, g, S, E);
        const int cr2 = (cb + G - 72) % G;
        pg8::Gemm g2{(const bf16*)(ws + WS_WMKVT) + (size_t)1024 * 2048, (const bf16*)(ws + WS_MEMN), 1024, 512, 2048, 2048, 2048}; pg8::StaticOrder S2; S2.init(1024, 512, G, cr2);
        pg8::EpiStore E2{(bf16*)(ws + WS_VMT), 512};
        pg8::gemm_phase<pg8::EpiStore, pg8::StaticOrder, true, true>(glds, g2, S2, E2);
    }
#endif
    GRID_BAR(2);
#ifndef NO_P2
    phase2(P, lds, tid, lane, wave);
#endif
    GRID_BAR(3);
#ifndef NO_P3
    phase3(P, lds, tid, lane, wave);
#endif
    GRID_BAR(4);
#ifndef NO_GEMM
    gdn_gate_norm_pass(P, tid);
    {
        pg8::Gemm g{H, (const bf16*)(ws + WS_WGT), TOK, 6144, 2048, 2048, 2048}; pg8::StaticOrder S; S.init(TOK, 6144, G, cb);
        pg8::EpiSig E{(unsigned char*)P.out + DO_GA, (unsigned char*)(proj + PC_GB), 2048, LDP * 2};
        pg8::gemm_phase<pg8::EpiSig, pg8::StaticOrder, true, true>(glds, g, S, E);
    }
    GRID_BAR(5);
    {
        bf16* Y = (bf16*)(ws + WS_Y); const bf16* WUPT = (const bf16*)(ws + WS_WUPT);
        pg8::StaticOrder S; S.init(TOK, 2048, G, cb);
        { pg8::Gemm g{proj + PC_OA, WUPT, TOK, 2048, 1024, LDP, 1024}; pg8::EpiGate<true> E{(const unsigned char*)P.out + DO_GA, 2048, Y, 2048};
          pg8::gemm_phase<pg8::EpiGate<true>, pg8::StaticOrder, true, true>(glds, g, S, E); }
        { pg8::Gemm g{proj + PC_OB, WUPT + (size_t)2048 * 1024, TOK, 2048, 1024, LDP, 1024}; pg8::EpiGate<false> E{(const unsigned char*)(proj + PC_GB), LDP * 2, Y, 2048};
          pg8::gemm_phase<pg8::EpiGate<false>, pg8::StaticOrder, true, true>(glds, g, S, E); }
        { pg8::Gemm g{proj + PC_OM, WUPT + (size_t)2 * 2048 * 1024, TOK, 2048, 1024, LDP, 1024}; pg8::EpiGate<false> E{(const unsigned char*)(proj + PC_GB) + 2048, LDP * 2, Y, 2048};
          pg8::gemm_phase<pg8::EpiGate<false>, pg8::StaticOrder, true, true>(glds, g, S, E); }
    }
    GRID_BAR(6);
    {
        pg8::Gemm g{(const bf16*)(ws + WS_Y), (const bf16*)(ws + WS_WOT), TOK, 2048, 2048, 2048, 2048}; pg8::StaticOrder S; S.init(TOK, 2048, G, cb);
        pg8::EpiRes1 E{P.x, (bf16*)(ws + WS_X1B), (float*)(ws + WS_SSQ)};
        pg8::gemm_phase<pg8::EpiRes1, pg8::StaticOrder, true, true>(glds, g, S, E);
    }
    GRID_BAR(7);
    {
        const float* SSQ = (const float*)(ws + WS_SSQ); float* RSTD = (float*)(ws + WS_RSTD);
        int t5 = threadIdx.x; asm volatile("" : "+v"(t5));
        const int g = cb * 512 + t5;
        if (g < TOK * 8) { const int row = g >> 3, part = g & 7; float sq = 0.f;
#pragma unroll
            for (int q = 0; q < 4; ++q) sq += SSQ[(size_t)(part * 4 + q) * 16384 + row];
            sq += __shfl_xor(sq, 1); sq += __shfl_xor(sq, 2); sq += __shfl_xor(sq, 4);
            if (part == 0) RSTD[row] = rsqrtf(sq * (1.f / 2048.f) + 1e-6f); }
    }
    GRID_BAR(8);
    {
        pg8::Gemm g{(const bf16*)(ws + WS_X1B), (const bf16*)(ws + WS_WFF1T), TOK, 8192, 2048, 2048, 2048}; pg8::StaticOrder S; S.init(TOK, 8192, G, cb);
        pg8::EpiFF1 E{(const float*)(ws + WS_RSTD), (bf16*)(ws + WS_U), 8192};
        pg8::gemm_phase<pg8::EpiFF1, pg8::StaticOrder, true, true>(glds, g, S, E);
    }
    GRID_BAR(9);
    {
        pg8::Gemm g{(const bf16*)(ws + WS_U), (const bf16*)(ws + WS_WFF2T), TOK, 2048, 8192, 8192, 8192}; pg8::StaticOrder S; S.init(TOK, 2048, G, cb, 4);
        pg8::EpiOut E{(const bf16*)(ws + WS_X1B), P.out};
        pg8::gemm_phase<pg8::EpiOut, pg8::StaticOrder, true, true>(glds, g, S, E);
    }
#endif
#ifdef PROBE_TS
    if (blockIdx.x == 0 && tid == 0) {
        const unsigned long long tend = __builtin_amdgcn_s_memrealtime();
        tsg_[12] = tend;
        long long qa = ((long long)(tsg_[PROBE_A1] - tsg_[PROBE_A0]) + 1500) / 3000; if (qa > 35) qa = 35;
        long long qb = ((long long)(tsg_[PROBE_B1] - tsg_[PROBE_B0]) + 1500) / 3000; if (qb > 35) qb = 35;
        long long qc = ((long long)(tsg_[PROBE_C1] - tsg_[PROBE_C0]) + 1500) / 3000; if (qc > 35) qc = 35;
        const unsigned long long until = tend + (unsigned long long)(qa + 36 * qb + 1296 * qc) * 2000ull;
        while (__builtin_amdgcn_s_memrealtime() < until) __builtin_amdgcn_s_sleep(8);
    }
#endif
}

extern "C" void kernel_launch(void* const* d_in, const int* in_sizes, int n_in, void* d_out, int out_size, void* d_ws, size_t ws_size, hipStream_t stream) {
    static int grid = 0;
    if (grid == 0) {
        if (n_in != 22 || out_size != TOK * DM || ws_size < WS_END) { fprintf(stderr, "kernel_launch: unexpected shapes (n_in %d out %d ws %zu)\n", n_in, out_size, ws_size); grid = -1; return; }
        int dev = 0, cus = 0, per_cu = 0;
        hipGetDevice(&dev); hipDeviceGetAttribute(&cus, hipDeviceAttributeMultiprocessorCount, dev);
        if (hipFuncSetAttribute((const void*)hybrid_fwd, hipFuncAttributeMaxDynamicSharedMemorySize, LDS_BYTES) != hipSuccess) { fprintf(stderr, "kernel_launch: hipFuncSetAttribute failed\n"); grid = -1; return; }
        if (hipOccupancyMaxActiveBlocksPerMultiprocessor(&per_cu, (const void*)hybrid_fwd, 512, LDS_BYTES) != hipSuccess || per_cu < 1) { fprintf(stderr, "kernel_launch: occupancy query says %d\n", per_cu); per_cu = 1; }
        (void)hipGetLastError();
        grid = cus * 1;
        if (grid <= 0) grid = 256;
    }
    if (grid < 0) return;
    if (hipMemsetAsync((char*)d_ws + WS_CTL, 0, 65536, stream) != hipSuccess) { fprintf(stderr, "kernel_launch: memset failed\n"); return; }
    Params p{};
    const float** pp = (const float**)&p;
    for (int i = 0; i < 22; ++i) pp[i] = (const float*)d_in[i];
    p.out = (float*)d_out; p.ws = (unsigned char*)d_ws;
    void* args[] = {&p};
    hipError_t e = hipLaunchCooperativeKernel((const void*)hybrid_fwd, dim3(grid), dim3(512), args, LDS_BYTES, stream);
    if (e != hipSuccess) fprintf(stderr, "cooperative launch failed: %s (grid %d)\n", hipGetErrorString(e), grid);
}
```

```cpp
#include <hip/hip_runtime.h>
#include <hip/hip_cooperative_groups.h>
#include <cstdio>
#include <cstdint>
namespace cg = cooperative_groups;

namespace pg8 {
#define PG8_LAS __attribute__((address_space(3)))
typedef unsigned short bf16_t;
typedef short bf16x8 __attribute__((ext_vector_type(8)));
typedef float f32x4 __attribute__((ext_vector_type(4)));
typedef unsigned u32x4 __attribute__((ext_vector_type(4)));
constexpr int BM = 256, BK = 64, HALF = 128, HTB = HALF * BK * 2  , STAGE_BYTES = 8 * HTB, NXCD = 8, WGM = 8;

__host__ __device__ __forceinline__ int lds_byte(int r, int c) { const int st = (r >> 4) * 2 + (c >> 5), rr = r & 15, cc = c & 31, ob = rr * 64 + cc * 2; return st * 1024 + (ob ^ (((ob >> 9) & 1) << 5)); }
__host__ __device__ __forceinline__ void stage_rc(int b, int& R, int& C) { const int st = b / 1024, sb = b % 1024, swz = sb ^ (((sb >> 9) & 1) << 5); R = (st >> 1) * 16 + swz / 64; C = (st & 1) * 32 + (swz % 64) / 2; }
__host__ __device__ __forceinline__ int perm32(int rho) { const int n = rho >> 4, i = rho & 15; return 8 * (i >> 2) + 4 * n + (i & 3); }

struct Unit { int pm, pn; };
struct Gemm { const bf16_t* A; const bf16_t* Bt; int M, N, K, lda, ldb; };

struct StaticOrder {
    int nM, nN, nwg, G, c, wgm;
    __host__ __device__ void init(int M, int N, int G_, int c_, int wgm_ = WGM) { nM = M / BM; nN = N / BM; nwg = nM * nN; G = G_; c = c_; wgm = wgm_; }
    __host__ __device__ bool next(int i, Unit& u) const {
        const long L = (long)i * G + c; if (L >= nwg) return false;
        int wgid = (int)L; { const int q = nwg / NXCD, r = nwg % NXCD, xcd = wgid % NXCD, off = wgid / NXCD; wgid = (xcd < r ? xcd * (q + 1) : r * (q + 1) + (xcd - r) * q) + off; }
        const int nig = wgm * nN, gid = wgid / nig, fm = gid * wgm, gsz = (nM - fm) < wgm ? (nM - fm) : wgm;
        u.pm = fm + ((wgid % nig) % gsz); u.pn = (wgid % nig) / gsz; return true;
    }
    __device__ __forceinline__ void a_ready(const Unit&) const {}
    __device__ __forceinline__ void done(const Unit&) const {}
};

typedef float f32x2_cv __attribute__((ext_vector_type(2))); typedef __bf16 bf16x2_cv __attribute__((ext_vector_type(2)));
__device__ __forceinline__ unsigned cvt_pk_bf16(float lo, float hi) { f32x2_cv v = {lo, hi}; bf16x2_cv b = __builtin_convertvector(v, bf16x2_cv); return __builtin_bit_cast(unsigned, b); }
template <class Epi, class Sched, bool ALIGN_EPI = false, bool SP2 = false>
__device__ __forceinline__ void gemm_phase(PG8_LAS unsigned char* lds, const Gemm g, const Sched& S, const Epi& E) {
    int tid_ = threadIdx.x; asm volatile("" : "+v"(tid_));
    const int tid = tid_, wid = __builtin_amdgcn_readfirstlane(tid >> 6), lane = tid & 63, wr = wid >> 2, wc = wid & 3, fr = lane & 15, fq = lane >> 4;
    const int K = g.K, nt = K / BK;
    unsigned voffA[2], voffB[2];
#pragma unroll
    for (int i = 0; i < 2; ++i) { int R, C; stage_rc(tid * 16 + i * 8192, R, C); const int Rb = Epi::PERM ? ((R & ~31) + perm32(R & 31)) : R;
        voffA[i] = (unsigned)(R * g.lda + C) * 2u; voffB[i] = (unsigned)(Rb * g.ldb + C) * 2u; }
    const size_t kstep = (size_t)(BK * 2);
    const size_t hstepA = (size_t)HALF * g.lda * 2, hstepB = (size_t)HALF * g.ldb * 2;
    const size_t tstepA = 2 * hstepA, tstepB = 2 * hstepB;
    const unsigned ldsw = (unsigned)wid * 1024u;
    const int aoff = lds_byte(wr * 64 + fr, fq * 8), boff = lds_byte(wc * 32 + fr, fq * 8);
#define PG8_SA(b, h) (((b) * 2 + (h)) * HTB)
#define PG8_SB(b, h) ((4 + (b) * 2 + (h)) * HTB)
#define PG8_STAGE(bufoff, gbase, voff) do { _Pragma("unroll") for (int _i = 0; _i < 2; ++_i) \
        __builtin_amdgcn_global_load_lds((const unsigned*)((const char*)(gbase) + (voff)[_i]), (PG8_LAS unsigned*)(lds + (bufoff) + ldsw + _i * 8192), 16, 0, 0); } while (0)
#define PG8_LDA(dst, b, h) do { _Pragma("unroll") for (int m = 0; m < 4; ++m) _Pragma("unroll") for (int k = 0; k < 2; ++k) dst[m][k] = *(const PG8_LAS bf16x8*)(lds + PG8_SA(b, h) + aoff + m * 2048 + k * 1024); } while (0)
#define PG8_LDB(dst, b, h) do { _Pragma("unroll") for (int n = 0; n < 2; ++n) _Pragma("unroll") for (int k = 0; k < 2; ++k) dst[n][k] = *(const PG8_LAS bf16x8*)(lds + PG8_SB(b, h) + boff + n * 2048 + k * 1024); } while (0)
#define PG8_MMA(ai, bj, At, Bt) do { __builtin_amdgcn_s_setprio(1); _Pragma("unroll") for (int m = 0; m < 4; ++m) _Pragma("unroll") for (int n = 0; n < 2; ++n) _Pragma("unroll") for (int k = 0; k < 2; ++k) \
        acc[ai][bj][m][n] = __builtin_amdgcn_mfma_f32_16x16x32_bf16(Bt[n][k], At[m][k], acc[ai][bj][m][n], 0, 0, 0); __builtin_amdgcn_s_setprio(0); } while (0)
#define PG8_WAIT_V(n) asm volatile("s_waitcnt vmcnt(" #n ")" ::: "memory")
#define PG8_WAIT_L(n) asm volatile("s_waitcnt lgkmcnt(" #n ")" ::: "memory")
#define PG8_BAR __builtin_amdgcn_s_barrier()
#define PG8_SCHED __builtin_amdgcn_sched_barrier(0)
    Unit cur, nxt; int ui = 0;
    if (!S.next(0, cur)) return;
    f32x4 acc[2][2][4][2];
#pragma unroll
    for (int a = 0; a < 2; ++a)
#pragma unroll
        for (int b = 0; b < 2; ++b)
#pragma unroll
            for (int m = 0; m < 4; ++m)
#pragma unroll
                for (int n = 0; n < 2; ++n) acc[a][b][m][n] = (f32x4){0.f, 0.f, 0.f, 0.f};
    bf16x8 At[4][2], B0[2][2], B1[2][2];
    const char* cA = (const char*)g.A + (size_t)cur.pm * tstepA; const char* cB = (const char*)g.Bt + (size_t)cur.pn * tstepB;
    S.a_ready(cur);
    if constexpr (SP2) {
        PG8_STAGE(PG8_SB(0, 0), cB, voffB); PG8_STAGE(PG8_SB(0, 1), cB + hstepB, voffB); PG8_STAGE(PG8_SA(0, 0), cA, voffA); PG8_STAGE(PG8_SA(0, 1), cA + hstepA, voffA);
        if (wr == 1) PG8_BAR;
        PG8_WAIT_V(2); PG8_BAR;
        PG8_STAGE(PG8_SB(1, 0), cB + kstep, voffB); PG8_STAGE(PG8_SA(1, 0), cA + kstep, voffA); PG8_STAGE(PG8_SB(1, 1), cB + hstepB + kstep, voffB);
        PG8_WAIT_V(6); PG8_BAR;
    } else {
        PG8_STAGE(PG8_SB(0, 0), cB, voffB); PG8_STAGE(PG8_SA(0, 0), cA, voffA); PG8_STAGE(PG8_SB(0, 1), cB + hstepB, voffB); PG8_STAGE(PG8_SA(0, 1), cA + hstepA, voffA);
        if (wr == 1) PG8_BAR;
        PG8_WAIT_V(4); PG8_BAR;
        PG8_STAGE(PG8_SB(1, 0), cB + kstep, voffB); PG8_STAGE(PG8_SA(1, 0), cA + kstep, voffA); PG8_STAGE(PG8_SB(1, 1), cB + hstepB + kstep, voffB);
        PG8_WAIT_V(6); PG8_BAR;
    }
    for (;;) {
        const bool has_next = S.next(ui + 1, nxt);
        const char* nA = has_next ? (const char*)g.A + (size_t)nxt.pm * tstepA : cA; const char* nB = has_next ? (const char*)g.Bt + (size_t)nxt.pn * tstepB : cB;
        for (int t = 0; t < nt; t += 2) {
            const bool last = (t == nt - 2);
            const char* a1 = cA + (size_t)(t + 1) * kstep;
            const char* a2 = last ? nA : cA + (size_t)(t + 2) * kstep; const char* b2 = last ? nB : cB + (size_t)(t + 2) * kstep;
            const char* a3 = a2 + kstep; const char* b3 = b2 + kstep;
            if (last && has_next) S.a_ready(nxt);
            if constexpr (SP2) {
            PG8_LDB(B0, 0, 0); PG8_LDB(B1, 0, 1); PG8_SCHED; PG8_LDA(At, 0, 0); PG8_STAGE(PG8_SA(1, 1), a1 + hstepA, voffA);
            PG8_WAIT_V(8); PG8_WAIT_L(0); PG8_BAR; PG8_MMA(0, 0, At, B0); PG8_MMA(0, 1, At, B1); PG8_BAR; PG8_SCHED;
            PG8_LDA(At, 0, 1); PG8_STAGE(PG8_SB(0, 0), b2, voffB); PG8_STAGE(PG8_SB(0, 1), b2 + hstepB, voffB); PG8_STAGE(PG8_SA(0, 0), a2, voffA);
            PG8_WAIT_V(8); PG8_WAIT_L(0); PG8_BAR; PG8_MMA(1, 0, At, B0); PG8_MMA(1, 1, At, B1); PG8_BAR; PG8_SCHED;
            PG8_LDB(B0, 1, 0); PG8_LDB(B1, 1, 1); PG8_SCHED; PG8_LDA(At, 1, 0); PG8_STAGE(PG8_SA(0, 1), a2 + hstepA, voffA);
            PG8_WAIT_V(8); PG8_WAIT_L(0); PG8_BAR; PG8_MMA(0, 0, At, B0); PG8_MMA(0, 1, At, B1); PG8_BAR; PG8_SCHED;
            PG8_LDA(At, 1, 1); PG8_STAGE(PG8_SB(1, 0), b3, voffB); PG8_STAGE(PG8_SB(1, 1), b3 + hstepB, voffB); PG8_STAGE(PG8_SA(1, 0), a3, voffA);
            PG8_WAIT_V(8); PG8_WAIT_L(0); PG8_BAR; PG8_MMA(1, 0, At, B0); PG8_MMA(1, 1, At, B1); PG8_BAR; PG8_SCHED;
            } else {
            PG8_LDB(B0, 0, 0); PG8_SCHED; PG8_LDA(At, 0, 0); PG8_STAGE(PG8_SA(1, 1), a1 + hstepA, voffA);
            PG8_WAIT_L(8); PG8_BAR; PG8_WAIT_L(0); PG8_MMA(0, 0, At, B0); PG8_BAR; PG8_SCHED;
            PG8_LDB(B1, 0, 1); PG8_STAGE(PG8_SB(0, 0), b2, voffB);
            PG8_BAR; PG8_WAIT_L(0); PG8_MMA(0, 1, At, B1); PG8_BAR;
            PG8_LDA(At, 0, 1); PG8_STAGE(PG8_SA(0, 0), a2, voffA);
            PG8_BAR; PG8_WAIT_L(0); PG8_MMA(1, 0, At, B0); PG8_BAR; PG8_SCHED;
            PG8_STAGE(PG8_SB(0, 1), b2 + hstepB, voffB);
            PG8_WAIT_V(6); PG8_BAR; PG8_MMA(1, 1, At, B1); PG8_BAR;
            PG8_LDB(B0, 1, 0); PG8_SCHED; PG8_LDA(At, 1, 0); PG8_STAGE(PG8_SA(0, 1), a2 + hstepA, voffA);
            PG8_WAIT_L(8); PG8_BAR; PG8_WAIT_L(0); PG8_MMA(0, 0, At, B0); PG8_BAR; PG8_SCHED;
            PG8_LDB(B1, 1, 1); PG8_STAGE(PG8_SB(1, 0), b3, voffB);
            PG8_BAR; PG8_WAIT_L(0); PG8_MMA(0, 1, At, B1); PG8_BAR;
            PG8_LDA(At, 1, 1); PG8_STAGE(PG8_SA(1, 0), a3, voffA);
            PG8_BAR; PG8_WAIT_L(0); PG8_MMA(1, 0, At, B0); PG8_BAR; PG8_SCHED;
            PG8_STAGE(PG8_SB(1, 1), b3 + hstepB, voffB);
            PG8_WAIT_V(6); PG8_BAR; PG8_MMA(1, 1, At, B1); PG8_BAR;
            }
        }
        if constexpr (ALIGN_EPI) { if (wr == 0) PG8_BAR; }
        if constexpr (!Epi::AFTER_DRAIN) { E(acc, cur, wr, wc, fr, fq); S.done(cur); }
        if (!has_next) break;
#pragma unroll
        for (int a = 0; a < 2; ++a)
#pragma unroll
            for (int b = 0; b < 2; ++b)
#pragma unroll
                for (int m = 0; m < 4; ++m)
#pragma unroll
                    for (int n = 0; n < 2; ++n) acc[a][b][m][n] = (f32x4){0.f, 0.f, 0.f, 0.f};
        cur = nxt; cA = nA; cB = nB; ++ui;
        if constexpr (ALIGN_EPI) { if (wr == 1) PG8_BAR; }
    }
    PG8_WAIT_V(0);
    if constexpr (!ALIGN_EPI) { if (wr == 0) PG8_BAR; }
    PG8_BAR;
    if constexpr (Epi::AFTER_DRAIN) { E.fused(acc, cur, wr, wc, fr, fq, lds, wid, lane); S.done(cur); }
#undef PG8_SA
#undef PG8_SB
#undef PG8_STAGE
#undef PG8_LDA
#undef PG8_LDB
#undef PG8_MMA
#undef PG8_WAIT_V
#undef PG8_WAIT_L
#undef PG8_BAR
#undef PG8_SCHED
}
}

constexpr int TOK = 16384, SEQ = 8192, DM = 2048, DIN = 14360, DFF = 8192;
constexpr int LDP = 7168;
constexpr int PC_QA = 0, PC_KA = 1024, PC_VA = 2048, PC_Z = 3072, PC_FK = 4096, PC_FQ = 5120, PC_QM = 6144;
constexpr int PC_OA = 0, PC_OB = PC_FQ, PC_OM = PC_QM, PC_GB = 1024, PC_GM = 3072;
constexpr float EPSN = 1e-6f;
constexpr float LOG2E = 1.4426950408889634f;
constexpr size_t MiB = 1u << 20;
constexpr size_t WS_CTL = 0, WS_W1T = 1 * MiB, WS_WFVT = 30 * MiB, WS_WMKVT = 34 * MiB, WS_UC = 1 * MiB;
constexpr size_t WS_SMALL = 42 * MiB, WS_KMEM = 44 * MiB, WS_VMT = 45 * MiB, WS_CUM = 46 * MiB, WS_CDEC = 46 * MiB + 512 * 1024,
                 WS_MEMN = 47 * MiB, WS_SSQ = 49 * MiB, WS_RSTD = 51 * MiB;
constexpr size_t WS_WGT = 52 * MiB, WS_WUPT = 76 * MiB, WS_WOT = 88 * MiB, WS_WFF1T = 96 * MiB, WS_WFF2T = 128 * MiB;
constexpr size_t WS_PROJ = 160 * MiB, WS_GDN = 384 * MiB, WS_END = 496 * MiB;
constexpr int FOXVT_LD = TOK;
constexpr size_t WS_Y = 384 * MiB, WS_X1B = 160 * MiB, WS_U = 224 * MiB;
constexpr size_t DO_H = 0, DO_FOXVT = 64 * MiB, DO_GA = 64 * MiB;
constexpr int GDN_CHUNK_BYTES = 57344;
constexpr int LDS_BYTES = 163840;

#define LAS __attribute__((address_space(3)))
typedef unsigned short bf16;
typedef short bf16x8 __attribute__((ext_vector_type(8)));
typedef float f32x4 __attribute__((ext_vector_type(4)));
typedef float f32x16 __attribute__((ext_vector_type(16)));
typedef unsigned u32x4 __attribute__((ext_vector_type(4)));
typedef unsigned u32x2 __attribute__((ext_vector_type(2)));

__device__ __forceinline__ unsigned pk2(float lo, float hi) { return pg8::cvt_pk_bf16(lo, hi); }
__device__ __forceinline__ float bf2f(unsigned short v) { return __uint_as_float(((unsigned)v) << 16); }
__device__ __forceinline__ float bflo(unsigned w) { return __uint_as_float(w << 16); }
__device__ __forceinline__ float bfhi(unsigned w) { return __uint_as_float(w & 0xffff0000u); }
__device__ __forceinline__ int crow(int r, int hi) { return (r & 3) + 8 * (r >> 2) + 4 * hi; }
__device__ __forceinline__ float sigmoidf_(float x) { return 1.f / (1.f + __expf(-x)); }
__device__ __forceinline__ float softplusf_(float x) { return fmaxf(x, 0.f) + log1pf(__expf(-fabsf(x))); }

namespace pg8 {
struct EpiStore {
    static constexpr bool PERM = true, AFTER_DRAIN = false;
    bf16_t* O; int ldc;
    __device__ __forceinline__ void operator()(const f32x4 (&acc)[2][2][4][2], const Unit& u, int wr, int wc, int fr, int fq) const {
        const int row0 = u.pm * BM + wr * 64 + fr, col0 = u.pn * BM + wc * 32 + 8 * fq;
#pragma unroll
        for (int ai = 0; ai < 2; ++ai)
#pragma unroll
            for (int m = 0; m < 4; ++m) { bf16_t* rowp = O + (size_t)(row0 + ai * HALF + m * 16) * ldc + col0;
#pragma unroll
                for (int bj = 0; bj < 2; ++bj) { const f32x4 v0 = acc[ai][bj][m][0], v1 = acc[ai][bj][m][1];
                    u32x4 w; w.x = cvt_pk_bf16(v0[0], v0[1]); w.y = cvt_pk_bf16(v0[2], v0[3]); w.z = cvt_pk_bf16(v1[0], v1[1]); w.w = cvt_pk_bf16(v1[2], v1[3]);
                    *(u32x4*)(rowp + bj * HALF) = w; } }
    }
};
struct EpiProj {
    static constexpr bool PERM = true, AFTER_DRAIN = false;
    bf16_t* O; int ldc; float* small;
    __device__ __forceinline__ void operator()(const f32x4 (&acc)[2][2][4][2], const Unit& u, int wr, int wc, int fr, int fq) const {
        const int row0 = u.pm * BM + wr * 64 + fr;
        if (u.pn == 28) {
            if (wc == 0) {
#pragma unroll
                for (int ai = 0; ai < 2; ++ai)
#pragma unroll
                    for (int m = 0; m < 4; ++m) { float* p = small + (size_t)(row0 + ai * HALF + m * 16) * 32 + 8 * fq;
                        *(f32x4*)p = acc[ai][0][m][0]; *(f32x4*)(p + 4) = acc[ai][0][m][1]; }
            }
            return;
        }
        const int col0 = u.pn * BM + wc * 32 + 8 * fq;
#pragma unroll
        for (int ai = 0; ai < 2; ++ai)
#pragma unroll
            for (int m = 0; m < 4; ++m) { bf16_t* rowp = O + (size_t)(row0 + ai * HALF + m * 16) * ldc + col0;
#pragma unroll
                for (int bj = 0; bj < 2; ++bj) { const f32x4 v0 = acc[ai][bj][m][0], v1 = acc[ai][bj][m][1];
                    u32x4 w; w.x = cvt_pk_bf16(v0[0], v0[1]); w.y = cvt_pk_bf16(v0[2], v0[3]); w.z = cvt_pk_bf16(v1[0], v1[1]); w.w = cvt_pk_bf16(v1[2], v1[3]);
                    *(u32x4*)(rowp + bj * HALF) = w; } }
    }
};
struct EpiSig {
    static constexpr bool PERM = true, AFTER_DRAIN = false;
    unsigned char* O0; unsigned char* O1; int ld0, ld1;
    __device__ __forceinline__ void operator()(const f32x4 (&acc)[2][2][4][2], const Unit& u, int wr, int wc, int fr, int fq) const {
        const int br = u.pn >> 3; unsigned char* O = br == 0 ? O0 : O1 + (size_t)(br - 1) * 2048; const int ldc = br == 0 ? ld0 : ld1;
        const int row0 = u.pm * BM + wr * 64 + fr, col0 = (u.pn & 7) * BM + wc * 32 + 8 * fq;
#pragma unroll
        for (int ai = 0; ai < 2; ++ai)
#pragma unroll
            for (int m = 0; m < 4; ++m) { unsigned char* rowp = O + (size_t)(row0 + ai * HALF + m * 16) * ldc + col0;
#pragma unroll
                for (int bj = 0; bj < 2; ++bj) { const f32x4 v0 = acc[ai][bj][m][0], v1 = acc[ai][bj][m][1]; unsigned q[8];
#pragma unroll
                    for (int e = 0; e < 4; ++e) { q[e] = (unsigned)(255.f * __builtin_amdgcn_rcpf(1.f + __builtin_amdgcn_exp2f(-1.4426950408889634f * v0[e])) + 0.5f);
                                                  q[4 + e] = (unsigned)(255.f * __builtin_amdgcn_rcpf(1.f + __builtin_amdgcn_exp2f(-1.4426950408889634f * v1[e])) + 0.5f); }
                    u32x2 w; w.x = q[0] | (q[1] << 8) | (q[2] << 16) | (q[3] << 24); w.y = q[4] | (q[5] << 8) | (q[6] << 16) | (q[7] << 24);
                    *(u32x2*)(rowp + bj * HALF) = w; } }
    }
};
template <bool FIRST> struct EpiGate {
    static constexpr bool PERM = true, AFTER_DRAIN = false;
    const unsigned char* G; int ldg; bf16_t* Y; int ldy;
    __device__ __forceinline__ void operator()(const f32x4 (&acc)[2][2][4][2], const Unit& u, int wr, int wc, int fr, int fq) const {
        const int row0 = u.pm * BM + wr * 64 + fr, col0 = u.pn * BM + wc * 32 + 8 * fq;
        constexpr float S = 1.f / 255.f;
#pragma unroll
        for (int ai = 0; ai < 2; ++ai)
#pragma unroll
            for (int m = 0; m < 4; ++m) { const size_t r = (size_t)(row0 + ai * HALF + m * 16);
#pragma unroll
                for (int bj = 0; bj < 2; ++bj) { const f32x4 v0 = acc[ai][bj][m][0], v1 = acc[ai][bj][m][1];
                    const u32x2 g = *(const u32x2*)(G + r * ldg + col0 + bj * HALF);
                    float o[8];
                    o[0] = v0[0] * ((float)(g.x & 0xffu) * S); o[1] = v0[1] * ((float)((g.x >> 8) & 0xffu) * S);
                    o[2] = v0[2] * ((float)((g.x >> 16) & 0xffu) * S); o[3] = v0[3] * ((float)(g.x >> 24) * S);
                    o[4] = v1[0] * ((float)(g.y & 0xffu) * S); o[5] = v1[1] * ((float)((g.y >> 8) & 0xffu) * S);
                    o[6] = v1[2] * ((float)((g.y >> 16) & 0xffu) * S); o[7] = v1[3] * ((float)(g.y >> 24) * S);
                    bf16_t* yp = Y + r * ldy + col0 + bj * HALF;
                    if (!FIRST) { const u32x4 y = *(const u32x4*)yp;
                        o[0] += __uint_as_float(y.x << 16); o[1] += __uint_as_float(y.x & 0xffff0000u);
                        o[2] += __uint_as_float(y.y << 16); o[3] += __uint_as_float(y.y & 0xffff0000u);
                        o[4] += __uint_as_float(y.z << 16); o[5] += __uint_as_float(y.z & 0xffff0000u);
                        o[6] += __uint_as_float(y.w << 16); o[7] += __uint_as_float(y.w & 0xffff0000u); }
                    u32x4 w; w.x = cvt_pk_bf16(o[0], o[1]); w.y = cvt_pk_bf16(o[2], o[3]); w.z = cvt_pk_bf16(o[4], o[5]); w.w = cvt_pk_bf16(o[6], o[7]);
                    *(u32x4*)yp = w; } }
    }
};
struct EpiRes1 {
    static constexpr bool PERM = false, AFTER_DRAIN = false;
    const float* X; bf16_t* XB; float* SSQ;
    __device__ __forceinline__ void operator()(const f32x4 (&acc)[2][2][4][2], const Unit& u, int wr, int wc, int fr, int fq) const {
        const int row0 = u.pm * BM + wr * 64 + fr, col0 = u.pn * BM + wc * 32 + 4 * fq;
#pragma unroll
        for (int ai = 0; ai < 2; ++ai)
#pragma unroll
            for (int m = 0; m < 4; ++m) { const int row = row0 + ai * HALF + m * 16; const size_t off = (size_t)row * 2048 + col0; float s = 0.f;
#pragma unroll
                for (int bj = 0; bj < 2; ++bj)
#pragma unroll
                    for (int n = 0; n < 2; ++n) { const size_t o = off + bj * HALF + n * 16; const f32x4 xv = *(const f32x4*)(X + o); const f32x4 v = xv + acc[ai][bj][m][n];
                        u32x2 w; w.x = cvt_pk_bf16(v[0], v[1]); w.y = cvt_pk_bf16(v[2], v[3]); *(u32x2*)(XB + o) = w;
                        s += (v[0] * v[0] + v[1] * v[1]) + (v[2] * v[2] + v[3] * v[3]); }
                s += __shfl_xor(s, 16); s += __shfl_xor(s, 32);
                if (fq == 0) SSQ[(size_t)(u.pn * 4 + wc) * 16384 + row] = s; }
    }
};
struct EpiFF1 {
    static constexpr bool PERM = true, AFTER_DRAIN = false;
    const float* RSTD; bf16_t* O; int ldc;
    __device__ __forceinline__ void operator()(const f32x4 (&acc)[2][2][4][2], const Unit& u, int wr, int wc, int fr, int fq) const {
        const int row0 = u.pm * BM + wr * 64 + fr, col0 = u.pn * BM + wc * 32 + 8 * fq;
        float rs[2][4];
#pragma unroll
        for (int ai = 0; ai < 2; ++ai)
#pragma unroll
            for (int m = 0; m < 4; ++m) rs[ai][m] = RSTD[row0 + ai * HALF + m * 16];
#pragma unroll
        for (int ai = 0; ai < 2; ++ai)
#pragma unroll
            for (int m = 0; m < 4; ++m) { const int row = row0 + ai * HALF + m * 16; const float rstd = rs[ai][m];
                bf16_t* rowp = O + (size_t)row * ldc + col0;
#pragma unroll
                for (int bj = 0; bj < 2; ++bj) { f32x4 v0 = acc[ai][bj][m][0] * rstd, v1 = acc[ai][bj][m][1] * rstd;
#pragma unroll
                    for (int e = 0; e < 4; ++e) { const float a = fmaxf(v0[e], 0.f), b = fmaxf(v1[e], 0.f); v0[e] = a * a; v1[e] = b * b; }
                    u32x4 w; w.x = cvt_pk_bf16(v0[0], v0[1]); w.y = cvt_pk_bf16(v0[2], v0[3]); w.z = cvt_pk_bf16(v1[0], v1[1]); w.w = cvt_pk_bf16(v1[2], v1[3]);
                    *(u32x4*)(rowp + bj * HALF) = w; } }
    }
};
struct EpiOut {
    static constexpr bool PERM = false, AFTER_DRAIN = false;
    const bf16_t* XB; float* OUT;
    __device__ __forceinline__ void operator()(const f32x4 (&acc)[2][2][4][2], const Unit& u, int wr, int wc, int fr, int fq) const {
        const int row0 = u.pm * BM + wr * 64 + fr, col0 = u.pn * BM + wc * 32 + 4 * fq;
#pragma unroll
        for (int ai = 0; ai < 2; ++ai)
#pragma unroll
            for (int m = 0; m < 4; ++m) { const size_t off = (size_t)(row0 + ai * HALF + m * 16) * 2048 + col0;
#pragma unroll
                for (int bj = 0; bj < 2; ++bj)
#pragma unroll
                    for (int n = 0; n < 2; ++n) { const size_t o = off + bj * HALF + n * 16; const u32x2 xb = *(const u32x2*)(XB + o);
                        f32x4 xv; xv[0] = __uint_as_float(xb.x << 16); xv[1] = __uint_as_float(xb.x & 0xffff0000u); xv[2] = __uint_as_float(xb.y << 16); xv[3] = __uint_as_float(xb.y & 0xffff0000u);
                        *(f32x4*)(OUT + o) = xv + acc[ai][bj][m][n]; } }
    }
};
}

struct Params {
    const float *x, *mem, *g_mix, *w_in, *conv_w, *a_log, *dt_bias, *gdn_norm_g, *fox_b_f, *fox_q_norm, *fox_k_norm, *g_mem, *w_mem_kv,
                *mem_q_norm, *mem_k_norm, *w_up_gdn, *w_up_fox, *w_up_mem, *w_out, *g_mlp, *w_ff1, *w_ff2;
    float* out; unsigned char* ws;
};

__device__ __forceinline__ float wave_sum(float v) {
#pragma unroll
    for (int o = 1; o < 64; o <<= 1) v += __shfl_xor(v, o);
    return v;
}

__device__ __forceinline__ void transpose_item(const float* W, int ldw, int n0src, bf16* WT, int K, int row0dst, const float* kscale,
                                               LAS float* scr, int kb, int nb, int lane) {
    const int k0 = 64 * kb, n0 = 32 * nb;
    float tv[32];
#pragma unroll
    for (int i = 0; i < 32; ++i) tv[i] = W[(size_t)(k0 + 2 * i + (lane >> 5)) * ldw + n0src + n0 + (lane & 31)];
#pragma unroll
    for (int i = 0; i < 32; ++i) { const int kk = 2 * i + (lane >> 5); float v = tv[i];
        if (kscale) v *= kscale[k0 + kk]; scr[kk * 33 + (lane & 31)] = v; }
    asm volatile("s_waitcnt lgkmcnt(0)" ::: "memory");
    const int c = lane & 7;
#pragma unroll
    for (int j = 0; j < 4; ++j) { const int n = (lane >> 3) + 8 * j; const LAS float* s = scr + (8 * c) * 33 + n;
        u32x4 o; o.x = pk2(s[0 * 33], s[1 * 33]); o.y = pk2(s[2 * 33], s[3 * 33]); o.z = pk2(s[4 * 33], s[5 * 33]); o.w = pk2(s[6 * 33], s[7 * 33]);
        *(u32x4*)(WT + (size_t)(row0dst + n0 + n) * K + k0 + 8 * c) = o; }
    asm volatile("s_waitcnt lgkmcnt(0)" ::: "memory");
}
__device__ __forceinline__ void transpose_job(const float* W, int ldw, int n0src, int K, int ncols, bf16* WT, int row0dst, const float* kscale,
                                              LAS float* scr, int gw, int ngw, int lane) {
    const int nblk = ncols / 32, nitems = (K / 64) * nblk;
    for (int it = gw; it < nitems; it += ngw) transpose_item(W, ldw, n0src, WT, K, row0dst, kscale, scr, it / nblk, it % nblk, lane);
}
__device__ __forceinline__ void rms_row_to_bf16(const float* xrow, const float* g, bf16* orow, int lane) {
    const f32x4* xr = (const f32x4*)xrow + lane; const f32x4* gr = (const f32x4*)g + lane;
    f32x4 v[8]; float s = 0.f;
#pragma unroll
    for (int j = 0; j < 8; ++j) { v[j] = xr[64 * j]; s += (v[j].x * v[j].x + v[j].y * v[j].y) + (v[j].z * v[j].z + v[j].w * v[j].w); }
    const float rstd = rsqrtf(wave_sum(s) * (1.f / 2048.f) + EPSN);
    u32x2* o8 = (u32x2*)orow + lane;
#pragma unroll
    for (int j = 0; j < 8; ++j) { const f32x4 gg = gr[64 * j]; u32x2 w; w.x = pk2(v[j].x * rstd * gg.x, v[j].y * rstd * gg.y); w.y = pk2(v[j].z * rstd * gg.z, v[j].w * rstd * gg.w); o8[64 * j] = w; }
}

__device__ __forceinline__ void phase0(const Params& P, unsigned char* lds, int tid, int lane, int wave) {
    unsigned char* ws = P.ws;
    bf16* W1T = (bf16*)(ws + WS_W1T); bf16* WFVT = (bf16*)(ws + WS_WFVT); bf16* WMKVT = (bf16*)(ws + WS_WMKVT); bf16* WGT = (bf16*)(ws + WS_WGT);
    bf16* WUPT = (bf16*)(ws + WS_WUPT); bf16* WOT = (bf16*)(ws + WS_WOT); bf16* WFF1T = (bf16*)(ws + WS_WFF1T); bf16* WFF2T = (bf16*)(ws + WS_WFF2T);
    LAS float* scr = (LAS float*)((LAS unsigned char*)lds + wave * 16384);
    const int G = gridDim.x, gw = blockIdx.x * 8 + wave, ngw = G * 8;
    bf16* H = (bf16*)((unsigned char*)P.out + DO_H);
    for (int m = gw; m < TOK; m += ngw) rms_row_to_bf16(P.x + (size_t)m * DM, P.g_mix, H + (size_t)m * DM, lane);
    bf16* MEMN = (bf16*)(ws + WS_MEMN);
    for (int m = gw; m < 512; m += ngw) rms_row_to_bf16(P.mem + (size_t)m * DM, P.g_mem, MEMN + (size_t)m * DM, lane);
    transpose_job(P.w_in, DIN, 0, 2048, 4096, W1T, 0, nullptr, scr, gw, ngw, lane);
    transpose_job(P.w_in, DIN, 5136, 2048, 1024, W1T, PC_FK, nullptr, scr, gw, ngw, lane);
    transpose_job(P.w_in, DIN, 4112, 2048, 1024, W1T, PC_FQ, nullptr, scr, gw, ngw, lane);
    transpose_job(P.w_in, DIN, 7192, 2048, 1024, W1T, PC_QM, nullptr, scr, gw, ngw, lane);
    transpose_job(P.w_in, DIN, 6160, 2048, 1024, WFVT, 0, nullptr, scr, gw, ngw, lane);
    transpose_job(P.w_in, DIN, 8216, 2048, 6144, WGT, 0, nullptr, scr, gw, ngw, lane);
    transpose_job(P.w_mem_kv, 2048, 0, 2048, 2048, WMKVT, 0, nullptr, scr, gw, ngw, lane);
    transpose_job(P.w_up_gdn, 2048, 0, 1024, 2048, WUPT, 0, nullptr, scr, gw, ngw, lane);
    transpose_job(P.w_up_fox, 2048, 0, 1024, 2048, WUPT + (size_t)2048 * 1024, 0, nullptr, scr, gw, ngw, lane);
    transpose_job(P.w_up_mem, 2048, 0, 1024, 2048, WUPT + (size_t)2 * 2048 * 1024, 0, nullptr, scr, gw, ngw, lane);
    transpose_job(P.w_out, 2048, 0, 2048, 2048, WOT, 0, nullptr, scr, gw, ngw, lane);
    transpose_job(P.w_ff1, 8192, 0, 2048, 8192, WFF1T, 0, P.g_mlp, scr, gw, ngw, lane);
    transpose_job(P.w_ff2, 2048, 0, 8192, 2048, WFF2T, 0, nullptr, scr, gw, ngw, lane);
    for (int idx = blockIdx.x * 512 + tid; idx < 256 * 2048; idx += G * 512) {
        const int row = idx >> 11, k = idx & 2047; float v = 0.f;
        if (row < 24) { const int col = row < 8 ? 4096 + row : (row < 16 ? 4104 + (row - 8) : 7184 + (row - 16)); v = P.w_in[(size_t)k * DIN + col]; }
        W1T[(size_t)(7168 + row) * 2048 + k] = (bf16)(pk2(v, 0.f) & 0xffffu);
    }
}


__device__ __forceinline__ void gdn_prep_unit(const Params& P, unsigned char* lds_, int bh, int n, int tid, int lane, int wave) {
    float* qs = (float*)lds_;
    float* ks = qs + 64 * 132;
    float* vs = ks + 64 * 132;
    float* Mm = vs + 64 * 132;
    float* QKd = Mm + 4096;
    float* gam = QKd + 4096;
    float* beta = gam + 64;
    float* egam = beta + 64;
    const int b = bh >> 3, h = bh & 7;
    const size_t r0 = (size_t)b * SEQ + (size_t)n * 64;
    const bf16* proj = (const bf16*)(P.ws + WS_PROJ);
    const float* small = (const float*)(P.ws + WS_SMALL);
    if (tid < 384) {
        const int c8 = tid % 48, tg = tid / 48, mat = c8 >> 4, ch0 = (c8 & 15) * 8, col = mat * 1024 + h * 128 + ch0, tb = tg * 8;
        u32x4 xr[11];
#pragma unroll
        for (int i = 0; i < 11; ++i) { const int tt = n * 64 + tb - 3 + i;
            xr[i] = tt >= 0 ? *(const u32x4*)(proj + (r0 + tb - 3 + i) * LDP + col) : u32x4{0u, 0u, 0u, 0u}; }
        f32x4 w0[4], w1[4];
#pragma unroll
        for (int i = 0; i < 4; ++i) { w0[i] = *(const f32x4*)(P.conv_w + i * 3072 + col); w1[i] = *(const f32x4*)(P.conv_w + i * 3072 + col + 4); }
        float* dstb = (mat == 0 ? qs : (mat == 1 ? ks : vs)) + tb * 132 + ch0;
#pragma unroll
        for (int t = 0; t < 8; ++t) {
            float y[8];
#pragma unroll
            for (int e = 0; e < 8; ++e) y[e] = 0.f;
#pragma unroll
            for (int i = 0; i < 4; ++i) { const u32x4 xv = xr[t + i];
                y[0] += bflo(xv.x) * w0[i].x; y[1] += bfhi(xv.x) * w0[i].y; y[2] += bflo(xv.y) * w0[i].z; y[3] += bfhi(xv.y) * w0[i].w;
                y[4] += bflo(xv.z) * w1[i].x; y[5] += bfhi(xv.z) * w1[i].y; y[6] += bflo(xv.w) * w1[i].z; y[7] += bfhi(xv.w) * w1[i].w; }
            f32x4 o0, o1;
            o0.x = y[0] * __builtin_amdgcn_rcpf(1.f + __builtin_amdgcn_exp2f(-LOG2E * y[0])); o0.y = y[1] * __builtin_amdgcn_rcpf(1.f + __builtin_amdgcn_exp2f(-LOG2E * y[1]));
            o0.z = y[2] * __builtin_amdgcn_rcpf(1.f + __builtin_amdgcn_exp2f(-LOG2E * y[2])); o0.w = y[3] * __builtin_amdgcn_rcpf(1.f + __builtin_amdgcn_exp2f(-LOG2E * y[3]));
            o1.x = y[4] * __builtin_amdgcn_rcpf(1.f + __builtin_amdgcn_exp2f(-LOG2E * y[4])); o1.y = y[5] * __builtin_amdgcn_rcpf(1.f + __builtin_amdgcn_exp2f(-LOG2E * y[5]));
            o1.z = y[6] * __builtin_amdgcn_rcpf(1.f + __builtin_amdgcn_exp2f(-LOG2E * y[6])); o1.w = y[7] * __builtin_amdgcn_rcpf(1.f + __builtin_amdgcn_exp2f(-LOG2E * y[7]));
            *(f32x4*)(dstb + t * 132) = o0; *(f32x4*)(dstb + t * 132 + 4) = o1;
        }
    }
    if (wave == 7) {
        const float av = small[(r0 + lane) * 32 + 8 + h], bv = small[(r0 + lane) * 32 + h];
        float g = -__expf(P.a_log[h]) * softplusf_(av + P.dt_bias[h]);
#pragma unroll
        for (int o = 1; o < 64; o <<= 1) { const float t_ = __shfl_up(g, o); if (lane >= o) g += t_; }
        gam[lane] = g; egam[lane] = __expf(g); beta[lane] = sigmoidf_(bv);
    }
    __syncthreads();
    for (int rb = wave * 16; rb < wave * 16 + 16; rb += 4) {
        float* rowp[4]; float av[4], cv[4], ss[4];
#pragma unroll
        for (int q = 0; q < 4; ++q) { const int rr = rb + q; rowp[q] = (rr < 64 ? qs + rr * 132 : ks + (rr - 64) * 132); av[q] = rowp[q][lane]; cv[q] = rowp[q][lane + 64]; ss[q] = av[q] * av[q] + cv[q] * cv[q]; }
#pragma unroll
        for (int o = 1; o < 64; o <<= 1)
#pragma unroll
            for (int q = 0; q < 4; ++q) ss[q] += __shfl_xor(ss[q], o);
#pragma unroll
        for (int q = 0; q < 4; ++q) { const float sc = rsqrtf(ss[q] + EPSN) * (rb < 64 ? 0.08838834764831845f : 1.f); rowp[q][lane] = av[q] * sc; rowp[q][lane + 64] = cv[q] * sc; }
    }
    __syncthreads();
    {
        const int mat = wave >> 2, ti = (wave >> 1) & 1, tj = wave & 1, c = lane & 31, hi = lane >> 5;
        const float* Arow = (mat == 0 ? ks : qs) + (32 * ti + c) * 132 + 8 * hi;
        const float* Brow = ks + (32 * tj + c) * 132 + 8 * hi;
        f32x16 acc = f32x16{};
#pragma unroll
        for (int k = 0; k < 8; ++k) {
            const f32x4 a0 = *(const f32x4*)(Arow + 16 * k), a1 = *(const f32x4*)(Arow + 16 * k + 4);
            const f32x4 b0 = *(const f32x4*)(Brow + 16 * k), b1 = *(const f32x4*)(Brow + 16 * k + 4);
            u32x4 aw, bw;
            aw.x = pk2(a0.x, a0.y); aw.y = pk2(a0.z, a0.w); aw.z = pk2(a1.x, a1.y); aw.w = pk2(a1.z, a1.w);
            bw.x = pk2(b0.x, b0.y); bw.y = pk2(b0.z, b0.w); bw.z = pk2(b1.x, b1.y); bw.w = pk2(b1.z, b1.w);
            acc = __builtin_amdgcn_mfma_f32_32x32x16_bf16(__builtin_bit_cast(bf16x8, aw), __builtin_bit_cast(bf16x8, bw), acc, 0, 0, 0);
        }
        const int jj = 32 * tj + c; const float gj = gam[jj];
        float* dbase = mat == 0 ? Mm + jj * 64 : QKd + jj; const int dstep = mat == 0 ? 1 : 64; const int strict = mat == 0 ? 1 : 0;
#pragma unroll
        for (int r = 0; r < 16; ++r) { const int ii = 32 * ti + crow(r, hi);
            const float e = __expf(fminf(gam[ii] - gj, 0.f));
            const float sc = mat == 0 ? beta[ii] : 1.f;
            dbase[ii * dstep] = (jj + strict <= ii) ? sc * acc[r] * e : 0.f; }
    }
    __syncthreads();
    unsigned char* gout = P.ws + WS_GDN + (size_t)(bh * 128 + n) * GDN_CHUNK_BYTES;
    unsigned char* uout = P.ws + WS_UC + (size_t)(bh * 128 + n) * 16384;
    const float glast = gam[63];
    for (int p = tid; p < 2560; p += 512) {
        float v[8]; unsigned char* dst;
        if (p < 1024) {
            const int f = p >> 6, ln = p & 63, rt = f >> 3, kk = f & 7, row = 32 * rt + (ln & 31), hi = ln >> 5;
            const float* src = qs + row * 132 + 16 * kk; const float sc = egam[row];
#pragma unroll
            for (int j = 0; j < 8; ++j) v[j] = src[crow(j, hi)] * sc;
            dst = gout + 16384 + (size_t)p * 16;
        } else if (p < 1536) {
            const int q = p - 1024, f = q >> 6, ln = q & 63, rt = f >> 2, kk = f & 3, row = 32 * rt + (ln & 31), hi = ln >> 5;
#pragma unroll
            for (int j = 0; j < 8; ++j) v[j] = QKd[row * 64 + 16 * kk + crow(j, hi)];
            dst = gout + 32768 + (size_t)q * 16;
        } else {
            const int q = p - 1536, f = q >> 6, ln = q & 63, rt = f >> 2, kk = f & 3, dk = 32 * rt + (ln & 31), hi = ln >> 5;
#pragma unroll
            for (int j = 0; j < 8; ++j) { const int tk = 16 * kk + crow(j, hi); v[j] = ks[tk * 132 + dk] * __expf(fminf(glast - gam[tk], 0.f)); }
            dst = gout + 40960 + (size_t)q * 16;
        }
        u32x4 o; o.x = pk2(v[0], v[1]); o.y = pk2(v[2], v[3]); o.z = pk2(v[4], v[5]); o.w = pk2(v[6], v[7]);
        *(u32x4*)dst = o;
    }
    if (tid == 0) ((float*)(P.ws + WS_CDEC))[bh * 128 + n] = __expf(glast);
    __syncthreads();
    if (tid < 256) {
        float* col = (tid < 128 ? ks : vs) + (tid & 127);
        int zero; asm volatile("v_mov_b32 %0, 0" : "=v"(zero));
        const float* bz = beta + zero; const float* ez = egam + zero;
#pragma unroll 1
        for (int ib = 0; ib < 4; ++ib) {
            float acc[16];
#pragma unroll
            for (int r = 0; r < 16; ++r) acc[r] = col[(ib * 16 + r) * 132] * (bz[ib * 16 + r] * (tid < 128 ? ez[ib * 16 + r] : 1.f));
#pragma unroll 8
            for (int j = 0; j < ib * 16; ++j) {
                const float xj = col[j * 132]; const float* mr = Mm + zero + j * 64 + ib * 16;
                const f32x4 m0 = *(const f32x4*)mr, m1 = *(const f32x4*)(mr + 4), m2 = *(const f32x4*)(mr + 8), m3 = *(const f32x4*)(mr + 12);
                acc[0] -= m0.x * xj; acc[1] -= m0.y * xj; acc[2] -= m0.z * xj; acc[3] -= m0.w * xj;
                acc[4] -= m1.x * xj; acc[5] -= m1.y * xj; acc[6] -= m1.z * xj; acc[7] -= m1.w * xj;
                acc[8] -= m2.x * xj; acc[9] -= m2.y * xj; acc[10] -= m2.z * xj; acc[11] -= m2.w * xj;
                acc[12] -= m3.x * xj; acc[13] -= m3.y * xj; acc[14] -= m3.z * xj; acc[15] -= m3.w * xj;
            }
#pragma unroll
            for (int r2 = 0; r2 < 15; ++r2) {
                const float* mr = Mm + (ib * 16 + r2) * 64 + ib * 16; float mm[16];
#pragma unroll
                for (int q = 0; q < 4; ++q) { const f32x4 t4 = *(const f32x4*)(mr + 4 * q); mm[4 * q] = t4.x; mm[4 * q + 1] = t4.y; mm[4 * q + 2] = t4.z; mm[4 * q + 3] = t4.w; }
#pragma unroll
                for (int r = r2 + 1; r < 16; ++r) acc[r] -= mm[r] * acc[r2];
            }
#pragma unroll
            for (int r = 0; r < 16; ++r) col[(ib * 16 + r) * 132] = acc[r];
        }
    }
    __syncthreads();
    for (int p = tid; p < 2048; p += 512) {
        float v[8]; unsigned char* dst;
        if (p < 1024) {
            const int f = p >> 6, ln = p & 63, rt = f >> 3, kk = f & 7, row = 32 * rt + (ln & 31), hi = ln >> 5;
            const float* src = ks + row * 132 + 16 * kk;
#pragma unroll
            for (int j = 0; j < 8; ++j) v[j] = -src[crow(j, hi)];
            dst = gout + (size_t)p * 16;
        } else {
            const int q = p - 1024, half = q & 1, ln = (q >> 1) & 63, g2 = q >> 7, rt = g2 & 1, w4 = g2 >> 1, hi = ln >> 5;
#pragma unroll
            for (int j = 0; j < 8; ++j) v[j] = vs[(32 * rt + crow(8 * half + j, hi)) * 132 + 32 * w4 + (ln & 31)];
            dst = uout + (size_t)q * 16;
        }
        u32x4 o; o.x = pk2(v[0], v[1]); o.y = pk2(v[2], v[3]); o.z = pk2(v[4], v[5]); o.w = pk2(v[6], v[7]);
        *(u32x4*)dst = o;
    }
    __syncthreads();
}

template <int GL, int NB> __device__ __forceinline__ void norm8b(bf16* const (&p)[NB], const bool (&ok)[NB], const float* gain, float mult, float inv_n) {
    u32x4 xv[NB];
#pragma unroll
    for (int b = 0; b < NB; ++b) xv[b] = ok[b] ? *(const u32x4*)p[b] : u32x4{0u, 0u, 0u, 0u};
    const f32x4 g0 = *(const f32x4*)gain, g1 = *(const f32x4*)(gain + 4);
#pragma unroll
    for (int b = 0; b < NB; ++b) {
        float v[8] = {bflo(xv[b].x), bfhi(xv[b].x), bflo(xv[b].y), bfhi(xv[b].y), bflo(xv[b].z), bfhi(xv[b].z), bflo(xv[b].w), bfhi(xv[b].w)};
        float ss = 0.f;
#pragma unroll
        for (int e = 0; e < 8; ++e) ss += v[e] * v[e];
#pragma unroll
        for (int o = 1; o < GL; o <<= 1) ss += __shfl_xor(ss, o);
        const float sc = rsqrtf(ss * inv_n + EPSN) * mult;
        u32x4 o; o.x = pk2(v[0] * sc * g0.x, v[1] * sc * g0.y); o.y = pk2(v[2] * sc * g0.z, v[3] * sc * g0.w);
        o.z = pk2(v[4] * sc * g1.x, v[5] * sc * g1.y); o.w = pk2(v[6] * sc * g1.z, v[7] * sc * g1.w);
        if (ok[b]) *(u32x4*)p[b] = o;
    }
}

__device__ __forceinline__ void phase2(const Params& P, unsigned char* lds, int tid, int lane, int wave) {
    const int G = gridDim.x;
    bf16* proj = (bf16*)(P.ws + WS_PROJ);
    if (blockIdx.x < 16) {
        const int bh = blockIdx.x, b = bh >> 3, h = bh & 7;
        const float* small = (const float*)(P.ws + WS_SMALL);
        float* cum = (float*)(P.ws + WS_CUM) + (size_t)bh * SEQ;
        float* wtot = (float*)lds;
        const float bf = P.fox_b_f[h];
        float v[16]; float run = 0.f;
#pragma unroll
        for (int e = 0; e < 16; ++e) { const float xx = small[((size_t)b * SEQ + tid * 16 + e) * 32 + 16 + h] + bf; run += -softplusf_(-xx) * LOG2E; v[e] = run; }
        float inc = run;
#pragma unroll
        for (int o = 1; o < 64; o <<= 1) { const float t_ = __shfl_up(inc, o); if (lane >= o) inc += t_; }
        if (lane == 63) wtot[wave] = inc;
        { float gq = tid < 128 ? fabsf(P.fox_q_norm[tid]) : 0.f, gk = tid < 128 ? fabsf(P.fox_k_norm[tid]) : 0.f;
#pragma unroll
          for (int o = 1; o < 64; o <<= 1) { gq = fmaxf(gq, __shfl_xor(gq, o)); gk = fmaxf(gk, __shfl_xor(gk, o)); }
          if (lane == 0) { wtot[8 + wave] = gq; wtot[16 + wave] = gk; } }
        __syncthreads();
        if (bh == 0 && tid == 0) { float gq = 0.f, gk = 0.f; for (int w = 0; w < 8; ++w) { gq = fmaxf(gq, wtot[8 + w]); gk = fmaxf(gk, wtot[16 + w]); }
            ((float*)(P.ws + WS_CDEC + 16384))[0] = 150.f + 2.f * 1.03f * (128.f * 0.08838834764831845f * LOG2E) * gq * gk; }
        float off = inc - run;
        for (int w = 0; w < wave; ++w) off += wtot[w];
#pragma unroll
        for (int e = 0; e < 16; ++e) cum[tid * 16 + e] = v[e] + off;
        __syncthreads();
    }
    for (int u = blockIdx.x; u < 2048; u += G) gdn_prep_unit(P, lds, u >> 7, u & 127, tid, lane, wave);
    for (int it0 = blockIdx.x; it0 < TOK / 2; it0 += 8 * G) {
        const int cidx = (tid & 255) * 8, isq = cidx >= 1024, d = cidx & 127;
        bf16* pp[8]; bool ok[8];
#pragma unroll
        for (int b = 0; b < 8; ++b) { const int it = it0 + b * G; ok[b] = it < TOK / 2; pp[b] = proj + (size_t)((ok[b] ? it : 0) * 2 + (tid >> 8)) * LDP + PC_FK + cidx; }
        norm8b<16, 8>(pp, ok, (isq ? P.fox_q_norm : P.fox_k_norm) + d, isq ? 0.08838834764831845f * LOG2E : 1.f, 1.f / 128.f);
    }
    for (int it0 = blockIdx.x; it0 < TOK / 4; it0 += 8 * G) {
        const int cidx = (tid & 127) * 8, d = cidx & 255;
        bf16* pp[8]; bool ok[8];
#pragma unroll
        for (int b = 0; b < 8; ++b) { const int it = it0 + b * G; ok[b] = it < TOK / 4; pp[b] = proj + (size_t)((ok[b] ? it : 0) * 4 + (tid >> 7)) * LDP + PC_QM + cidx; }
        norm8b<32, 8>(pp, ok, P.mem_q_norm + d, 0.0625f * LOG2E, 1.f / 256.f);
    }
    bf16* kmem = (bf16*)(P.ws + WS_KMEM);
    for (int it = blockIdx.x; it < 512 / 4; it += G) {
        const int cidx = (tid & 127) * 8, d = cidx & 255;
        bf16* pp[1] = {kmem + (size_t)(it * 4 + (tid >> 7)) * 1024 + cidx}; const bool ok[1] = {true};
        norm8b<32, 1>(pp, ok, P.mem_k_norm + d, 1.f, 1.f / 256.f);
    }
}

template <int DQK, bool FOX>
__device__ __forceinline__ void attn_unit(unsigned char* lds_, const bf16* Q, int ldq, const bf16* K, int ldk, const bf16* VT, int ldvt, bf16* O, int ldo,
                                          const float* cum, float skip_lim, int t0, int ntiles, int tid, int lane, int wave, int& dbg_tiles, unsigned char* dbg_ws = nullptr) {
    asm volatile("" : "+v"(tid), "+v"(lane));
    constexpr int KS = DQK / 16, KPITCH = DQK * 2 + 16, VPITCH = 136, ND = FOX ? 4 : 2, NH = (DQK / 32) / ND, VCH = ND / 2;
    constexpr int KCH = 64 * DQK / 8 / 512;
    LAS unsigned char* lds = (LAS unsigned char*)lds_;
    LAS unsigned char* Ks = lds; LAS unsigned char* VTs = lds + 64 * KPITCH; LAS float* cbs = (LAS float*)(lds + 64 * KPITCH + 128 * VPITCH);
    const int c = lane & 31, hi = lane >> 5;
    const int qrow = t0 + wave * 32 + c;
    bf16x8 qf[KS];
    { const bf16* qp = Q + (size_t)qrow * ldq + 8 * hi;
#pragma unroll
      for (int k = 0; k < KS; ++k) qf[k] = *(const bf16x8*)(qp + 16 * k); }
    float cref = 0.f; int jmin = 0;
    if (FOX) {
        cref = cum[t0];
        LAS int* jm = (LAS int*)(cbs + 64);
        if (wave < 2) { const int j = wave * 64 + lane; bool need = false; if (j < ntiles) need = (cref - cum[64 * j + 63]) >= -skip_lim;
            const unsigned long long mk = __ballot(need); if (lane == 0) jm[wave] = mk ? (int)__builtin_ctzll(mk) + wave * 64 : (1 << 20); }
        __syncthreads();
        jmin = min(min(jm[0], jm[1]), ntiles - 1);
        jmin = __builtin_amdgcn_readfirstlane(jmin);
    }
    dbg_tiles = 0;
#ifdef PROBE_TS
    if (FOX && dbg_ws && blockIdx.x == 16 && tid == 0) { volatile unsigned long long* dg_ = (volatile unsigned long long*)(dbg_ws + WS_CTL + 32768); dg_[16] += (unsigned long long)(ntiles - jmin) * 375ull; }
#endif
#pragma unroll 1
    for (int half = 0; half < NH; ++half) {
        f32x16 o[ND]; float m = -1e30f, l = 0.f;
#pragma unroll
        for (int d = 0; d < ND; ++d) o[d] = f32x16{};
        constexpr bool PREF = (DQK == 128);
        u32x4 kpre[KCH], vpre[VCH]; float cpre = 0.f;
#define ATT_PREFETCH(j_) do { const int kv0_ = 64 * (j_); \
            _Pragma("unroll") for (int i = 0; i < KCH; ++i) { const int id = tid + 512 * i, row = id / (DQK / 8), cc = id % (DQK / 8); kpre[i] = *(const u32x4*)(K + (size_t)(kv0_ + row) * ldk + cc * 8); } \
            _Pragma("unroll") for (int i = 0; i < VCH; ++i) { const int id = tid + 512 * i, row = id >> 3, cc = id & 7; vpre[i] = *(const u32x4*)(VT + (size_t)(half * ND * 32 + row) * ldvt + kv0_ + cc * 8); } \
            if (FOX) { if (tid < 64) cpre = cum[kv0_ + tid] - cref; } } while (0)
        if (PREF) ATT_PREFETCH(jmin);
#pragma unroll 1
        for (int j = jmin; j < ntiles; ++j) {
            __syncthreads();
            if (!PREF) ATT_PREFETCH(j);
#pragma unroll
            for (int i = 0; i < KCH; ++i) { const int id = tid + 512 * i, row = id / (DQK / 8), cc = id % (DQK / 8); *(LAS u32x4*)(Ks + row * KPITCH + cc * 16) = kpre[i]; }
#pragma unroll
            for (int i = 0; i < VCH; ++i) { const int id = tid + 512 * i, row = id >> 3, cc = id & 7; LAS u32x2* d2 = (LAS u32x2*)(VTs + row * VPITCH + cc * 16);
                d2[0] = (u32x2){vpre[i].x, vpre[i].y}; d2[1] = (u32x2){vpre[i].z, vpre[i].w}; }
            if (FOX) { if (tid < 64) cbs[tid] = cpre; }
            __syncthreads();
            if (PREF && j + 1 < ntiles) ATT_PREFETCH(j + 1);
            const int kv0 = 64 * j;
            if (FOX && kv0 > t0 + wave * 32 + 31) continue;
            f32x16 p0 = f32x16{}, p1 = f32x16{};
            const LAS unsigned char* vb = VTs + c * VPITCH + hi * 8;
            u32x2 vlo[FOX ? 8 : 1], vhh[FOX ? 8 : 1];
            if constexpr (false) {
                const LAS unsigned char* kb = Ks + c * KPITCH + hi * 16;
                bf16x8 kf[2 * KS];
#pragma unroll
                for (int k = 0; k < KS; ++k) { kf[2 * k] = *(const LAS bf16x8*)(kb + k * 32); kf[2 * k + 1] = *(const LAS bf16x8*)(kb + 32 * KPITCH + k * 32); }
                __builtin_amdgcn_sched_barrier(0);
#pragma unroll
                for (int k = 0; k < KS; ++k) {
                    p0 = __builtin_amdgcn_mfma_f32_32x32x16_bf16(kf[2 * k], qf[k], p0, 0, 0, 0);
                    p1 = __builtin_amdgcn_mfma_f32_32x32x16_bf16(kf[2 * k + 1], qf[k], p1, 0, 0, 0); }
                __builtin_amdgcn_sched_barrier(0);
#pragma unroll
                for (int d = 0; d < 2; ++d)
#pragma unroll
                    for (int cc = 0; cc < 4; ++cc) { vlo[d * 4 + cc] = *(const LAS u32x2*)(vb + d * 32 * VPITCH + cc * 32); vhh[d * 4 + cc] = *(const LAS u32x2*)(vb + d * 32 * VPITCH + cc * 32 + 16); }
                __builtin_amdgcn_sched_barrier(0);
            } else {
                const LAS unsigned char* kb = Ks + c * KPITCH + hi * 16;
#pragma unroll
                for (int k = 0; k < KS; ++k) {
                    const bf16x8 a0 = *(const LAS bf16x8*)(kb + k * 32), a1 = *(const LAS bf16x8*)(kb + 32 * KPITCH + k * 32);
                    p0 = __builtin_amdgcn_mfma_f32_32x32x16_bf16(a0, qf[k], p0, 0, 0, 0);
                    p1 = __builtin_amdgcn_mfma_f32_32x32x16_bf16(a1, qf[k], p1, 0, 0, 0); }
            }
            if (FOX) {
#pragma unroll
                for (int r4 = 0; r4 < 4; ++r4) { const f32x4 b0 = *(const LAS f32x4*)(cbs + 8 * r4 + 4 * hi), b1 = *(const LAS f32x4*)(cbs + 32 + 8 * r4 + 4 * hi);
#pragma unroll
                    for (int e = 0; e < 4; ++e) { p0[4 * r4 + e] -= b0[e]; p1[4 * r4 + e] -= b1[e]; } }
                if (kv0 + 63 > t0 + wave * 32) {
#pragma unroll
                    for (int r = 0; r < 16; ++r) { const int kv = kv0 + crow(r, hi); if (kv > qrow) p0[r] = -INFINITY; if (kv + 32 > qrow) p1[r] = -INFINITY; }
                }
            }
            float mx = p0[0];
#pragma unroll
            for (int r = 1; r < 16; ++r) mx = fmaxf(mx, p0[r]);
#pragma unroll
            for (int r = 0; r < 16; ++r) mx = fmaxf(mx, p1[r]);
            mx = fmaxf(mx, __shfl_xor(mx, 32));
            const float mn = fmaxf(m, mx), alpha = __builtin_amdgcn_exp2f(m - mn); m = mn;
            float ps = 0.f;
#pragma unroll
            for (int r = 0; r < 16; ++r) { p0[r] = __builtin_amdgcn_exp2f(p0[r] - mn); p1[r] = __builtin_amdgcn_exp2f(p1[r] - mn); ps += p0[r] + p1[r]; }
            l = l * alpha + ps;
#pragma unroll
            for (int d = 0; d < ND; ++d)
#pragma unroll
                for (int r = 0; r < 16; ++r) o[d][r] *= alpha;
            bf16x8 pb[4];
#pragma unroll
            for (int cc = 0; cc < 4; ++cc) { u32x4 w;
                if (cc < 2) { w.x = pk2(p0[8 * cc + 0], p0[8 * cc + 1]); w.y = pk2(p0[8 * cc + 2], p0[8 * cc + 3]); w.z = pk2(p0[8 * cc + 4], p0[8 * cc + 5]); w.w = pk2(p0[8 * cc + 6], p0[8 * cc + 7]); }
                else { const int c2 = cc - 2; w.x = pk2(p1[8 * c2 + 0], p1[8 * c2 + 1]); w.y = pk2(p1[8 * c2 + 2], p1[8 * c2 + 3]); w.z = pk2(p1[8 * c2 + 4], p1[8 * c2 + 5]); w.w = pk2(p1[8 * c2 + 6], p1[8 * c2 + 7]); }
                pb[cc] = __builtin_bit_cast(bf16x8, w); }
            if constexpr (false) {
                u32x2 wlo[8], whh[8];
#pragma unroll
                for (int d = 0; d < 2; ++d)
#pragma unroll
                    for (int cc = 0; cc < 4; ++cc) { wlo[d * 4 + cc] = *(const LAS u32x2*)(vb + (d + 2) * 32 * VPITCH + cc * 32); whh[d * 4 + cc] = *(const LAS u32x2*)(vb + (d + 2) * 32 * VPITCH + cc * 32 + 16); }
                __builtin_amdgcn_sched_barrier(0);
#pragma unroll
                for (int cc = 0; cc < 4; ++cc)
#pragma unroll
                    for (int d = 0; d < 2; ++d) { const u32x4 av = (u32x4){vlo[d * 4 + cc].x, vlo[d * 4 + cc].y, vhh[d * 4 + cc].x, vhh[d * 4 + cc].y};
                        o[d] = __builtin_amdgcn_mfma_f32_32x32x16_bf16(__builtin_bit_cast(bf16x8, av), pb[cc], o[d], 0, 0, 0); }
                __builtin_amdgcn_sched_barrier(0);
#pragma unroll
                for (int cc = 0; cc < 4; ++cc)
#pragma unroll
                    for (int d = 0; d < 2; ++d) { const u32x4 av = (u32x4){wlo[d * 4 + cc].x, wlo[d * 4 + cc].y, whh[d * 4 + cc].x, whh[d * 4 + cc].y};
                        o[d + 2] = __builtin_amdgcn_mfma_f32_32x32x16_bf16(__builtin_bit_cast(bf16x8, av), pb[cc], o[d + 2], 0, 0, 0); }
            } else {
#pragma unroll
              for (int d = 0; d < ND; ++d)
#pragma unroll
                  for (int cc = 0; cc < 4; ++cc) {
                      const u32x2 lo = *(const LAS u32x2*)(vb + d * 32 * VPITCH + cc * 32), hh = *(const LAS u32x2*)(vb + d * 32 * VPITCH + cc * 32 + 16);
                      const u32x4 av = (u32x4){lo.x, lo.y, hh.x, hh.y};
                      o[d] = __builtin_amdgcn_mfma_f32_32x32x16_bf16(__builtin_bit_cast(bf16x8, av), pb[cc], o[d], 0, 0, 0); } }
        }
        l += __shfl_xor(l, 32);
        const float rl = 1.f / l;
        bf16* op = O + (size_t)qrow * ldo + half * ND * 32 + 4 * hi;
#pragma unroll
        for (int d = 0; d < ND; ++d)
#pragma unroll
            for (int r4 = 0; r4 < 4; ++r4) { u32x2 w; w.x = pk2(o[d][4 * r4 + 0] * rl, o[d][4 * r4 + 1] * rl); w.y = pk2(o[d][4 * r4 + 2] * rl, o[d][4 * r4 + 3] * rl);
                *(u32x2*)(op + 32 * d + 8 * r4) = w; }
    }
    __syncthreads();
}

__device__ __forceinline__ void gdn_scan_wg(const Params& P, unsigned char* lds_, int unit, int tid, int lane, int wave) {
    const int bh = unit >> 2, quart = unit & 3;
    LAS unsigned char* lds = (LAS unsigned char*)lds_;
    const int b = bh >> 3, h = bh & 7;
    const unsigned char* gsrc = P.ws + WS_GDN + (size_t)bh * 128 * GDN_CHUNK_BYTES;
    const unsigned char* usrc = P.ws + WS_UC + (size_t)bh * 128 * 16384;
    const float* cdec = (const float*)(P.ws + WS_CDEC) + bh * 128;
    bf16* proj = (bf16*)(P.ws + WS_PROJ);
#define SCAN_BAR() asm volatile("s_waitcnt lgkmcnt(0)\n\ts_barrier" ::: "memory")
    constexpr int OB = 114688;
    if (wave >= 4) {
        const int lt = tid - 256, tk = lt >> 2, q4 = lt & 3;
        const size_t rowb = (size_t)b * SEQ + tk;
        bf16* obase = proj + rowb * LDP + PC_OA + h * 128 + q4 * 32;
        u32x4 r[14];
#pragma unroll
        for (int k = 0; k < 14; ++k) r[k] = *(const u32x4*)(gsrc + (size_t)(lt + 256 * k) * 16);
#pragma unroll
        for (int k = 0; k < 14; ++k) *(LAS u32x4*)(lds + (lt + 256 * k) * 16) = r[k];
#pragma unroll
        for (int k = 0; k < 14; ++k) r[k] = *(const u32x4*)(gsrc + (size_t)GDN_CHUNK_BYTES + (size_t)(lt + 256 * k) * 16);
        __syncthreads();
#define GDN_NORM(CH) do { if (q4 == quart) { const LAS unsigned char* ob_ = lds + OB + ((CH) & 1) * 16384 + tk * 256 + q4 * 64; bf16* op_ = obase + (size_t)(CH) * 64 * LDP; \
            _Pragma("unroll") for (int i = 0; i < 4; ++i) { const u32x4 w_ = *(const LAS u32x4*)(ob_ + i * 16); *(u32x4*)(op_ + 8 * i) = w_; } } } while (0)
#pragma unroll 1
        for (int n = 0; n < 128; ++n) {
            if (n + 1 < 128) {
                LAS unsigned char* d = lds + ((n + 1) & 1) * GDN_CHUNK_BYTES;
#pragma unroll
                for (int k = 0; k < 14; ++k) *(LAS u32x4*)(d + (lt + 256 * k) * 16) = r[k];
            }
            if (n + 2 < 128) {
                const unsigned char* s2 = gsrc + (size_t)(n + 2) * GDN_CHUNK_BYTES;
#pragma unroll
                for (int k = 0; k < 14; ++k) r[k] = *(const u32x4*)(s2 + (size_t)(lt + 256 * k) * 16);
            }
            if (n > 0) GDN_NORM(n - 1);
            SCAN_BAR();
        }
        GDN_NORM(127);
#undef GDN_NORM
    } else if (wave >= 1) {
        __syncthreads();
#pragma unroll 1
        for (int n = 0; n < 128; ++n) SCAN_BAR();
    } else {
        const int w4 = quart, c = lane & 31, hi = lane >> 5;
        f32x16 S[4];
#pragma unroll
        for (int t = 0; t < 4; ++t) S[t] = f32x16{};
        bf16x8 Sb[8];
#pragma unroll
        for (int k = 0; k < 8; ++k) Sb[k] = bf16x8{};
        u32x4 ucn[4];
#pragma unroll
        for (int i = 0; i < 4; ++i) ucn[i] = *(const u32x4*)(usrc + (size_t)((w4 * 2 + (i >> 1)) * 64 + lane) * 32 + (i & 1) * 16);
        float cdn = cdec[0];
        __syncthreads();
#pragma unroll 1
        for (int n = 0; n < 128; ++n) {
            const LAS unsigned char* fb = lds + (n & 1) * GDN_CHUNK_BYTES + lane * 16;
            f32x16 U[2];
#pragma unroll
            for (int rt = 0; rt < 2; ++rt) { const u32x4 a = ucn[2 * rt], bq = ucn[2 * rt + 1];
                U[rt][0] = bflo(a.x); U[rt][1] = bfhi(a.x); U[rt][2] = bflo(a.y); U[rt][3] = bfhi(a.y); U[rt][4] = bflo(a.z); U[rt][5] = bfhi(a.z); U[rt][6] = bflo(a.w); U[rt][7] = bfhi(a.w);
                U[rt][8] = bflo(bq.x); U[rt][9] = bfhi(bq.x); U[rt][10] = bflo(bq.y); U[rt][11] = bfhi(bq.y); U[rt][12] = bflo(bq.z); U[rt][13] = bfhi(bq.z); U[rt][14] = bflo(bq.w); U[rt][15] = bfhi(bq.w); }
            const float cd = cdn;
            if (n + 1 < 128) {
                const unsigned char* us = usrc + (size_t)(n + 1) * 16384;
#pragma unroll
                for (int i = 0; i < 4; ++i) ucn[i] = *(const u32x4*)(us + (size_t)((w4 * 2 + (i >> 1)) * 64 + lane) * 32 + (i & 1) * 16);
                cdn = cdec[n + 1];
            }
#define FRAG(off) (*(const LAS bf16x8*)(fb + (off)))
#define SBAR() __builtin_amdgcn_sched_barrier(0)
            bf16x8 A0[8], A1[8];
#pragma unroll
            for (int i = 0; i < 8; ++i) A0[i] = FRAG(((i & 1) * 8 + (i >> 1)) * 1024);
            SBAR();
#pragma unroll
            for (int i = 0; i < 8; ++i) A1[i] = FRAG(((i & 1) * 8 + 4 + (i >> 1)) * 1024);
            SBAR();
#pragma unroll
            for (int i = 0; i < 8; ++i) U[i & 1] = __builtin_amdgcn_mfma_f32_32x32x16_bf16(A0[i], Sb[i >> 1], U[i & 1], 0, 0, 0);
            SBAR();
#pragma unroll
            for (int i = 0; i < 8; ++i) A0[i] = FRAG(16384 + ((i & 1) * 8 + (i >> 1)) * 1024);
            SBAR();
#pragma unroll
            for (int i = 0; i < 8; ++i) U[i & 1] = __builtin_amdgcn_mfma_f32_32x32x16_bf16(A1[i], Sb[4 + (i >> 1)], U[i & 1], 0, 0, 0);
            SBAR();
#pragma unroll
            for (int i = 0; i < 8; ++i) A1[i] = FRAG(16384 + ((i & 1) * 8 + 4 + (i >> 1)) * 1024);
            SBAR();
            f32x16 Ov[2]; Ov[0] = f32x16{}; Ov[1] = f32x16{};
#pragma unroll
            for (int i = 0; i < 8; ++i) Ov[i & 1] = __builtin_amdgcn_mfma_f32_32x32x16_bf16(A0[i], Sb[i >> 1], Ov[i & 1], 0, 0, 0);
            SBAR();
#pragma unroll
            for (int i = 0; i < 8; ++i) A0[i] = FRAG(32768 + ((i & 1) * 4 + (i >> 1)) * 1024);
            SBAR();
#pragma unroll
            for (int i = 0; i < 8; ++i) Ov[i & 1] = __builtin_amdgcn_mfma_f32_32x32x16_bf16(A1[i], Sb[4 + (i >> 1)], Ov[i & 1], 0, 0, 0);
            SBAR();
            bf16x8 Ub[4];
#pragma unroll
            for (int k2 = 0; k2 < 4; ++k2) { const f32x16& uu = U[k2 >> 1]; const int o8 = 8 * (k2 & 1); u32x4 w;
                w.x = pk2(uu[o8 + 0], uu[o8 + 1]); w.y = pk2(uu[o8 + 2], uu[o8 + 3]); w.z = pk2(uu[o8 + 4], uu[o8 + 5]); w.w = pk2(uu[o8 + 6], uu[o8 + 7]); Ub[k2] = __builtin_bit_cast(bf16x8, w); }
#pragma unroll
            for (int i = 0; i < 8; ++i) A1[i] = FRAG(40960 + ((i & 3) * 4 + (i >> 2)) * 1024);
            SBAR();
#pragma unroll
            for (int i = 0; i < 8; ++i) Ov[i & 1] = __builtin_amdgcn_mfma_f32_32x32x16_bf16(A0[i], Ub[i >> 1], Ov[i & 1], 0, 0, 0);
            SBAR();
#pragma unroll
            for (int i = 0; i < 8; ++i) A0[i] = FRAG(40960 + ((i & 3) * 4 + 2 + (i >> 2)) * 1024);
            SBAR();
#pragma unroll
            for (int t = 0; t < 4; ++t)
#pragma unroll
                for (int r = 0; r < 16; ++r) S[t][r] *= cd;
#pragma unroll
            for (int i = 0; i < 8; ++i) S[i & 3] = __builtin_amdgcn_mfma_f32_32x32x16_bf16(A1[i], Ub[i >> 2], S[i & 3], 0, 0, 0);
            SBAR();
#pragma unroll
            for (int i = 0; i < 8; ++i) S[i & 3] = __builtin_amdgcn_mfma_f32_32x32x16_bf16(A0[i], Ub[2 + (i >> 2)], S[i & 3], 0, 0, 0);
            SBAR();
            { LAS bf16* ob = (LAS bf16*)(lds + OB + (n & 1) * 16384);
#pragma unroll
              for (int rt = 0; rt < 2; ++rt)
#pragma unroll
                  for (int r = 0; r < 16; ++r) ob[(32 * rt + crow(r, hi)) * 128 + 32 * w4 + c] = (bf16)(pk2(Ov[rt][r], 0.f) & 0xffffu); }
#pragma unroll
            for (int k = 0; k < 8; ++k) { const f32x16& ss = S[k >> 1]; const int o8 = 8 * (k & 1); u32x4 w;
                w.x = pk2(ss[o8 + 0], ss[o8 + 1]); w.y = pk2(ss[o8 + 2], ss[o8 + 3]); w.z = pk2(ss[o8 + 4], ss[o8 + 5]); w.w = pk2(ss[o8 + 6], ss[o8 + 7]); Sb[k] = __builtin_bit_cast(bf16x8, w); }
#undef FRAG
#undef SBAR
            SCAN_BAR();
        }
    }
    __syncthreads();
}

__device__ __forceinline__ void phase3(const Params& P, unsigned char* lds, int tid, int lane, int wave) {
    bf16* proj = (bf16*)(P.ws + WS_PROJ);
#ifndef NO_SCAN
    if (blockIdx.x < 64) gdn_scan_wg(P, lds, blockIdx.x, tid, lane, wave);
#endif
#ifdef PROBE_TS
    if (blockIdx.x == 0 && tid == 0) ((volatile unsigned long long*)(P.ws + WS_CTL + 32768))[10] = __builtin_amdgcn_s_memrealtime();
#endif
    unsigned* ctr = (unsigned*)(P.ws + WS_CTL);
    LAS unsigned* sh = (LAS unsigned*)((LAS unsigned char*)lds + LDS_BYTES - 64);
    const bf16* foxvt = (const bf16*)((const unsigned char*)P.out + DO_FOXVT);
    const float* cum = (const float*)(P.ws + WS_CUM);
    const bf16* kmem = (const bf16*)(P.ws + WS_KMEM); const bf16* vmt = (const bf16*)(P.ws + WS_VMT);
#ifdef STATIC_P3
    for (unsigned idx_ = (blockIdx.x < 16 ? 100000u : blockIdx.x - 16u); idx_ < 768u; idx_ += 240u) {
        const unsigned idx = __builtin_amdgcn_readfirstlane(idx_);
#else
    for (;;) {
        if (tid == 0) sh[0] = atomicAdd(ctr, 1u);
        __syncthreads();
        const unsigned idx = __builtin_amdgcn_readfirstlane(sh[0]);
        __syncthreads();
        if (idx >= 512u + 256u) break;
#endif
        int dbg_t = 0;
#ifdef PROBE_TS
        if (blockIdx.x == 16 && tid == 0) ((volatile unsigned long long*)(P.ws + WS_CTL + 32768))[20] = __builtin_amdgcn_s_memrealtime();
#endif
        if (idx < 512u) {
#ifndef NO_FOXATT
            const int qb = 31 - (int)(idx >> 4), bh = idx & 15, b = bh >> 3, h = bh & 7;
            bf16* Qp = proj + (size_t)b * SEQ * LDP + PC_FQ + h * 128;
            const bf16* Kp = proj + (size_t)b * SEQ * LDP + PC_FK + h * 128;
            const bf16* Vp = foxvt + (size_t)(h * 128) * TOK + (size_t)b * SEQ;
            attn_unit<128, true>(lds, Qp, LDP, Kp, LDP, Vp, TOK, Qp, LDP, cum + (size_t)bh * SEQ, ((const float*)(P.ws + WS_CDEC + 16384))[0], qb * 256, (qb + 1) * 4, tid, lane, wave, dbg_t, P.ws);
#ifdef PROBE_TS
            if (blockIdx.x == 16 && tid == 0) { volatile unsigned long long* dg = (volatile unsigned long long*)(P.ws + WS_CTL + 32768); dg[14] += __builtin_amdgcn_s_memrealtime() - dg[20]; }
#endif
#endif
        } else {
#ifndef NO_MEMATT
            const int u = idx - 512, qb = u & 31, bh = u >> 5, b = bh >> 2, h = bh & 3;
            bf16* Qp = proj + (size_t)b * SEQ * LDP + PC_QM + h * 256;
            const bf16* Kp = kmem + (size_t)b * 256 * 1024 + h * 256;
            const bf16* Vp = vmt + (size_t)(h * 256) * 512 + b * 256;
            attn_unit<256, false>(lds, Qp, LDP, Kp, 1024, Vp, 512, Qp, LDP, nullptr, 0.f, qb * 256, 4, tid, lane, wave, dbg_t);
#ifdef PROBE_TS
            if (blockIdx.x == 16 && tid == 0) { volatile unsigned long long* dg = (volatile unsigned long long*)(P.ws + WS_CTL + 32768); dg[18] += __builtin_amdgcn_s_memrealtime() - dg[20]; }
#endif
#endif
        }
    }
#ifdef PROBE_TS
    if (blockIdx.x == 0 && tid == 0) ((volatile unsigned long long*)(P.ws + WS_CTL + 32768))[11] = __builtin_amdgcn_s_memrealtime();
#endif
}


__device__ __forceinline__ void gdn_gate_norm_pass(const Params& P, int tid) {
    bf16* proj = (bf16*)(P.ws + WS_PROJ);
    const int cidx = (tid & 127) * 8, d = cidx & 127;
    const f32x4 g0 = *(const f32x4*)(P.gdn_norm_g + d), g1 = *(const f32x4*)(P.gdn_norm_g + d + 4);
    const float gg[8] = {g0.x, g0.y, g0.z, g0.w, g1.x, g1.y, g1.z, g1.w};
    for (int it0 = blockIdx.x; it0 < TOK / 4; it0 += 4 * gridDim.x) {
        u32x4 ov[4], zv[4]; bool ok[4]; bf16* op[4];
#pragma unroll
        for (int b = 0; b < 4; ++b) { const int it = it0 + b * gridDim.x; ok[b] = it < TOK / 4; const size_t row = (size_t)((ok[b] ? it : 0) * 4 + (tid >> 7));
            op[b] = proj + row * LDP + PC_OA + cidx; ov[b] = *(const u32x4*)op[b]; zv[b] = *(const u32x4*)(proj + row * LDP + PC_Z + cidx); }
#pragma unroll
        for (int b = 0; b < 4; ++b) {
            const float v[8] = {bflo(ov[b].x), bfhi(ov[b].x), bflo(ov[b].y), bfhi(ov[b].y), bflo(ov[b].z), bfhi(ov[b].z), bflo(ov[b].w), bfhi(ov[b].w)};
            const float z[8] = {bflo(zv[b].x), bfhi(zv[b].x), bflo(zv[b].y), bfhi(zv[b].y), bflo(zv[b].z), bfhi(zv[b].z), bflo(zv[b].w), bfhi(zv[b].w)};
            float ss = 0.f;
#pragma unroll
            for (int e = 0; e < 8; ++e) ss += v[e] * v[e];
            ss += __shfl_xor(ss, 1); ss += __shfl_xor(ss, 2); ss += __shfl_xor(ss, 4); ss += __shfl_xor(ss, 8);
            const float rstd = rsqrtf(ss * (1.f / 128.f) + EPSN);
            float o[8];
#pragma unroll
            for (int e = 0; e < 8; ++e) o[e] = v[e] * rstd * gg[e] * (z[e] * __builtin_amdgcn_rcpf(1.f + __builtin_amdgcn_exp2f(-LOG2E * z[e])));
            u32x4 w; w.x = pk2(o[0], o[1]); w.y = pk2(o[2], o[3]); w.z = pk2(o[4], o[5]); w.w = pk2(o[6], o[7]);
            if (ok[b]) *(u32x4*)op[b] = w;
        }
    }
}

#define RLX_AGENT __ATOMIC_RELAXED, __HIP_MEMORY_SCOPE_AGENT
#define XB_TMO      128
#define XB_XCNT(j)  (256  + 64 * (j))
#define XB_XSUB(j)  (1280 + 64 * (j))
#define XB_XGEN(j)  (2304 + 64 * (j))
#define XB_TOP      3328
#define XB_TOPGEN   3392
#define XCD_BAR_WORDS 3456
#define XB_SPIN_CAP (1u << 22)

__device__ __forceinline__ unsigned xb_ld(unsigned* p)              { return __hip_atomic_load(p, __ATOMIC_RELAXED, __HIP_MEMORY_SCOPE_AGENT); }
__device__ __forceinline__ unsigned xb_add(unsigned* p, unsigned v) { return __hip_atomic_fetch_add(p, v, __ATOMIC_RELAXED, __HIP_MEMORY_SCOPE_AGENT); }
__device__ __forceinline__ unsigned xb_xcc_id() { return (unsigned)__builtin_amdgcn_s_getreg((3 << 11) | 20) & 0xFu; }
#define XB_SPIN(cond, bar) do { unsigned _sp = 0; while (cond) { __builtin_amdgcn_s_sleep(1); \
    if ((++_sp & 255u) == 0u) { if (xb_ld(&(bar)[XB_TMO])) break; if (_sp > XB_SPIN_CAP) { atomicAdd(&(bar)[XB_TMO], 1u); break; } } } } while (0)

struct XcdBarrier {
    unsigned* bar; unsigned x;
    volatile LAS unsigned* st;
};

__device__ __forceinline__ XcdBarrier xcd_barrier_post(unsigned* bar, volatile LAS unsigned* st) {
    XcdBarrier b; b.bar = bar; b.x = xb_xcc_id(); b.st = st;
    if (threadIdx.x == 0) (void)xb_add(&bar[XB_XCNT(b.x)], 1u);
    return b;
}
__device__ __forceinline__ void xcd_barrier_complete(unsigned* bar, unsigned x, unsigned& nloc, unsigned& nx) {
    const unsigned G = gridDim.x * gridDim.y * gridDim.z;
    unsigned sum, cnt, mine, sp = 0u;
    for (;;) {
        sum = 0u; cnt = 0u; mine = 0u;
#pragma unroll
        for (unsigned j = 0; j < 16; ++j) { const unsigned c = xb_ld(&bar[XB_XCNT(j)]); sum += c; cnt += (c > 0u) ? 1u : 0u; mine = (j == x) ? c : mine; }
        if (sum == G) break;
        __builtin_amdgcn_s_sleep(1);
        if ((++sp & 255u) == 0u) { if (xb_ld(&bar[XB_TMO])) break; if (sp > XB_SPIN_CAP) { atomicAdd(&bar[XB_TMO], 1u); break; } }
    }
    nloc = mine > 0u ? mine : 1u; nx = cnt > 0u ? cnt : 1u;
}

__device__ __forceinline__ void xcd_barrier(const XcdBarrier& b) {
    asm volatile("s_waitcnt vmcnt(0)" ::: "memory");
    __syncthreads();
    if (threadIdx.x == 0) {
        unsigned* bar = b.bar;
        __builtin_amdgcn_s_waitcnt(0);
        unsigned nloc = b.st[0], nx = b.st[1];
        if (nloc == 0u) { xcd_barrier_complete(bar, b.x, nloc, nx); b.st[0] = nloc; b.st[1] = nx; }
        const unsigned old = xb_add(&bar[XB_XSUB(b.x)], 1u);
        const unsigned gen = old / nloc;
        if (old + 1u == (gen + 1u) * nloc) {
            __builtin_amdgcn_fence(__ATOMIC_RELEASE, "agent");
            asm volatile("s_waitcnt vmcnt(0)" ::: "memory");
            const unsigned og = xb_add(&bar[XB_TOP], 1u);
            const unsigned tg = og / nx;
            if (og + 1u == (tg + 1u) * nx) xb_add(&bar[XB_TOPGEN], 1u);
            else XB_SPIN(xb_ld(&bar[XB_TOPGEN]) == tg, bar);
            __builtin_amdgcn_fence(__ATOMIC_ACQUIRE, "agent");
            xb_add(&bar[XB_XGEN(b.x)], 1u);
            asm volatile("s_waitcnt vmcnt(0)" ::: "memory");
        } else {
            XB_SPIN(xb_ld(&bar[XB_XGEN(b.x)]) == gen, bar);
            __builtin_amdgcn_fence(__ATOMIC_ACQUIRE, "agent");
            asm volatile("s_waitcnt vmcnt(0)" ::: "memory");
        }
    }
    __syncthreads();
}

__global__ void __launch_bounds__(512, 2) hybrid_fwd(Params P) {
    extern __shared__ __attribute__((aligned(16))) unsigned char lds[];
    cg::grid_group grid = cg::this_grid();
    const int tid = threadIdx.x, lane = tid & 63, wave = __builtin_amdgcn_readfirstlane(tid >> 6);
    const int G = gridDim.x, cb = blockIdx.x;
    unsigned char* ws = P.ws;
    LAS unsigned char* glds = (LAS unsigned char*)lds;
    bf16* H = (bf16*)((unsigned char*)P.out + DO_H);
    bf16* proj = (bf16*)(ws + WS_PROJ);
    volatile LAS unsigned* bst = (volatile LAS unsigned*)(glds + LDS_BYTES - 32);
    if (tid < 2) bst[tid] = 0u;
    __syncthreads();
    XcdBarrier bar = xcd_barrier_post((unsigned*)(ws + WS_CTL) + 1024, bst);
#ifdef PROBE_TS
    volatile unsigned long long* tsg_ = (volatile unsigned long long*)(ws + WS_CTL + 32768);
    if (blockIdx.x == 0 && tid == 0) tsg_[0] = __builtin_amdgcn_s_memrealtime();
#endif
    grid.sync();
#ifdef PROBE_TS
#define GRID_BAR(k_) do { xcd_barrier(bar); if (blockIdx.x == 0 && tid == 0) tsg_[k_] = __builtin_amdgcn_s_memrealtime(); } while (0)
#else
#define GRID_BAR(k_) xcd_barrier(bar)
#endif

#ifndef NO_P0
    phase0(P, lds, tid, lane, wave);
#endif
    GRID_BAR(1);
#ifndef NO_GEMM
    {
        pg8::Gemm g{H, (const bf16*)(ws + WS_W1T), TOK, 7424, 2048, 2048, 2048}; pg8::StaticOrder S; S.init(TOK, 7424, G, cb);
        pg8::EpiProj E{proj, LDP, (float*)(ws + WS_SMALL)};
        pg8::gemm_phase<pg8::EpiProj, pg8::StaticOrder, true, true>(glds, g, S, E);
    }
    {
        pg8::Gemm g{(const bf16*)(ws + WS_WFVT), H, 1024, TOK, 2048, 2048, 2048}; pg8::StaticOrder S; S.init(1024, TOK, G, cb);
        pg8::EpiStore E{(bf16*)((unsigned char*)P.out + DO_FOXVT), TOK};
        pg8::gemm_phase<pg8::EpiStore, pg8::StaticOrder, true, true>(glds, g, S, E);
    }
    {
        const int cr = (cb + G - 64) % G;
        pg8::Gemm g{(const bf16*)(ws + WS_MEMN), (const bf16*)(ws + WS_WMKVT), 512, 1024, 2048, 2048, 2048}; pg8::StaticOrder S; S.init(512, 1024, G, cr);
        pg8::EpiStore E{(bf16*)(ws + WS_KMEM), 1024};
        pg8::gemm_phase<pg8::EpiStore, pg8::StaticOrder, true, true>(glds, g, S, E);
        const int cr2 = (cb + G - 72) % G;
        pg8::Gemm g2{(const bf16*)(ws + WS_WMKVT) + (size_t)1024 * 2048, (const bf16*)(ws + WS_MEMN), 1024, 512, 2048, 2048, 2048}; pg8::StaticOrder S2; S2.init(1024, 512, G, cr2);
        pg8::EpiStore E2{(bf16*)(ws + WS_VMT), 512};
        pg8::gemm_phase<pg8::EpiStore, pg8::StaticOrder, true, true>(glds, g2, S2, E2);
    }
#endif
    GRID_BAR(2);
#ifndef NO_P2
    phase2(P, lds, tid, lane, wave);
#endif
    GRID_BAR(3);
#ifndef NO_P3
    phase3(P, lds, tid, lane, wave);
#endif
    GRID_BAR(4);
#ifndef NO_GEMM
    gdn_gate_norm_pass(P, tid);
    {
        pg8::Gemm g{H, (const bf16*)(ws + WS_WGT), TOK, 6144, 2048, 2048, 2048}; pg8::StaticOrder S; S.init(TOK, 6144, G, cb);
        pg8::EpiSig E{(unsigned char*)P.out + DO_GA, (unsigned char*)(proj + PC_GB), 2048, LDP * 2};
        pg8::gemm_phase<pg8::EpiSig, pg8::StaticOrder, true, true>(glds, g, S, E);
    }
    GRID_BAR(5);
    {
        bf16* Y = (bf16*)(ws + WS_Y); const bf16* WUPT = (const bf16*)(ws + WS_WUPT);
        pg8::StaticOrder S; S.init(TOK, 2048, G, cb);
        { pg8::Gemm g{proj + PC_OA, WUPT, TOK, 2048, 1024, LDP, 1024}; pg8::EpiGate<true> E{(const unsigned char*)P.out + DO_GA, 2048, Y, 2048};
          pg8::gemm_phase<pg8::EpiGate<true>, pg8::StaticOrder, true, true>(glds, g, S, E); }
        { pg8::Gemm g{proj + PC_OB, WUPT + (size_t)2048 * 1024, TOK, 2048, 1024, LDP, 1024}; pg8::EpiGate<false> E{(const unsigned char*)(proj + PC_GB), LDP * 2, Y, 2048};
          pg8::gemm_phase<pg8::EpiGate<false>, pg8::StaticOrder, true, true>(glds, g, S, E); }
        { pg8::Gemm g{proj + PC_OM, WUPT + (size_t)2 * 2048 * 1024, TOK, 2048, 1024, LDP, 1024}; pg8::EpiGate<false> E{(const unsigned char*)(proj + PC_GB) + 2048, LDP * 2, Y, 2048};
          pg8::gemm_phase<pg8::EpiGate<false>, pg8::StaticOrder, true, true>(glds, g, S, E); }
    }
    GRID_BAR(6);
    {
        pg8::Gemm g{(const bf16*)(ws + WS_Y), (const bf16*)(ws + WS_WOT), TOK, 2048, 2048, 2048, 2048}; pg8::StaticOrder S; S.init(TOK, 2048, G, cb);
        pg8::EpiRes1 E{P.x, (bf16*)(ws + WS_X1B), (float*)(ws + WS_SSQ)};
        pg8::gemm_phase<pg8::EpiRes1, pg8::StaticOrder, true, true>(glds, g, S, E);
    }
    GRID_BAR(7);
    {
        const float* SSQ = (const float*)(ws + WS_SSQ); float* RSTD = (float*)(ws + WS_RSTD);
        int t5 = threadIdx.x; asm volatile("" : "+v"(t5));
        const int g = cb * 512 + t5;
        if (g < TOK * 8) { const int row = g >> 3, part = g & 7; float sq = 0.f;
#pragma unroll
            for (int q = 0; q < 4; ++q) sq += SSQ[(size_t)(part * 4 + q) * 16384 + row];
            sq += __shfl_xor(sq, 1); sq += __shfl_xor(sq, 2); sq += __shfl_xor(sq, 4);
            if (part == 0) RSTD[row] = rsqrtf(sq * (1.f / 2048.f) + 1e-6f); }
    }
    GRID_BAR(8);
    {
        pg8::Gemm g{(const bf16*)(ws + WS_X1B), (const bf16*)(ws + WS_WFF1T), TOK, 8192, 2048, 2048, 2048}; pg8::StaticOrder S; S.init(TOK, 8192, G, cb);
        pg8::EpiFF1 E{(const float*)(ws + WS_RSTD), (bf16*)(ws + WS_U), 8192};
        pg8::gemm_phase<pg8::EpiFF1, pg8::StaticOrder, true, true>(glds, g, S, E);
    }
    GRID_BAR(9);
    {
        pg8::Gemm g{(const bf16*)(ws + WS_U), (const bf16*)(ws + WS_WFF2T), TOK, 2048, 8192, 8192, 8192}; pg8::StaticOrder S; S.init(TOK, 2048, G, cb, 4);
        pg8::EpiOut E{(const bf16*)(ws + WS_X1B), P.out};
        pg8::gemm_phase<pg8::EpiOut, pg8::StaticOrder, true, true>(glds, g, S, E);
    }
#endif
#ifdef PROBE_TS
    if (blockIdx.x == 0 && tid == 0) {
        const unsigned long long tend = __builtin_amdgcn_s_memrealtime();
        tsg_[12] = tend;
        long long qa = ((long long)(tsg_[PROBE_A1] - tsg_[PROBE_A0]) + 1500) / 3000; if (qa > 35) qa = 35;
        long long qb = ((long long)(tsg_[PROBE_B1] - tsg_[PROBE_B0]) + 1500) / 3000; if (qb > 35) qb = 35;
        long long qc = ((long long)(tsg_[PROBE_C1] - tsg_[PROBE_C0]) + 1500) / 3000; if (qc > 35) qc = 35;
        const unsigned long long until = tend + (unsigned long long)(qa + 36 * qb + 1296 * qc) * 2000ull;
        while (__builtin_amdgcn_s_memrealtime() < until) __builtin_amdgcn_s_sleep(8);
    }
#endif
}

extern "C" void kernel_launch(void* const* d_in, const int* in_sizes, int n_in, void* d_out, int out_size, void* d_ws, size_t ws_size, hipStream_t stream) {
    static int grid = 0;
    if (grid == 0) {
        if (n_in != 22 || out_size != TOK * DM || ws_size < WS_END) { fprintf(stderr, "kernel_launch: unexpected shapes (n_in %d out %d ws %zu)\n", n_in, out_size, ws_size); grid = -1; return; }
        int dev = 0, cus = 0, per_cu = 0;
        hipGetDevice(&dev); hipDeviceGetAttribute(&cus, hipDeviceAttributeMultiprocessorCount, dev);
        if (hipFuncSetAttribute((const void*)hybrid_fwd, hipFuncAttributeMaxDynamicSharedMemorySize, LDS_BYTES) != hipSuccess) { fprintf(stderr, "kernel_launch: hipFuncSetAttribute failed\n"); grid = -1; return; }
        if (hipOccupancyMaxActiveBlocksPerMultiprocessor(&per_cu, (const void*)hybrid_fwd, 512, LDS_BYTES) != hipSuccess || per_cu < 1) { fprintf(stderr, "kernel_launch: occupancy query says %d\n", per_cu); per_cu = 1; }
        (void)hipGetLastError();
        grid = cus * 1;
        if (grid <= 0) grid = 256;
    }
    if (grid < 0) return;
    if (hipMemsetAsync((char*)d_ws + WS_CTL, 0, 65536, stream) != hipSuccess) { fprintf(stderr, "kernel_launch: memset failed\n"); return; }
    Params p{};
    const float** pp = (const float**)&p;
    for (int i = 0; i < 22; ++i) pp[i] = (const float*)d_in[i];
    p.out = (float*)d_out; p.ws = (unsigned char*)d_ws;
    void* args[] = {&p};
    hipError_t e = hipLaunchCooperativeKernel((const void*)hybrid_fwd, dim3(grid), dim3(512), args, LDS_BYTES, stream);
    if (e != hipSuccess) fprintf(stderr, "cooperative launch failed: %s (grid %d)\n", hipGetErrorString(e), grid);
}
```
